# Optimizing an MI355X kernel written in HIP

```python
import jax, jax.numpy as jnp
from jax import lax
import numpy as np

D_MODEL = 1024
BATCH = 8
SEQ = 4096
DEPTH = 2

HEAD_DIM = 64
D_A = D_MODEL // 4
D_B = 3 * D_MODEL // 8
D_C = 3 * D_MODEL // 8
D_MIX = D_A + D_B + D_C
N_HEADS_A = D_A // HEAD_DIM
N_BLOCKS_B = D_B // HEAD_DIM
N_HEADS_C = D_C // HEAD_DIM
CHUNK = 128
CONV_B = 4
LRU_C = 8.0
LORA_W = 64
LORA_A = 64
LORA_G = 128
D_FF = 2816
CONV_FF = 3
N_MOD = 6
EPS = 1e-6
LN_EPS = 1e-5
GN_EPS = 64e-5
P_A = 2 * D_A
P_B = 2 * D_B
P_C = 3 * D_C + LORA_W + LORA_A + LORA_G
P_IN = P_A + P_B + P_C

kernel_name = "hybrid_sgu_rglru_rwkv7_adaln"


def rms_norm(x, g):
    xf = x.astype(jnp.float32)
    y = xf * lax.rsqrt(jnp.mean(xf * xf, axis=-1, keepdims=True) + EPS)
    return (y * g.astype(jnp.float32)).astype(x.dtype)


def causal_dwconv(x, w, b):
    k_w = w.shape[0]
    s = x.shape[1]
    xp = jnp.pad(x, ((0, 0), (k_w - 1, 0), (0, 0)))
    y = b + w[0] * xp[:, 0:s]
    for j in range(1, k_w):
        y = y + w[j] * xp[:, j:j + s]
    return y


def token_shift(x):
    return jnp.pad(x[:, :-1], ((0, 0), (1, 0), (0, 0)))


def chunked_sgu(p, ln_g, ln_b, w_s, b_s):
    z = jax.nn.gelu(p)
    u, v = jnp.split(z, 2, axis=-1)
    vf = v.astype(jnp.float32)
    mu = jnp.mean(vf, axis=-1, keepdims=True)
    var = jnp.mean(jnp.square(vf - mu), axis=-1, keepdims=True)
    v = ((vf - mu) * lax.rsqrt(var + LN_EPS) * ln_g.astype(jnp.float32) + ln_b.astype(jnp.float32)).astype(p.dtype)
    bn, s, _ = v.shape
    v = v.reshape(bn, s // CHUNK, CHUNK, N_HEADS_A, HEAD_DIM)
    mask = jnp.tril(jnp.ones((CHUNK, CHUNK), dtype=bool))
    w = jnp.where(mask, w_s, 0.0)
    mixed = jnp.einsum('hts,bnshd->bnthd', w, v) + b_s.T[None, None, :, :, None]
    return u * mixed.reshape(bn, s, D_A)


def rg_lru_block(p, conv_w, conv_b, w_ra, b_ra, w_ix, b_ix, lam):
    xr, yg = jnp.split(p, 2, axis=-1)
    xr = causal_dwconv(xr, conv_w, conv_b)
    bn, s, _ = xr.shape
    xh = xr.reshape(bn, s, N_BLOCKS_B, HEAD_DIM)
    r = jax.nn.sigmoid(jnp.einsum('bshi,hij->bshj', xh, w_ra).reshape(bn, s, D_B) + b_ra)
    i = jax.nn.sigmoid(jnp.einsum('bshi,hij->bshj', xh, w_ix).reshape(bn, s, D_B) + b_ix)
    log_a = (-LRU_C * r.astype(jnp.float32)) * jax.nn.softplus(-lam.astype(jnp.float32))
    a = jnp.exp(log_a)
    bterm = jnp.sqrt(-jnp.expm1(2.0 * log_a)) * (i * xr).astype(jnp.float32)

    def combine(left, right):
        a1, b1 = left
        a2, b2 = right
        return a1 * a2, a2 * b1 + b2

    _, h = lax.associative_scan(combine, (a, bterm), axis=1)
    return jax.nn.gelu(yg) * h.astype(p.dtype)


def rwkv7_time_mix(p, mu, w0, w2, a0, a2, g2, k_k, k_a, r_k, ln_w, ln_b):
    p = p + (token_shift(p) - p) * mu
    r, k, v, xw, xa, xg = jnp.split(
        p, [D_C, 2 * D_C, 3 * D_C, 3 * D_C + LORA_W, 3 * D_C + LORA_W + LORA_A], axis=-1)
    w = -jax.nn.softplus(-(w0 + jnp.tanh(xw) @ w2)) - 0.5
    decay = jnp.exp(-jnp.exp(w.astype(jnp.float32)))
    a = jax.nn.sigmoid(a0 + xa @ a2)
    g = jax.nn.sigmoid(xg) @ g2
    bn, s, _ = r.shape

    def heads(t):
        return t.astype(jnp.float32).reshape(bn, s, N_HEADS_C, HEAD_DIM)

    kk = heads(k * k_k)
    kk = kk * lax.rsqrt(jnp.maximum(jnp.sum(kk * kk, axis=-1, keepdims=True), 1e-24))
    k = k * (1.0 + (a - 1.0) * k_a)
    rh, kh, vh, wh, ah = heads(r), heads(k), heads(v), heads(decay), heads(a)

    def step(state, inp):
        r_t, w_t, k_t, v_t, kk_t, a_t = inp
        sa = jnp.einsum('bhvk,bhk->bhv', state, kk_t)
        state = (state * w_t[:, :, None, :]
                 - sa[..., :, None] * (kk_t * a_t)[..., None, :]
                 + v_t[..., :, None] * k_t[..., None, :])
        return state, jnp.einsum('bhvk,bhk->bhv', state, r_t)

    seq_first = [jnp.moveaxis(t, 1, 0) for t in (rh, wh, kh, vh, kk, ah)]
    state0 = jnp.zeros((bn, N_HEADS_C, HEAD_DIM, HEAD_DIM), jnp.float32)
    _, out = lax.scan(step, state0, tuple(seq_first))
    out = jnp.moveaxis(out, 0, 1)
    mean = jnp.mean(out, axis=-1, keepdims=True)
    var = jnp.mean(jnp.square(out - mean), axis=-1, keepdims=True)
    out = ((out - mean) * lax.rsqrt(var + GN_EPS) * ln_w.astype(jnp.float32).reshape(N_HEADS_C, HEAD_DIM)
           + ln_b.astype(jnp.float32).reshape(N_HEADS_C, HEAD_DIM))
    bonus = jnp.sum(rh * kh * r_k.astype(jnp.float32), axis=-1, keepdims=True) * vh
    out = (out + bonus).reshape(bn, s, D_C).astype(p.dtype)
    return out * g


def conv_glu_ffn(h, w_up, conv_w, conv_b, w_down):
    gate, val = jnp.split(h @ w_up, 2, axis=-1)
    gate = causal_dwconv(gate, conv_w, conv_b)
    return (jax.nn.silu(gate) * val) @ w_down


def setup_inputs(seed: int = 0) -> dict:
    key = jax.random.key(seed)
    ks = jax.random.split(key, 40)
    f32 = jnp.float32
    nrm = lambda k, shape, s: jax.random.normal(k, shape, f32) * s
    L = DEPTH
    u_a = jax.random.uniform(ks[15], (L, D_B), f32, 0.9, 0.999)
    s_a = u_a ** (1.0 / LRU_C)
    return {
        "x": nrm(ks[0], (BATCH, SEQ, D_MODEL), 1.0),
        "c": nrm(ks[1], (BATCH, D_MODEL), 1.0),
        "w_mod": nrm(ks[2], (L, D_MODEL, N_MOD * D_MODEL), 0.5 * D_MODEL ** -0.5),
        "b_mod": nrm(ks[3], (L, N_MOD * D_MODEL), 0.02),
        "norm_mix": 1.0 + nrm(ks[4], (L, D_MODEL), 0.02),
        "w_in": nrm(ks[5], (L, D_MODEL, P_IN), D_MODEL ** -0.5),
        "w_out": nrm(ks[6], (L, D_MIX, D_MODEL), D_MIX ** -0.5),
        "sgu_ln_g": 1.0 + nrm(ks[7], (L, D_A), 0.02),
        "sgu_ln_b": nrm(ks[8], (L, D_A), 0.02),
        "sgu_w": nrm(ks[9], (L, N_HEADS_A, CHUNK, CHUNK), 0.05),
        "sgu_b": 1.0 + nrm(ks[10], (L, N_HEADS_A, CHUNK), 0.02),
        "lru_conv_w": nrm(ks[11], (L, CONV_B, D_B), CONV_B ** -0.5),
        "lru_conv_b": nrm(ks[12], (L, D_B), 0.02),
        "lru_w_a": nrm(ks[13], (L, N_BLOCKS_B, HEAD_DIM, HEAD_DIM), HEAD_DIM ** -0.5),
        "lru_b_a": nrm(ks[14], (L, D_B), 0.02),
        "lru_w_x": nrm(ks[16], (L, N_BLOCKS_B, HEAD_DIM, HEAD_DIM), HEAD_DIM ** -0.5),
        "lru_b_x": nrm(ks[17], (L, D_B), 0.02),
        "lru_lambda": jnp.log(s_a) - jnp.log1p(-s_a),
        "rwkv_mu": jax.random.uniform(ks[18], (L, P_C), f32, 0.0, 1.0),
        "rwkv_w0": jax.random.uniform(ks[19], (L, D_C), f32, -6.0, -1.0),
        "rwkv_w2": nrm(ks[20], (L, LORA_W, D_C), 0.5 * LORA_W ** -0.5),
        "rwkv_a0": nrm(ks[21], (L, D_C), 0.1),
        "rwkv_a2": nrm(ks[22], (L, LORA_A, D_C), 0.5 * LORA_A ** -0.5),
        "rwkv_g2": nrm(ks[23], (L, LORA_G, D_C), LORA_G ** -0.5),
        "rwkv_k_k": 0.85 + nrm(ks[24], (L, D_C), 0.02),
        "rwkv_k_a": 1.0 + nrm(ks[25], (L, D_C), 0.02),
        "rwkv_r_k": nrm(ks[26], (L, N_HEADS_C, HEAD_DIM), 0.1),
        "rwkv_ln_w": 1.0 + nrm(ks[27], (L, D_C), 0.02),
        "rwkv_ln_b": nrm(ks[28], (L, D_C), 0.02),
        "norm_ffn": 1.0 + nrm(ks[29], (L, D_MODEL), 0.02),
        "ffn_w_up": nrm(ks[30], (L, D_MODEL, 2 * D_FF), D_MODEL ** -0.5),
        "ffn_conv_w": nrm(ks[31], (L, CONV_FF, D_FF), CONV_FF ** -0.5),
        "ffn_conv_b": nrm(ks[32], (L, D_FF), 0.02),
        "ffn_w_down": nrm(ks[33], (L, D_FF, D_MODEL), D_FF ** -0.5),
        "norm_final": 1.0 + nrm(ks[34], (D_MODEL,), 0.02),
    }


def reference(x, c, w_mod, b_mod, norm_mix, w_in, w_out,
              sgu_ln_g, sgu_ln_b, sgu_w, sgu_b,
              lru_conv_w, lru_conv_b, lru_w_a, lru_b_a, lru_w_x, lru_b_x, lru_lambda,
              rwkv_mu, rwkv_w0, rwkv_w2, rwkv_a0, rwkv_a2, rwkv_g2, rwkv_k_k, rwkv_k_a,
              rwkv_r_k, rwkv_ln_w, rwkv_ln_b,
              norm_ffn, ffn_w_up, ffn_conv_w, ffn_conv_b, ffn_w_down, norm_final):
    c_act = jax.nn.silu(c)
    for l in range(DEPTH):
        mod = c_act @ w_mod[l] + b_mod[l]
        sh1, sc1, gt1, sh2, sc2, gt2 = [m[:, None, :] for m in jnp.split(mod, N_MOD, axis=-1)]
        h = rms_norm(x, norm_mix[l]) * (1.0 + sc1) + sh1
        p = h @ w_in[l]
        p_a, p_b, p_c = jnp.split(p, [P_A, P_A + P_B], axis=-1)
        y_a = chunked_sgu(p_a, sgu_ln_g[l], sgu_ln_b[l], sgu_w[l], sgu_b[l])
        y_b = rg_lru_block(p_b, lru_conv_w[l], lru_conv_b[l], lru_w_a[l], lru_b_a[l],
                           lru_w_x[l], lru_b_x[l], lru_lambda[l])
        y_c = rwkv7_time_mix(p_c, rwkv_mu[l], rwkv_w0[l], rwkv_w2[l], rwkv_a0[l], rwkv_a2[l],
                             rwkv_g2[l], rwkv_k_k[l], rwkv_k_a[l], rwkv_r_k[l],
                             rwkv_ln_w[l], rwkv_ln_b[l])
        y = jnp.concatenate([y_a, y_b, y_c], axis=-1) @ w_out[l]
        x = x + gt1 * y
        h = rms_norm(x, norm_ffn[l]) * (1.0 + sc2) + sh2
        x = x + gt2 * conv_glu_ffn(h, ffn_w_up[l], ffn_conv_w[l], ffn_conv_b[l], ffn_w_down[l])
    return rms_norm(x, norm_final)
```

```cpp
#include <hip/hip_runtime.h>
#include <hip/hip_cooperative_groups.h>
#include <cstdio>
#include <cstdint>
namespace pg8 {
#define PG8_LAS __attribute__((address_space(3)))
typedef unsigned short bf16_t;
typedef short bf16x8 __attribute__((ext_vector_type(8)));
typedef float f32x4 __attribute__((ext_vector_type(4)));
typedef unsigned u32x4 __attribute__((ext_vector_type(4)));
constexpr int BM = 256, BK = 64, HALF = 128, HTB = HALF * BK * 2  , STAGE_BYTES = 8 * HTB, NXCD = 8, WGM = 8;

__host__ __device__ __forceinline__ int lds_byte(int r, int c) { const int st = (r >> 4) * 2 + (c >> 5), rr = r & 15, cc = c & 31, ob = rr * 64 + cc * 2; return st * 1024 + (ob ^ (((ob >> 9) & 1) << 5)); }
__host__ __device__ __forceinline__ void stage_rc(int b, int& R, int& C) { const int st = b / 1024, sb = b % 1024, swz = sb ^ (((sb >> 9) & 1) << 5); R = (st >> 1) * 16 + swz / 64; C = (st & 1) * 32 + (swz % 64) / 2; }
__host__ __device__ __forceinline__ int perm32(int rho) { const int n = rho >> 4, i = rho & 15; return 8 * (i >> 2) + 4 * n + (i & 3); }

struct Unit { int pm, pn; };
struct Gemm { const bf16_t* A; const bf16_t* Bt; int M, N, K; };

struct StaticOrder {
    int nM, nN, nwg, G, c;
    __host__ __device__ void init(int M, int N, int G_, int c_) { nM = M / BM; nN = N / BM; nwg = nM * nN; G = G_; c = c_; }
    __host__ __device__ bool next(int i, Unit& u) const {
        const long L = (long)i * G + c; if (L >= nwg) return false;
        int wgid = (int)L; { const int q = nwg / NXCD, r = nwg % NXCD, xcd = wgid % NXCD, off = wgid / NXCD; wgid = (xcd < r ? xcd * (q + 1) : r * (q + 1) + (xcd - r) * q) + off; }
        const int nig = WGM * nN, gid = wgid / nig, fm = gid * WGM, gsz = (nM - fm) < WGM ? (nM - fm) : WGM;
        u.pm = fm + ((wgid % nig) % gsz); u.pn = (wgid % nig) / gsz; return true;
    }
    __device__ __forceinline__ void a_ready(const Unit&) const {}
    __device__ __forceinline__ void done(const Unit&) const {}
};

__device__ __forceinline__ unsigned cvt_pk_bf16(float lo, float hi) { unsigned r; asm volatile("v_cvt_pk_bf16_f32 %0, %1, %2" : "=v"(r) : "v"(lo), "v"(hi)); return r; }
typedef float f32x2 __attribute__((ext_vector_type(2)));
__device__ __forceinline__ f32x2 gelu_pk(f32x2 v) {
    const f32x2 av = __builtin_elementwise_abs(v), d = av * 0.2316418882f + 1.0f;
    f32x2 t; t.x = __builtin_amdgcn_rcpf(d.x); t.y = __builtin_amdgcn_rcpf(d.y);
    f32x2 q = t * 0.5307027145f + (-0.7265760135f); q = q * t + 0.7107068705f; q = q * t + (-0.142248368f); q = q * t + 0.127414796f; q = q * t;
    const f32x2 s = (v * v) * (-0.72134752044f);
    f32x2 e; e.x = __builtin_amdgcn_exp2f(s.x); e.y = __builtin_amdgcn_exp2f(s.y);
    const f32x2 m = v * (q * e), r = v - m;
    f32x2 o; o.x = v.x < 0.f ? m.x : r.x; o.y = v.y < 0.f ? m.y : r.y; return o;
}

template <int ACT  > struct EpiBf16 {
    static constexpr bool PERM = true, AFTER_DRAIN = false; static_assert(ACT == 0 || ACT == 1, "EpiBf16: ACT is 0 (none) or 1 (gelu_pk)");
    bf16_t* O; int ldc; const float* bias; int split_cols; size_t split_stride; float scale0;
    __device__ __forceinline__ void operator()(const f32x4 (&acc)[2][2][4][2], const Unit& u, int wr, int wc, int fr, int fq) const {
        const int row0 = u.pm * BM + wr * 64 + fr; int colt = u.pn * BM; bf16_t* base = O;
        float sc = 1.f; if (split_cols) { const int t = colt / split_cols; base += (size_t)t * split_stride; colt -= t * split_cols; if (t == 0) sc = scale0; }
        const int col0 = colt + wc * 32 + 8 * fq, bcol0 = u.pn * BM + wc * 32 + 8 * fq;
        f32x4 bv[2][2];
#pragma unroll
        for (int bj = 0; bj < 2; ++bj)
#pragma unroll
            for (int n = 0; n < 2; ++n) bv[bj][n] = bias ? *(const f32x4*)(bias + bcol0 + bj * HALF + 4 * n) : (f32x4){0.f, 0.f, 0.f, 0.f};
#pragma unroll
        for (int ai = 0; ai < 2; ++ai)
#pragma unroll
            for (int m = 0; m < 4; ++m) { bf16_t* rowp = base + (size_t)(row0 + ai * HALF + m * 16) * ldc + col0;
#pragma unroll
                for (int bj = 0; bj < 2; ++bj) { f32x4 v0 = acc[ai][bj][m][0] + bv[bj][0], v1 = acc[ai][bj][m][1] + bv[bj][1];
                    if (ACT == 1) { f32x2 a = gelu_pk((f32x2){v0[0], v0[1]}), b = gelu_pk((f32x2){v0[2], v0[3]}), c = gelu_pk((f32x2){v1[0], v1[1]}), d = gelu_pk((f32x2){v1[2], v1[3]});
                        v0 = (f32x4){a.x, a.y, b.x, b.y}; v1 = (f32x4){c.x, c.y, d.x, d.y}; }
                    v0 = v0 * sc; v1 = v1 * sc; u32x4 w; w.x = cvt_pk_bf16(v0[0], v0[1]); w.y = cvt_pk_bf16(v0[2], v0[3]); w.z = cvt_pk_bf16(v1[0], v1[1]); w.w = cvt_pk_bf16(v1[2], v1[3]);
                    *(u32x4*)(rowp + bj * HALF) = w; } }
    }
};

struct EpiRes {
    static constexpr bool PERM = false, AFTER_DRAIN = false;
    const float* base; float* out; int ldc; const float* gate; int gate_ld; int rows_per_batch;
    __device__ __forceinline__ void operator()(const f32x4 (&acc)[2][2][4][2], const Unit& u, int wr, int wc, int fr, int fq) const {
        const int row0 = u.pm * BM + wr * 64 + fr, col0 = u.pn * BM + wc * 32 + 4 * fq;
        const float* gp = gate + (size_t)((u.pm * BM) / rows_per_batch) * gate_ld + col0;
        f32x4 gv[2][2];
#pragma unroll
        for (int bj = 0; bj < 2; ++bj)
#pragma unroll
            for (int n = 0; n < 2; ++n) gv[bj][n] = *(const f32x4*)(gp + bj * HALF + n * 16);
#pragma unroll
        for (int ai = 0; ai < 2; ++ai)
#pragma unroll
            for (int m = 0; m < 4; ++m) { const size_t off = (size_t)(row0 + ai * HALF + m * 16) * ldc + col0;
#pragma unroll
                for (int bj = 0; bj < 2; ++bj)
#pragma unroll
                    for (int n = 0; n < 2; ++n) { const f32x4 bs = *(const f32x4*)(base + off + bj * HALF + n * 16);
                        *(f32x4*)(out + off + bj * HALF + n * 16) = bs + gv[bj][n] * acc[ai][bj][m][n]; } }
    }
};
struct EpiGV {
    static constexpr bool PERM = true, AFTER_DRAIN = false;
    bf16_t* G; bf16_t* V; int ldc;
    __device__ __forceinline__ void operator()(const f32x4 (&acc)[2][2][4][2], const Unit& u, int wr, int wc, int fr, int fq) const {
        const int row0 = u.pm * BM + wr * 64 + fr, col0 = u.pn * HALF + wc * 32 + 8 * fq;
#pragma unroll
        for (int ai = 0; ai < 2; ++ai)
#pragma unroll
            for (int m = 0; m < 4; ++m) { const size_t off = (size_t)(row0 + ai * HALF + m * 16) * ldc + col0;
#pragma unroll
                for (int bj = 0; bj < 2; ++bj) { const f32x4 v0 = acc[ai][bj][m][0], v1 = acc[ai][bj][m][1];
                    u32x4 w; w.x = cvt_pk_bf16(v0[0], v0[1]); w.y = cvt_pk_bf16(v0[2], v0[3]); w.z = cvt_pk_bf16(v1[0], v1[1]); w.w = cvt_pk_bf16(v1[2], v1[3]);
                    *(u32x4*)((bj ? V : G) + off) = w; } }
    }
};
template <class Epi, class Sched, bool ALIGN_EPI = false, bool SP2 = false>
__device__ __forceinline__ void gemm_phase(PG8_LAS unsigned char* lds, const Gemm g, const Sched& S, const Epi& E) {
    int tid_ = threadIdx.x; asm volatile("" : "+v"(tid_));
    const int tid = tid_, wid = __builtin_amdgcn_readfirstlane(tid >> 6), lane = tid & 63, wr = wid >> 2, wc = wid & 3, fr = lane & 15, fq = lane >> 4;
    const int K = g.K, nt = K / BK;
    unsigned voffA[2], voffB[2];
#pragma unroll
    for (int i = 0; i < 2; ++i) { int R, C; stage_rc(tid * 16 + i * 8192, R, C); const int Rb = Epi::PERM ? ((R & ~31) + perm32(R & 31)) : R;
        voffA[i] = (unsigned)(R * K + C) * 2u; voffB[i] = (unsigned)(Rb * K + C) * 2u; }
    const size_t kstep = (size_t)(BK * 2);
    const size_t hstep = (size_t)HALF * K * 2;
    const size_t tstep = 2 * hstep;
    const unsigned ldsw = (unsigned)wid * 1024u;
    const int aoff = lds_byte(wr * 64 + fr, fq * 8), boff = lds_byte(wc * 32 + fr, fq * 8);
#define PG8_SA(b, h) (((b) * 2 + (h)) * HTB)
#define PG8_SB(b, h) ((4 + (b) * 2 + (h)) * HTB)
#define PG8_STAGE(bufoff, gbase, voff) do { _Pragma("unroll") for (int _i = 0; _i < 2; ++_i) \
        __builtin_amdgcn_global_load_lds((const unsigned*)((const char*)(gbase) + (voff)[_i]), (PG8_LAS unsigned*)(lds + (bufoff) + ldsw + _i * 8192), 16, 0, 0); } while (0)
#define PG8_LDA(dst, b, h) do { _Pragma("unroll") for (int m = 0; m < 4; ++m) _Pragma("unroll") for (int k = 0; k < 2; ++k) dst[m][k] = *(const PG8_LAS bf16x8*)(lds + PG8_SA(b, h) + aoff + m * 2048 + k * 1024); } while (0)
#define PG8_LDB(dst, b, h) do { _Pragma("unroll") for (int n = 0; n < 2; ++n) _Pragma("unroll") for (int k = 0; k < 2; ++k) dst[n][k] = *(const PG8_LAS bf16x8*)(lds + PG8_SB(b, h) + boff + n * 2048 + k * 1024); } while (0)
#define PG8_MMA(ai, bj, At, Bt) do { __builtin_amdgcn_s_setprio(1); _Pragma("unroll") for (int m = 0; m < 4; ++m) _Pragma("unroll") for (int n = 0; n < 2; ++n) _Pragma("unroll") for (int k = 0; k < 2; ++k) \
        acc[ai][bj][m][n] = __builtin_amdgcn_mfma_f32_16x16x32_bf16(Bt[n][k], At[m][k], acc[ai][bj][m][n], 0, 0, 0); __builtin_amdgcn_s_setprio(0); } while (0)
#define PG8_WAIT_V(n) asm volatile("s_waitcnt vmcnt(" #n ")" ::: "memory")
#define PG8_WAIT_L(n) asm volatile("s_waitcnt lgkmcnt(" #n ")" ::: "memory")
#define PG8_BAR __builtin_amdgcn_s_barrier()
#define PG8_SCHED __builtin_amdgcn_sched_barrier(0)
    Unit cur, nxt; int ui = 0;
    if (!S.next(0, cur)) return;
    f32x4 acc[2][2][4][2];
#pragma unroll
    for (int a = 0; a < 2; ++a)
#pragma unroll
        for (int b = 0; b < 2; ++b)
#pragma unroll
            for (int m = 0; m < 4; ++m)
#pragma unroll
                for (int n = 0; n < 2; ++n) acc[a][b][m][n] = (f32x4){0.f, 0.f, 0.f, 0.f};
    bf16x8 At[4][2], B0[2][2], B1[2][2];
    const char* cA = (const char*)g.A + (size_t)cur.pm * tstep; const char* cB = (const char*)g.Bt + (size_t)cur.pn * tstep;
    S.a_ready(cur);
    if constexpr (SP2) {
        PG8_STAGE(PG8_SB(0, 0), cB, voffB); PG8_STAGE(PG8_SB(0, 1), cB + hstep, voffB); PG8_STAGE(PG8_SA(0, 0), cA, voffA); PG8_STAGE(PG8_SA(0, 1), cA + hstep, voffA);
        if (wr == 1) PG8_BAR;
        PG8_WAIT_V(2); PG8_BAR;
        PG8_STAGE(PG8_SB(1, 0), cB + kstep, voffB); PG8_STAGE(PG8_SA(1, 0), cA + kstep, voffA); PG8_STAGE(PG8_SB(1, 1), cB + hstep + kstep, voffB);
        PG8_WAIT_V(6); PG8_BAR;
    } else {
        PG8_STAGE(PG8_SB(0, 0), cB, voffB); PG8_STAGE(PG8_SA(0, 0), cA, voffA); PG8_STAGE(PG8_SB(0, 1), cB + hstep, voffB); PG8_STAGE(PG8_SA(0, 1), cA + hstep, voffA);
        if (wr == 1) PG8_BAR;
        PG8_WAIT_V(4); PG8_BAR;
        PG8_STAGE(PG8_SB(1, 0), cB + kstep, voffB); PG8_STAGE(PG8_SA(1, 0), cA + kstep, voffA); PG8_STAGE(PG8_SB(1, 1), cB + hstep + kstep, voffB);
        PG8_WAIT_V(6); PG8_BAR;
    }
    for (;;) {
        const bool has_next = S.next(ui + 1, nxt);
        const char* nA = has_next ? (const char*)g.A + (size_t)nxt.pm * tstep : cA; const char* nB = has_next ? (const char*)g.Bt + (size_t)nxt.pn * tstep : cB;
        for (int t = 0; t < nt; t += 2) {
            const bool last = (t == nt - 2);
            const char* a1 = cA + (size_t)(t + 1) * kstep;
            const char* a2 = last ? nA : cA + (size_t)(t + 2) * kstep; const char* b2 = last ? nB : cB + (size_t)(t + 2) * kstep;
            const char* a3 = a2 + kstep; const char* b3 = b2 + kstep;
            if (last && has_next) S.a_ready(nxt);
            if constexpr (SP2) {
            PG8_LDB(B0, 0, 0); PG8_LDB(B1, 0, 1); PG8_SCHED; PG8_LDA(At, 0, 0); PG8_STAGE(PG8_SA(1, 1), a1 + hstep, voffA);
            PG8_WAIT_V(8); PG8_WAIT_L(0); PG8_BAR; PG8_MMA(0, 0, At, B0); PG8_MMA(0, 1, At, B1); PG8_BAR; PG8_SCHED;
            PG8_LDA(At, 0, 1); PG8_STAGE(PG8_SB(0, 0), b2, voffB); PG8_STAGE(PG8_SB(0, 1), b2 + hstep, voffB); PG8_STAGE(PG8_SA(0, 0), a2, voffA);
            PG8_WAIT_V(8); PG8_WAIT_L(0); PG8_BAR; PG8_MMA(1, 0, At, B0); PG8_MMA(1, 1, At, B1); PG8_BAR; PG8_SCHED;
            PG8_LDB(B0, 1, 0); PG8_LDB(B1, 1, 1); PG8_SCHED; PG8_LDA(At, 1, 0); PG8_STAGE(PG8_SA(0, 1), a2 + hstep, voffA);
            PG8_WAIT_V(8); PG8_WAIT_L(0); PG8_BAR; PG8_MMA(0, 0, At, B0); PG8_MMA(0, 1, At, B1); PG8_BAR; PG8_SCHED;
            PG8_LDA(At, 1, 1); PG8_STAGE(PG8_SB(1, 0), b3, voffB); PG8_STAGE(PG8_SB(1, 1), b3 + hstep, voffB); PG8_STAGE(PG8_SA(1, 0), a3, voffA);
            PG8_WAIT_V(8); PG8_WAIT_L(0); PG8_BAR; PG8_MMA(1, 0, At, B0); PG8_MMA(1, 1, At, B1); PG8_BAR; PG8_SCHED;
            } else {
            PG8_LDB(B0, 0, 0); PG8_SCHED; PG8_LDA(At, 0, 0); PG8_STAGE(PG8_SA(1, 1), a1 + hstep, voffA);
            PG8_WAIT_L(8); PG8_BAR; PG8_WAIT_L(0); PG8_MMA(0, 0, At, B0); PG8_BAR; PG8_SCHED;
            PG8_LDB(B1, 0, 1); PG8_STAGE(PG8_SB(0, 0), b2, voffB);
            PG8_BAR; PG8_WAIT_L(0); PG8_MMA(0, 1, At, B1); PG8_BAR;
            PG8_LDA(At, 0, 1); PG8_STAGE(PG8_SA(0, 0), a2, voffA);
            PG8_BAR; PG8_WAIT_L(0); PG8_MMA(1, 0, At, B0); PG8_BAR; PG8_SCHED;
            PG8_STAGE(PG8_SB(0, 1), b2 + hstep, voffB);
            PG8_WAIT_V(6); PG8_BAR; PG8_MMA(1, 1, At, B1); PG8_BAR;
            PG8_LDB(B0, 1, 0); PG8_SCHED; PG8_LDA(At, 1, 0); PG8_STAGE(PG8_SA(0, 1), a2 + hstep, voffA);
            PG8_WAIT_L(8); PG8_BAR; PG8_WAIT_L(0); PG8_MMA(0, 0, At, B0); PG8_BAR; PG8_SCHED;
            PG8_LDB(B1, 1, 1); PG8_STAGE(PG8_SB(1, 0), b3, voffB);
            PG8_BAR; PG8_WAIT_L(0); PG8_MMA(0, 1, At, B1); PG8_BAR;
            PG8_LDA(At, 1, 1); PG8_STAGE(PG8_SA(1, 0), a3, voffA);
            PG8_BAR; PG8_WAIT_L(0); PG8_MMA(1, 0, At, B0); PG8_BAR; PG8_SCHED;
            PG8_STAGE(PG8_SB(1, 1), b3 + hstep, voffB);
            PG8_WAIT_V(6); PG8_BAR; PG8_MMA(1, 1, At, B1); PG8_BAR;
            }
        }
        if constexpr (ALIGN_EPI) { if (wr == 0) PG8_BAR; }
        if constexpr (!Epi::AFTER_DRAIN) { E(acc, cur, wr, wc, fr, fq); S.done(cur); }
        if (!has_next) break;
#pragma unroll
        for (int a = 0; a < 2; ++a)
#pragma unroll
            for (int b = 0; b < 2; ++b)
#pragma unroll
                for (int m = 0; m < 4; ++m)
#pragma unroll
                    for (int n = 0; n < 2; ++n) acc[a][b][m][n] = (f32x4){0.f, 0.f, 0.f, 0.f};
        cur = nxt; cA = nA; cB = nB; ++ui;
        if constexpr (ALIGN_EPI) { if (wr == 1) PG8_BAR; }
    }
    PG8_WAIT_V(0);
    if constexpr (!ALIGN_EPI) { if (wr == 0) PG8_BAR; }
    PG8_BAR;
    if constexpr (Epi::AFTER_DRAIN) { E.fused(acc, cur, wr, wc, fr, fq, lds, wid, lane); S.done(cur); }
#undef PG8_SA
#undef PG8_SB
#undef PG8_STAGE
#undef PG8_LDA
#undef PG8_LDB
#undef PG8_MMA
#undef PG8_WAIT_V
#undef PG8_WAIT_L
#undef PG8_BAR
#undef PG8_SCHED
}
}

namespace cg = cooperative_groups;
#ifndef MK_MODE
#define MK_MODE 1
#endif
constexpr int NWAVES = 8;

constexpr int NB = 8, SEQ = 4096, DM = 1024, NL = 2;
constexpr int M = NB * SEQ;
constexpr int PIN = 2688, PINP = 2816;
constexpr int DFF = 2816, DUP = 2 * DFF;
constexpr int DA = 256, DB = 384, DC = 384;
constexpr int NMOD = 6 * DM;
constexpr int PC_OFF = 1280;
constexpr int NPHASE = 22;

constexpr size_t MiB = 1u << 20;
constexpr size_t WS_CTL = 0, CTL_ZERO_BYTES = 64 * 1024;
constexpr size_t WS_SMALL = 1 * MiB;
constexpr size_t SM_SGUW = 0, SM_LRUWA = 256 * 1024, SM_LRUWX = 352 * 1024, SM_RW2 = 448 * 1024, SM_RA2 = 544 * 1024, SM_RG2 = 640 * 1024;
constexpr size_t WS_MOD = 2 * MiB;
constexpr size_t WS_LRUS = 3 * MiB;
constexpr size_t WS_WIN = 4 * MiB, WS_WOUT = 15 * MiB, WS_WUP = 19 * MiB, WS_WDN = 41 * MiB;
constexpr size_t WS_HY = 64 * MiB;
constexpr size_t WS_P = 128 * MiB;
constexpr size_t WS_UV = 304 * MiB;
constexpr size_t WS_R = 304 * MiB, WS_K = 328 * MiB, WS_V = 352 * MiB, WS_KK = 376 * MiB, WS_BV = 400 * MiB;
constexpr size_t WS_WD = 424 * MiB;
constexpr size_t WS_Q2 = 472 * MiB;
constexpr size_t WS_END = 512 * MiB;
static_assert(WS_Q2 + (size_t)M * 384 * 2 <= WS_END && WS_UV + (size_t)M * DFF * 2 <= WS_END && WS_P + (size_t)M * PINP * 2 <= WS_UV, "d_ws map");
static_assert(WS_WDN + (size_t)NL * DM * DFF * 2 <= WS_HY && WS_WIN + (size_t)NL * PINP * DM * 2 <= WS_WOUT && WS_WUP + (size_t)NL * DUP * DM * 2 <= WS_WDN, "weights map");
constexpr int CW_BAR = 1024;

constexpr int RING_BYTES = 131072;
constexpr int LDSCTL_OFF = RING_BYTES, MISC_OFF = LDSCTL_OFF + 320;
constexpr int LDS_BYTES = 147456;

#define GAS __attribute__((address_space(1)))
#define LAS __attribute__((address_space(3)))
typedef unsigned short bf16;
typedef float f32x4 __attribute__((ext_vector_type(4)));
typedef float f32x2 __attribute__((ext_vector_type(2)));
typedef float f32x16 __attribute__((ext_vector_type(16)));
typedef short bf16x8 __attribute__((ext_vector_type(8)));
typedef unsigned u32x2 __attribute__((ext_vector_type(2)));
typedef unsigned u32x4 __attribute__((ext_vector_type(4)));
typedef GAS unsigned gu32;
#define RLX_AGENT __ATOMIC_RELAXED, __HIP_MEMORY_SCOPE_AGENT

__device__ __forceinline__ float bflo(unsigned w) { return __builtin_bit_cast(float, w << 16); }
__device__ __forceinline__ float bfhi(unsigned w) { return __builtin_bit_cast(float, w & 0xffff0000u); }
__device__ __forceinline__ float bf1(bf16 u) { return __builtin_bit_cast(float, (unsigned)u << 16); }
__device__ __forceinline__ unsigned pk2(float lo, float hi) { return pg8::cvt_pk_bf16(lo, hi); }
__device__ __forceinline__ bf16 f2bf(float f) { return (bf16)(pg8::cvt_pk_bf16(f, f) & 0xffffu); }
__device__ __forceinline__ f32x4 unpack4(u32x2 w) { return (f32x4){bflo(w.x), bfhi(w.x), bflo(w.y), bfhi(w.y)}; }
__device__ __forceinline__ u32x2 pack4(f32x4 v) { u32x2 w; w.x = pk2(v[0], v[1]); w.y = pk2(v[2], v[3]); return w; }

__device__ __forceinline__ float fsigmoid(float x) { return __builtin_amdgcn_rcpf(1.f + __expf(-x)); }
__device__ __forceinline__ float fgelu(float x) { const float y = 1.5957691216f * x * (1.f + 0.044715f * x * x); return x * fsigmoid(y); }
__device__ __forceinline__ float fsilu(float x) { return x * fsigmoid(x); }
__device__ __forceinline__ float fsoftplus(float x) { return fmaxf(x, 0.f) + log1pf(__expf(-fabsf(x))); }
__device__ __forceinline__ float ftanh(float x) { return 1.f - 2.f * __builtin_amdgcn_rcpf(1.f + __expf(2.f * x)); }

__device__ __forceinline__ int opaque_tid() { int t = threadIdx.x; asm volatile("" : "+v"(t)); return t; }
template <int CTRL> __device__ __forceinline__ float dppf(float x) { return __builtin_bit_cast(float, __builtin_amdgcn_mov_dpp(__builtin_bit_cast(int, x), CTRL, 0xf, 0xf, true)); }
__device__ __forceinline__ float red16(float p) { p += dppf<0xB1>(p); p += dppf<0x4E>(p); p += dppf<0x141>(p); p += dppf<0x128>(p); return p; }
__device__ __forceinline__ float wave_sum(float v) {
#pragma unroll
    for (int o = 1; o < 64; o <<= 1) v += __shfl_xor(v, o);
    return v;
}
#define XB_TMO      128
#define XB_XCNT(j)  (256  + 64 * (j))
#define XB_XSUB(j)  (1280 + 64 * (j))
#define XB_XGEN(j)  (2304 + 64 * (j))
#define XB_TOP      3328
#define XB_TOPGEN   3392
#define XCD_BAR_WORDS 3456
#define XB_SPIN_CAP (1u << 18)

__device__ __forceinline__ unsigned xb_ld(unsigned* p)              { return __hip_atomic_load(p, __ATOMIC_RELAXED, __HIP_MEMORY_SCOPE_AGENT); }
__device__ __forceinline__ unsigned xb_add(unsigned* p, unsigned v) { return __hip_atomic_fetch_add(p, v, __ATOMIC_RELAXED, __HIP_MEMORY_SCOPE_AGENT); }
__device__ __forceinline__ unsigned xb_xcc_id() { return (unsigned)__builtin_amdgcn_s_getreg((3 << 11) | 20) & 0xFu; }
#define XB_SPIN(cond, bar) do { unsigned _sp = 0; while (cond) { __builtin_amdgcn_s_sleep(1); \
    if ((++_sp & 255u) == 0u) { if (xb_ld(&(bar)[XB_TMO])) break; if (_sp > XB_SPIN_CAP) { atomicAdd(&(bar)[XB_TMO], 1u); break; } } } } while (0)

struct XcdBarrier {
    unsigned* bar; unsigned x;
    volatile LAS unsigned* st;
};

__device__ __forceinline__ XcdBarrier xcd_barrier_post(unsigned* bar, volatile LAS unsigned* st) {
    XcdBarrier b; b.bar = bar; b.x = xb_xcc_id(); b.st = st;
    if (threadIdx.x == 0) (void)xb_add(&bar[XB_XCNT(b.x)], 1u);
    return b;
}
__device__ __forceinline__ void xcd_barrier_complete(unsigned* bar, unsigned x, unsigned& nloc, unsigned& nx) {
    const unsigned G = gridDim.x * gridDim.y * gridDim.z;
    unsigned sum, cnt, mine, sp = 0u;
    for (;;) {
        sum = 0u; cnt = 0u; mine = 0u;
#pragma unroll
        for (unsigned j = 0; j < 16; ++j) { const unsigned c = xb_ld(&bar[XB_XCNT(j)]); sum += c; cnt += (c > 0u) ? 1u : 0u; mine = (j == x) ? c : mine; }
        if (sum == G) break;
        __builtin_amdgcn_s_sleep(1);
        if ((++sp & 255u) == 0u) { if (xb_ld(&bar[XB_TMO])) break; if (sp > XB_SPIN_CAP) { atomicAdd(&bar[XB_TMO], 1u); break; } }
    }
    nloc = mine > 0u ? mine : 1u; nx = cnt > 0u ? cnt : 1u;
}

__device__ __forceinline__ void xcd_barrier(const XcdBarrier& b) {
    asm volatile("s_waitcnt vmcnt(0)" ::: "memory");
    __syncthreads();
    if (threadIdx.x == 0) {
        unsigned* bar = b.bar;
        __builtin_amdgcn_s_waitcnt(0);
        unsigned nloc = b.st[0], nx = b.st[1];
        if (nloc == 0u) { xcd_barrier_complete(bar, b.x, nloc, nx); b.st[0] = nloc; b.st[1] = nx; }
        const unsigned old = xb_add(&bar[XB_XSUB(b.x)], 1u);
        const unsigned gen = old / nloc;
        if (old + 1u == (gen + 1u) * nloc) {
            __builtin_amdgcn_fence(__ATOMIC_RELEASE, "agent");
            asm volatile("s_waitcnt vmcnt(0)" ::: "memory");
            const unsigned og = xb_add(&bar[XB_TOP], 1u);
            const unsigned tg = og / nx;
            if (og + 1u == (tg + 1u) * nx) xb_add(&bar[XB_TOPGEN], 1u);
            else XB_SPIN(xb_ld(&bar[XB_TOPGEN]) == tg, bar);
            __builtin_amdgcn_fence(__ATOMIC_ACQUIRE, "agent");
            xb_add(&bar[XB_XGEN(b.x)], 1u);
            asm volatile("s_waitcnt vmcnt(0)" ::: "memory");
        } else {
            XB_SPIN(xb_ld(&bar[XB_XGEN(b.x)]) == gen, bar);
            __builtin_amdgcn_fence(__ATOMIC_ACQUIRE, "agent");
            asm volatile("s_waitcnt vmcnt(0)" ::: "memory");
        }
    }
    __syncthreads();
}

struct Frame {
    LAS unsigned char* lds;
    volatile LAS unsigned* MISC;
    gu32* ctl;
    int wave, vcu, G;
    const float *x, *c, *w_mod, *b_mod, *norm_mix, *w_in, *w_out, *sgu_ln_g, *sgu_ln_b, *sgu_w, *sgu_b, *lru_conv_w, *lru_conv_b, *lru_w_a, *lru_b_a, *lru_w_x, *lru_b_x, *lru_lambda,
        *rwkv_mu, *rwkv_w0, *rwkv_w2, *rwkv_a0, *rwkv_a2, *rwkv_g2, *rwkv_k_k, *rwkv_k_a, *rwkv_r_k, *rwkv_ln_w, *rwkv_ln_b, *norm_ffn, *ffn_w_up, *ffn_conv_w, *ffn_conv_b, *ffn_w_down, *norm_final;
    float* out;
    bf16 *SGUW, *LRUWA, *LRUWX, *RW2, *RA2, *RG2;
    float *MOD, *LRUSA, *LRUSH;
    bf16 *WIN, *WOUT, *WUP, *WDN;
    bf16 *HY, *P, *UG, *UV, *R, *K, *V, *KK, *BV, *Q2;
    float *O, *WD;
};

__device__ __forceinline__ void p0_transpose_item(const float* W, int K, int N, bf16* WT, int k0, int n0, int drow0, LAS float* scr, int lane) {
#pragma unroll 8
    for (int i = 0; i < 32; ++i) { const int kk = 2 * i + (lane >> 5); scr[kk * 33 + (lane & 31)] = W[(size_t)(k0 + kk) * N + n0 + (lane & 31)]; }
    asm volatile("s_waitcnt lgkmcnt(0)" ::: "memory");
    const int c = lane & 7;
#pragma unroll
    for (int j = 0; j < 4; ++j) { const int n = (lane >> 3) + 8 * j; const LAS float* s = scr + (8 * c) * 33 + n;
        u32x4 o; o.x = pk2(s[0 * 33], s[1 * 33]); o.y = pk2(s[2 * 33], s[3 * 33]); o.z = pk2(s[4 * 33], s[5 * 33]); o.w = pk2(s[6 * 33], s[7 * 33]);
        *(u32x4*)(WT + (size_t)(drow0 + n) * K + k0 + 8 * c) = o; }
    asm volatile("s_waitcnt lgkmcnt(0)" ::: "memory");
}
__device__ __forceinline__ void p0_prologue(Frame& F) {
    const int tid = opaque_tid(), lane = tid & 63, wave = F.wave;
    const int gw = F.vcu * NWAVES + wave, NGW = F.G * NWAVES;
    const int gt = F.vcu * (NWAVES * 64) + tid, NGT = F.G * NWAVES * 64;
    if (F.vcu < 192) {
        LAS float* cact = (LAS float*)(F.lds + 73728);
        LAS float* red = (LAS float*)(F.lds + 106496);
        for (int i = tid; i < NB * DM; i += NWAVES * 64) { const float cv = F.c[i]; cact[i] = cv * fsigmoid(cv); }
        __syncthreads();
        const int l = F.vcu / 96, n0 = (F.vcu % 96) * 64;
        const float* wm = F.w_mod + ((size_t)l * DM + 128 * wave) * NMOD + n0 + lane;
        float acc[NB];
#pragma unroll
        for (int b = 0; b < NB; ++b) acc[b] = 0.f;
        for (int k4 = 0; k4 < 128; k4 += 4) {
            const float w0 = wm[(size_t)(k4 + 0) * NMOD], w1 = wm[(size_t)(k4 + 1) * NMOD], w2 = wm[(size_t)(k4 + 2) * NMOD], w3 = wm[(size_t)(k4 + 3) * NMOD];
#pragma unroll
            for (int b = 0; b < NB; ++b) { const f32x4 cv = *(const LAS f32x4*)(cact + b * DM + 128 * wave + k4); acc[b] += cv[0] * w0 + cv[1] * w1 + cv[2] * w2 + cv[3] * w3; }
        }
#pragma unroll
        for (int b = 0; b < NB; ++b) red[(wave * NB + b) * 64 + lane] = acc[b];
        __syncthreads();
        { const int b = tid >> 6, col = tid & 63; float s = F.b_mod[l * NMOD + n0 + col];
#pragma unroll
          for (int w = 0; w < NWAVES; ++w) s += red[(w * NB + b) * 64 + col];
          F.MOD[(size_t)(l * NB + b) * NMOD + n0 + col] = s; }
        __syncthreads();
    }
    {
        LAS float* scr = (LAS float*)(F.lds + wave * 9216);
        constexpr int I_IN = (DM / 64) * (PIN / 32), I_OUT = (DM / 64) * (DM / 32), I_UP = (DM / 64) * (DUP / 32), I_DN = (DFF / 64) * (DM / 32);
        constexpr int PER_L = I_IN + I_OUT + I_UP + I_DN;
        for (int it = gw; it < NL * PER_L; it += NGW) {
            const int l = it / PER_L; int r = it % PER_L;
            if (r < I_IN) { const int nblk = PIN / 32, kb = r / nblk, nb = r % nblk; p0_transpose_item(F.w_in + (size_t)l * DM * PIN, DM, PIN, F.WIN + (size_t)l * PINP * DM, 64 * kb, 32 * nb, 32 * nb, scr, lane); continue; } r -= I_IN;
            if (r < I_OUT) { const int nblk = DM / 32, kb = r / nblk, nb = r % nblk; p0_transpose_item(F.w_out + (size_t)l * DM * DM, DM, DM, F.WOUT + (size_t)l * DM * DM, 64 * kb, 32 * nb, 32 * nb, scr, lane); continue; } r -= I_OUT;
            if (r < I_UP) { const int nblk = DUP / 32, kb = r / nblk, nb = r % nblk; const int n0 = 32 * nb, isv = n0 >= DFF ? 1 : 0, j = n0 - isv * DFF, drow = (j / 128) * 256 + isv * 128 + (j % 128);
                p0_transpose_item(F.ffn_w_up + (size_t)l * DM * DUP, DM, DUP, F.WUP + (size_t)l * DUP * DM, 64 * kb, n0, drow, scr, lane); continue; } r -= I_UP;
            { const int nblk = DM / 32, kb = r / nblk, nb = r % nblk; p0_transpose_item(F.ffn_w_down + (size_t)l * DFF * DM, DFF, DM, F.WDN + (size_t)l * DM * DFF, 64 * kb, 32 * nb, 32 * nb, scr, lane); }
        }
        for (int i = gt; i < NL * (PINP - PIN) * DM / 8; i += NGT) { const int l = i / ((PINP - PIN) * DM / 8), o = i % ((PINP - PIN) * DM / 8);
            *(u32x4*)(F.WIN + (size_t)l * PINP * DM + (size_t)PIN * DM + (size_t)o * 8) = (u32x4){0u, 0u, 0u, 0u}; }
    }
    for (int i = gt; i < NL * 4 * 128 * 128; i += NGT) { const int s = i & 127, t = (i >> 7) & 127; F.SGUW[i] = s <= t ? f2bf(F.sgu_w[i]) : (bf16)0; }
    for (int i = gt; i < NL * 6 * 64 * 64; i += NGT) { const int ii = i & 63, j = (i >> 6) & 63, lh = i >> 12;
        F.LRUWA[i] = f2bf(F.lru_w_a[(size_t)lh * 4096 + ii * 64 + j]); F.LRUWX[i] = f2bf(F.lru_w_x[(size_t)lh * 4096 + ii * 64 + j]); }
    for (int i = gt; i < NL * 384 * 64; i += NGT) { const int k = i & 63, n = (i >> 6) % 384, l = i / (384 * 64);
        F.RW2[i] = f2bf(F.rwkv_w2[(size_t)l * 64 * 384 + k * 384 + n]); F.RA2[i] = f2bf(F.rwkv_a2[(size_t)l * 64 * 384 + k * 384 + n]); }
    for (int i = gt; i < NL * 384 * 128; i += NGT) { const int k = i & 127, n = (i >> 7) % 384, l = i / (384 * 128);
        F.RG2[i] = f2bf(F.rwkv_g2[(size_t)l * 128 * 384 + k * 384 + n]); }
}

__device__ __forceinline__ void norm_mod_phase(Frame& F, const float* X, const float* gamma, const float* mod_l, int sh_idx, int sc_idx, bf16* H) {
    const int gw = F.vcu * NWAVES + F.wave, NGW = F.G * NWAVES, lane = opaque_tid() & 63;
    for (int m = gw; m < M; m += NGW) {
        const f32x4* xr = (const f32x4*)(X + (size_t)m * DM) + lane;
        f32x4 v[4]; float s = 0.f;
#pragma unroll
        for (int j = 0; j < 4; ++j) { v[j] = xr[64 * j]; s += (v[j][0] * v[j][0] + v[j][1] * v[j][1]) + (v[j][2] * v[j][2] + v[j][3] * v[j][3]); }
        const float rstd = __builtin_amdgcn_rsqf(wave_sum(s) * (1.f / DM) + 1e-6f);
        const float* mb = mod_l + (size_t)(m >> 12) * NMOD;
        u32x2* o8 = (u32x2*)(H + (size_t)m * DM) + lane;
#pragma unroll
        for (int j = 0; j < 4; ++j) { const int c = 4 * (lane + 64 * j);
            const f32x4 g = *(const f32x4*)(gamma + c), sc = *(const f32x4*)(mb + sc_idx * DM + c), sh = *(const f32x4*)(mb + sh_idx * DM + c);
            const f32x4 y = (v[j] * rstd) * g * (sc + 1.f) + sh; o8[64 * j] = pack4(y); }
    }
}
__device__ __forceinline__ void final_norm_phase(Frame& F, float* X, const float* gamma) {
    const int gw = F.vcu * NWAVES + F.wave, NGW = F.G * NWAVES, lane = opaque_tid() & 63;
    for (int m = gw; m < M; m += NGW) {
        f32x4* xr = (f32x4*)(X + (size_t)m * DM) + lane;
        f32x4 v[4]; float s = 0.f;
#pragma unroll
        for (int j = 0; j < 4; ++j) { v[j] = xr[64 * j]; s += (v[j][0] * v[j][0] + v[j][1] * v[j][1]) + (v[j][2] * v[j][2] + v[j][3] * v[j][3]); }
        const float rstd = __builtin_amdgcn_rsqf(wave_sum(s) * (1.f / DM) + 1e-6f);
#pragma unroll
        for (int j = 0; j < 4; ++j) { const f32x4 g = *(const f32x4*)(gamma + 4 * (lane + 64 * j)); xr[64 * j] = (v[j] * rstd) * g; }
    }
}

__device__ __forceinline__ void mix_chunk(Frame& F, const int l, const int ch) {
    const int wave = F.wave;
    const int n = ch & 31; const size_t r0 = (size_t)ch * 128;
    const bf16* P = F.P; bf16* Y = F.HY;
    LAS unsigned char* lds = F.lds;
#ifndef MK_MIXMASK
#define MK_MIXMASK 7
#endif
    if (MK_MIXMASK & 1) {
        const int tid = opaque_tid(), lane = tid & 63, r = lane & 31, hh = lane >> 5;
        LAS bf16* VT = (LAS bf16*)lds;
        LAS f32x2* ST = (LAS f32x2*)(lds + 69632);
        const int t = tid & 127, q = __builtin_amdgcn_readfirstlane(tid >> 7);
        const bf16* src = P + (r0 + t) * PINP + 256 + 64 * q;
        float v[64]; float s = 0.f, ss = 0.f;
#pragma unroll
        for (int i = 0; i < 8; ++i) { const u32x4 w = *(const u32x4*)(src + 8 * i);
            const float e0 = fgelu(bflo(w.x)), e1 = fgelu(bfhi(w.x)), e2 = fgelu(bflo(w.y)), e3 = fgelu(bfhi(w.y)), e4 = fgelu(bflo(w.z)), e5 = fgelu(bfhi(w.z)), e6 = fgelu(bflo(w.w)), e7 = fgelu(bfhi(w.w));
            v[8 * i + 0] = e0; v[8 * i + 1] = e1; v[8 * i + 2] = e2; v[8 * i + 3] = e3; v[8 * i + 4] = e4; v[8 * i + 5] = e5; v[8 * i + 6] = e6; v[8 * i + 7] = e7;
            s += ((e0 + e1) + (e2 + e3)) + ((e4 + e5) + (e6 + e7)); ss += ((e0 * e0 + e1 * e1) + (e2 * e2 + e3 * e3)) + ((e4 * e4 + e5 * e5) + (e6 * e6 + e7 * e7)); }
        ST[q * 128 + t] = (f32x2){s, ss};
        __syncthreads();
        const f32x2 a0 = ST[t], a1 = ST[128 + t], a2 = ST[256 + t], a3 = ST[384 + t];
        const float mean = ((a0.x + a1.x) + (a2.x + a3.x)) * (1.f / 256.f), ex2 = ((a0.y + a1.y) + (a2.y + a3.y)) * (1.f / 256.f);
        const float rstd = __builtin_amdgcn_rsqf(fmaxf(ex2 - mean * mean, 0.f) + 1e-5f);
        const float* lg = F.sgu_ln_g + l * DA + 64 * q; const float* lb = F.sgu_ln_b + l * DA + 64 * q;
#pragma unroll
        for (int i = 0; i < 64; ++i) VT[(64 * q + i) * 136 + t] = f2bf((v[i] - mean) * rstd * lg[i] + lb[i]);
        __syncthreads();
        const int h = wave >> 1, dh = wave & 1;
        const bf16* Wg = F.SGUW + (size_t)(l * 4 + h) * 128 * 128;
        const LAS bf16* vrow = VT + (64 * h + 32 * dh + r) * 136 + 8 * hh;
#pragma unroll 1
        for (int tb = 0; tb < 4; ++tb) {
            f32x16 acc;
#pragma unroll
            for (int i = 0; i < 16; ++i) acc[i] = 0.f;
            const bf16* wrow = Wg + (size_t)(32 * tb + r) * 128 + 8 * hh;
#pragma unroll 2
            for (int ks = 0; ks < 2 * (tb + 1); ++ks) {
                const bf16x8 a = *(const LAS bf16x8*)(vrow + 16 * ks);
                const bf16x8 b = *(const bf16x8*)(wrow + 16 * ks);
                acc = __builtin_amdgcn_mfma_f32_32x32x16_bf16(a, b, acc, 0, 0, 0);
            }
            const int tt = 32 * tb + r; const size_t row = r0 + tt;
            const float bias = F.sgu_b[(l * 4 + h) * 128 + tt];
#pragma unroll
            for (int g = 0; g < 4; ++g) { const int c4 = 64 * h + 32 * dh + 8 * g + 4 * hh;
                const f32x4 u = unpack4(*(const u32x2*)(P + row * PINP + c4));
                f32x4 y; y[0] = fgelu(u[0]) * (acc[4 * g + 0] + bias); y[1] = fgelu(u[1]) * (acc[4 * g + 1] + bias); y[2] = fgelu(u[2]) * (acc[4 * g + 2] + bias); y[3] = fgelu(u[3]) * (acc[4 * g + 3] + bias);
                *(u32x2*)(Y + row * DM + c4) = pack4(y); }
        }
    }
    __syncthreads();
    if (MK_MIXMASK & 2) {
        const int tid = opaque_tid(), lane = tid & 63, r = lane & 31, hh = lane >> 5;
        LAS bf16* XC = (LAS bf16*)lds;
        LAS float* LA = (LAS float*)(lds + 25088);
        LAS float* BT = (LAS float*)(lds + 25088 + 49152);
        const int c = tid; const bool act = tid < DB;
        float cw0 = 0.f, cw1 = 0.f, cw2 = 0.f, cw3 = 0.f, cb = 0.f, bra = 0.f, bix = 0.f, sp8 = 0.f, x1 = 0.f, x2 = 0.f, x3 = 0.f, hst = 0.f, ca = 1.f;
        if (act) {
            cw0 = F.lru_conv_w[(l * 4 + 0) * DB + c]; cw1 = F.lru_conv_w[(l * 4 + 1) * DB + c]; cw2 = F.lru_conv_w[(l * 4 + 2) * DB + c]; cw3 = F.lru_conv_w[(l * 4 + 3) * DB + c];
            cb = F.lru_conv_b[l * DB + c]; bra = F.lru_b_a[l * DB + c]; bix = F.lru_b_x[l * DB + c];
            sp8 = -8.f * fsoftplus(-F.lru_lambda[l * DB + c]);
            if (n > 0) { x3 = bf1(P[(r0 - 3) * PINP + 512 + c]); x2 = bf1(P[(r0 - 2) * PINP + 512 + c]); x1 = bf1(P[(r0 - 1) * PINP + 512 + c]); }
        }
        for (int tq = 0; tq < 4; ++tq) {
            float xcv[32];
            if (act) {
#pragma unroll
                for (int i = 0; i < 32; ++i) { const float xr = bf1(P[(r0 + 32 * tq + i) * PINP + 512 + c]);
                    const float xc = cb + cw0 * x3 + cw1 * x2 + cw2 * x1 + cw3 * xr; x3 = x2; x2 = x1; x1 = xr; xcv[i] = xc; XC[i * 392 + c] = f2bf(xc); }
            } else {
#pragma unroll
                for (int i = 0; i < 32; ++i) xcv[i] = 0.f;
            }
            __syncthreads();
            for (int k = 0; k < 3; ++k) {
                const int id = wave + 8 * k, mat = id / 12, hb = (id % 12) >> 1, jt = id & 1;
                const bf16* Wt = (mat ? F.LRUWX : F.LRUWA) + (size_t)((l * 6 + hb) * 64 + 32 * jt + r) * 64 + 8 * hh;
                const LAS bf16* xrow = XC + r * 392 + 64 * hb + 8 * hh;
                f32x16 acc;
#pragma unroll
                for (int i = 0; i < 16; ++i) acc[i] = 0.f;
#pragma unroll
                for (int ks = 0; ks < 4; ++ks) { const bf16x8 a = *(const LAS bf16x8*)(xrow + 16 * ks); const bf16x8 b = *(const bf16x8*)(Wt + 16 * ks);
                    acc = __builtin_amdgcn_mfma_f32_32x32x16_bf16(a, b, acc, 0, 0, 0); }
                LAS float* dst = (mat ? BT : LA) + 64 * hb + 32 * jt + r;
#pragma unroll
                for (int rg = 0; rg < 16; ++rg) dst[((rg & 3) + 8 * (rg >> 2) + 4 * hh) * DB] = acc[rg];
            }
            __syncthreads();
            if (act) {
#pragma unroll
                for (int i = 0; i < 32; ++i) {
                    const float rg = fsigmoid(LA[i * DB + c] + bra), ig = fsigmoid(BT[i * DB + c] + bix);
                    const float la = sp8 * rg;
                    const float a = __expf(la), bt = sqrtf(fmaxf(-expm1f(2.f * la), 0.f)) * (ig * xcv[i]);
                    hst = a * hst + bt; ca *= a;
                    const size_t row = r0 + 32 * tq + i;
                    const float gl = fgelu(bf1(P[row * PINP + 896 + c]));
                    Y[row * DM + 256 + c] = f2bf(gl * hst); F.Q2[row * DB + c] = f2bf(gl * ca);
                }
            }
        }
        if (act) { F.LRUSA[(size_t)ch * DB + c] = ca; F.LRUSH[(size_t)ch * DB + c] = hst; }
    }
    __syncthreads();
    if (MK_MIXMASK & 4) {
        const int tid = opaque_tid(), lane = tid & 63, r = lane & 31, hh = lane >> 5; (void)tid;
        LAS bf16* TW = (LAS bf16*)lds;
        LAS bf16* XA = TW + 128 * 72;
        LAS bf16* SG = XA + 128 * 72;
        const float* mu = F.rwkv_mu + l * 1408;
        {
            const bf16* pc = P + PC_OFF + 1152 + 4 * lane; const f32x4 mu4 = *(const f32x4*)(mu + 1152 + 4 * lane);
            const int t0 = 16 * wave;
            f32x4 prev = (f32x4){0.f, 0.f, 0.f, 0.f};
            if (t0 > 0 || n > 0) prev = unpack4(*(const u32x2*)(pc + (r0 + t0 - 1) * PINP));
            LAS bf16* dst = lane < 16 ? TW + 4 * lane : (lane < 32 ? XA + 4 * (lane - 16) : SG + 4 * (lane - 32));
            const int dstride = lane < 32 ? 72 : 136;
#pragma unroll 4
            for (int i = 0; i < 16; ++i) { const int t = t0 + i;
                const f32x4 cur = unpack4(*(const u32x2*)(pc + (r0 + t) * PINP));
                const f32x4 xs = cur + (prev - cur) * mu4; prev = cur;
                f32x4 y;
#pragma unroll
                for (int e = 0; e < 4; ++e) y[e] = lane < 16 ? ftanh(xs[e]) : (lane < 32 ? xs[e] : fsigmoid(xs[e]));
                *(LAS u32x2*)(dst + t * dstride) = pack4(y); }
        }
        __syncthreads();
        for (int k = 0; k < 3; ++k) {
            const int task = wave + 8 * k, h = task % 6, tb = task / 6;
            const int t = 32 * tb + r; const size_t row = r0 + t; const bool hasprev = (t > 0) || (n > 0);
            const bf16* prow = P + row * PINP + PC_OFF; const bf16* pprev = prow - PINP;
            const LAS bf16* twr = TW + (32 * tb + r) * 72 + 8 * hh; const LAS bf16* xar = XA + (32 * tb + r) * 72 + 8 * hh; const LAS bf16* sgr = SG + (32 * tb + r) * 136 + 8 * hh;
            float sumsq = 0.f;
#pragma unroll
            for (int nt = 0; nt < 2; ++nt)
#pragma unroll
                for (int g = 0; g < 4; ++g) { const int n4 = 64 * h + 32 * nt + 8 * g + 4 * hh;
                    f32x4 kc = unpack4(*(const u32x2*)(prow + 384 + n4)), kp = (f32x4){0.f, 0.f, 0.f, 0.f};
                    if (hasprev) kp = unpack4(*(const u32x2*)(pprev + 384 + n4));
                    const f32x4 mk = *(const f32x4*)(mu + 384 + n4), kk_ = *(const f32x4*)(F.rwkv_k_k + l * DC + n4);
                    kc = (kc + (kp - kc) * mk) * kk_;
                    sumsq += (kc[0] * kc[0] + kc[1] * kc[1]) + (kc[2] * kc[2] + kc[3] * kc[3]); if (g & 1) asm volatile("" ::: "memory"); }
            sumsq += __shfl_xor(sumsq, 32);
            const float rn = __builtin_amdgcn_rsqf(fmaxf(sumsq, 1e-24f));
            {
                f32x16 ag[2];
#pragma unroll
                for (int nt = 0; nt < 2; ++nt) {
#pragma unroll
                    for (int i = 0; i < 16; ++i) ag[nt][i] = 0.f;
                    const bf16* g2r = F.RG2 + ((size_t)l * 384 + 64 * h + 32 * nt + r) * 128 + 8 * hh;
#pragma unroll
                    for (int ks = 0; ks < 8; ++ks)
                        ag[nt] = __builtin_amdgcn_mfma_f32_32x32x16_bf16(*(const bf16x8*)(g2r + 16 * ks), *(const LAS bf16x8*)(sgr + 16 * ks), ag[nt], 0, 0, 0);
                }
#pragma unroll
                for (int nt = 0; nt < 2; ++nt)
#pragma unroll
                    for (int g = 0; g < 4; ++g) { const int n4 = 64 * h + 32 * nt + 8 * g + 4 * hh;
                        *(u32x2*)(Y + row * DM + 640 + n4) = pack4((f32x4){ag[nt][4 * g + 0], ag[nt][4 * g + 1], ag[nt][4 * g + 2], ag[nt][4 * g + 3]}); }
            }
#pragma unroll
            for (int nt = 0; nt < 2; ++nt) {
                f32x16 aw, aa;
#pragma unroll
                for (int i = 0; i < 16; ++i) { aw[i] = 0.f; aa[i] = 0.f; }
                const int nrow = 64 * h + 32 * nt + r;
                const bf16* w2r = F.RW2 + ((size_t)l * 384 + nrow) * 64 + 8 * hh; const bf16* a2r = F.RA2 + ((size_t)l * 384 + nrow) * 64 + 8 * hh;
#pragma unroll
                for (int ks = 0; ks < 4; ++ks) {
                    aw = __builtin_amdgcn_mfma_f32_32x32x16_bf16(*(const bf16x8*)(w2r + 16 * ks), *(const LAS bf16x8*)(twr + 16 * ks), aw, 0, 0, 0);
                    aa = __builtin_amdgcn_mfma_f32_32x32x16_bf16(*(const bf16x8*)(a2r + 16 * ks), *(const LAS bf16x8*)(xar + 16 * ks), aa, 0, 0, 0); }
#pragma unroll
                for (int g = 0; g < 4; ++g) { const int n4 = 64 * h + 32 * nt + 8 * g + 4 * hh;
                    f32x4 rc = unpack4(*(const u32x2*)(prow + n4)), kc = unpack4(*(const u32x2*)(prow + 384 + n4)), vc = unpack4(*(const u32x2*)(prow + 768 + n4));
                    f32x4 rp = (f32x4){0.f, 0.f, 0.f, 0.f}, kp = rp, vp = rp;
                    if (hasprev) { rp = unpack4(*(const u32x2*)(pprev + n4)); kp = unpack4(*(const u32x2*)(pprev + 384 + n4)); vp = unpack4(*(const u32x2*)(pprev + 768 + n4)); }
                    const f32x4 mr = *(const f32x4*)(mu + n4), mk = *(const f32x4*)(mu + 384 + n4), mv = *(const f32x4*)(mu + 768 + n4);
                    rc = rc + (rp - rc) * mr; kc = kc + (kp - kc) * mk; vc = vc + (vp - vc) * mv;
                    const f32x4 w0 = *(const f32x4*)(F.rwkv_w0 + l * DC + n4), a0 = *(const f32x4*)(F.rwkv_a0 + l * DC + n4), kk_ = *(const f32x4*)(F.rwkv_k_k + l * DC + n4), ka_ = *(const f32x4*)(F.rwkv_k_a + l * DC + n4);
                    f32x4 dec, km, kk4, bv4;
#pragma unroll
                    for (int e = 0; e < 4; ++e) {
                        const float wv = -fsoftplus(-(w0[e] + aw[4 * g + e])) - 0.5f; dec[e] = __expf(-__expf(wv));
                        const float a = fsigmoid(a0[e] + aa[4 * g + e]);
                        kk4[e] = kc[e] * kk_[e] * rn; bv4[e] = kk4[e] * a;
                        km[e] = kc[e] * (1.f + (a - 1.f) * ka_[e]); }
                    *(u32x2*)(F.R + row * DC + n4) = pack4(rc); *(u32x2*)(F.K + row * DC + n4) = pack4(km); *(u32x2*)(F.V + row * DC + n4) = pack4(vc);
                    *(f32x4*)(F.WD + row * DC + n4) = dec; *(u32x2*)(F.KK + row * DC + n4) = pack4(kk4); *(u32x2*)(F.BV + row * DC + n4) = pack4(bv4); asm volatile("" ::: "memory"); }
            }
        }
    }
    __syncthreads();
}

__device__ __forceinline__ void rwkv_scan_item(Frame& F, const int it) {
    const int tid = opaque_tid();
    const int b = it / 12, h = (it % 12) >> 1, hf = it & 1;
    constexpr int BUFF = 5 * 2048 + 1024;
    LAS float* buf = (LAS float*)F.lds;
    LAS float* obuf = buf + 2 * BUFF;
    const int gl = tid & 15, row = tid >> 4;
    const int st = tid >> 4, q = tid & 15, vst = tid >> 3, vq = tid & 7;
    const size_t base = (size_t)b * SEQ * DC + 64 * h;
    const bf16* gKK = F.KK + base + (size_t)st * DC + 4 * q; const bf16* gBV = F.BV + base + (size_t)st * DC + 4 * q;
    const bf16* gK = F.K + base + (size_t)st * DC + 4 * q;   const bf16* gR = F.R + base + (size_t)st * DC + 4 * q;
    const float* gW = F.WD + base + (size_t)st * DC + 4 * q;
    const bf16* gV = F.V + base + (size_t)vst * DC + 32 * hf + 4 * vq;
    float* gO = F.O + base + 32 * hf + (size_t)(tid >> 4) * DC + 2 * (tid & 15);
    u32x2 rkk, rbv, rk, rr, rv = (u32x2){0u, 0u}; f32x4 rw;
#define SC_LOAD(ck) do { const size_t _o = (size_t)(ck) * 32 * DC; rkk = *(const u32x2*)(gKK + _o); rbv = *(const u32x2*)(gBV + _o); rk = *(const u32x2*)(gK + _o); rr = *(const u32x2*)(gR + _o); \
        rw = *(const f32x4*)(gW + _o); if (tid < 256) rv = *(const u32x2*)(gV + _o); } while (0)
#define SC_STORE(bb) do { LAS float* _b = (bb); *(LAS f32x4*)(_b + st * 64 + 4 * q) = unpack4(rkk); *(LAS f32x4*)(_b + 2048 + st * 64 + 4 * q) = rw; *(LAS f32x4*)(_b + 4096 + st * 64 + 4 * q) = unpack4(rbv); \
        *(LAS f32x4*)(_b + 6144 + st * 64 + 4 * q) = unpack4(rk); *(LAS f32x4*)(_b + 8192 + st * 64 + 4 * q) = unpack4(rr); if (tid < 256) *(LAS f32x4*)(_b + 10240 + vst * 32 + 4 * vq) = unpack4(rv); } while (0)
    SC_LOAD(0); SC_STORE(buf);
    __syncthreads();
    float s0 = 0.f, s1 = 0.f, s2 = 0.f, s3 = 0.f;
    for (int ck = 0; ck < SEQ / 32; ++ck) {
        const LAS float* cb = buf + (ck & 1) * BUFF; LAS float* ob = obuf + (ck & 1) * 1024;
        if (ck + 1 < SEQ / 32) SC_LOAD(ck + 1);
#pragma unroll 4
        for (int tt = 0; tt < 32; ++tt) {
            const f32x4 kk = *(const LAS f32x4*)(cb + tt * 64 + 4 * gl), w = *(const LAS f32x4*)(cb + 2048 + tt * 64 + 4 * gl), bb = *(const LAS f32x4*)(cb + 4096 + tt * 64 + 4 * gl);
            const f32x4 k4 = *(const LAS f32x4*)(cb + 6144 + tt * 64 + 4 * gl), r4 = *(const LAS f32x4*)(cb + 8192 + tt * 64 + 4 * gl);
            const float vv = cb[10240 + tt * 32 + row];
            float p = (s0 * kk[0] + s1 * kk[1]) + (s2 * kk[2] + s3 * kk[3]);
            p = red16(p);
            s0 = fmaf(s0, w[0], vv * k4[0]); s1 = fmaf(s1, w[1], vv * k4[1]); s2 = fmaf(s2, w[2], vv * k4[2]); s3 = fmaf(s3, w[3], vv * k4[3]);
            s0 = fmaf(-p, bb[0], s0); s1 = fmaf(-p, bb[1], s1); s2 = fmaf(-p, bb[2], s2); s3 = fmaf(-p, bb[3], s3);
            float o = (s0 * r4[0] + s1 * r4[1]) + (s2 * r4[2] + s3 * r4[3]);
            o = red16(o);
            if (gl == 0) ob[tt * 32 + row] = o;
        }
        if (ck + 1 < SEQ / 32) SC_STORE(buf + ((ck + 1) & 1) * BUFF);
        __syncthreads();
        *(f32x2*)(gO + (size_t)ck * 32 * DC) = *(const LAS f32x2*)(ob + 2 * tid);
    }
#undef SC_LOAD
#undef SC_STORE
}
__device__ __forceinline__ void lru_fin_chunk(Frame& F, const int ch) {
    const int tid = opaque_tid(); if (tid >= 384) return;
    const int q = tid % 96, rs = tid / 96, b = ch >> 5, n = ch & 31;
    f32x4 hin = (f32x4){0.f, 0.f, 0.f, 0.f};
    for (int j = 0; j < n; ++j) { const f32x4 a = *(const f32x4*)(F.LRUSA + (size_t)(b * 32 + j) * DB + 4 * q), hh = *(const f32x4*)(F.LRUSH + (size_t)(b * 32 + j) * DB + 4 * q); hin = a * hin + hh; }
    bf16* Y = F.HY;
#pragma unroll 4
    for (int t = rs; t < 128; t += 4) { const size_t row = (size_t)ch * 128 + t;
        const f32x4 q1 = unpack4(*(const u32x2*)(Y + row * DM + 256 + 4 * q)), q2 = unpack4(*(const u32x2*)(F.Q2 + row * DB + 4 * q));
        *(u32x2*)(Y + row * DM + 256 + 4 * q) = pack4(q1 + q2 * hin); }
}
__device__ __forceinline__ void rwkv_fin_phase(Frame& F, const int l) {
    const int gw = F.vcu * NWAVES + F.wave, NGW = F.G * NWAVES, lane = opaque_tid() & 63, sub = lane >> 4, q = lane & 15;
    bf16* Y = F.HY;
    for (int idx = gw * 4 + sub; idx < M * 6; idx += NGW * 4) {
        const int m = idx / 6, h = idx - 6 * m; const int n4 = 64 * h + 4 * q; const size_t o = (size_t)m * DC + n4;
        const f32x4 ov = *(const f32x4*)(F.O + o);
        const float mean = red16((ov[0] + ov[1]) + (ov[2] + ov[3])) * (1.f / 64.f);
        const f32x4 d = ov - mean;
        const float var = red16((d[0] * d[0] + d[1] * d[1]) + (d[2] * d[2] + d[3] * d[3])) * (1.f / 64.f);
        const float rstd = __builtin_amdgcn_rsqf(var + 64e-5f);
        const f32x4 lw = *(const f32x4*)(F.rwkv_ln_w + l * DC + n4), lb = *(const f32x4*)(F.rwkv_ln_b + l * DC + n4), rk = *(const f32x4*)(F.rwkv_r_k + l * DC + n4);
        const f32x4 r4 = unpack4(*(const u32x2*)(F.R + o)), k4 = unpack4(*(const u32x2*)(F.K + o)), v4 = unpack4(*(const u32x2*)(F.V + o));
        const f32x4 t4 = r4 * k4 * rk;
        const float bs = red16((t4[0] + t4[1]) + (t4[2] + t4[3]));
        const f32x4 g4 = unpack4(*(const u32x2*)(Y + (size_t)m * DM + 640 + n4));
        const f32x4 y = ((d * rstd) * lw + lb + v4 * bs) * g4;
        *(u32x2*)(Y + (size_t)m * DM + 640 + n4) = pack4(y);
    }
}
__device__ __forceinline__ void ffn_glu_phase(Frame& F, const int l) {
    constexpr int CG = DFF / 8, SEG = 32, NSEG = M / SEG;
    const int gt = F.vcu * (NWAVES * 64) + opaque_tid(), NGT = F.G * NWAVES * 64;
    for (int id = gt; id < NSEG * CG; id += NGT) {
        const int rsg = id / CG, cg8 = id - rsg * CG; const int col = 8 * cg8; const size_t row0 = (size_t)rsg * SEG;
        float w0[8], w1[8], w2[8], cb[8], x1[8], x2[8];
        { const float* cw = F.ffn_conv_w + (size_t)l * 3 * DFF + col; const float* cbp = F.ffn_conv_b + (size_t)l * DFF + col;
#pragma unroll
          for (int e = 0; e < 8; ++e) { w0[e] = cw[e]; w1[e] = cw[DFF + e]; w2[e] = cw[2 * DFF + e]; cb[e] = cbp[e]; x1[e] = 0.f; x2[e] = 0.f; } }
        if ((row0 & (SEQ - 1)) != 0) {
            const u32x4 a = *(const u32x4*)(F.UG + (row0 - 2) * DFF + col), bq = *(const u32x4*)(F.UG + (row0 - 1) * DFF + col);
            x2[0] = bflo(a.x); x2[1] = bfhi(a.x); x2[2] = bflo(a.y); x2[3] = bfhi(a.y); x2[4] = bflo(a.z); x2[5] = bfhi(a.z); x2[6] = bflo(a.w); x2[7] = bfhi(a.w);
            x1[0] = bflo(bq.x); x1[1] = bfhi(bq.x); x1[2] = bflo(bq.y); x1[3] = bfhi(bq.y); x1[4] = bflo(bq.z); x1[5] = bfhi(bq.z); x1[6] = bflo(bq.w); x1[7] = bfhi(bq.w);
        }
#pragma unroll 4
        for (int i = 0; i < SEG; ++i) {
            const u32x4 gq = *(const u32x4*)(F.UG + (row0 + i) * DFF + col), vq = *(const u32x4*)(F.UV + (row0 + i) * DFF + col);
            float x0[8], vv[8], y[8];
            x0[0] = bflo(gq.x); x0[1] = bfhi(gq.x); x0[2] = bflo(gq.y); x0[3] = bfhi(gq.y); x0[4] = bflo(gq.z); x0[5] = bfhi(gq.z); x0[6] = bflo(gq.w); x0[7] = bfhi(gq.w);
            vv[0] = bflo(vq.x); vv[1] = bfhi(vq.x); vv[2] = bflo(vq.y); vv[3] = bfhi(vq.y); vv[4] = bflo(vq.z); vv[5] = bfhi(vq.z); vv[6] = bflo(vq.w); vv[7] = bfhi(vq.w);
#pragma unroll
            for (int e = 0; e < 8; ++e) { const float gc = cb[e] + w0[e] * x2[e] + w1[e] * x1[e] + w2[e] * x0[e]; y[e] = fsilu(gc) * vv[e]; x2[e] = x1[e]; x1[e] = x0[e]; }
            u32x4 o; o.x = pk2(y[0], y[1]); o.y = pk2(y[2], y[3]); o.z = pk2(y[4], y[5]); o.w = pk2(y[6], y[7]);
            *(u32x4*)(F.UV + (row0 + i) * DFF + col) = o;
        }
    }
}

struct Args { const float* in[35]; float* out; unsigned char* ws; int ph_lo, ph_hi; };
__device__ __forceinline__ void frame_init(Frame& F, LAS unsigned char* lds) {
    typedef const __attribute__((address_space(4))) Args* ArgP;
    ArgP ap = (ArgP)__builtin_amdgcn_kernarg_segment_ptr(); asm volatile("" : "+s"(ap));
    F.lds = lds; F.MISC = (volatile LAS unsigned*)(lds + MISC_OFF);
    F.wave = __builtin_amdgcn_readfirstlane(threadIdx.x >> 6);
    F.G = gridDim.x; { const int bx = blockIdx.x; F.vcu = (F.G % 8 == 0) ? (bx % 8) * (F.G / 8) + bx / 8 : bx; }
    unsigned char* ws = ap->ws;
    F.ctl = (gu32*)(ws + WS_CTL);
    F.x = ap->in[0]; F.c = ap->in[1]; F.w_mod = ap->in[2]; F.b_mod = ap->in[3]; F.norm_mix = ap->in[4]; F.w_in = ap->in[5]; F.w_out = ap->in[6];
    F.sgu_ln_g = ap->in[7]; F.sgu_ln_b = ap->in[8]; F.sgu_w = ap->in[9]; F.sgu_b = ap->in[10];
    F.lru_conv_w = ap->in[11]; F.lru_conv_b = ap->in[12]; F.lru_w_a = ap->in[13]; F.lru_b_a = ap->in[14]; F.lru_w_x = ap->in[15]; F.lru_b_x = ap->in[16]; F.lru_lambda = ap->in[17];
    F.rwkv_mu = ap->in[18]; F.rwkv_w0 = ap->in[19]; F.rwkv_w2 = ap->in[20]; F.rwkv_a0 = ap->in[21]; F.rwkv_a2 = ap->in[22]; F.rwkv_g2 = ap->in[23]; F.rwkv_k_k = ap->in[24]; F.rwkv_k_a = ap->in[25];
    F.rwkv_r_k = ap->in[26]; F.rwkv_ln_w = ap->in[27]; F.rwkv_ln_b = ap->in[28]; F.norm_ffn = ap->in[29]; F.ffn_w_up = ap->in[30]; F.ffn_conv_w = ap->in[31]; F.ffn_conv_b = ap->in[32];
    F.ffn_w_down = ap->in[33]; F.norm_final = ap->in[34]; F.out = ap->out;
    F.SGUW = (bf16*)(ws + WS_SMALL + SM_SGUW); F.LRUWA = (bf16*)(ws + WS_SMALL + SM_LRUWA); F.LRUWX = (bf16*)(ws + WS_SMALL + SM_LRUWX);
    F.RW2 = (bf16*)(ws + WS_SMALL + SM_RW2); F.RA2 = (bf16*)(ws + WS_SMALL + SM_RA2); F.RG2 = (bf16*)(ws + WS_SMALL + SM_RG2);
    F.MOD = (float*)(ws + WS_MOD); F.LRUSA = (float*)(ws + WS_LRUS); F.LRUSH = F.LRUSA + 256 * DB;
    F.WIN = (bf16*)(ws + WS_WIN); F.WOUT = (bf16*)(ws + WS_WOUT); F.WUP = (bf16*)(ws + WS_WUP); F.WDN = (bf16*)(ws + WS_WDN);
    F.HY = (bf16*)(ws + WS_HY); F.P = (bf16*)(ws + WS_P); F.UG = (bf16*)(ws + WS_P); F.UV = (bf16*)(ws + WS_UV); F.O = (float*)(ws + WS_P);
    F.R = (bf16*)(ws + WS_R); F.K = (bf16*)(ws + WS_K); F.V = (bf16*)(ws + WS_V); F.KK = (bf16*)(ws + WS_KK); F.BV = (bf16*)(ws + WS_BV); F.WD = (float*)(ws + WS_WD); F.Q2 = (bf16*)(ws + WS_Q2);
}
__global__ void __launch_bounds__(NWAVES * 64, 2) mk_fwd(Args args) {
    extern __shared__ __attribute__((aligned(16))) unsigned char lds_raw[];
    LAS unsigned char* const lds = (LAS unsigned char*)lds_raw;
    for (int u = threadIdx.x; u < (LDS_BYTES - LDSCTL_OFF) / 4; u += NWAVES * 64) ((LAS unsigned*)(lds + LDSCTL_OFF))[u] = 0u;
    __syncthreads();
#if MK_MODE == 2
    XcdBarrier bar = xcd_barrier_post((unsigned*)((gu32*)(args.ws + WS_CTL) + CW_BAR), (volatile LAS unsigned*)(lds + MISC_OFF) + 8);
#define GRID_BAR() xcd_barrier(bar)
#elif MK_MODE == 1
    cg::grid_group grid = cg::this_grid();
#define GRID_BAR() grid.sync()
#else
#define GRID_BAR() do { } while (0)
#endif
    const int lo = args.ph_lo, hi = args.ph_hi;
#define IN(k) (lo <= (k) && (k) < hi)
#ifndef MK_PHMASK
#define MK_PHMASK 0xFFF
#endif
#define EN(t) (((MK_PHMASK) >> (t)) & 1)
#define SEAM(k) do { if (IN(k) && IN((k) + 1)) GRID_BAR(); } while (0)

    if (EN(0) && IN(0)) { Frame F; frame_init(F, lds); p0_prologue(F); } SEAM(0);
    for (int l = 0; l < NL; ++l) {
        const int pb = 1 + 10 * l;
        if (EN(1) && IN(pb + 0)) { Frame F; frame_init(F, lds); const float* mod_l = F.MOD + (size_t)l * NB * NMOD; const float* Xin = (l == 0) ? F.x : F.out; (void)mod_l; (void)Xin; norm_mod_phase(F, Xin, F.norm_mix + l * DM, mod_l, 0, 1, F.HY); } SEAM(pb + 0);
        if (EN(2) && IN(pb + 1)) { Frame F; frame_init(F, lds); const float* mod_l = F.MOD + (size_t)l * NB * NMOD; const float* Xin = (l == 0) ? F.x : F.out; (void)mod_l; (void)Xin; pg8::Gemm g{F.HY, F.WIN + (size_t)l * PINP * DM, M, PINP, DM}; pg8::StaticOrder S; S.init(M, PINP, F.G, (int)blockIdx.x);
            pg8::EpiBf16<0> E{F.P, PINP, nullptr, 0, 0, 1.f};
            pg8::gemm_phase<pg8::EpiBf16<0>, pg8::StaticOrder, true, true>(F.lds, g, S, E); } SEAM(pb + 1);
        if (EN(3) && IN(pb + 2)) { Frame F; frame_init(F, lds); const float* mod_l = F.MOD + (size_t)l * NB * NMOD; const float* Xin = (l == 0) ? F.x : F.out; (void)mod_l; (void)Xin; for (int ch = F.vcu; ch < M / 128; ch += F.G) mix_chunk(F, l, ch); } SEAM(pb + 2);
        if (EN(4) && IN(pb + 3)) { Frame F; frame_init(F, lds); const float* mod_l = F.MOD + (size_t)l * NB * NMOD; const float* Xin = (l == 0) ? F.x : F.out; (void)mod_l; (void)Xin;
            if (F.G >= 128) { if (F.vcu < 96) rwkv_scan_item(F, F.vcu); else for (int ch = F.vcu - 96; ch < M / 128; ch += F.G - 96) lru_fin_chunk(F, ch); }
            else { for (int it = F.vcu; it < 96; it += F.G) { rwkv_scan_item(F, it); __syncthreads(); } for (int ch = F.vcu; ch < M / 128; ch += F.G) lru_fin_chunk(F, ch); }
        } SEAM(pb + 3);
        if (EN(5) && IN(pb + 4)) { Frame F; frame_init(F, lds); const float* mod_l = F.MOD + (size_t)l * NB * NMOD; const float* Xin = (l == 0) ? F.x : F.out; (void)mod_l; (void)Xin; rwkv_fin_phase(F, l); } SEAM(pb + 4);
        if (EN(6) && IN(pb + 5)) { Frame F; frame_init(F, lds); const float* mod_l = F.MOD + (size_t)l * NB * NMOD; const float* Xin = (l == 0) ? F.x : F.out; (void)mod_l; (void)Xin; pg8::Gemm g{F.HY, F.WOUT + (size_t)l * DM * DM, M, DM, DM}; pg8::StaticOrder S; S.init(M, DM, F.G, (int)blockIdx.x);
            pg8::EpiRes E{Xin, F.out, DM, mod_l + 2 * DM, NMOD, SEQ};
            pg8::gemm_phase<pg8::EpiRes, pg8::StaticOrder, true, true>(F.lds, g, S, E); } SEAM(pb + 5);
        if (EN(7) && IN(pb + 6)) { Frame F; frame_init(F, lds); const float* mod_l = F.MOD + (size_t)l * NB * NMOD; const float* Xin = (l == 0) ? F.x : F.out; (void)mod_l; (void)Xin; norm_mod_phase(F, F.out, F.norm_ffn + l * DM, mod_l, 3, 4, F.HY); } SEAM(pb + 6);
        if (EN(8) && IN(pb + 7)) { Frame F; frame_init(F, lds); const float* mod_l = F.MOD + (size_t)l * NB * NMOD; const float* Xin = (l == 0) ? F.x : F.out; (void)mod_l; (void)Xin; pg8::Gemm g{F.HY, F.WUP + (size_t)l * DUP * DM, M, DUP, DM}; pg8::StaticOrder S; S.init(M, DUP, F.G, (int)blockIdx.x);
            pg8::EpiGV E{F.UG, F.UV, DFF};
            pg8::gemm_phase<pg8::EpiGV, pg8::StaticOrder, true, true>(F.lds, g, S, E); } SEAM(pb + 7);
        if (EN(9) && IN(pb + 8)) { Frame F; frame_init(F, lds); const float* mod_l = F.MOD + (size_t)l * NB * NMOD; const float* Xin = (l == 0) ? F.x : F.out; (void)mod_l; (void)Xin; ffn_glu_phase(F, l); } SEAM(pb + 8);
        if (EN(10) && IN(pb + 9)) { Frame F; frame_init(F, lds); const float* mod_l = F.MOD + (size_t)l * NB * NMOD; const float* Xin = (l == 0) ? F.x : F.out; (void)mod_l; (void)Xin; pg8::Gemm g{F.UV, F.WDN + (size_t)l * DM * DFF, M, DM, DFF}; pg8::StaticOrder S; S.init(M, DM, F.G, (int)blockIdx.x);
            pg8::EpiRes E{F.out, F.out, DM, mod_l + 5 * DM, NMOD, SEQ};
            pg8::gemm_phase<pg8::EpiRes, pg8::StaticOrder, true, true>(F.lds, g, S, E); } SEAM(pb + 9);
    }
    if (EN(11) && IN(NPHASE - 1)) { Frame F; frame_init(F, lds); final_norm_phase(F, F.out, F.norm_final); }
#undef IN
#undef SEAM
}

extern "C" void kernel_launch(void* const* d_in, const int* in_sizes, int n_in, void* d_out, int out_size, void* d_ws, size_t ws_size, hipStream_t stream) {
    static int grid = 0;
    if (grid == 0) {
        if (n_in != 35 || in_sizes[0] != M * DM || out_size != M * DM || ws_size < WS_END) { fprintf(stderr, "kernel_launch: unexpected shapes (n_in %d, in0 %d, out %d, ws %zu); nothing launched\n", n_in, n_in > 0 ? in_sizes[0] : -1, out_size, ws_size); grid = -1; return; }
        int dev = 0, cus = 0, per_cu = 0;
        if (hipGetDevice(&dev) != hipSuccess || hipDeviceGetAttribute(&cus, hipDeviceAttributeMultiprocessorCount, dev) != hipSuccess) { grid = -1; return; }
        if (hipFuncSetAttribute((const void*)mk_fwd, hipFuncAttributeMaxDynamicSharedMemorySize, LDS_BYTES) != hipSuccess) { fprintf(stderr, "kernel_launch: hipFuncSetAttribute failed\n"); grid = -1; return; }
        if (hipOccupancyMaxActiveBlocksPerMultiprocessor(&per_cu, (const void*)mk_fwd, NWAVES * 64, LDS_BYTES) != hipSuccess || per_cu < 1) { fprintf(stderr, "kernel_launch: occupancy query says %d blocks per CU\n", per_cu); per_cu = 1; }
        (void)hipGetLastError();
        grid = cus;
    }
    if (grid < 0) return;
    Args a{};
    for (int i = 0; i < 35; ++i) a.in[i] = (const float*)d_in[i];
    a.out = (float*)d_out; a.ws = (unsigned char*)d_ws;
#if MK_MODE == 0
    for (int ph = 0; ph < NPHASE; ++ph) { a.ph_lo = ph; a.ph_hi = ph + 1; hipLaunchKernelGGL(mk_fwd, dim3(grid), dim3(NWAVES * 64), LDS_BYTES, stream, a); }
#else
    (void)hipMemsetAsync((char*)d_ws + WS_CTL, 0, CTL_ZERO_BYTES, stream);
    a.ph_lo = 0; a.ph_hi = NPHASE;
#if MK_MODE == 1
    void* kargs[] = {&a};
    hipError_t e = hipLaunchCooperativeKernel((const void*)mk_fwd, dim3(grid), dim3(NWAVES * 64), kargs, LDS_BYTES, stream);
    if (e != hipSuccess) fprintf(stderr, "kernel_launch: cooperative launch failed: %s (grid %d)\n", hipGetErrorString(e), grid);
#else
    hipLaunchKernelGGL(mk_fwd, dim3(grid), dim3(NWAVES * 64), LDS_BYTES, stream, a);
#endif
#endif
}
```

```cpp
#include <hip/hip_runtime.h>
#include <hip/hip_cooperative_groups.h>
#include <cstdio>
#include <cstdint>
namespace pg8 {
#define PG8_LAS __attribute__((address_space(3)))
typedef unsigned short bf16_t;
typedef short bf16x8 __attribute__((ext_vector_type(8)));
typedef float f32x4 __attribute__((ext_vector_type(4)));
typedef unsigned u32x4 __attribute__((ext_vector_type(4)));
constexpr int BM = 256, BK = 64, HALF = 128, HTB = HALF * BK * 2  , STAGE_BYTES = 8 * HTB, NXCD = 8, WGM = 8;

__host__ __device__ __forceinline__ int lds_byte(int r, int c) { const int st = (r >> 4) * 2 + (c >> 5), rr = r & 15, cc = c & 31, ob = rr * 64 + cc * 2; return st * 1024 + (ob ^ (((ob >> 9) & 1) << 5)); }
__host__ __device__ __forceinline__ void stage_rc(int b, int& R, int& C) { const int st = b / 1024, sb = b % 1024, swz = sb ^ (((sb >> 9) & 1) << 5); R = (st >> 1) * 16 + swz / 64; C = (st & 1) * 32 + (swz % 64) / 2; }
__host__ __device__ __forceinline__ int perm32(int rho) { const int n = rho >> 4, i = rho & 15; return 8 * (i >> 2) + 4 * n + (i & 3); }

struct Unit { int pm, pn; };
struct Gemm { const bf16_t* A; const bf16_t* Bt; int M, N, K; };

struct StaticOrder {
    int nM, nN, nwg, G, c;
    __host__ __device__ void init(int M, int N, int G_, int c_) { nM = M / BM; nN = N / BM; nwg = nM * nN; G = G_; c = c_; }
    __host__ __device__ bool next(int i, Unit& u) const {
        const long L = (long)i * G + c; if (L >= nwg) return false;
        int wgid = (int)L; { const int q = nwg / NXCD, r = nwg % NXCD, xcd = wgid % NXCD, off = wgid / NXCD; wgid = (xcd < r ? xcd * (q + 1) : r * (q + 1) + (xcd - r) * q) + off; }
        const int nig = WGM * nN, gid = wgid / nig, fm = gid * WGM, gsz = (nM - fm) < WGM ? (nM - fm) : WGM;
        u.pm = fm + ((wgid % nig) % gsz); u.pn = (wgid % nig) / gsz; return true;
    }
    __device__ __forceinline__ void a_ready(const Unit&) const {}
    __device__ __forceinline__ void done(const Unit&) const {}
};

__device__ __forceinline__ unsigned cvt_pk_bf16(float lo, float hi) { unsigned r; asm volatile("v_cvt_pk_bf16_f32 %0, %1, %2" : "=v"(r) : "v"(lo), "v"(hi)); return r; }
typedef float f32x2 __attribute__((ext_vector_type(2)));
__device__ __forceinline__ f32x2 gelu_pk(f32x2 v) {
    const f32x2 av = __builtin_elementwise_abs(v), d = av * 0.2316418882f + 1.0f;
    f32x2 t; t.x = __builtin_amdgcn_rcpf(d.x); t.y = __builtin_amdgcn_rcpf(d.y);
    f32x2 q = t * 0.5307027145f + (-0.7265760135f); q = q * t + 0.7107068705f; q = q * t + (-0.142248368f); q = q * t + 0.127414796f; q = q * t;
    const f32x2 s = (v * v) * (-0.72134752044f);
    f32x2 e; e.x = __builtin_amdgcn_exp2f(s.x); e.y = __builtin_amdgcn_exp2f(s.y);
    const f32x2 m = v * (q * e), r = v - m;
    f32x2 o; o.x = v.x < 0.f ? m.x : r.x; o.y = v.y < 0.f ? m.y : r.y; return o;
}

template <int ACT  > struct EpiBf16 {
    static constexpr bool PERM = true, AFTER_DRAIN = false; static_assert(ACT == 0 || ACT == 1, "EpiBf16: ACT is 0 (none) or 1 (gelu_pk)");
    bf16_t* O; int ldc; const float* bias; int split_cols; size_t split_stride; float scale0;
    __device__ __forceinline__ void operator()(const f32x4 (&acc)[2][2][4][2], const Unit& u, int wr, int wc, int fr, int fq) const {
        const int row0 = u.pm * BM + wr * 64 + fr; int colt = u.pn * BM; bf16_t* base = O;
        float sc = 1.f; if (split_cols) { const int t = colt / split_cols; base += (size_t)t * split_stride; colt -= t * split_cols; if (t == 0) sc = scale0; }
        const int col0 = colt + wc * 32 + 8 * fq, bcol0 = u.pn * BM + wc * 32 + 8 * fq;
        f32x4 bv[2][2];
#pragma unroll
        for (int bj = 0; bj < 2; ++bj)
#pragma unroll
            for (int n = 0; n < 2; ++n) bv[bj][n] = bias ? *(const f32x4*)(bias + bcol0 + bj * HALF + 4 * n) : (f32x4){0.f, 0.f, 0.f, 0.f};
#pragma unroll
        for (int ai = 0; ai < 2; ++ai)
#pragma unroll
            for (int m = 0; m < 4; ++m) { bf16_t* rowp = base + (size_t)(row0 + ai * HALF + m * 16) * ldc + col0;
#pragma unroll
                for (int bj = 0; bj < 2; ++bj) { f32x4 v0 = acc[ai][bj][m][0] + bv[bj][0], v1 = acc[ai][bj][m][1] + bv[bj][1];
                    if (ACT == 1) { f32x2 a = gelu_pk((f32x2){v0[0], v0[1]}), b = gelu_pk((f32x2){v0[2], v0[3]}), c = gelu_pk((f32x2){v1[0], v1[1]}), d = gelu_pk((f32x2){v1[2], v1[3]});
                        v0 = (f32x4){a.x, a.y, b.x, b.y}; v1 = (f32x4){c.x, c.y, d.x, d.y}; }
                    v0 = v0 * sc; v1 = v1 * sc; u32x4 w; w.x = cvt_pk_bf16(v0[0], v0[1]); w.y = cvt_pk_bf16(v0[2], v0[3]); w.z = cvt_pk_bf16(v1[0], v1[1]); w.w = cvt_pk_bf16(v1[2], v1[3]);
                    *(u32x4*)(rowp + bj * HALF) = w; } }
    }
};

struct EpiRes {
    static constexpr bool PERM = false, AFTER_DRAIN = false;
    const float* base; float* out; int ldc; const float* gate; int gate_ld; int rows_per_batch;
    __device__ __forceinline__ void operator()(const f32x4 (&acc)[2][2][4][2], const Unit& u, int wr, int wc, int fr, int fq) const {
        const int row0 = u.pm * BM + wr * 64 + fr, col0 = u.pn * BM + wc * 32 + 4 * fq;
        const float* gp = gate + (size_t)((u.pm * BM) / rows_per_batch) * gate_ld + col0;
        f32x4 gv[2][2];
#pragma unroll
        for (int bj = 0; bj < 2; ++bj)
#pragma unroll
            for (int n = 0; n < 2; ++n) gv[bj][n] = *(const f32x4*)(gp + bj * HALF + n * 16);
#pragma unroll
        for (int ai = 0; ai < 2; ++ai)
#pragma unroll
            for (int m = 0; m < 4; ++m) { const size_t off = (size_t)(row0 + ai * HALF + m * 16) * ldc + col0;
#pragma unroll
                for (int bj = 0; bj < 2; ++bj)
#pragma unroll
                    for (int n = 0; n < 2; ++n) { const f32x4 bs = *(const f32x4*)(base + off + bj * HALF + n * 16);
                        *(f32x4*)(out + off + bj * HALF + n * 16) = bs + gv[bj][n] * acc[ai][bj][m][n]; } }
    }
};
struct EpiGV {
    static constexpr bool PERM = true, AFTER_DRAIN = false;
    bf16_t* G; bf16_t* V; int ldc;
    __device__ __forceinline__ void operator()(const f32x4 (&acc)[2][2][4][2], const Unit& u, int wr, int wc, int fr, int fq) const {
        const int row0 = u.pm * BM + wr * 64 + fr, col0 = u.pn * HALF + wc * 32 + 8 * fq;
#pragma unroll
        for (int ai = 0; ai < 2; ++ai)
#pragma unroll
            for (int m = 0; m < 4; ++m) { const size_t off = (size_t)(row0 + ai * HALF + m * 16) * ldc + col0;
#pragma unroll
                for (int bj = 0; bj < 2; ++bj) { const f32x4 v0 = acc[ai][bj][m][0], v1 = acc[ai][bj][m][1];
                    u32x4 w; w.x = cvt_pk_bf16(v0[0], v0[1]); w.y = cvt_pk_bf16(v0[2], v0[3]); w.z = cvt_pk_bf16(v1[0], v1[1]); w.w = cvt_pk_bf16(v1[2], v1[3]);
                    *(u32x4*)((bj ? V : G) + off) = w; } }
    }
};
template <class Epi, class Sched, bool ALIGN_EPI = false, bool SP2 = false>
__device__ __forceinline__ void gemm_phase(PG8_LAS unsigned char* lds, const Gemm g, const Sched& S, const Epi& E) {
    int tid_ = threadIdx.x; asm volatile("" : "+v"(tid_));
    const int tid = tid_, wid = __builtin_amdgcn_readfirstlane(tid >> 6), lane = tid & 63, wr = wid >> 2, wc = wid & 3, fr = lane & 15, fq = lane >> 4;
    const int K = g.K, nt = K / BK;
    unsigned voffA[2], voffB[2];
#pragma unroll
    for (int i = 0; i < 2; ++i) { int R, C; stage_rc(tid * 16 + i * 8192, R, C); const int Rb = Epi::PERM ? ((R & ~31) + perm32(R & 31)) : R;
        voffA[i] = (unsigned)(R * K + C) * 2u; voffB[i] = (unsigned)(Rb * K + C) * 2u; }
    const size_t kstep = (size_t)(BK * 2);
    const size_t hstep = (size_t)HALF * K * 2;
    const size_t tstep = 2 * hstep;
    const unsigned ldsw = (unsigned)wid * 1024u;
    const int aoff = lds_byte(wr * 64 + fr, fq * 8), boff = lds_byte(wc * 32 + fr, fq * 8);
#define PG8_SA(b, h) (((b) * 2 + (h)) * HTB)
#define PG8_SB(b, h) ((4 + (b) * 2 + (h)) * HTB)
#define PG8_STAGE(bufoff, gbase, voff) do { _Pragma("unroll") for (int _i = 0; _i < 2; ++_i) \
        __builtin_amdgcn_global_load_lds((const unsigned*)((const char*)(gbase) + (voff)[_i]), (PG8_LAS unsigned*)(lds + (bufoff) + ldsw + _i * 8192), 16, 0, 0); } while (0)
#define PG8_LDA(dst, b, h) do { _Pragma("unroll") for (int m = 0; m < 4; ++m) _Pragma("unroll") for (int k = 0; k < 2; ++k) dst[m][k] = *(const PG8_LAS bf16x8*)(lds + PG8_SA(b, h) + aoff + m * 2048 + k * 1024); } while (0)
#define PG8_LDB(dst, b, h) do { _Pragma("unroll") for (int n = 0; n < 2; ++n) _Pragma("unroll") for (int k = 0; k < 2; ++k) dst[n][k] = *(const PG8_LAS bf16x8*)(lds + PG8_SB(b, h) + boff + n * 2048 + k * 1024); } while (0)
#define PG8_MMA(ai, bj, At, Bt) do { __builtin_amdgcn_s_setprio(1); _Pragma("unroll") for (int m = 0; m < 4; ++m) _Pragma("unroll") for (int n = 0; n < 2; ++n) _Pragma("unroll") for (int k = 0; k < 2; ++k) \
        acc[ai][bj][m][n] = __builtin_amdgcn_mfma_f32_16x16x32_bf16(Bt[n][k], At[m][k], acc[ai][bj][m][n], 0, 0, 0); __builtin_amdgcn_s_setprio(0); } while (0)
#define PG8_WAIT_V(n) asm volatile("s_waitcnt vmcnt(" #n ")" ::: "memory")
#define PG8_WAIT_L(n) asm volatile("s_waitcnt lgkmcnt(" #n ")" ::: "memory")
#define PG8_BAR __builtin_amdgcn_s_barrier()
#define PG8_SCHED __builtin_amdgcn_sched_barrier(0)
    Unit cur, nxt; int ui = 0;
    if (!S.next(0, cur)) return;
    f32x4 acc[2][2][4][2];
#pragma unroll
    for (int a = 0; a < 2; ++a)
#pragma unroll
        for (int b = 0; b < 2; ++b)
#pragma unroll
            for (int m = 0; m < 4; ++m)
#pragma unroll
                for (int n = 0; n < 2; ++n) acc[a][b][m][n] = (f32x4){0.f, 0.f, 0.f, 0.f};
    bf16x8 At[4][2], B0[2][2], B1[2][2];
    const char* cA = (const char*)g.A + (size_t)cur.pm * tstep; const char* cB = (const char*)g.Bt + (size_t)cur.pn * tstep;
    S.a_ready(cur);
    if constexpr (SP2) {
        PG8_STAGE(PG8_SB(0, 0), cB, voffB); PG8_STAGE(PG8_SB(0, 1), cB + hstep, voffB); PG8_STAGE(PG8_SA(0, 0), cA, voffA); PG8_STAGE(PG8_SA(0, 1), cA + hstep, voffA);
        if (wr == 1) PG8_BAR;
        PG8_WAIT_V(2); PG8_BAR;
        PG8_STAGE(PG8_SB(1, 0), cB + kstep, voffB); PG8_STAGE(PG8_SA(1, 0), cA + kstep, voffA); PG8_STAGE(PG8_SB(1, 1), cB + hstep + kstep, voffB);
        PG8_WAIT_V(6); PG8_BAR;
    } else {
        PG8_STAGE(PG8_SB(0, 0), cB, voffB); PG8_STAGE(PG8_SA(0, 0), cA, voffA); PG8_STAGE(PG8_SB(0, 1), cB + hstep, voffB); PG8_STAGE(PG8_SA(0, 1), cA + hstep, voffA);
        if (wr == 1) PG8_BAR;
        PG8_WAIT_V(4); PG8_BAR;
        PG8_STAGE(PG8_SB(1, 0), cB + kstep, voffB); PG8_STAGE(PG8_SA(1, 0), cA + kstep, voffA); PG8_STAGE(PG8_SB(1, 1), cB + hstep + kstep, voffB);
        PG8_WAIT_V(6); PG8_BAR;
    }
    for (;;) {
        const bool has_next = S.next(ui + 1, nxt);
        const char* nA = has_next ? (const char*)g.A + (size_t)nxt.pm * tstep : cA; const char* nB = has_next ? (const char*)g.Bt + (size_t)nxt.pn * tstep : cB;
        for (int t = 0; t < nt; t += 2) {
            const bool last = (t == nt - 2);
            const char* a1 = cA + (size_t)(t + 1) * kstep;
            const char* a2 = last ? nA : cA + (size_t)(t + 2) * kstep; const char* b2 = last ? nB : cB + (size_t)(t + 2) * kstep;
            const char* a3 = a2 + kstep; const char* b3 = b2 + kstep;
            if (last && has_next) S.a_ready(nxt);
            if constexpr (SP2) {
            PG8_LDB(B0, 0, 0); PG8_LDB(B1, 0, 1); PG8_SCHED; PG8_LDA(At, 0, 0); PG8_STAGE(PG8_SA(1, 1), a1 + hstep, voffA);
            PG8_WAIT_V(8); PG8_WAIT_L(0); PG8_BAR; PG8_MMA(0, 0, At, B0); PG8_MMA(0, 1, At, B1); PG8_BAR; PG8_SCHED;
            PG8_LDA(At, 0, 1); PG8_STAGE(PG8_SB(0, 0), b2, voffB); PG8_STAGE(PG8_SB(0, 1), b2 + hstep, voffB); PG8_STAGE(PG8_SA(0, 0), a2, voffA);
            PG8_WAIT_V(8); PG8_WAIT_L(0); PG8_BAR; PG8_MMA(1, 0, At, B0); PG8_MMA(1, 1, At, B1); PG8_BAR; PG8_SCHED;
            PG8_LDB(B0, 1, 0); PG8_LDB(B1, 1, 1); PG8_SCHED; PG8_LDA(At, 1, 0); PG8_STAGE(PG8_SA(0, 1), a2 + hstep, voffA);
            PG8_WAIT_V(8); PG8_WAIT_L(0); PG8_BAR; PG8_MMA(0, 0, At, B0); PG8_MMA(0, 1, At, B1); PG8_BAR; PG8_SCHED;
            PG8_LDA(At, 1, 1); PG8_STAGE(PG8_SB(1, 0), b3, voffB); PG8_STAGE(PG8_SB(1, 1), b3 + hstep, voffB); PG8_STAGE(PG8_SA(1, 0), a3, voffA);
            PG8_WAIT_V(8); PG8_WAIT_L(0); PG8_BAR; PG8_MMA(1, 0, At, B0); PG8_MMA(1, 1, At, B1); PG8_BAR; PG8_SCHED;
            } else {
            PG8_LDB(B0, 0, 0); PG8_SCHED; PG8_LDA(At, 0, 0); PG8_STAGE(PG8_SA(1, 1), a1 + hstep, voffA);
            PG8_WAIT_L(8); PG8_BAR; PG8_WAIT_L(0); PG8_MMA(0, 0, At, B0); PG8_BAR; PG8_SCHED;
            PG8_LDB(B1, 0, 1); PG8_STAGE(PG8_SB(0, 0), b2, voffB);
            PG8_BAR; PG8_WAIT_L(0); PG8_MMA(0, 1, At, B1); PG8_BAR;
            PG8_LDA(At, 0, 1); PG8_STAGE(PG8_SA(0, 0), a2, voffA);
            PG8_BAR; PG8_WAIT_L(0); PG8_MMA(1, 0, At, B0); PG8_BAR; PG8_SCHED;
            PG8_STAGE(PG8_SB(0, 1), b2 + hstep, voffB);
            PG8_WAIT_V(6); PG8_BAR; PG8_MMA(1, 1, At, B1); PG8_BAR;
            PG8_LDB(B0, 1, 0); PG8_SCHED; PG8_LDA(At, 1, 0); PG8_STAGE(PG8_SA(0, 1), a2 + hstep, voffA);
            PG8_WAIT_L(8); PG8_BAR; PG8_WAIT_L(0); PG8_MMA(0, 0, At, B0); PG8_BAR; PG8_SCHED;
            PG8_LDB(B1, 1, 1); PG8_STAGE(PG8_SB(1, 0), b3, voffB);
            PG8_BAR; PG8_WAIT_L(0); PG8_MMA(0, 1, At, B1); PG8_BAR;
            PG8_LDA(At, 1, 1); PG8_STAGE(PG8_SA(1, 0), a3, voffA);
            PG8_BAR; PG8_WAIT_L(0); PG8_MMA(1, 0, At, B0); PG8_BAR; PG8_SCHED;
            PG8_STAGE(PG8_SB(1, 1), b3 + hstep, voffB);
            PG8_WAIT_V(6); PG8_BAR; PG8_MMA(1, 1, At, B1); PG8_BAR;
            }
        }
        if constexpr (ALIGN_EPI) { if (wr == 0) PG8_BAR; }
        if constexpr (!Epi::AFTER_DRAIN) { E(acc, cur, wr, wc, fr, fq); S.done(cur); }
        if (!has_next) break;
#pragma unroll
        for (int a = 0; a < 2; ++a)
#pragma unroll
            for (int b = 0; b < 2; ++b)
#pragma unroll
                for (int m = 0; m < 4; ++m)
#pragma unroll
                    for (int n = 0; n < 2; ++n) acc[a][b][m][n] = (f32x4){0.f, 0.f, 0.f, 0.f};
        cur = nxt; cA = nA; cB = nB; ++ui;
        if constexpr (ALIGN_EPI) { if (wr == 1) PG8_BAR; }
    }
    PG8_WAIT_V(0);
    if constexpr (!ALIGN_EPI) { if (wr == 0) PG8_BAR; }
    PG8_BAR;
    if constexpr (Epi::AFTER_DRAIN) { E.fused(acc, cur, wr, wc, fr, fq, lds, wid, lane); S.done(cur); }
#undef PG8_SA
#undef PG8_SB
#undef PG8_STAGE
#undef PG8_LDA
#undef PG8_LDB
#undef PG8_MMA
#undef PG8_WAIT_V
#undef PG8_WAIT_L
#undef PG8_BAR
#undef PG8_SCHED
}
}

namespace cg = cooperative_groups;
#ifndef MK_MODE
#define MK_MODE 2
#endif
constexpr int NWAVES = 8;

constexpr int NB = 8, SEQ = 4096, DM = 1024, NL = 2;
constexpr int M = NB * SEQ;
constexpr int PIN = 2688, PINP = 2816;
constexpr int DFF = 2816, DUP = 2 * DFF;
constexpr int DA = 256, DB = 384, DC = 384;
constexpr int NMOD = 6 * DM;
constexpr int PC_OFF = 1280;
constexpr int NPHASE = 22;

constexpr size_t MiB = 1u << 20;
constexpr size_t WS_CTL = 0, CTL_ZERO_BYTES = 64 * 1024;
constexpr size_t WS_SMALL = 1 * MiB;
constexpr size_t SM_SGUW = 0, SM_LRUWA = 256 * 1024, SM_LRUWX = 352 * 1024, SM_RW2 = 448 * 1024, SM_RA2 = 544 * 1024, SM_RG2 = 640 * 1024;
constexpr size_t WS_MOD = 2 * MiB;
constexpr size_t WS_LRUS = 3 * MiB;
constexpr size_t WS_WIN = 4 * MiB, WS_WOUT = 15 * MiB, WS_WUP = 19 * MiB, WS_WDN = 41 * MiB;
constexpr size_t WS_HY = 64 * MiB;
constexpr size_t WS_P = 128 * MiB;
constexpr size_t WS_UV = 304 * MiB;
constexpr size_t WS_R = 304 * MiB, WS_K = 328 * MiB, WS_V = 352 * MiB, WS_KK = 376 * MiB, WS_BV = 400 * MiB;
constexpr size_t WS_WD = 424 * MiB;
constexpr size_t WS_Q2 = 472 * MiB;
constexpr size_t WS_END = 512 * MiB;
static_assert(WS_Q2 + (size_t)M * 384 * 2 <= WS_END && WS_UV + (size_t)M * DFF * 2 <= WS_END && WS_P + (size_t)M * PINP * 2 <= WS_UV, "d_ws map");
static_assert(WS_WDN + (size_t)NL * DM * DFF * 2 <= WS_HY && WS_WIN + (size_t)NL * PINP * DM * 2 <= WS_WOUT && WS_WUP + (size_t)NL * DUP * DM * 2 <= WS_WDN, "weights map");
constexpr int CW_BAR = 1024;

constexpr int RING_BYTES = 131072;
constexpr int LDSCTL_OFF = RING_BYTES, MISC_OFF = LDSCTL_OFF + 320;
constexpr int LDS_BYTES = 147456;

#define GAS __attribute__((address_space(1)))
#define LAS __attribute__((address_space(3)))
typedef unsigned short bf16;
typedef float f32x4 __attribute__((ext_vector_type(4)));
typedef float f32x2 __attribute__((ext_vector_type(2)));
typedef float f32x16 __attribute__((ext_vector_type(16)));
typedef short bf16x8 __attribute__((ext_vector_type(8)));
typedef unsigned u32x2 __attribute__((ext_vector_type(2)));
typedef unsigned u32x4 __attribute__((ext_vector_type(4)));
typedef GAS unsigned gu32;
#define RLX_AGENT __ATOMIC_RELAXED, __HIP_MEMORY_SCOPE_AGENT

__device__ __forceinline__ float bflo(unsigned w) { return __builtin_bit_cast(float, w << 16); }
__device__ __forceinline__ float bfhi(unsigned w) { return __builtin_bit_cast(float, w & 0xffff0000u); }
__device__ __forceinline__ float bf1(bf16 u) { return __builtin_bit_cast(float, (unsigned)u << 16); }
__device__ __forceinline__ unsigned pk2(float lo, float hi) { return pg8::cvt_pk_bf16(lo, hi); }
__device__ __forceinline__ bf16 f2bf(float f) { return (bf16)(pg8::cvt_pk_bf16(f, f) & 0xffffu); }
__device__ __forceinline__ f32x4 unpack4(u32x2 w) { return (f32x4){bflo(w.x), bfhi(w.x), bflo(w.y), bfhi(w.y)}; }
__device__ __forceinline__ u32x2 pack4(f32x4 v) { u32x2 w; w.x = pk2(v[0], v[1]); w.y = pk2(v[2], v[3]); return w; }

__device__ __forceinline__ float fsigmoid(float x) { return __builtin_amdgcn_rcpf(1.f + __expf(-x)); }
__device__ __forceinline__ float fgelu(float x) { const float y = 1.5957691216f * x * (1.f + 0.044715f * x * x); return x * fsigmoid(y); }
__device__ __forceinline__ float fsilu(float x) { return x * fsigmoid(x); }
__device__ __forceinline__ float fsoftplus(float x) { return fmaxf(x, 0.f) + log1pf(__expf(-fabsf(x))); }
__device__ __forceinline__ float ftanh(float x) { return 1.f - 2.f * __builtin_amdgcn_rcpf(1.f + __expf(2.f * x)); }

__device__ __forceinline__ int opaque_tid() { int t = threadIdx.x; asm volatile("" : "+v"(t)); return t; }
template <int CTRL> __device__ __forceinline__ float dppf(float x) { return __builtin_bit_cast(float, __builtin_amdgcn_mov_dpp(__builtin_bit_cast(int, x), CTRL, 0xf, 0xf, true)); }
__device__ __forceinline__ float red16(float p) { p += dppf<0xB1>(p); p += dppf<0x4E>(p); p += dppf<0x141>(p); p += dppf<0x128>(p); return p; }
__device__ __forceinline__ float wave_sum(float v) {
#pragma unroll
    for (int o = 1; o < 64; o <<= 1) v += __shfl_xor(v, o);
    return v;
}
#define XB_TMO      128
#define XB_XCNT(j)  (256  + 64 * (j))
#define XB_XSUB(j)  (1280 + 64 * (j))
#define XB_XGEN(j)  (2304 + 64 * (j))
#define XB_TOP      3328
#define XB_TOPGEN   3392
#define XCD_BAR_WORDS 3456
#define XB_SPIN_CAP (1u << 18)

__device__ __forceinline__ unsigned xb_ld(unsigned* p)              { return __hip_atomic_load(p, __ATOMIC_RELAXED, __HIP_MEMORY_SCOPE_AGENT); }
__device__ __forceinline__ unsigned xb_add(unsigned* p, unsigned v) { return __hip_atomic_fetch_add(p, v, __ATOMIC_RELAXED, __HIP_MEMORY_SCOPE_AGENT); }
__device__ __forceinline__ unsigned xb_xcc_id() { return (unsigned)__builtin_amdgcn_s_getreg((3 << 11) | 20) & 0xFu; }
#define XB_SPIN(cond, bar) do { unsigned _sp = 0; while (cond) { __builtin_amdgcn_s_sleep(1); \
    if ((++_sp & 255u) == 0u) { if (xb_ld(&(bar)[XB_TMO])) break; if (_sp > XB_SPIN_CAP) { atomicAdd(&(bar)[XB_TMO], 1u); break; } } } } while (0)

struct XcdBarrier {
    unsigned* bar; unsigned x;
    volatile LAS unsigned* st;
};

__device__ __forceinline__ XcdBarrier xcd_barrier_post(unsigned* bar, volatile LAS unsigned* st) {
    XcdBarrier b; b.bar = bar; b.x = xb_xcc_id(); b.st = st;
    if (threadIdx.x == 0) (void)xb_add(&bar[XB_XCNT(b.x)], 1u);
    return b;
}
__device__ __forceinline__ void xcd_barrier_complete(unsigned* bar, unsigned x, unsigned& nloc, unsigned& nx) {
    const unsigned G = gridDim.x * gridDim.y * gridDim.z;
    unsigned sum, cnt, mine, sp = 0u;
    for (;;) {
        sum = 0u; cnt = 0u; mine = 0u;
#pragma unroll
        for (unsigned j = 0; j < 16; ++j) { const unsigned c = xb_ld(&bar[XB_XCNT(j)]); sum += c; cnt += (c > 0u) ? 1u : 0u; mine = (j == x) ? c : mine; }
        if (sum == G) break;
        __builtin_amdgcn_s_sleep(1);
        if ((++sp & 255u) == 0u) { if (xb_ld(&bar[XB_TMO])) break; if (sp > XB_SPIN_CAP) { atomicAdd(&bar[XB_TMO], 1u); break; } }
    }
    nloc = mine > 0u ? mine : 1u; nx = cnt > 0u ? cnt : 1u;
}

__device__ __forceinline__ void xcd_barrier(const XcdBarrier& b) {
    asm volatile("s_waitcnt vmcnt(0)" ::: "memory");
    __syncthreads();
    if (threadIdx.x == 0) {
        unsigned* bar = b.bar;
        __builtin_amdgcn_s_waitcnt(0);
        unsigned nloc = b.st[0], nx = b.st[1];
        if (nloc == 0u) { xcd_barrier_complete(bar, b.x, nloc, nx); b.st[0] = nloc; b.st[1] = nx; }
        const unsigned old = xb_add(&bar[XB_XSUB(b.x)], 1u);
        const unsigned gen = old / nloc;
        if (old + 1u == (gen + 1u) * nloc) {
            __builtin_amdgcn_fence(__ATOMIC_RELEASE, "agent");
            asm volatile("s_waitcnt vmcnt(0)" ::: "memory");
            const unsigned og = xb_add(&bar[XB_TOP], 1u);
            const unsigned tg = og / nx;
            if (og + 1u == (tg + 1u) * nx) xb_add(&bar[XB_TOPGEN], 1u);
            else XB_SPIN(xb_ld(&bar[XB_TOPGEN]) == tg, bar);
            __builtin_amdgcn_fence(__ATOMIC_ACQUIRE, "agent");
            xb_add(&bar[XB_XGEN(b.x)], 1u);
            asm volatile("s_waitcnt vmcnt(0)" ::: "memory");
        } else {
            XB_SPIN(xb_ld(&bar[XB_XGEN(b.x)]) == gen, bar);
            __builtin_amdgcn_fence(__ATOMIC_ACQUIRE, "agent");
            asm volatile("s_waitcnt vmcnt(0)" ::: "memory");
        }
    }
    __syncthreads();
}

struct Frame {
    LAS unsigned char* lds;
    volatile LAS unsigned* MISC;
    gu32* ctl;
    int wave, vcu, G;
    const float *x, *c, *w_mod, *b_mod, *norm_mix, *w_in, *w_out, *sgu_ln_g, *sgu_ln_b, *sgu_w, *sgu_b, *lru_conv_w, *lru_conv_b, *lru_w_a, *lru_b_a, *lru_w_x, *lru_b_x, *lru_lambda,
        *rwkv_mu, *rwkv_w0, *rwkv_w2, *rwkv_a0, *rwkv_a2, *rwkv_g2, *rwkv_k_k, *rwkv_k_a, *rwkv_r_k, *rwkv_ln_w, *rwkv_ln_b, *norm_ffn, *ffn_w_up, *ffn_conv_w, *ffn_conv_b, *ffn_w_down, *norm_final;
    float* out;
    bf16 *SGUW, *LRUWA, *LRUWX, *RW2, *RA2, *RG2;
    float *MOD, *LRUSA, *LRUSH;
    bf16 *WIN, *WOUT, *WUP, *WDN;
    bf16 *HY, *P, *UG, *UV, *R, *K, *V, *KK, *BV, *Q2;
    float *O, *WD;
};

__device__ __forceinline__ void p0_transpose_item(const float* W, int K, int N, bf16* WT, int k0, int n0, int drow0, LAS float* scr, int lane) {
#pragma unroll 8
    for (int i = 0; i < 32; ++i) { const int kk = 2 * i + (lane >> 5); scr[kk * 33 + (lane & 31)] = W[(size_t)(k0 + kk) * N + n0 + (lane & 31)]; }
    asm volatile("s_waitcnt lgkmcnt(0)" ::: "memory");
    const int c = lane & 7;
#pragma unroll
    for (int j = 0; j < 4; ++j) { const int n = (lane >> 3) + 8 * j; const LAS float* s = scr + (8 * c) * 33 + n;
        u32x4 o; o.x = pk2(s[0 * 33], s[1 * 33]); o.y = pk2(s[2 * 33], s[3 * 33]); o.z = pk2(s[4 * 33], s[5 * 33]); o.w = pk2(s[6 * 33], s[7 * 33]);
        *(u32x4*)(WT + (size_t)(drow0 + n) * K + k0 + 8 * c) = o; }
    asm volatile("s_waitcnt lgkmcnt(0)" ::: "memory");
}
__device__ __forceinline__ void p0_prologue(Frame& F) {
    const int tid = opaque_tid(), lane = tid & 63, wave = F.wave;
    const int gw = F.vcu * NWAVES + wave, NGW = F.G * NWAVES;
    const int gt = F.vcu * (NWAVES * 64) + tid, NGT = F.G * NWAVES * 64;
    if (F.vcu < 192) {
        LAS float* cact = (LAS float*)(F.lds + 73728);
        LAS float* red = (LAS float*)(F.lds + 106496);
        for (int i = tid; i < NB * DM; i += NWAVES * 64) { const float cv = F.c[i]; cact[i] = cv * fsigmoid(cv); }
        __syncthreads();
        const int l = F.vcu / 96, n0 = (F.vcu % 96) * 64;
        const float* wm = F.w_mod + ((size_t)l * DM + 128 * wave) * NMOD + n0 + lane;
        float acc[NB];
#pragma unroll
        for (int b = 0; b < NB; ++b) acc[b] = 0.f;
        for (int k4 = 0; k4 < 128; k4 += 4) {
            const float w0 = wm[(size_t)(k4 + 0) * NMOD], w1 = wm[(size_t)(k4 + 1) * NMOD], w2 = wm[(size_t)(k4 + 2) * NMOD], w3 = wm[(size_t)(k4 + 3) * NMOD];
#pragma unroll
            for (int b = 0; b < NB; ++b) { const f32x4 cv = *(const LAS f32x4*)(cact + b * DM + 128 * wave + k4); acc[b] += cv[0] * w0 + cv[1] * w1 + cv[2] * w2 + cv[3] * w3; }
        }
#pragma unroll
        for (int b = 0; b < NB; ++b) red[(wave * NB + b) * 64 + lane] = acc[b];
        __syncthreads();
        { const int b = tid >> 6, col = tid & 63; float s = F.b_mod[l * NMOD + n0 + col];
#pragma unroll
          for (int w = 0; w < NWAVES; ++w) s += red[(w * NB + b) * 64 + col];
          F.MOD[(size_t)(l * NB + b) * NMOD + n0 + col] = s; }
        __syncthreads();
    }
    {
        LAS float* scr = (LAS float*)(F.lds + wave * 9216);
        constexpr int I_IN = (DM / 64) * (PIN / 32), I_OUT = (DM / 64) * (DM / 32), I_UP = (DM / 64) * (DUP / 32), I_DN = (DFF / 64) * (DM / 32);
        constexpr int PER_L = I_IN + I_OUT + I_UP + I_DN;
        for (int it = gw; it < NL * PER_L; it += NGW) {
            const int l = it / PER_L; int r = it % PER_L;
            if (r < I_IN) { const int nblk = PIN / 32, kb = r / nblk, nb = r % nblk; p0_transpose_item(F.w_in + (size_t)l * DM * PIN, DM, PIN, F.WIN + (size_t)l * PINP * DM, 64 * kb, 32 * nb, 32 * nb, scr, lane); continue; } r -= I_IN;
            if (r < I_OUT) { const int nblk = DM / 32, kb = r / nblk, nb = r % nblk; p0_transpose_item(F.w_out + (size_t)l * DM * DM, DM, DM, F.WOUT + (size_t)l * DM * DM, 64 * kb, 32 * nb, 32 * nb, scr, lane); continue; } r -= I_OUT;
            if (r < I_UP) { const int nblk = DUP / 32, kb = r / nblk, nb = r % nblk; const int n0 = 32 * nb, isv = n0 >= DFF ? 1 : 0, j = n0 - isv * DFF, drow = (j / 128) * 256 + isv * 128 + (j % 128);
                p0_transpose_item(F.ffn_w_up + (size_t)l * DM * DUP, DM, DUP, F.WUP + (size_t)l * DUP * DM, 64 * kb, n0, drow, scr, lane); continue; } r -= I_UP;
            { const int nblk = DM / 32, kb = r / nblk, nb = r % nblk; p0_transpose_item(F.ffn_w_down + (size_t)l * DFF * DM, DFF, DM, F.WDN + (size_t)l * DM * DFF, 64 * kb, 32 * nb, 32 * nb, scr, lane); }
        }
        for (int i = gt; i < NL * (PINP - PIN) * DM / 8; i += NGT) { const int l = i / ((PINP - PIN) * DM / 8), o = i % ((PINP - PIN) * DM / 8);
            *(u32x4*)(F.WIN + (size_t)l * PINP * DM + (size_t)PIN * DM + (size_t)o * 8) = (u32x4){0u, 0u, 0u, 0u}; }
    }
    for (int i = gt; i < NL * 4 * 128 * 128; i += NGT) { const int s = i & 127, t = (i >> 7) & 127; F.SGUW[i] = s <= t ? f2bf(F.sgu_w[i]) : (bf16)0; }
    for (int i = gt; i < NL * 6 * 64 * 64; i += NGT) { const int ii = i & 63, j = (i >> 6) & 63, lh = i >> 12;
        F.LRUWA[i] = f2bf(F.lru_w_a[(size_t)lh * 4096 + ii * 64 + j]); F.LRUWX[i] = f2bf(F.lru_w_x[(size_t)lh * 4096 + ii * 64 + j]); }
    for (int i = gt; i < NL * 384 * 64; i += NGT) { const int k = i & 63, n = (i >> 6) % 384, l = i / (384 * 64);
        F.RW2[i] = f2bf(F.rwkv_w2[(size_t)l * 64 * 384 + k * 384 + n]); F.RA2[i] = f2bf(F.rwkv_a2[(size_t)l * 64 * 384 + k * 384 + n]); }
    for (int i = gt; i < NL * 384 * 128; i += NGT) { const int k = i & 127, n = (i >> 7) % 384, l = i / (384 * 128);
        F.RG2[i] = f2bf(F.rwkv_g2[(size_t)l * 128 * 384 + k * 384 + n]); }
}

__device__ __forceinline__ void norm_mod_phase(Frame& F, const float* X, const float* gamma, const float* mod_l, int sh_idx, int sc_idx, bf16* H) {
    const int gw = F.vcu * NWAVES + F.wave, NGW = F.G * NWAVES, lane = opaque_tid() & 63;
    for (int m = gw; m < M; m += NGW) {
        const f32x4* xr = (const f32x4*)(X + (size_t)m * DM) + lane;
        f32x4 v[4]; float s = 0.f;
#pragma unroll
        for (int j = 0; j < 4; ++j) { v[j] = xr[64 * j]; s += (v[j][0] * v[j][0] + v[j][1] * v[j][1]) + (v[j][2] * v[j][2] + v[j][3] * v[j][3]); }
        const float rstd = __builtin_amdgcn_rsqf(wave_sum(s) * (1.f / DM) + 1e-6f);
        const float* mb = mod_l + (size_t)(m >> 12) * NMOD;
        u32x2* o8 = (u32x2*)(H + (size_t)m * DM) + lane;
#pragma unroll
        for (int j = 0; j < 4; ++j) { const int c = 4 * (lane + 64 * j);
            const f32x4 g = *(const f32x4*)(gamma + c), sc = *(const f32x4*)(mb + sc_idx * DM + c), sh = *(const f32x4*)(mb + sh_idx * DM + c);
            const f32x4 y = (v[j] * rstd) * g * (sc + 1.f) + sh; o8[64 * j] = pack4(y); }
    }
}
__device__ __forceinline__ void final_norm_phase(Frame& F, float* X, const float* gamma) {
    const int gw = F.vcu * NWAVES + F.wave, NGW = F.G * NWAVES, lane = opaque_tid() & 63;
    for (int m = gw; m < M; m += NGW) {
        f32x4* xr = (f32x4*)(X + (size_t)m * DM) + lane;
        f32x4 v[4]; float s = 0.f;
#pragma unroll
        for (int j = 0; j < 4; ++j) { v[j] = xr[64 * j]; s += (v[j][0] * v[j][0] + v[j][1] * v[j][1]) + (v[j][2] * v[j][2] + v[j][3] * v[j][3]); }
        const float rstd = __builtin_amdgcn_rsqf(wave_sum(s) * (1.f / DM) + 1e-6f);
#pragma unroll
        for (int j = 0; j < 4; ++j) { const f32x4 g = *(const f32x4*)(gamma + 4 * (lane + 64 * j)); xr[64 * j] = (v[j] * rstd) * g; }
    }
}

__device__ __forceinline__ void mix_chunk(Frame& F, const int l, const int ch) {
    const int wave = F.wave;
    const int n = ch & 31; const size_t r0 = (size_t)ch * 128;
    const bf16* P = F.P; bf16* Y = F.HY;
    LAS unsigned char* lds = F.lds;
#ifndef MK_MIXMASK
#define MK_MIXMASK 7
#endif
    if (MK_MIXMASK & 1) {
        const int tid = opaque_tid(), lane = tid & 63, r = lane & 31, hh = lane >> 5;
        LAS bf16* VT = (LAS bf16*)lds;
        LAS f32x2* ST = (LAS f32x2*)(lds + 69632);
        const int t = tid & 127, q = __builtin_amdgcn_readfirstlane(tid >> 7);
        const bf16* src = P + (r0 + t) * PINP + 256 + 64 * q;
        float v[64]; float s = 0.f, ss = 0.f;
#pragma unroll
        for (int i = 0; i < 8; ++i) { const u32x4 w = *(const u32x4*)(src + 8 * i);
            const float e0 = fgelu(bflo(w.x)), e1 = fgelu(bfhi(w.x)), e2 = fgelu(bflo(w.y)), e3 = fgelu(bfhi(w.y)), e4 = fgelu(bflo(w.z)), e5 = fgelu(bfhi(w.z)), e6 = fgelu(bflo(w.w)), e7 = fgelu(bfhi(w.w));
            v[8 * i + 0] = e0; v[8 * i + 1] = e1; v[8 * i + 2] = e2; v[8 * i + 3] = e3; v[8 * i + 4] = e4; v[8 * i + 5] = e5; v[8 * i + 6] = e6; v[8 * i + 7] = e7;
            s += ((e0 + e1) + (e2 + e3)) + ((e4 + e5) + (e6 + e7)); ss += ((e0 * e0 + e1 * e1) + (e2 * e2 + e3 * e3)) + ((e4 * e4 + e5 * e5) + (e6 * e6 + e7 * e7)); }
        ST[q * 128 + t] = (f32x2){s, ss};
        __syncthreads();
        const f32x2 a0 = ST[t], a1 = ST[128 + t], a2 = ST[256 + t], a3 = ST[384 + t];
        const float mean = ((a0.x + a1.x) + (a2.x + a3.x)) * (1.f / 256.f), ex2 = ((a0.y + a1.y) + (a2.y + a3.y)) * (1.f / 256.f);
        const float rstd = __builtin_amdgcn_rsqf(fmaxf(ex2 - mean * mean, 0.f) + 1e-5f);
        const float* lg = F.sgu_ln_g + l * DA + 64 * q; const float* lb = F.sgu_ln_b + l * DA + 64 * q;
#pragma unroll
        for (int i = 0; i < 64; ++i) VT[(64 * q + i) * 136 + t] = f2bf((v[i] - mean) * rstd * lg[i] + lb[i]);
        __syncthreads();
        const int h = wave >> 1, dh = wave & 1;
        const bf16* Wg = F.SGUW + (size_t)(l * 4 + h) * 128 * 128;
        const LAS bf16* vrow = VT + (64 * h + 32 * dh + r) * 136 + 8 * hh;
#pragma unroll 1
        for (int tb = 0; tb < 4; ++tb) {
            f32x16 acc;
#pragma unroll
            for (int i = 0; i < 16; ++i) acc[i] = 0.f;
            const bf16* wrow = Wg + (size_t)(32 * tb + r) * 128 + 8 * hh;
#pragma unroll 2
            for (int ks = 0; ks < 2 * (tb + 1); ++ks) {
                const bf16x8 a = *(const LAS bf16x8*)(vrow + 16 * ks);
                const bf16x8 b = *(const bf16x8*)(wrow + 16 * ks);
                acc = __builtin_amdgcn_mfma_f32_32x32x16_bf16(a, b, acc, 0, 0, 0);
            }
            const int tt = 32 * tb + r; const size_t row = r0 + tt;
            const float bias = F.sgu_b[(l * 4 + h) * 128 + tt];
#pragma unroll
            for (int g = 0; g < 4; ++g) { const int c4 = 64 * h + 32 * dh + 8 * g + 4 * hh;
                const f32x4 u = unpack4(*(const u32x2*)(P + row * PINP + c4));
                f32x4 y; y[0] = fgelu(u[0]) * (acc[4 * g + 0] + bias); y[1] = fgelu(u[1]) * (acc[4 * g + 1] + bias); y[2] = fgelu(u[2]) * (acc[4 * g + 2] + bias); y[3] = fgelu(u[3]) * (acc[4 * g + 3] + bias);
                *(u32x2*)(Y + row * DM + c4) = pack4(y); }
        }
    }
    __syncthreads();
    if (MK_MIXMASK & 2) {
        const int tid = opaque_tid(), lane = tid & 63, r = lane & 31, hh = lane >> 5;
        LAS bf16* XC = (LAS bf16*)lds;
        LAS float* LA = (LAS float*)(lds + 25088);
        LAS float* BT = (LAS float*)(lds + 25088 + 49152);
        const int c = tid; const bool act = tid < DB;
        float cw0 = 0.f, cw1 = 0.f, cw2 = 0.f, cw3 = 0.f, cb = 0.f, bra = 0.f, bix = 0.f, sp8 = 0.f, x1 = 0.f, x2 = 0.f, x3 = 0.f, hst = 0.f, ca = 1.f;
        if (act) {
            cw0 = F.lru_conv_w[(l * 4 + 0) * DB + c]; cw1 = F.lru_conv_w[(l * 4 + 1) * DB + c]; cw2 = F.lru_conv_w[(l * 4 + 2) * DB + c]; cw3 = F.lru_conv_w[(l * 4 + 3) * DB + c];
            cb = F.lru_conv_b[l * DB + c]; bra = F.lru_b_a[l * DB + c]; bix = F.lru_b_x[l * DB + c];
            sp8 = -8.f * fsoftplus(-F.lru_lambda[l * DB + c]);
            if (n > 0) { x3 = bf1(P[(r0 - 3) * PINP + 512 + c]); x2 = bf1(P[(r0 - 2) * PINP + 512 + c]); x1 = bf1(P[(r0 - 1) * PINP + 512 + c]); }
        }
        for (int tq = 0; tq < 4; ++tq) {
            float xcv[32];
            if (act) {
#pragma unroll
                for (int i = 0; i < 32; ++i) { const float xr = bf1(P[(r0 + 32 * tq + i) * PINP + 512 + c]);
                    const float xc = cb + cw0 * x3 + cw1 * x2 + cw2 * x1 + cw3 * xr; x3 = x2; x2 = x1; x1 = xr; xcv[i] = xc; XC[i * 392 + c] = f2bf(xc); }
            } else {
#pragma unroll
                for (int i = 0; i < 32; ++i) xcv[i] = 0.f;
            }
            __syncthreads();
            for (int k = 0; k < 3; ++k) {
                const int id = wave + 8 * k, mat = id / 12, hb = (id % 12) >> 1, jt = id & 1;
                const bf16* Wt = (mat ? F.LRUWX : F.LRUWA) + (size_t)((l * 6 + hb) * 64 + 32 * jt + r) * 64 + 8 * hh;
                const LAS bf16* xrow = XC + r * 392 + 64 * hb + 8 * hh;
                f32x16 acc;
#pragma unroll
                for (int i = 0; i < 16; ++i) acc[i] = 0.f;
#pragma unroll
                for (int ks = 0; ks < 4; ++ks) { const bf16x8 a = *(const LAS bf16x8*)(xrow + 16 * ks); const bf16x8 b = *(const bf16x8*)(Wt + 16 * ks);
                    acc = __builtin_amdgcn_mfma_f32_32x32x16_bf16(a, b, acc, 0, 0, 0); }
                LAS float* dst = (mat ? BT : LA) + 64 * hb + 32 * jt + r;
#pragma unroll
                for (int rg = 0; rg < 16; ++rg) dst[((rg & 3) + 8 * (rg >> 2) + 4 * hh) * DB] = acc[rg];
            }
            __syncthreads();
            if (act) {
#pragma unroll
                for (int i = 0; i < 32; ++i) {
                    const float rg = fsigmoid(LA[i * DB + c] + bra), ig = fsigmoid(BT[i * DB + c] + bix);
                    const float la = sp8 * rg;
                    const float a = __expf(la), bt = sqrtf(fmaxf(-expm1f(2.f * la), 0.f)) * (ig * xcv[i]);
                    hst = a * hst + bt; ca *= a;
                    const size_t row = r0 + 32 * tq + i;
                    const float gl = fgelu(bf1(P[row * PINP + 896 + c]));
                    Y[row * DM + 256 + c] = f2bf(gl * hst); F.Q2[row * DB + c] = f2bf(gl * ca);
                }
            }
        }
        if (act) { F.LRUSA[(size_t)ch * DB + c] = ca; F.LRUSH[(size_t)ch * DB + c] = hst; }
    }
    __syncthreads();
    if (MK_MIXMASK & 4) {
        const int tid = opaque_tid(), lane = tid & 63, r = lane & 31, hh = lane >> 5; (void)tid;
        LAS bf16* TW = (LAS bf16*)lds;
        LAS bf16* XA = TW + 128 * 72;
        LAS bf16* SG = XA + 128 * 72;
        const float* mu = F.rwkv_mu + l * 1408;
        {
            const bf16* pc = P + PC_OFF + 1152 + 4 * lane; const f32x4 mu4 = *(const f32x4*)(mu + 1152 + 4 * lane);
            const int t0 = 16 * wave;
            f32x4 prev = (f32x4){0.f, 0.f, 0.f, 0.f};
            if (t0 > 0 || n > 0) prev = unpack4(*(const u32x2*)(pc + (r0 + t0 - 1) * PINP));
            LAS bf16* dst = lane < 16 ? TW + 4 * lane : (lane < 32 ? XA + 4 * (lane - 16) : SG + 4 * (lane - 32));
            const int dstride = lane < 32 ? 72 : 136;
#pragma unroll 4
            for (int i = 0; i < 16; ++i) { const int t = t0 + i;
                const f32x4 cur = unpack4(*(const u32x2*)(pc + (r0 + t) * PINP));
                const f32x4 xs = cur + (prev - cur) * mu4; prev = cur;
                f32x4 y;
#pragma unroll
                for (int e = 0; e < 4; ++e) y[e] = lane < 16 ? ftanh(xs[e]) : (lane < 32 ? xs[e] : fsigmoid(xs[e]));
                *(LAS u32x2*)(dst + t * dstride) = pack4(y); }
        }
        __syncthreads();
        for (int k = 0; k < 3; ++k) {
            const int task = wave + 8 * k, h = task % 6, tb = task / 6;
            const int t = 32 * tb + r; const size_t row = r0 + t; const bool hasprev = (t > 0) || (n > 0);
            const bf16* prow = P + row * PINP + PC_OFF; const bf16* pprev = prow - PINP;
            const LAS bf16* twr = TW + (32 * tb + r) * 72 + 8 * hh; const LAS bf16* xar = XA + (32 * tb + r) * 72 + 8 * hh; const LAS bf16* sgr = SG + (32 * tb + r) * 136 + 8 * hh;
            float sumsq = 0.f;
#pragma unroll
            for (int nt = 0; nt < 2; ++nt)
#pragma unroll
                for (int g = 0; g < 4; ++g) { const int n4 = 64 * h + 32 * nt + 8 * g + 4 * hh;
                    f32x4 kc = unpack4(*(const u32x2*)(prow + 384 + n4)), kp = (f32x4){0.f, 0.f, 0.f, 0.f};
                    if (hasprev) kp = unpack4(*(const u32x2*)(pprev + 384 + n4));
                    const f32x4 mk = *(const f32x4*)(mu + 384 + n4), kk_ = *(const f32x4*)(F.rwkv_k_k + l * DC + n4);
                    kc = (kc + (kp - kc) * mk) * kk_;
                    sumsq += (kc[0] * kc[0] + kc[1] * kc[1]) + (kc[2] * kc[2] + kc[3] * kc[3]); if (g & 1) asm volatile("" ::: "memory"); }
            sumsq += __shfl_xor(sumsq, 32);
            const float rn = __builtin_amdgcn_rsqf(fmaxf(sumsq, 1e-24f));
            {
                f32x16 ag[2];
#pragma unroll
                for (int nt = 0; nt < 2; ++nt) {
#pragma unroll
                    for (int i = 0; i < 16; ++i) ag[nt][i] = 0.f;
                    const bf16* g2r = F.RG2 + ((size_t)l * 384 + 64 * h + 32 * nt + r) * 128 + 8 * hh;
#pragma unroll
                    for (int ks = 0; ks < 8; ++ks)
                        ag[nt] = __builtin_amdgcn_mfma_f32_32x32x16_bf16(*(const bf16x8*)(g2r + 16 * ks), *(const LAS bf16x8*)(sgr + 16 * ks), ag[nt], 0, 0, 0);
                }
#pragma unroll
                for (int nt = 0; nt < 2; ++nt)
#pragma unroll
                    for (int g = 0; g < 4; ++g) { const int n4 = 64 * h + 32 * nt + 8 * g + 4 * hh;
                        *(u32x2*)(Y + row * DM + 640 + n4) = pack4((f32x4){ag[nt][4 * g + 0], ag[nt][4 * g + 1], ag[nt][4 * g + 2], ag[nt][4 * g + 3]}); }
            }
#pragma unroll
            for (int nt = 0; nt < 2; ++nt) {
                f32x16 aw, aa;
#pragma unroll
                for (int i = 0; i < 16; ++i) { aw[i] = 0.f; aa[i] = 0.f; }
                const int nrow = 64 * h + 32 * nt + r;
                const bf16* w2r = F.RW2 + ((size_t)l * 384 + nrow) * 64 + 8 * hh; const bf16* a2r = F.RA2 + ((size_t)l * 384 + nrow) * 64 + 8 * hh;
#pragma unroll
                for (int ks = 0; ks < 4; ++ks) {
                    aw = __builtin_amdgcn_mfma_f32_32x32x16_bf16(*(const bf16x8*)(w2r + 16 * ks), *(const LAS bf16x8*)(twr + 16 * ks), aw, 0, 0, 0);
                    aa = __builtin_amdgcn_mfma_f32_32x32x16_bf16(*(const bf16x8*)(a2r + 16 * ks), *(const LAS bf16x8*)(xar + 16 * ks), aa, 0, 0, 0); }
#pragma unroll
                for (int g = 0; g < 4; ++g) { const int n4 = 64 * h + 32 * nt + 8 * g + 4 * hh;
                    f32x4 rc = unpack4(*(const u32x2*)(prow + n4)), kc = unpack4(*(const u32x2*)(prow + 384 + n4)), vc = unpack4(*(const u32x2*)(prow + 768 + n4));
                    f32x4 rp = (f32x4){0.f, 0.f, 0.f, 0.f}, kp = rp, vp = rp;
                    if (hasprev) { rp = unpack4(*(const u32x2*)(pprev + n4)); kp = unpack4(*(const u32x2*)(pprev + 384 + n4)); vp = unpack4(*(const u32x2*)(pprev + 768 + n4)); }
                    const f32x4 mr = *(const f32x4*)(mu + n4), mk = *(const f32x4*)(mu + 384 + n4), mv = *(const f32x4*)(mu + 768 + n4);
                    rc = rc + (rp - rc) * mr; kc = kc + (kp - kc) * mk; vc = vc + (vp - vc) * mv;
                    const f32x4 w0 = *(const f32x4*)(F.rwkv_w0 + l * DC + n4), a0 = *(const f32x4*)(F.rwkv_a0 + l * DC + n4), kk_ = *(const f32x4*)(F.rwkv_k_k + l * DC + n4), ka_ = *(const f32x4*)(F.rwkv_k_a + l * DC + n4);
                    f32x4 dec, km, kk4, bv4;
#pragma unroll
                    for (int e = 0; e < 4; ++e) {
                        const float wv = -fsoftplus(-(w0[e] + aw[4 * g + e])) - 0.5f; dec[e] = __expf(-__expf(wv));
                        const float a = fsigmoid(a0[e] + aa[4 * g + e]);
                        kk4[e] = kc[e] * kk_[e] * rn; bv4[e] = kk4[e] * a;
                        km[e] = kc[e] * (1.f + (a - 1.f) * ka_[e]); }
                    *(u32x2*)(F.R + row * DC + n4) = pack4(rc); *(u32x2*)(F.K + row * DC + n4) = pack4(km); *(u32x2*)(F.V + row * DC + n4) = pack4(vc);
                    *(f32x4*)(F.WD + row * DC + n4) = dec; *(u32x2*)(F.KK + row * DC + n4) = pack4(kk4); *(u32x2*)(F.BV + row * DC + n4) = pack4(bv4); asm volatile("" ::: "memory"); }
            }
        }
    }
    __syncthreads();
}

__device__ __forceinline__ void rwkv_scan_item(Frame& F, const int it) {
    const int tid = opaque_tid();
    const int b = it / 12, h = (it % 12) >> 1, hf = it & 1;
    constexpr int BUFF = 5 * 2048 + 1024;
    LAS float* buf = (LAS float*)F.lds;
    LAS float* obuf = buf + 2 * BUFF;
    const int gl = tid & 15, row = tid >> 4;
    const int st = tid >> 4, q = tid & 15, vst = tid >> 3, vq = tid & 7;
    const size_t base = (size_t)b * SEQ * DC + 64 * h;
    const bf16* gKK = F.KK + base + (size_t)st * DC + 4 * q; const bf16* gBV = F.BV + base + (size_t)st * DC + 4 * q;
    const bf16* gK = F.K + base + (size_t)st * DC + 4 * q;   const bf16* gR = F.R + base + (size_t)st * DC + 4 * q;
    const float* gW = F.WD + base + (size_t)st * DC + 4 * q;
    const bf16* gV = F.V + base + (size_t)vst * DC + 32 * hf + 4 * vq;
    float* gO = F.O + base + 32 * hf + (size_t)(tid >> 4) * DC + 2 * (tid & 15);
    u32x2 rkk, rbv, rk, rr, rv = (u32x2){0u, 0u}; f32x4 rw;
#define SC_LOAD(ck) do { const size_t _o = (size_t)(ck) * 32 * DC; rkk = *(const u32x2*)(gKK + _o); rbv = *(const u32x2*)(gBV + _o); rk = *(const u32x2*)(gK + _o); rr = *(const u32x2*)(gR + _o); \
        rw = *(const f32x4*)(gW + _o); if (tid < 256) rv = *(const u32x2*)(gV + _o); } while (0)
#define SC_STORE(bb) do { LAS float* _b = (bb); *(LAS f32x4*)(_b + st * 64 + 4 * q) = unpack4(rkk); *(LAS f32x4*)(_b + 2048 + st * 64 + 4 * q) = rw; *(LAS f32x4*)(_b + 4096 + st * 64 + 4 * q) = unpack4(rbv); \
        *(LAS f32x4*)(_b + 6144 + st * 64 + 4 * q) = unpack4(rk); *(LAS f32x4*)(_b + 8192 + st * 64 + 4 * q) = unpack4(rr); if (tid < 256) *(LAS f32x4*)(_b + 10240 + vst * 32 + 4 * vq) = unpack4(rv); } while (0)
    SC_LOAD(0); SC_STORE(buf);
    __syncthreads();
    float s0 = 0.f, s1 = 0.f, s2 = 0.f, s3 = 0.f;
    for (int ck = 0; ck < SEQ / 32; ++ck) {
        const LAS float* cb = buf + (ck & 1) * BUFF; LAS float* ob = obuf + (ck & 1) * 1024;
        if (ck + 1 < SEQ / 32) SC_LOAD(ck + 1);
#pragma unroll 4
        for (int tt = 0; tt < 32; ++tt) {
            const f32x4 kk = *(const LAS f32x4*)(cb + tt * 64 + 4 * gl), w = *(const LAS f32x4*)(cb + 2048 + tt * 64 + 4 * gl), bb = *(const LAS f32x4*)(cb + 4096 + tt * 64 + 4 * gl);
            const f32x4 k4 = *(const LAS f32x4*)(cb + 6144 + tt * 64 + 4 * gl), r4 = *(const LAS f32x4*)(cb + 8192 + tt * 64 + 4 * gl);
            const float vv = cb[10240 + tt * 32 + row];
            float p = (s0 * kk[0] + s1 * kk[1]) + (s2 * kk[2] + s3 * kk[3]);
            p = red16(p);
            s0 = fmaf(s0, w[0], vv * k4[0]); s1 = fmaf(s1, w[1], vv * k4[1]); s2 = fmaf(s2, w[2], vv * k4[2]); s3 = fmaf(s3, w[3], vv * k4[3]);
            s0 = fmaf(-p, bb[0], s0); s1 = fmaf(-p, bb[1], s1); s2 = fmaf(-p, bb[2], s2); s3 = fmaf(-p, bb[3], s3);
            float o = (s0 * r4[0] + s1 * r4[1]) + (s2 * r4[2] + s3 * r4[3]);
            o = red16(o);
            if (gl == 0) ob[tt * 32 + row] = o;
        }
        if (ck + 1 < SEQ / 32) SC_STORE(buf + ((ck + 1) & 1) * BUFF);
        __syncthreads();
        *(f32x2*)(gO + (size_t)ck * 32 * DC) = *(const LAS f32x2*)(ob + 2 * tid);
    }
#undef SC_LOAD
#undef SC_STORE
}
__device__ __forceinline__ void lru_fin_chunk(Frame& F, const int ch) {
    const int tid = opaque_tid(); if (tid >= 384) return;
    const int q = tid % 96, rs = tid / 96, b = ch >> 5, n = ch & 31;
    f32x4 hin = (f32x4){0.f, 0.f, 0.f, 0.f};
    for (int j = 0; j < n; ++j) { const f32x4 a = *(const f32x4*)(F.LRUSA + (size_t)(b * 32 + j) * DB + 4 * q), hh = *(const f32x4*)(F.LRUSH + (size_t)(b * 32 + j) * DB + 4 * q); hin = a * hin + hh; }
    bf16* Y = F.HY;
#pragma unroll 4
    for (int t = rs; t < 128; t += 4) { const size_t row = (size_t)ch * 128 + t;
        const f32x4 q1 = unpack4(*(const u32x2*)(Y + row * DM + 256 + 4 * q)), q2 = unpack4(*(const u32x2*)(F.Q2 + row * DB + 4 * q));
        *(u32x2*)(Y + row * DM + 256 + 4 * q) = pack4(q1 + q2 * hin); }
}
__device__ __forceinline__ void rwkv_fin_phase(Frame& F, const int l) {
    const int gw = F.vcu * NWAVES + F.wave, NGW = F.G * NWAVES, lane = opaque_tid() & 63, sub = lane >> 4, q = lane & 15;
    bf16* Y = F.HY;
    for (int idx = gw * 4 + sub; idx < M * 6; idx += NGW * 4) {
        const int m = idx / 6, h = idx - 6 * m; const int n4 = 64 * h + 4 * q; const size_t o = (size_t)m * DC + n4;
        const f32x4 ov = *(const f32x4*)(F.O + o);
        const float mean = red16((ov[0] + ov[1]) + (ov[2] + ov[3])) * (1.f / 64.f);
        const f32x4 d = ov - mean;
        const float var = red16((d[0] * d[0] + d[1] * d[1]) + (d[2] * d[2] + d[3] * d[3])) * (1.f / 64.f);
        const float rstd = __builtin_amdgcn_rsqf(var + 64e-5f);
        const f32x4 lw = *(const f32x4*)(F.rwkv_ln_w + l * DC + n4), lb = *(const f32x4*)(F.rwkv_ln_b + l * DC + n4), rk = *(const f32x4*)(F.rwkv_r_k + l * DC + n4);
        const f32x4 r4 = unpack4(*(const u32x2*)(F.R + o)), k4 = unpack4(*(const u32x2*)(F.K + o)), v4 = unpack4(*(const u32x2*)(F.V + o));
        const f32x4 t4 = r4 * k4 * rk;
        const float bs = red16((t4[0] + t4[1]) + (t4[2] + t4[3]));
        const f32x4 g4 = unpack4(*(const u32x2*)(Y + (size_t)m * DM + 640 + n4));
        const f32x4 y = ((d * rstd) * lw + lb + v4 * bs) * g4;
        *(u32x2*)(Y + (size_t)m * DM + 640 + n4) = pack4(y);
    }
}
__device__ __forceinline__ void ffn_glu_phase(Frame& F, const int l) {
    constexpr int CG = DFF / 8, SEG = 32, NSEG = M / SEG;
    const int gt = F.vcu * (NWAVES * 64) + opaque_tid(), NGT = F.G * NWAVES * 64;
    for (int id = gt; id < NSEG * CG; id += NGT) {
        const int rsg = id / CG, cg8 = id - rsg * CG; const int col = 8 * cg8; const size_t row0 = (size_t)rsg * SEG;
        float w0[8], w1[8], w2[8], cb[8], x1[8], x2[8];
        { const float* cw = F.ffn_conv_w + (size_t)l * 3 * DFF + col; const float* cbp = F.ffn_conv_b + (size_t)l * DFF + col;
#pragma unroll
          for (int e = 0; e < 8; ++e) { w0[e] = cw[e]; w1[e] = cw[DFF + e]; w2[e] = cw[2 * DFF + e]; cb[e] = cbp[e]; x1[e] = 0.f; x2[e] = 0.f; } }
        if ((row0 & (SEQ - 1)) != 0) {
            const u32x4 a = *(const u32x4*)(F.UG + (row0 - 2) * DFF + col), bq = *(const u32x4*)(F.UG + (row0 - 1) * DFF + col);
            x2[0] = bflo(a.x); x2[1] = bfhi(a.x); x2[2] = bflo(a.y); x2[3] = bfhi(a.y); x2[4] = bflo(a.z); x2[5] = bfhi(a.z); x2[6] = bflo(a.w); x2[7] = bfhi(a.w);
            x1[0] = bflo(bq.x); x1[1] = bfhi(bq.x); x1[2] = bflo(bq.y); x1[3] = bfhi(bq.y); x1[4] = bflo(bq.z); x1[5] = bfhi(bq.z); x1[6] = bflo(bq.w); x1[7] = bfhi(bq.w);
        }
#pragma unroll 4
        for (int i = 0; i < SEG; ++i) {
            const u32x4 gq = *(const u32x4*)(F.UG + (row0 + i) * DFF + col), vq = *(const u32x4*)(F.UV + (row0 + i) * DFF + col);
            float x0[8], vv[8], y[8];
            x0[0] = bflo(gq.x); x0[1] = bfhi(gq.x); x0[2] = bflo(gq.y); x0[3] = bfhi(gq.y); x0[4] = bflo(gq.z); x0[5] = bfhi(gq.z); x0[6] = bflo(gq.w); x0[7] = bfhi(gq.w);
            vv[0] = bflo(vq.x); vv[1] = bfhi(vq.x); vv[2] = bflo(vq.y); vv[3] = bfhi(vq.y); vv[4] = bflo(vq.z); vv[5] = bfhi(vq.z); vv[6] = bflo(vq.w); vv[7] = bfhi(vq.w);
#pragma unroll
            for (int e = 0; e < 8; ++e) { const float gc = cb[e] + w0[e] * x2[e] + w1[e] * x1[e] + w2[e] * x0[e]; y[e] = fsilu(gc) * vv[e]; x2[e] = x1[e]; x1[e] = x0[e]; }
            u32x4 o; o.x = pk2(y[0], y[1]); o.y = pk2(y[2], y[3]); o.z = pk2(y[4], y[5]); o.w = pk2(y[6], y[7]);
            *(u32x4*)(F.UV + (row0 + i) * DFF + col) = o;
        }
    }
}

struct Args { const float* in[35]; float* out; unsigned char* ws; int ph_lo, ph_hi; };
__device__ __forceinline__ void frame_init(Frame& F, LAS unsigned char* lds) {
    typedef const __attribute__((address_space(4))) Args* ArgP;
    ArgP ap = (ArgP)__builtin_amdgcn_kernarg_segment_ptr(); asm volatile("" : "+s"(ap));
    F.lds = lds; F.MISC = (volatile LAS unsigned*)(lds + MISC_OFF);
    F.wave = __builtin_amdgcn_readfirstlane(threadIdx.x >> 6);
    F.G = gridDim.x; { const int bx = blockIdx.x; F.vcu = (F.G % 8 == 0) ? (bx % 8) * (F.G / 8) + bx / 8 : bx; }
    unsigned char* ws = ap->ws;
    F.ctl = (gu32*)(ws + WS_CTL);
    F.x = ap->in[0]; F.c = ap->in[1]; F.w_mod = ap->in[2]; F.b_mod = ap->in[3]; F.norm_mix = ap->in[4]; F.w_in = ap->in[5]; F.w_out = ap->in[6];
    F.sgu_ln_g = ap->in[7]; F.sgu_ln_b = ap->in[8]; F.sgu_w = ap->in[9]; F.sgu_b = ap->in[10];
    F.lru_conv_w = ap->in[11]; F.lru_conv_b = ap->in[12]; F.lru_w_a = ap->in[13]; F.lru_b_a = ap->in[14]; F.lru_w_x = ap->in[15]; F.lru_b_x = ap->in[16]; F.lru_lambda = ap->in[17];
    F.rwkv_mu = ap->in[18]; F.rwkv_w0 = ap->in[19]; F.rwkv_w2 = ap->in[20]; F.rwkv_a0 = ap->in[21]; F.rwkv_a2 = ap->in[22]; F.rwkv_g2 = ap->in[23]; F.rwkv_k_k = ap->in[24]; F.rwkv_k_a = ap->in[25];
    F.rwkv_r_k = ap->in[26]; F.rwkv_ln_w = ap->in[27]; F.rwkv_ln_b = ap->in[28]; F.norm_ffn = ap->in[29]; F.ffn_w_up = ap->in[30]; F.ffn_conv_w = ap->in[31]; F.ffn_conv_b = ap->in[32];
    F.ffn_w_down = ap->in[33]; F.norm_final = ap->in[34]; F.out = ap->out;
    F.SGUW = (bf16*)(ws + WS_SMALL + SM_SGUW); F.LRUWA = (bf16*)(ws + WS_SMALL + SM_LRUWA); F.LRUWX = (bf16*)(ws + WS_SMALL + SM_LRUWX);
    F.RW2 = (bf16*)(ws + WS_SMALL + SM_RW2); F.RA2 = (bf16*)(ws + WS_SMALL + SM_RA2); F.RG2 = (bf16*)(ws + WS_SMALL + SM_RG2);
    F.MOD = (float*)(ws + WS_MOD); F.LRUSA = (float*)(ws + WS_LRUS); F.LRUSH = F.LRUSA + 256 * DB;
    F.WIN = (bf16*)(ws + WS_WIN); F.WOUT = (bf16*)(ws + WS_WOUT); F.WUP = (bf16*)(ws + WS_WUP); F.WDN = (bf16*)(ws + WS_WDN);
    F.HY = (bf16*)(ws + WS_HY); F.P = (bf16*)(ws + WS_P); F.UG = (bf16*)(ws + WS_P); F.UV = (bf16*)(ws + WS_UV); F.O = (float*)(ws + WS_P);
    F.R = (bf16*)(ws + WS_R); F.K = (bf16*)(ws + WS_K); F.V = (bf16*)(ws + WS_V); F.KK = (bf16*)(ws + WS_KK); F.BV = (bf16*)(ws + WS_BV); F.WD = (float*)(ws + WS_WD); F.Q2 = (bf16*)(ws + WS_Q2);
}
__global__ void __launch_bounds__(NWAVES * 64, 2) mk_fwd(Args args) {
    extern __shared__ __attribute__((aligned(16))) unsigned char lds_raw[];
    LAS unsigned char* const lds = (LAS unsigned char*)lds_raw;
    for (int u = threadIdx.x; u < (LDS_BYTES - LDSCTL_OFF) / 4; u += NWAVES * 64) ((LAS unsigned*)(lds + LDSCTL_OFF))[u] = 0u;
    __syncthreads();
#if MK_MODE == 2
    XcdBarrier bar = xcd_barrier_post((unsigned*)((gu32*)(args.ws + WS_CTL) + CW_BAR), (volatile LAS unsigned*)(lds + MISC_OFF) + 8);
#define GRID_BAR() xcd_barrier(bar)
#elif MK_MODE == 1
    cg::grid_group grid = cg::this_grid();
#define GRID_BAR() grid.sync()
#else
#define GRID_BAR() do { } while (0)
#endif
    const int lo = args.ph_lo, hi = args.ph_hi;
#define IN(k) (lo <= (k) && (k) < hi)
#ifndef MK_PHMASK
#define MK_PHMASK 0xFFF
#endif
#define EN(t) (((MK_PHMASK) >> (t)) & 1)
#define SEAM(k) do { if (IN(k) && IN((k) + 1)) GRID_BAR(); } while (0)

    if (EN(0) && IN(0)) { Frame F; frame_init(F, lds); p0_prologue(F); } SEAM(0);
    for (int l = 0; l < NL; ++l) {
        const int pb = 1 + 10 * l;
        if (EN(1) && IN(pb + 0)) { Frame F; frame_init(F, lds); const float* mod_l = F.MOD + (size_t)l * NB * NMOD; const float* Xin = (l == 0) ? F.x : F.out; (void)mod_l; (void)Xin; norm_mod_phase(F, Xin, F.norm_mix + l * DM, mod_l, 0, 1, F.HY); } SEAM(pb + 0);
        if (EN(2) && IN(pb + 1)) { Frame F; frame_init(F, lds); const float* mod_l = F.MOD + (size_t)l * NB * NMOD; const float* Xin = (l == 0) ? F.x : F.out; (void)mod_l; (void)Xin; pg8::Gemm g{F.HY, F.WIN + (size_t)l * PINP * DM, M, PINP, DM}; pg8::StaticOrder S; S.init(M, PINP, F.G, (int)blockIdx.x);
            pg8::EpiBf16<0> E{F.P, PINP, nullptr, 0, 0, 1.f};
            pg8::gemm_phase<pg8::EpiBf16<0>, pg8::StaticOrder, true, true>(F.lds, g, S, E); } SEAM(pb + 1);
        if (EN(3) && IN(pb + 2)) { Frame F; frame_init(F, lds); const float* mod_l = F.MOD + (size_t)l * NB * NMOD; const float* Xin = (l == 0) ? F.x : F.out; (void)mod_l; (void)Xin; for (int ch = F.vcu; ch < M / 128; ch += F.G) mix_chunk(F, l, ch); } SEAM(pb + 2);
        if (EN(4) && IN(pb + 3)) { Frame F; frame_init(F, lds); const float* mod_l = F.MOD + (size_t)l * NB * NMOD; const float* Xin = (l == 0) ? F.x : F.out; (void)mod_l; (void)Xin;
            if (F.G >= 128) { if (F.vcu < 96) rwkv_scan_item(F, F.vcu); else for (int ch = F.vcu - 96; ch < M / 128; ch += F.G - 96) lru_fin_chunk(F, ch); }
            else { for (int it = F.vcu; it < 96; it += F.G) { rwkv_scan_item(F, it); __syncthreads(); } for (int ch = F.vcu; ch < M / 128; ch += F.G) lru_fin_chunk(F, ch); }
        } SEAM(pb + 3);
        if (EN(5) && IN(pb + 4)) { Frame F; frame_init(F, lds); const float* mod_l = F.MOD + (size_t)l * NB * NMOD; const float* Xin = (l == 0) ? F.x : F.out; (void)mod_l; (void)Xin; rwkv_fin_phase(F, l); } SEAM(pb + 4);
        if (EN(6) && IN(pb + 5)) { Frame F; frame_init(F, lds); const float* mod_l = F.MOD + (size_t)l * NB * NMOD; const float* Xin = (l == 0) ? F.x : F.out; (void)mod_l; (void)Xin; pg8::Gemm g{F.HY, F.WOUT + (size_t)l * DM * DM, M, DM, DM}; pg8::StaticOrder S; S.init(M, DM, F.G, (int)blockIdx.x);
            pg8::EpiRes E{Xin, F.out, DM, mod_l + 2 * DM, NMOD, SEQ};
            pg8::gemm_phase<pg8::EpiRes, pg8::StaticOrder, true, true>(F.lds, g, S, E); } SEAM(pb + 5);
        if (EN(7) && IN(pb + 6)) { Frame F; frame_init(F, lds); const float* mod_l = F.MOD + (size_t)l * NB * NMOD; const float* Xin = (l == 0) ? F.x : F.out; (void)mod_l; (void)Xin; norm_mod_phase(F, F.out, F.norm_ffn + l * DM, mod_l, 3, 4, F.HY); } SEAM(pb + 6);
        if (EN(8) && IN(pb + 7)) { Frame F; frame_init(F, lds); const float* mod_l = F.MOD + (size_t)l * NB * NMOD; const float* Xin = (l == 0) ? F.x : F.out; (void)mod_l; (void)Xin; pg8::Gemm g{F.HY, F.WUP + (size_t)l * DUP * DM, M, DUP, DM}; pg8::StaticOrder S; S.init(M, DUP, F.G, (int)blockIdx.x);
            pg8::EpiGV E{F.UG, F.UV, DFF};
            pg8::gemm_phase<pg8::EpiGV, pg8::StaticOrder, true, true>(F.lds, g, S, E); } SEAM(pb + 7);
        if (EN(9) && IN(pb + 8)) { Frame F; frame_init(F, lds); const float* mod_l = F.MOD + (size_t)l * NB * NMOD; const float* Xin = (l == 0) ? F.x : F.out; (void)mod_l; (void)Xin; ffn_glu_phase(F, l); } SEAM(pb + 8);
        if (EN(10) && IN(pb + 9)) { Frame F; frame_init(F, lds); const float* mod_l = F.MOD + (size_t)l * NB * NMOD; const float* Xin = (l == 0) ? F.x : F.out; (void)mod_l; (void)Xin; pg8::Gemm g{F.UV, F.WDN + (size_t)l * DM * DFF, M, DM, DFF}; pg8::StaticOrder S; S.init(M, DM, F.G, (int)blockIdx.x);
            pg8::EpiRes E{F.out, F.out, DM, mod_l + 5 * DM, NMOD, SEQ};
            pg8::gemm_phase<pg8::EpiRes, pg8::StaticOrder, true, true>(F.lds, g, S, E); } SEAM(pb + 9);
    }
    if (EN(11) && IN(NPHASE - 1)) { Frame F; frame_init(F, lds); final_norm_phase(F, F.out, F.norm_final); }
#undef IN
#undef SEAM
}

extern "C" void kernel_launch(void* const* d_in, const int* in_sizes, int n_in, void* d_out, int out_size, void* d_ws, size_t ws_size, hipStream_t stream) {
    static int grid = 0;
    if (grid == 0) {
        if (n_in != 35 || in_sizes[0] != M * DM || out_size != M * DM || ws_size < WS_END) { fprintf(stderr, "kernel_launch: unexpected shapes (n_in %d, in0 %d, out %d, ws %zu); nothing launched\n", n_in, n_in > 0 ? in_sizes[0] : -1, out_size, ws_size); grid = -1; return; }
        int dev = 0, cus = 0, per_cu = 0;
        if (hipGetDevice(&dev) != hipSuccess || hipDeviceGetAttribute(&cus, hipDeviceAttributeMultiprocessorCount, dev) != hipSuccess) { grid = -1; return; }
        if (hipFuncSetAttribute((const void*)mk_fwd, hipFuncAttributeMaxDynamicSharedMemorySize, LDS_BYTES) != hipSuccess) { fprintf(stderr, "kernel_launch: hipFuncSetAttribute failed\n"); grid = -1; return; }
        if (hipOccupancyMaxActiveBlocksPerMultiprocessor(&per_cu, (const void*)mk_fwd, NWAVES * 64, LDS_BYTES) != hipSuccess || per_cu < 1) { fprintf(stderr, "kernel_launch: occupancy query says %d blocks per CU\n", per_cu); per_cu = 1; }
        (void)hipGetLastError();
        grid = cus;
    }
    if (grid < 0) return;
    Args a{};
    for (int i = 0; i < 35; ++i) a.in[i] = (const float*)d_in[i];
    a.out = (float*)d_out; a.ws = (unsigned char*)d_ws;
#if MK_MODE == 0
    for (int ph = 0; ph < NPHASE; ++ph) { a.ph_lo = ph; a.ph_hi = ph + 1; hipLaunchKernelGGL(mk_fwd, dim3(grid), dim3(NWAVES * 64), LDS_BYTES, stream, a); }
#else
    (void)hipMemsetAsync((char*)d_ws + WS_CTL, 0, CTL_ZERO_BYTES, stream);
    a.ph_lo = 0; a.ph_hi = NPHASE;
#if MK_MODE == 1
    void* kargs[] = {&a};
    hipError_t e = hipLaunchCooperativeKernel((const void*)mk_fwd, dim3(grid), dim3(NWAVES * 64), kargs, LDS_BYTES, stream);
    if (e != hipSuccess) fprintf(stderr, "kernel_launch: cooperative launch failed: %s (grid %d)\n", hipGetErrorString(e), grid);
#else
    hipLaunchKernelGGL(mk_fwd, dim3(grid), dim3(NWAVES * 64), LDS_BYTES, stream, a);
#endif
#endif
}
```

```cpp
#include <hip/hip_runtime.h>
#include <hip/hip_cooperative_groups.h>
#include <cstdio>
#include <cstdint>
namespace pg8 {
#define PG8_LAS __attribute__((address_space(3)))
typedef unsigned short bf16_t;
typedef short bf16x8 __attribute__((ext_vector_type(8)));
typedef float f32x4 __attribute__((ext_vector_type(4)));
typedef unsigned u32x4 __attribute__((ext_vector_type(4)));
constexpr int BM = 256, BK = 64, HALF = 128, HTB = HALF * BK * 2  , STAGE_BYTES = 8 * HTB, NXCD = 8, WGM = 8;

__host__ __device__ __forceinline__ int lds_byte(int r, int c) { const int st = (r >> 4) * 2 + (c >> 5), rr = r & 15, cc = c & 31, ob = rr * 64 + cc * 2; return st * 1024 + (ob ^ (((ob >> 9) & 1) << 5)); }
__host__ __device__ __forceinline__ void stage_rc(int b, int& R, int& C) { const int st = b / 1024, sb = b % 1024, swz = sb ^ (((sb >> 9) & 1) << 5); R = (st >> 1) * 16 + swz / 64; C = (st & 1) * 32 + (swz % 64) / 2; }
__host__ __device__ __forceinline__ int perm32(int rho) { const int n = rho >> 4, i = rho & 15; return 8 * (i >> 2) + 4 * n + (i & 3); }

struct Unit { int pm, pn; };
struct Gemm { const bf16_t* A; const bf16_t* Bt; int M, N, K; };

struct StaticOrder {
    int nM, nN, nwg, G, c;
    __host__ __device__ void init(int M, int N, int G_, int c_) { nM = M / BM; nN = N / BM; nwg = nM * nN; G = G_; c = c_; }
    __host__ __device__ bool next(int i, Unit& u) const {
        const long L = (long)i * G + c; if (L >= nwg) return false;
        int wgid = (int)L; { const int q = nwg / NXCD, r = nwg % NXCD, xcd = wgid % NXCD, off = wgid / NXCD; wgid = (xcd < r ? xcd * (q + 1) : r * (q + 1) + (xcd - r) * q) + off; }
        const int nig = WGM * nN, gid = wgid / nig, fm = gid * WGM, gsz = (nM - fm) < WGM ? (nM - fm) : WGM;
        u.pm = fm + ((wgid % nig) % gsz); u.pn = (wgid % nig) / gsz; return true;
    }
    __device__ __forceinline__ void a_ready(const Unit&) const {}
    __device__ __forceinline__ void done(const Unit&) const {}
};

__device__ __forceinline__ unsigned cvt_pk_bf16(float lo, float hi) { unsigned r; asm volatile("v_cvt_pk_bf16_f32 %0, %1, %2" : "=v"(r) : "v"(lo), "v"(hi)); return r; }
typedef float f32x2 __attribute__((ext_vector_type(2)));
__device__ __forceinline__ f32x2 gelu_pk(f32x2 v) {
    const f32x2 av = __builtin_elementwise_abs(v), d = av * 0.2316418882f + 1.0f;
    f32x2 t; t.x = __builtin_amdgcn_rcpf(d.x); t.y = __builtin_amdgcn_rcpf(d.y);
    f32x2 q = t * 0.5307027145f + (-0.7265760135f); q = q * t + 0.7107068705f; q = q * t + (-0.142248368f); q = q * t + 0.127414796f; q = q * t;
    const f32x2 s = (v * v) * (-0.72134752044f);
    f32x2 e; e.x = __builtin_amdgcn_exp2f(s.x); e.y = __builtin_amdgcn_exp2f(s.y);
    const f32x2 m = v * (q * e), r = v - m;
    f32x2 o; o.x = v.x < 0.f ? m.x : r.x; o.y = v.y < 0.f ? m.y : r.y; return o;
}

template <int ACT  > struct EpiBf16 {
    static constexpr bool PERM = true, AFTER_DRAIN = false; static_assert(ACT == 0 || ACT == 1, "EpiBf16: ACT is 0 (none) or 1 (gelu_pk)");
    bf16_t* O; int ldc; const float* bias; int split_cols; size_t split_stride; float scale0;
    __device__ __forceinline__ void operator()(const f32x4 (&acc)[2][2][4][2], const Unit& u, int wr, int wc, int fr, int fq) const {
        const int row0 = u.pm * BM + wr * 64 + fr; int colt = u.pn * BM; bf16_t* base = O;
        float sc = 1.f; if (split_cols) { const int t = colt / split_cols; base += (size_t)t * split_stride; colt -= t * split_cols; if (t == 0) sc = scale0; }
        const int col0 = colt + wc * 32 + 8 * fq, bcol0 = u.pn * BM + wc * 32 + 8 * fq;
        f32x4 bv[2][2];
#pragma unroll
        for (int bj = 0; bj < 2; ++bj)
#pragma unroll
            for (int n = 0; n < 2; ++n) bv[bj][n] = bias ? *(const f32x4*)(bias + bcol0 + bj * HALF + 4 * n) : (f32x4){0.f, 0.f, 0.f, 0.f};
#pragma unroll
        for (int ai = 0; ai < 2; ++ai)
#pragma unroll
            for (int m = 0; m < 4; ++m) { bf16_t* rowp = base + (size_t)(row0 + ai * HALF + m * 16) * ldc + col0;
#pragma unroll
                for (int bj = 0; bj < 2; ++bj) { f32x4 v0 = acc[ai][bj][m][0] + bv[bj][0], v1 = acc[ai][bj][m][1] + bv[bj][1];
                    if (ACT == 1) { f32x2 a = gelu_pk((f32x2){v0[0], v0[1]}), b = gelu_pk((f32x2){v0[2], v0[3]}), c = gelu_pk((f32x2){v1[0], v1[1]}), d = gelu_pk((f32x2){v1[2], v1[3]});
                        v0 = (f32x4){a.x, a.y, b.x, b.y}; v1 = (f32x4){c.x, c.y, d.x, d.y}; }
                    v0 = v0 * sc; v1 = v1 * sc; u32x4 w; w.x = cvt_pk_bf16(v0[0], v0[1]); w.y = cvt_pk_bf16(v0[2], v0[3]); w.z = cvt_pk_bf16(v1[0], v1[1]); w.w = cvt_pk_bf16(v1[2], v1[3]);
                    *(u32x4*)(rowp + bj * HALF) = w; } }
    }
};

struct EpiRes {
    static constexpr bool PERM = false, AFTER_DRAIN = false;
    const float* base; float* out; int ldc; const float* gate; int gate_ld; int rows_per_batch;
    __device__ __forceinline__ void operator()(const f32x4 (&acc)[2][2][4][2], const Unit& u, int wr, int wc, int fr, int fq) const {
        const int row0 = u.pm * BM + wr * 64 + fr, col0 = u.pn * BM + wc * 32 + 4 * fq;
        const float* gp = gate + (size_t)((u.pm * BM) / rows_per_batch) * gate_ld + col0;
        f32x4 gv[2][2];
#pragma unroll
        for (int bj = 0; bj < 2; ++bj)
#pragma unroll
            for (int n = 0; n < 2; ++n) gv[bj][n] = *(const f32x4*)(gp + bj * HALF + n * 16);
        f32x4 pre[3][2][2];
#define ER_LOAD(slot, g_) do { const size_t off_ = (size_t)(row0 + ((g_) >> 2) * HALF + ((g_) & 3) * 16) * ldc + col0; _Pragma("unroll") for (int bj = 0; bj < 2; ++bj) _Pragma("unroll") for (int n = 0; n < 2; ++n) pre[slot][bj][n] = *(const f32x4*)(base + off_ + bj * HALF + n * 16); } while (0)
        ER_LOAD(0, 0); ER_LOAD(1, 1);
#pragma unroll
        for (int g = 0; g < 8; ++g) { const int ai = g >> 2, m = g & 3; const size_t off = (size_t)(row0 + ai * HALF + m * 16) * ldc + col0;
            if (g + 2 < 8) ER_LOAD((g + 2) % 3, g + 2);
#pragma unroll
            for (int bj = 0; bj < 2; ++bj)
#pragma unroll
                for (int n = 0; n < 2; ++n) *(f32x4*)(out + off + bj * HALF + n * 16) = pre[g % 3][bj][n] + gv[bj][n] * acc[ai][bj][m][n]; }
#undef ER_LOAD
    }
};
struct EpiGV {
    static constexpr bool PERM = true, AFTER_DRAIN = false;
    bf16_t* G; bf16_t* V; int ldc;
    __device__ __forceinline__ void operator()(const f32x4 (&acc)[2][2][4][2], const Unit& u, int wr, int wc, int fr, int fq) const {
        const int row0 = u.pm * BM + wr * 64 + fr, col0 = u.pn * HALF + wc * 32 + 8 * fq;
#pragma unroll
        for (int ai = 0; ai < 2; ++ai)
#pragma unroll
            for (int m = 0; m < 4; ++m) { const size_t off = (size_t)(row0 + ai * HALF + m * 16) * ldc + col0;
#pragma unroll
                for (int bj = 0; bj < 2; ++bj) { const f32x4 v0 = acc[ai][bj][m][0], v1 = acc[ai][bj][m][1];
                    u32x4 w; w.x = cvt_pk_bf16(v0[0], v0[1]); w.y = cvt_pk_bf16(v0[2], v0[3]); w.z = cvt_pk_bf16(v1[0], v1[1]); w.w = cvt_pk_bf16(v1[2], v1[3]);
                    *(u32x4*)((bj ? V : G) + off) = w; } }
    }
};
template <class Epi, class Sched, bool ALIGN_EPI = false, bool SP2 = false>
__device__ __forceinline__ void gemm_phase(PG8_LAS unsigned char* lds, const Gemm g, const Sched& S, const Epi& E) {
    int tid_ = threadIdx.x; asm volatile("" : "+v"(tid_));
    const int tid = tid_, wid = __builtin_amdgcn_readfirstlane(tid >> 6), lane = tid & 63, wr = wid >> 2, wc = wid & 3, fr = lane & 15, fq = lane >> 4;
    const int K = g.K, nt = K / BK;
    unsigned voffA[2], voffB[2];
#pragma unroll
    for (int i = 0; i < 2; ++i) { int R, C; stage_rc(tid * 16 + i * 8192, R, C); const int Rb = Epi::PERM ? ((R & ~31) + perm32(R & 31)) : R;
        voffA[i] = (unsigned)(R * K + C) * 2u; voffB[i] = (unsigned)(Rb * K + C) * 2u; }
    const size_t kstep = (size_t)(BK * 2);
    const size_t hstep = (size_t)HALF * K * 2;
    const size_t tstep = 2 * hstep;
    const unsigned ldsw = (unsigned)wid * 1024u;
    const int aoff = lds_byte(wr * 64 + fr, fq * 8), boff = lds_byte(wc * 32 + fr, fq * 8);
#define PG8_SA(b, h) (((b) * 2 + (h)) * HTB)
#define PG8_SB(b, h) ((4 + (b) * 2 + (h)) * HTB)
#define PG8_STAGE(bufoff, gbase, voff) do { _Pragma("unroll") for (int _i = 0; _i < 2; ++_i) \
        __builtin_amdgcn_global_load_lds((const unsigned*)((const char*)(gbase) + (voff)[_i]), (PG8_LAS unsigned*)(lds + (bufoff) + ldsw + _i * 8192), 16, 0, 0); } while (0)
#define PG8_LDA(dst, b, h) do { _Pragma("unroll") for (int m = 0; m < 4; ++m) _Pragma("unroll") for (int k = 0; k < 2; ++k) dst[m][k] = *(const PG8_LAS bf16x8*)(lds + PG8_SA(b, h) + aoff + m * 2048 + k * 1024); } while (0)
#define PG8_LDB(dst, b, h) do { _Pragma("unroll") for (int n = 0; n < 2; ++n) _Pragma("unroll") for (int k = 0; k < 2; ++k) dst[n][k] = *(const PG8_LAS bf16x8*)(lds + PG8_SB(b, h) + boff + n * 2048 + k * 1024); } while (0)
#define PG8_MMA(ai, bj, At, Bt) do { __builtin_amdgcn_s_setprio(1); _Pragma("unroll") for (int m = 0; m < 4; ++m) _Pragma("unroll") for (int n = 0; n < 2; ++n) _Pragma("unroll") for (int k = 0; k < 2; ++k) \
        acc[ai][bj][m][n] = __builtin_amdgcn_mfma_f32_16x16x32_bf16(Bt[n][k], At[m][k], acc[ai][bj][m][n], 0, 0, 0); __builtin_amdgcn_s_setprio(0); } while (0)
#define PG8_WAIT_V(n) asm volatile("s_waitcnt vmcnt(" #n ")" ::: "memory")
#define PG8_WAIT_L(n) asm volatile("s_waitcnt lgkmcnt(" #n ")" ::: "memory")
#define PG8_BAR __builtin_amdgcn_s_barrier()
#define PG8_SCHED __builtin_amdgcn_sched_barrier(0)
    Unit cur, nxt; int ui = 0;
    if (!S.next(0, cur)) return;
    f32x4 acc[2][2][4][2];
#pragma unroll
    for (int a = 0; a < 2; ++a)
#pragma unroll
        for (int b = 0; b < 2; ++b)
#pragma unroll
            for (int m = 0; m < 4; ++m)
#pragma unroll
                for (int n = 0; n < 2; ++n) acc[a][b][m][n] = (f32x4){0.f, 0.f, 0.f, 0.f};
    bf16x8 At[4][2], B0[2][2], B1[2][2];
    const char* cA = (const char*)g.A + (size_t)cur.pm * tstep; const char* cB = (const char*)g.Bt + (size_t)cur.pn * tstep;
    S.a_ready(cur);
    if constexpr (SP2) {
        PG8_STAGE(PG8_SB(0, 0), cB, voffB); PG8_STAGE(PG8_SB(0, 1), cB + hstep, voffB); PG8_STAGE(PG8_SA(0, 0), cA, voffA); PG8_STAGE(PG8_SA(0, 1), cA + hstep, voffA);
        if (wr == 1) PG8_BAR;
        PG8_WAIT_V(2); PG8_BAR;
        PG8_STAGE(PG8_SB(1, 0), cB + kstep, voffB); PG8_STAGE(PG8_SA(1, 0), cA + kstep, voffA); PG8_STAGE(PG8_SB(1, 1), cB + hstep + kstep, voffB);
        PG8_WAIT_V(6); PG8_BAR;
    } else {
        PG8_STAGE(PG8_SB(0, 0), cB, voffB); PG8_STAGE(PG8_SA(0, 0), cA, voffA); PG8_STAGE(PG8_SB(0, 1), cB + hstep, voffB); PG8_STAGE(PG8_SA(0, 1), cA + hstep, voffA);
        if (wr == 1) PG8_BAR;
        PG8_WAIT_V(4); PG8_BAR;
        PG8_STAGE(PG8_SB(1, 0), cB + kstep, voffB); PG8_STAGE(PG8_SA(1, 0), cA + kstep, voffA); PG8_STAGE(PG8_SB(1, 1), cB + hstep + kstep, voffB);
        PG8_WAIT_V(6); PG8_BAR;
    }
    for (;;) {
        const bool has_next = S.next(ui + 1, nxt);
        const char* nA = has_next ? (const char*)g.A + (size_t)nxt.pm * tstep : cA; const char* nB = has_next ? (const char*)g.Bt + (size_t)nxt.pn * tstep : cB;
        for (int t = 0; t < nt; t += 2) {
            const bool last = (t == nt - 2);
            const char* a1 = cA + (size_t)(t + 1) * kstep;
            const char* a2 = last ? nA : cA + (size_t)(t + 2) * kstep; const char* b2 = last ? nB : cB + (size_t)(t + 2) * kstep;
            const char* a3 = a2 + kstep; const char* b3 = b2 + kstep;
            if (last && has_next) S.a_ready(nxt);
            if constexpr (SP2) {
            PG8_LDB(B0, 0, 0); PG8_LDB(B1, 0, 1); PG8_SCHED; PG8_LDA(At, 0, 0); PG8_STAGE(PG8_SA(1, 1), a1 + hstep, voffA);
            PG8_WAIT_V(8); PG8_WAIT_L(0); PG8_BAR; PG8_MMA(0, 0, At, B0); PG8_MMA(0, 1, At, B1); PG8_BAR; PG8_SCHED;
            PG8_LDA(At, 0, 1); PG8_STAGE(PG8_SB(0, 0), b2, voffB); PG8_STAGE(PG8_SB(0, 1), b2 + hstep, voffB); PG8_STAGE(PG8_SA(0, 0), a2, voffA);
            PG8_WAIT_V(8); PG8_WAIT_L(0); PG8_BAR; PG8_MMA(1, 0, At, B0); PG8_MMA(1, 1, At, B1); PG8_BAR; PG8_SCHED;
            PG8_LDB(B0, 1, 0); PG8_LDB(B1, 1, 1); PG8_SCHED; PG8_LDA(At, 1, 0); PG8_STAGE(PG8_SA(0, 1), a2 + hstep, voffA);
            PG8_WAIT_V(8); PG8_WAIT_L(0); PG8_BAR; PG8_MMA(0, 0, At, B0); PG8_MMA(0, 1, At, B1); PG8_BAR; PG8_SCHED;
            PG8_LDA(At, 1, 1); PG8_STAGE(PG8_SB(1, 0), b3, voffB); PG8_STAGE(PG8_SB(1, 1), b3 + hstep, voffB); PG8_STAGE(PG8_SA(1, 0), a3, voffA);
            PG8_WAIT_V(8); PG8_WAIT_L(0); PG8_BAR; PG8_MMA(1, 0, At, B0); PG8_MMA(1, 1, At, B1); PG8_BAR; PG8_SCHED;
            } else {
            PG8_LDB(B0, 0, 0); PG8_SCHED; PG8_LDA(At, 0, 0); PG8_STAGE(PG8_SA(1, 1), a1 + hstep, voffA);
            PG8_WAIT_L(8); PG8_BAR; PG8_WAIT_L(0); PG8_MMA(0, 0, At, B0); PG8_BAR; PG8_SCHED;
            PG8_LDB(B1, 0, 1); PG8_STAGE(PG8_SB(0, 0), b2, voffB);
            PG8_BAR; PG8_WAIT_L(0); PG8_MMA(0, 1, At, B1); PG8_BAR;
            PG8_LDA(At, 0, 1); PG8_STAGE(PG8_SA(0, 0), a2, voffA);
            PG8_BAR; PG8_WAIT_L(0); PG8_MMA(1, 0, At, B0); PG8_BAR; PG8_SCHED;
            PG8_STAGE(PG8_SB(0, 1), b2 + hstep, voffB);
            PG8_WAIT_V(6); PG8_BAR; PG8_MMA(1, 1, At, B1); PG8_BAR;
            PG8_LDB(B0, 1, 0); PG8_SCHED; PG8_LDA(At, 1, 0); PG8_STAGE(PG8_SA(0, 1), a2 + hstep, voffA);
            PG8_WAIT_L(8); PG8_BAR; PG8_WAIT_L(0); PG8_MMA(0, 0, At, B0); PG8_BAR; PG8_SCHED;
            PG8_LDB(B1, 1, 1); PG8_STAGE(PG8_SB(1, 0), b3, voffB);
            PG8_BAR; PG8_WAIT_L(0); PG8_MMA(0, 1, At, B1); PG8_BAR;
            PG8_LDA(At, 1, 1); PG8_STAGE(PG8_SA(1, 0), a3, voffA);
            PG8_BAR; PG8_WAIT_L(0); PG8_MMA(1, 0, At, B0); PG8_BAR; PG8_SCHED;
            PG8_STAGE(PG8_SB(1, 1), b3 + hstep, voffB);
            PG8_WAIT_V(6); PG8_BAR; PG8_MMA(1, 1, At, B1); PG8_BAR;
            }
        }
        if constexpr (ALIGN_EPI) { if (wr == 0) PG8_BAR; }
        if constexpr (!Epi::AFTER_DRAIN) { E(acc, cur, wr, wc, fr, fq); S.done(cur); }
        if (!has_next) break;
#pragma unroll
        for (int a = 0; a < 2; ++a)
#pragma unroll
            for (int b = 0; b < 2; ++b)
#pragma unroll
                for (int m = 0; m < 4; ++m)
#pragma unroll
                    for (int n = 0; n < 2; ++n) acc[a][b][m][n] = (f32x4){0.f, 0.f, 0.f, 0.f};
        cur = nxt; cA = nA; cB = nB; ++ui;
        if constexpr (ALIGN_EPI) { if (wr == 1) PG8_BAR; }
    }
    PG8_WAIT_V(0);
    if constexpr (!ALIGN_EPI) { if (wr == 0) PG8_BAR; }
    PG8_BAR;
    if constexpr (Epi::AFTER_DRAIN) { E.fused(acc, cur, wr, wc, fr, fq, lds, wid, lane); S.done(cur); }
#undef PG8_SA
#undef PG8_SB
#undef PG8_STAGE
#undef PG8_LDA
#undef PG8_LDB
#undef PG8_MMA
#undef PG8_WAIT_V
#undef PG8_WAIT_L
#undef PG8_BAR
#undef PG8_SCHED
}
}

namespace cg = cooperative_groups;
#ifndef MK_MODE
#define MK_MODE 2
#endif
constexpr int NWAVES = 8;

constexpr int NB = 8, SEQ = 4096, DM = 1024, NL = 2;
constexpr int M = NB * SEQ;
constexpr int PIN = 2688, PINP = 2816;
constexpr int DFF = 2816, DUP = 2 * DFF;
constexpr int DA = 256, DB = 384, DC = 384;
constexpr int NMOD = 6 * DM;
constexpr int PC_OFF = 1280;
constexpr int NPHASE = 22;

constexpr size_t MiB = 1u << 20;
constexpr size_t WS_CTL = 0, CTL_ZERO_BYTES = 64 * 1024;
constexpr size_t WS_SMALL = 1 * MiB;
constexpr size_t SM_SGUW = 0, SM_LRUWA = 256 * 1024, SM_LRUWX = 352 * 1024, SM_RW2 = 448 * 1024, SM_RA2 = 544 * 1024, SM_RG2 = 640 * 1024;
constexpr size_t WS_MOD = 2 * MiB;
constexpr size_t WS_LRUS = 3 * MiB;
constexpr size_t WS_WIN = 4 * MiB, WS_WOUT = 15 * MiB, WS_WUP = 19 * MiB, WS_WDN = 41 * MiB;
constexpr size_t WS_HY = 64 * MiB;
constexpr size_t WS_P = 128 * MiB;
constexpr size_t WS_UV = 304 * MiB;
constexpr size_t WS_R = 304 * MiB, WS_K = 328 * MiB, WS_V = 352 * MiB, WS_KK = 376 * MiB, WS_BV = 400 * MiB;
constexpr size_t WS_WD = 424 * MiB;
constexpr size_t WS_Q2 = 472 * MiB;
constexpr size_t WS_END = 512 * MiB;
static_assert(WS_Q2 + (size_t)M * 384 * 2 <= WS_END && WS_UV + (size_t)M * DFF * 2 <= WS_END && WS_P + (size_t)M * PINP * 2 <= WS_UV, "d_ws map");
static_assert(WS_WDN + (size_t)NL * DM * DFF * 2 <= WS_HY && WS_WIN + (size_t)NL * PINP * DM * 2 <= WS_WOUT && WS_WUP + (size_t)NL * DUP * DM * 2 <= WS_WDN, "weights map");
constexpr int CW_BAR = 1024;

constexpr int RING_BYTES = 131072;
constexpr int LDSCTL_OFF = RING_BYTES, MISC_OFF = LDSCTL_OFF + 320;
constexpr int LDS_BYTES = 147456;

#define GAS __attribute__((address_space(1)))
#define LAS __attribute__((address_space(3)))
typedef unsigned short bf16;
typedef float f32x4 __attribute__((ext_vector_type(4)));
typedef float f32x2 __attribute__((ext_vector_type(2)));
typedef float f32x16 __attribute__((ext_vector_type(16)));
typedef short bf16x8 __attribute__((ext_vector_type(8)));
typedef unsigned u32x2 __attribute__((ext_vector_type(2)));
typedef unsigned u32x4 __attribute__((ext_vector_type(4)));
typedef GAS unsigned gu32;
#define RLX_AGENT __ATOMIC_RELAXED, __HIP_MEMORY_SCOPE_AGENT

__device__ __forceinline__ float bflo(unsigned w) { return __builtin_bit_cast(float, w << 16); }
__device__ __forceinline__ float bfhi(unsigned w) { return __builtin_bit_cast(float, w & 0xffff0000u); }
__device__ __forceinline__ float bf1(bf16 u) { return __builtin_bit_cast(float, (unsigned)u << 16); }
__device__ __forceinline__ unsigned pk2(float lo, float hi) { return pg8::cvt_pk_bf16(lo, hi); }
__device__ __forceinline__ bf16 f2bf(float f) { return (bf16)(pg8::cvt_pk_bf16(f, f) & 0xffffu); }
__device__ __forceinline__ f32x4 unpack4(u32x2 w) { return (f32x4){bflo(w.x), bfhi(w.x), bflo(w.y), bfhi(w.y)}; }
__device__ __forceinline__ u32x2 pack4(f32x4 v) { u32x2 w; w.x = pk2(v[0], v[1]); w.y = pk2(v[2], v[3]); return w; }

__device__ __forceinline__ float fexp(float x) { return __builtin_amdgcn_exp2f(x * 1.4426950408889634f); }
__device__ __forceinline__ float flog(float x) { return __builtin_amdgcn_logf(x) * 0.6931471805599453f; }
__device__ __forceinline__ float fsigmoid(float x) { return __builtin_amdgcn_rcpf(1.f + fexp(-x)); }
__device__ __forceinline__ float fgelu(float x) { const float y = 1.5957691216f * x * (1.f + 0.044715f * x * x); return x * fsigmoid(y); }
__device__ __forceinline__ float fsilu(float x) { return x * fsigmoid(x); }
__device__ __forceinline__ float fsoftplus(float x) { return fmaxf(x, 0.f) + flog(1.f + fexp(-fabsf(x))); }
__device__ __forceinline__ float fsoftplus_acc(float x) { return fmaxf(x, 0.f) + log1pf(expf(-fabsf(x))); }
__device__ __forceinline__ float ftanh(float x) { return 1.f - 2.f * __builtin_amdgcn_rcpf(1.f + fexp(2.f * x)); }
__device__ __forceinline__ float fnegexpm1(float x) {
    const float ser = -x * (1.f + x * (0.5f + x * (0.16666667f + x * (0.041666668f + x * (0.008333334f + x * 0.0013888889f)))));
    return x > -0.25f ? ser : 1.f - fexp(x);
}
__device__ __forceinline__ int opaque_tid() { int t = threadIdx.x; asm volatile("" : "+v"(t)); return t; }
template <int CTRL> __device__ __forceinline__ float dppf(float x) { return __builtin_bit_cast(float, __builtin_amdgcn_mov_dpp(__builtin_bit_cast(int, x), CTRL, 0xf, 0xf, true)); }
__device__ __forceinline__ float red16(float p) { p += dppf<0xB1>(p); p += dppf<0x4E>(p); p += dppf<0x141>(p); p += dppf<0x128>(p); return p; }
__device__ __forceinline__ float wave_sum(float v) {
#pragma unroll
    for (int o = 1; o < 64; o <<= 1) v += __shfl_xor(v, o);
    return v;
}
#define XB_TMO      128
#define XB_XCNT(j)  (256  + 64 * (j))
#define XB_XSUB(j)  (1280 + 64 * (j))
#define XB_XGEN(j)  (2304 + 64 * (j))
#define XB_TOP      3328
#define XB_TOPGEN   3392
#define XCD_BAR_WORDS 3456
#define XB_SPIN_CAP (1u << 18)

__device__ __forceinline__ unsigned xb_ld(unsigned* p)              { return __hip_atomic_load(p, __ATOMIC_RELAXED, __HIP_MEMORY_SCOPE_AGENT); }
__device__ __forceinline__ unsigned xb_add(unsigned* p, unsigned v) { return __hip_atomic_fetch_add(p, v, __ATOMIC_RELAXED, __HIP_MEMORY_SCOPE_AGENT); }
__device__ __forceinline__ unsigned xb_xcc_id() { return (unsigned)__builtin_amdgcn_s_getreg((3 << 11) | 20) & 0xFu; }
#define XB_SPIN(cond, bar) do { unsigned _sp = 0; while (cond) { __builtin_amdgcn_s_sleep(1); \
    if ((++_sp & 255u) == 0u) { if (xb_ld(&(bar)[XB_TMO])) break; if (_sp > XB_SPIN_CAP) { atomicAdd(&(bar)[XB_TMO], 1u); break; } } } } while (0)

struct XcdBarrier {
    unsigned* bar; unsigned x;
    volatile LAS unsigned* st;
};

__device__ __forceinline__ XcdBarrier xcd_barrier_post(unsigned* bar, volatile LAS unsigned* st) {
    XcdBarrier b; b.bar = bar; b.x = xb_xcc_id(); b.st = st;
    if (threadIdx.x == 0) (void)xb_add(&bar[XB_XCNT(b.x)], 1u);
    return b;
}
__device__ __forceinline__ void xcd_barrier_complete(unsigned* bar, unsigned x, unsigned& nloc, unsigned& nx) {
    const unsigned G = gridDim.x * gridDim.y * gridDim.z;
    unsigned sum, cnt, mine, sp = 0u;
    for (;;) {
        sum = 0u; cnt = 0u; mine = 0u;
#pragma unroll
        for (unsigned j = 0; j < 16; ++j) { const unsigned c = xb_ld(&bar[XB_XCNT(j)]); sum += c; cnt += (c > 0u) ? 1u : 0u; mine = (j == x) ? c : mine; }
        if (sum == G) break;
        __builtin_amdgcn_s_sleep(1);
        if ((++sp & 255u) == 0u) { if (xb_ld(&bar[XB_TMO])) break; if (sp > XB_SPIN_CAP) { atomicAdd(&bar[XB_TMO], 1u); break; } }
    }
    nloc = mine > 0u ? mine : 1u; nx = cnt > 0u ? cnt : 1u;
}

__device__ __forceinline__ void xcd_barrier(const XcdBarrier& b) {
    asm volatile("s_waitcnt vmcnt(0)" ::: "memory");
    __syncthreads();
    if (threadIdx.x == 0) {
        unsigned* bar = b.bar;
        __builtin_amdgcn_s_waitcnt(0);
        unsigned nloc = b.st[0], nx = b.st[1];
        if (nloc == 0u) { xcd_barrier_complete(bar, b.x, nloc, nx); b.st[0] = nloc; b.st[1] = nx; }
        const unsigned old = xb_add(&bar[XB_XSUB(b.x)], 1u);
        const unsigned gen = old / nloc;
        if (old + 1u == (gen + 1u) * nloc) {
            __builtin_amdgcn_fence(__ATOMIC_RELEASE, "agent");
            asm volatile("s_waitcnt vmcnt(0)" ::: "memory");
            const unsigned og = xb_add(&bar[XB_TOP], 1u);
            const unsigned tg = og / nx;
            if (og + 1u == (tg + 1u) * nx) xb_add(&bar[XB_TOPGEN], 1u);
            else XB_SPIN(xb_ld(&bar[XB_TOPGEN]) == tg, bar);
            __builtin_amdgcn_fence(__ATOMIC_ACQUIRE, "agent");
            xb_add(&bar[XB_XGEN(b.x)], 1u);
            asm volatile("s_waitcnt vmcnt(0)" ::: "memory");
        } else {
            XB_SPIN(xb_ld(&bar[XB_XGEN(b.x)]) == gen, bar);
            __builtin_amdgcn_fence(__ATOMIC_ACQUIRE, "agent");
            asm volatile("s_waitcnt vmcnt(0)" ::: "memory");
        }
    }
    __syncthreads();
}

struct Frame {
    LAS unsigned char* lds;
    volatile LAS unsigned* MISC;
    gu32* ctl;
    int wave, vcu, G;
    const float *x, *c, *w_mod, *b_mod, *norm_mix, *w_in, *w_out, *sgu_ln_g, *sgu_ln_b, *sgu_w, *sgu_b, *lru_conv_w, *lru_conv_b, *lru_w_a, *lru_b_a, *lru_w_x, *lru_b_x, *lru_lambda,
        *rwkv_mu, *rwkv_w0, *rwkv_w2, *rwkv_a0, *rwkv_a2, *rwkv_g2, *rwkv_k_k, *rwkv_k_a, *rwkv_r_k, *rwkv_ln_w, *rwkv_ln_b, *norm_ffn, *ffn_w_up, *ffn_conv_w, *ffn_conv_b, *ffn_w_down, *norm_final;
    float* out;
    bf16 *SGUW, *LRUWA, *LRUWX, *RW2, *RA2, *RG2;
    float *MOD, *LRUSA, *LRUSH;
    bf16 *WIN, *WOUT, *WUP, *WDN;
    bf16 *HY, *P, *UG, *UV, *R, *K, *V, *KK, *BV, *Q2;
    float *O, *WD;
};

__device__ __forceinline__ void p0_transpose_item(const float* W, int K, int N, bf16* WT, int k0, int n0, int drow0, LAS float* scr, int lane) {
#pragma unroll 8
    for (int i = 0; i < 32; ++i) { const int kk = 2 * i + (lane >> 5); scr[kk * 33 + (lane & 31)] = W[(size_t)(k0 + kk) * N + n0 + (lane & 31)]; }
    asm volatile("s_waitcnt lgkmcnt(0)" ::: "memory");
    const int c = lane & 7;
#pragma unroll
    for (int j = 0; j < 4; ++j) { const int n = (lane >> 3) + 8 * j; const LAS float* s = scr + (8 * c) * 33 + n;
        u32x4 o; o.x = pk2(s[0 * 33], s[1 * 33]); o.y = pk2(s[2 * 33], s[3 * 33]); o.z = pk2(s[4 * 33], s[5 * 33]); o.w = pk2(s[6 * 33], s[7 * 33]);
        *(u32x4*)(WT + (size_t)(drow0 + n) * K + k0 + 8 * c) = o; }
    asm volatile("s_waitcnt lgkmcnt(0)" ::: "memory");
}
__device__ __forceinline__ void p0_prologue(Frame& F) {
    const int tid = opaque_tid(), lane = tid & 63, wave = F.wave;
    const int gw = F.vcu * NWAVES + wave, NGW = F.G * NWAVES;
    const int gt = F.vcu * (NWAVES * 64) + tid, NGT = F.G * NWAVES * 64;
    if (F.vcu < 192) {
        LAS float* cact = (LAS float*)(F.lds + 73728);
        LAS float* red = (LAS float*)(F.lds + 106496);
        for (int i = tid; i < NB * DM; i += NWAVES * 64) { const float cv = F.c[i]; cact[i] = cv * fsigmoid(cv); }
        __syncthreads();
        const int l = F.vcu / 96, n0 = (F.vcu % 96) * 64;
        const float* wm = F.w_mod + ((size_t)l * DM + 128 * wave) * NMOD + n0 + lane;
        float acc[NB];
#pragma unroll
        for (int b = 0; b < NB; ++b) acc[b] = 0.f;
        for (int k4 = 0; k4 < 128; k4 += 4) {
            const float w0 = wm[(size_t)(k4 + 0) * NMOD], w1 = wm[(size_t)(k4 + 1) * NMOD], w2 = wm[(size_t)(k4 + 2) * NMOD], w3 = wm[(size_t)(k4 + 3) * NMOD];
#pragma unroll
            for (int b = 0; b < NB; ++b) { const f32x4 cv = *(const LAS f32x4*)(cact + b * DM + 128 * wave + k4); acc[b] += cv[0] * w0 + cv[1] * w1 + cv[2] * w2 + cv[3] * w3; }
        }
#pragma unroll
        for (int b = 0; b < NB; ++b) red[(wave * NB + b) * 64 + lane] = acc[b];
        __syncthreads();
        { const int b = tid >> 6, col = tid & 63; float s = F.b_mod[l * NMOD + n0 + col];
#pragma unroll
          for (int w = 0; w < NWAVES; ++w) s += red[(w * NB + b) * 64 + col];
          F.MOD[(size_t)(l * NB + b) * NMOD + n0 + col] = s; }
        __syncthreads();
    }
    {
        LAS float* scr = (LAS float*)(F.lds + wave * 9216);
        constexpr int I_IN = (DM / 64) * (PIN / 32), I_OUT = (DM / 64) * (DM / 32), I_UP = (DM / 64) * (DUP / 32), I_DN = (DFF / 64) * (DM / 32);
        constexpr int PER_L = I_IN + I_OUT + I_UP + I_DN;
        for (int it = gw; it < NL * PER_L; it += NGW) {
            const int l = it / PER_L; int r = it % PER_L;
            if (r < I_IN) { const int nblk = PIN / 32, kb = r / nblk, nb = r % nblk; p0_transpose_item(F.w_in + (size_t)l * DM * PIN, DM, PIN, F.WIN + (size_t)l * PINP * DM, 64 * kb, 32 * nb, 32 * nb, scr, lane); continue; } r -= I_IN;
            if (r < I_OUT) { const int nblk = DM / 32, kb = r / nblk, nb = r % nblk; p0_transpose_item(F.w_out + (size_t)l * DM * DM, DM, DM, F.WOUT + (size_t)l * DM * DM, 64 * kb, 32 * nb, 32 * nb, scr, lane); continue; } r -= I_OUT;
            if (r < I_UP) { const int nblk = DUP / 32, kb = r / nblk, nb = r % nblk; const int n0 = 32 * nb, isv = n0 >= DFF ? 1 : 0, j = n0 - isv * DFF, drow = (j / 128) * 256 + isv * 128 + (j % 128);
                p0_transpose_item(F.ffn_w_up + (size_t)l * DM * DUP, DM, DUP, F.WUP + (size_t)l * DUP * DM, 64 * kb, n0, drow, scr, lane); continue; } r -= I_UP;
            { const int nblk = DM / 32, kb = r / nblk, nb = r % nblk; p0_transpose_item(F.ffn_w_down + (size_t)l * DFF * DM, DFF, DM, F.WDN + (size_t)l * DM * DFF, 64 * kb, 32 * nb, 32 * nb, scr, lane); }
        }
        for (int i = gt; i < NL * (PINP - PIN) * DM / 8; i += NGT) { const int l = i / ((PINP - PIN) * DM / 8), o = i % ((PINP - PIN) * DM / 8);
            *(u32x4*)(F.WIN + (size_t)l * PINP * DM + (size_t)PIN * DM + (size_t)o * 8) = (u32x4){0u, 0u, 0u, 0u}; }
    }
    for (int i = gt; i < NL * 4 * 128 * 128; i += NGT) { const int s = i & 127, t = (i >> 7) & 127; F.SGUW[i] = s <= t ? f2bf(F.sgu_w[i]) : (bf16)0; }
    for (int i = gt; i < NL * 6 * 64 * 64; i += NGT) { const int ii = i & 63, j = (i >> 6) & 63, lh = i >> 12;
        F.LRUWA[i] = f2bf(F.lru_w_a[(size_t)lh * 4096 + ii * 64 + j]); F.LRUWX[i] = f2bf(F.lru_w_x[(size_t)lh * 4096 + ii * 64 + j]); }
    for (int i = gt; i < NL * 384 * 64; i += NGT) { const int k = i & 63, n = (i >> 6) % 384, l = i / (384 * 64);
        F.RW2[i] = f2bf(F.rwkv_w2[(size_t)l * 64 * 384 + k * 384 + n]); F.RA2[i] = f2bf(F.rwkv_a2[(size_t)l * 64 * 384 + k * 384 + n]); }
    for (int i = gt; i < NL * 384 * 128; i += NGT) { const int k = i & 127, n = (i >> 7) % 384, l = i / (384 * 128);
        F.RG2[i] = f2bf(F.rwkv_g2[(size_t)l * 128 * 384 + k * 384 + n]); }
}

__device__ __forceinline__ void norm_mod_phase(Frame& F, const float* X, const float* gamma, const float* mod_l, int sh_idx, int sc_idx, bf16* H) {
    const int gw = F.vcu * NWAVES + F.wave, NGW = F.G * NWAVES, lane = opaque_tid() & 63;
    f32x4 g[4], nx[4];
#pragma unroll
    for (int j = 0; j < 4; ++j) g[j] = *(const f32x4*)(gamma + 4 * (lane + 64 * j));
    if (gw < M) {
#pragma unroll
        for (int j = 0; j < 4; ++j) nx[j] = ((const f32x4*)(X + (size_t)gw * DM) + lane)[64 * j];
    }
    for (int m = gw; m < M; m += NGW) {
        f32x4 v[4]; float s = 0.f;
#pragma unroll
        for (int j = 0; j < 4; ++j) { v[j] = nx[j]; s += (v[j][0] * v[j][0] + v[j][1] * v[j][1]) + (v[j][2] * v[j][2] + v[j][3] * v[j][3]); }
        if (m + NGW < M) {
#pragma unroll
            for (int j = 0; j < 4; ++j) nx[j] = ((const f32x4*)(X + (size_t)(m + NGW) * DM) + lane)[64 * j];
        }
        const float* mb = mod_l + (size_t)(m >> 12) * NMOD;
        f32x4 sc[4], sh[4];
#pragma unroll
        for (int j = 0; j < 4; ++j) { const int c = 4 * (lane + 64 * j); sc[j] = *(const f32x4*)(mb + sc_idx * DM + c); sh[j] = *(const f32x4*)(mb + sh_idx * DM + c); }
        const float rstd = __builtin_amdgcn_rsqf(wave_sum(s) * (1.f / DM) + 1e-6f);
        u32x2* o8 = (u32x2*)(H + (size_t)m * DM) + lane;
#pragma unroll
        for (int j = 0; j < 4; ++j) { const f32x4 y = (v[j] * rstd) * g[j] * (sc[j] + 1.f) + sh[j]; o8[64 * j] = pack4(y); }
    }
}
__device__ __forceinline__ void final_norm_phase(Frame& F, float* X, const float* gamma) {
    const int gw = F.vcu * NWAVES + F.wave, NGW = F.G * NWAVES, lane = opaque_tid() & 63;
    f32x4 g[4], nx[4];
#pragma unroll
    for (int j = 0; j < 4; ++j) g[j] = *(const f32x4*)(gamma + 4 * (lane + 64 * j));
    if (gw < M) {
#pragma unroll
        for (int j = 0; j < 4; ++j) nx[j] = ((const f32x4*)(X + (size_t)gw * DM) + lane)[64 * j];
    }
    for (int m = gw; m < M; m += NGW) {
        f32x4 v[4]; float s = 0.f;
#pragma unroll
        for (int j = 0; j < 4; ++j) { v[j] = nx[j]; s += (v[j][0] * v[j][0] + v[j][1] * v[j][1]) + (v[j][2] * v[j][2] + v[j][3] * v[j][3]); }
        if (m + NGW < M) {
#pragma unroll
            for (int j = 0; j < 4; ++j) nx[j] = ((const f32x4*)(X + (size_t)(m + NGW) * DM) + lane)[64 * j];
        }
        const float rstd = __builtin_amdgcn_rsqf(wave_sum(s) * (1.f / DM) + 1e-6f);
        f32x4* xr = (f32x4*)(X + (size_t)m * DM) + lane;
#pragma unroll
        for (int j = 0; j < 4; ++j) xr[64 * j] = (v[j] * rstd) * g[j];
    }
}

__device__ __forceinline__ void mix_chunk(Frame& F, const int l, const int ch) {
    const int wave = F.wave;
    const int n = ch & 31; const size_t r0 = (size_t)ch * 128;
    const bf16* P = F.P; bf16* Y = F.HY;
    LAS unsigned char* lds = F.lds;
#ifndef MK_MIXDUP
#define MK_MIXDUP 0
#endif
    for (int mrep = 0; mrep <= ((MK_MIXDUP) & 1); ++mrep) {
        if (mrep) __syncthreads();
        const int tid = opaque_tid(), lane = tid & 63, r = lane & 31, hh = lane >> 5;
        LAS bf16* VT = (LAS bf16*)lds;
        LAS f32x2* ST = (LAS f32x2*)(lds + 69632);
        const int t = tid & 127, q = __builtin_amdgcn_readfirstlane(tid >> 7);
        const bf16* src = P + (r0 + t) * PINP + 256 + 64 * q;
        float v[64]; float s = 0.f, ss = 0.f;
#pragma unroll
        for (int i = 0; i < 8; ++i) { const u32x4 w = *(const u32x4*)(src + 8 * i);
            const float e0 = fgelu(bflo(w.x)), e1 = fgelu(bfhi(w.x)), e2 = fgelu(bflo(w.y)), e3 = fgelu(bfhi(w.y)), e4 = fgelu(bflo(w.z)), e5 = fgelu(bfhi(w.z)), e6 = fgelu(bflo(w.w)), e7 = fgelu(bfhi(w.w));
            v[8 * i + 0] = e0; v[8 * i + 1] = e1; v[8 * i + 2] = e2; v[8 * i + 3] = e3; v[8 * i + 4] = e4; v[8 * i + 5] = e5; v[8 * i + 6] = e6; v[8 * i + 7] = e7;
            s += ((e0 + e1) + (e2 + e3)) + ((e4 + e5) + (e6 + e7)); ss += ((e0 * e0 + e1 * e1) + (e2 * e2 + e3 * e3)) + ((e4 * e4 + e5 * e5) + (e6 * e6 + e7 * e7)); }
        ST[q * 128 + t] = (f32x2){s, ss};
        __syncthreads();
        const f32x2 a0 = ST[t], a1 = ST[128 + t], a2 = ST[256 + t], a3 = ST[384 + t];
        const float mean = ((a0.x + a1.x) + (a2.x + a3.x)) * (1.f / 256.f), ex2 = ((a0.y + a1.y) + (a2.y + a3.y)) * (1.f / 256.f);
        const float rstd = __builtin_amdgcn_rsqf(fmaxf(ex2 - mean * mean, 0.f) + 1e-5f);
        const float* lg = F.sgu_ln_g + l * DA + 64 * q; const float* lb = F.sgu_ln_b + l * DA + 64 * q;
#pragma unroll
        for (int i = 0; i < 64; ++i) VT[(64 * q + i) * 136 + t] = f2bf((v[i] - mean) * rstd * lg[i] + lb[i]);
        __syncthreads();
        const int h = wave >> 1, dh = wave & 1;
        const bf16* Wg = F.SGUW + (size_t)(l * 4 + h) * 128 * 128;
        const LAS bf16* vrow = VT + (64 * h + 32 * dh + r) * 136 + 8 * hh;
#pragma unroll 1
        for (int tb = 0; tb < 4; ++tb) {
            f32x16 acc;
#pragma unroll
            for (int i = 0; i < 16; ++i) acc[i] = 0.f;
            const bf16* wrow = Wg + (size_t)(32 * tb + r) * 128 + 8 * hh;
#pragma unroll 2
            for (int ks = 0; ks < 2 * (tb + 1); ++ks) {
                const bf16x8 a = *(const LAS bf16x8*)(vrow + 16 * ks);
                const bf16x8 b = *(const bf16x8*)(wrow + 16 * ks);
                acc = __builtin_amdgcn_mfma_f32_32x32x16_bf16(a, b, acc, 0, 0, 0);
            }
            const int tt = 32 * tb + r; const size_t row = r0 + tt;
            const float bias = F.sgu_b[(l * 4 + h) * 128 + tt];
            u32x2 uq[4];
#pragma unroll
            for (int g = 0; g < 4; ++g) uq[g] = *(const u32x2*)(P + row * PINP + 64 * h + 32 * dh + 8 * g + 4 * hh);
#pragma unroll
            for (int g = 0; g < 4; ++g) { const int c4 = 64 * h + 32 * dh + 8 * g + 4 * hh;
                const f32x4 u = unpack4(uq[g]);
                f32x4 y; y[0] = fgelu(u[0]) * (acc[4 * g + 0] + bias); y[1] = fgelu(u[1]) * (acc[4 * g + 1] + bias); y[2] = fgelu(u[2]) * (acc[4 * g + 2] + bias); y[3] = fgelu(u[3]) * (acc[4 * g + 3] + bias);
                *(u32x2*)(Y + row * DM + c4) = pack4(y); }
        }
    }
    __syncthreads();
    for (int mrep = 0; mrep <= (((MK_MIXDUP) >> 1) & 1); ++mrep) {
        if (mrep) __syncthreads();
        const int tid = opaque_tid(), lane = tid & 63, r = lane & 31, hh = lane >> 5;
        LAS bf16* XC = (LAS bf16*)lds;
        LAS float* LA = (LAS float*)(lds + 25088);
        LAS float* BT = (LAS float*)(lds + 25088 + 49152);
        const int q = tid % 96, rs = tid / 96, c4 = 4 * q; const bool act = tid < DB;
        f32x4 cw0, cw1, cw2, cw3, cb, bra, bix, sp8;
        { cw0 = *(const f32x4*)(F.lru_conv_w + (l * 4 + 0) * DB + c4); cw1 = *(const f32x4*)(F.lru_conv_w + (l * 4 + 1) * DB + c4); cw2 = *(const f32x4*)(F.lru_conv_w + (l * 4 + 2) * DB + c4); cw3 = *(const f32x4*)(F.lru_conv_w + (l * 4 + 3) * DB + c4);
          cb = *(const f32x4*)(F.lru_conv_b + l * DB + c4); bra = *(const f32x4*)(F.lru_b_a + l * DB + c4); bix = *(const f32x4*)(F.lru_b_x + l * DB + c4);
          const f32x4 lam = *(const f32x4*)(F.lru_lambda + l * DB + c4);
#pragma unroll
          for (int e = 0; e < 4; ++e) sp8[e] = -8.f * fsoftplus_acc(-lam[e]); }
        float hst = 0.f, ca = 1.f;
        for (int tq = 0; tq < 4; ++tq) {
            if (act) {
                const bf16* src = P + (r0 + 32 * tq + 8 * rs) * PINP + 512 + c4;
                u32x2 raw[11];
                const bool hashalo = (n > 0) || (tq > 0) || (rs > 0);
#pragma unroll
                for (int i = 0; i < 11; ++i) raw[i] = (i >= 3 || hashalo) ? *(const u32x2*)(src + (ptrdiff_t)(i - 3) * PINP) : (u32x2){0u, 0u};
                f32x4 x3 = unpack4(raw[0]), x2 = unpack4(raw[1]), x1 = unpack4(raw[2]);
#pragma unroll
                for (int i = 0; i < 8; ++i) { const f32x4 x0 = unpack4(raw[3 + i]);
                    const f32x4 xc = cb + cw0 * x3 + cw1 * x2 + cw2 * x1 + cw3 * x0; x3 = x2; x2 = x1; x1 = x0;
                    *(LAS u32x2*)(XC + (8 * rs + i) * 392 + c4) = pack4(xc); }
            }
            __syncthreads();
            for (int k = 0; k < 3; ++k) {
                const int id = wave + 8 * k, mat = id / 12, hb = (id % 12) >> 1, jt = id & 1;
                const bf16* Wt = (mat ? F.LRUWX : F.LRUWA) + (size_t)((l * 6 + hb) * 64 + 32 * jt + r) * 64 + 8 * hh;
                const LAS bf16* xrow = XC + r * 392 + 64 * hb + 8 * hh;
                f32x16 acc;
#pragma unroll
                for (int i = 0; i < 16; ++i) acc[i] = 0.f;
#pragma unroll
                for (int ks = 0; ks < 4; ++ks) { const bf16x8 a = *(const LAS bf16x8*)(xrow + 16 * ks); const bf16x8 b = *(const bf16x8*)(Wt + 16 * ks);
                    acc = __builtin_amdgcn_mfma_f32_32x32x16_bf16(a, b, acc, 0, 0, 0); }
                LAS float* dst = (mat ? BT : LA) + 64 * hb + 32 * jt + r;
#pragma unroll
                for (int rg = 0; rg < 16; ++rg) dst[((rg & 3) + 8 * (rg >> 2) + 4 * hh) * DB] = acc[rg];
            }
            __syncthreads();
            if (act) {
#pragma unroll 2
                for (int i = 0; i < 8; ++i) { const int tl = rs + 4 * i;
                    const f32x4 rp = *(const LAS f32x4*)(LA + tl * DB + c4) + bra, ip = *(const LAS f32x4*)(BT + tl * DB + c4) + bix;
                    const f32x4 xc = unpack4(*(const LAS u32x2*)(XC + tl * 392 + c4));
                    f32x4 av, bv;
#pragma unroll
                    for (int e = 0; e < 4; ++e) { const float la = sp8[e] * fsigmoid(rp[e]); av[e] = fexp(la);
                        bv[e] = __builtin_amdgcn_sqrtf(fmaxf(fnegexpm1(2.f * la), 0.f)) * (fsigmoid(ip[e]) * xc[e]); }
                    *(LAS f32x4*)(LA + tl * DB + c4) = av; *(LAS f32x4*)(BT + tl * DB + c4) = bv; }
            }
            __syncthreads();
            if (act) {
#pragma unroll 8
                for (int i = 0; i < 32; ++i) { const float a = LA[i * DB + tid], bt = BT[i * DB + tid]; hst = a * hst + bt; ca *= a; LA[i * DB + tid] = hst; BT[i * DB + tid] = ca; }
            }
            __syncthreads();
            if (act) {
                u32x2 yg[8];
#pragma unroll
                for (int i = 0; i < 8; ++i) yg[i] = *(const u32x2*)(P + (r0 + 32 * tq + rs + 4 * i) * PINP + 896 + c4);
#pragma unroll
                for (int i = 0; i < 8; ++i) { const int tl = rs + 4 * i; const size_t row = r0 + 32 * tq + tl;
                    const f32x4 h4 = *(const LAS f32x4*)(LA + tl * DB + c4), ca4 = *(const LAS f32x4*)(BT + tl * DB + c4), y4 = unpack4(yg[i]);
                    f32x4 gl; gl[0] = fgelu(y4[0]); gl[1] = fgelu(y4[1]); gl[2] = fgelu(y4[2]); gl[3] = fgelu(y4[3]);
                    *(u32x2*)(Y + row * DM + 256 + c4) = pack4(gl * h4); *(u32x2*)(F.Q2 + row * DB + c4) = pack4(gl * ca4); }
            }
        }
        if (act) { F.LRUSA[(size_t)ch * DB + tid] = ca; F.LRUSH[(size_t)ch * DB + tid] = hst; }
    }
    __syncthreads();
    for (int mrep = 0; mrep <= (((MK_MIXDUP) >> 2) & 1); ++mrep) {
        if (mrep) __syncthreads();
        const int tid = opaque_tid(), lane = tid & 63, r = lane & 31, hh = lane >> 5;
        LAS bf16* TW = (LAS bf16*)lds;
        LAS bf16* XA = TW + 32 * 72;
        LAS bf16* SG = XA + 32 * 72;
        LAS float* LW = (LAS float*)(lds + 17920);
        LAS bf16* LAa = (LAS bf16*)(lds + 67072);
        LAS bf16* LG = (LAS bf16*)(lds + 91648);
        const float* mu = F.rwkv_mu + l * 1408;
        const int q = tid % 96, rs = tid / 96, n4 = 4 * q; const bool act3 = tid < 384;
        f32x4 p_mr, p_mk, p_mv, p_w0, p_a0, p_kk, p_ka;
        { p_mr = *(const f32x4*)(mu + n4); p_mk = *(const f32x4*)(mu + 384 + n4); p_mv = *(const f32x4*)(mu + 768 + n4);
          p_w0 = *(const f32x4*)(F.rwkv_w0 + l * DC + n4); p_a0 = *(const f32x4*)(F.rwkv_a0 + l * DC + n4); p_kk = *(const f32x4*)(F.rwkv_k_k + l * DC + n4); p_ka = *(const f32x4*)(F.rwkv_k_a + l * DC + n4); }
        const bf16* pc = P + PC_OFF + 1152 + 4 * lane; const f32x4 mu4 = *(const f32x4*)(mu + 1152 + 4 * lane);
        LAS bf16* c1dst = lane < 16 ? TW + 4 * lane : (lane < 32 ? XA + 4 * (lane - 16) : SG + 4 * (lane - 32));
        const int c1stride = lane < 32 ? 72 : 136;
#ifndef MK_CDUP
#define MK_CDUP 0
#endif
        for (int tb = 0; tb < 4; ++tb) {
            for (int c12 = 0; c12 <= ((MK_CDUP) & 1); ++c12) {
            if (c12) __syncthreads();
            {
                const int t0 = 32 * tb + 4 * wave;
                f32x4 prev = (f32x4){0.f, 0.f, 0.f, 0.f};
                if (t0 > 0 || n > 0) prev = unpack4(*(const u32x2*)(pc + (r0 + t0 - 1) * PINP));
#pragma unroll
                for (int i = 0; i < 4; ++i) {
                    const f32x4 cur = unpack4(*(const u32x2*)(pc + (r0 + t0 + i) * PINP));
                    const f32x4 xs = cur + (prev - cur) * mu4; prev = cur;
                    f32x4 y;
#pragma unroll
                    for (int e = 0; e < 4; ++e) y[e] = lane < 16 ? ftanh(xs[e]) : (lane < 32 ? xs[e] : fsigmoid(xs[e]));
                    *(LAS u32x2*)(c1dst + (4 * wave + i) * c1stride) = pack4(y); }
            }
            __syncthreads();
            for (int u = wave; u < 36; u += 8) {
                const int lora = u < 12 ? 0 : (u < 24 ? 1 : 2), nt = u - 12 * lora;
                f32x16 acc;
#pragma unroll
                for (int i = 0; i < 16; ++i) acc[i] = 0.f;
                const int nrow = 32 * nt + r;
                if (lora == 0) { const bf16* wr = F.RG2 + ((size_t)l * 384 + nrow) * 128 + 8 * hh; const LAS bf16* xr = SG + r * 136 + 8 * hh;
#pragma unroll
                    for (int ks = 0; ks < 8; ++ks) acc = __builtin_amdgcn_mfma_f32_32x32x16_bf16(*(const LAS bf16x8*)(xr + 16 * ks), *(const bf16x8*)(wr + 16 * ks), acc, 0, 0, 0);
                } else { const bf16* wr = (lora == 1 ? F.RW2 : F.RA2) + ((size_t)l * 384 + nrow) * 64 + 8 * hh; const LAS bf16* xr = (lora == 1 ? TW : XA) + r * 72 + 8 * hh;
#pragma unroll
                    for (int ks = 0; ks < 4; ++ks) acc = __builtin_amdgcn_mfma_f32_32x32x16_bf16(*(const LAS bf16x8*)(xr + 16 * ks), *(const bf16x8*)(wr + 16 * ks), acc, 0, 0, 0);
                }
                if (lora == 1) { LAS float* d = LW + 32 * nt + r;
#pragma unroll
                    for (int rg = 0; rg < 16; ++rg) d[((rg & 3) + 8 * (rg >> 2) + 4 * hh) * 384] = acc[rg];
                } else { LAS bf16* d = (lora == 0 ? LG : LAa) + 32 * nt + r;
#pragma unroll
                    for (int rg = 0; rg < 16; ++rg) d[((rg & 3) + 8 * (rg >> 2) + 4 * hh) * 384] = f2bf(acc[rg]); }
            }
            __syncthreads();
            }
            for (int c3r = 0; c3r <= (((MK_CDUP) >> 1) & 1); ++c3r)
            if (act3) {
                struct RowIn { u32x2 rc, kc, vc, rp, kp, vp; };
#define C3_LOAD(T, i) do { const int t_ = 32 * tb + rs + 4 * (i); const bf16* prow_ = P + (r0 + t_) * PINP + PC_OFF + n4; T.rc = *(const u32x2*)(prow_); T.kc = *(const u32x2*)(prow_ + 384); T.vc = *(const u32x2*)(prow_ + 768); \
        if (t_ > 0 || n > 0) { T.rp = *(const u32x2*)(prow_ - PINP); T.kp = *(const u32x2*)(prow_ - PINP + 384); T.vp = *(const u32x2*)(prow_ - PINP + 768); } else { T.rp = (u32x2){0u, 0u}; T.kp = T.rp; T.vp = T.rp; } } while (0)
                RowIn rin[2];
                C3_LOAD(rin[0], 0);
#pragma unroll
                for (int i = 0; i < 8; ++i) {
                    if (i + 1 < 8) C3_LOAD(rin[(i + 1) & 1], i + 1);
                    const RowIn& T = rin[i & 1];
                    const int tl = rs + 4 * i; const size_t row = r0 + 32 * tb + tl;
                    f32x4 rc = unpack4(T.rc), kc = unpack4(T.kc), vc = unpack4(T.vc);
                    const f32x4 rp = unpack4(T.rp), kp = unpack4(T.kp), vp = unpack4(T.vp);
                    rc = rc + (rp - rc) * p_mr; kc = kc + (kp - kc) * p_mk; vc = vc + (vp - vc) * p_mv;
                    const f32x4 lw = *(const LAS f32x4*)(LW + tl * 384 + n4), la = unpack4(*(const LAS u32x2*)(LAa + tl * 384 + n4));
                    const u32x2 lg = *(const LAS u32x2*)(LG + tl * 384 + n4);
                    const f32x4 kr = kc * p_kk;
                    const float ss = red16((kr[0] * kr[0] + kr[1] * kr[1]) + (kr[2] * kr[2] + kr[3] * kr[3]));
                    const float rn = __builtin_amdgcn_rsqf(fmaxf(ss, 1e-24f));
                    f32x4 dec, km, kk4, bv4;
#pragma unroll
                    for (int e = 0; e < 4; ++e) {
                        const float wv = -fsoftplus(-(p_w0[e] + lw[e])) - 0.5f; dec[e] = fexp(-fexp(wv));
                        const float a = fsigmoid(p_a0[e] + la[e]);
                        kk4[e] = kr[e] * rn; bv4[e] = kk4[e] * a;
                        km[e] = kc[e] * (1.f + (a - 1.f) * p_ka[e]); }
                    *(u32x2*)(F.R + row * DC + n4) = pack4(rc); *(u32x2*)(F.K + row * DC + n4) = pack4(km); *(u32x2*)(F.V + row * DC + n4) = pack4(vc);
                    *(f32x4*)(F.WD + row * DC + n4) = dec; *(u32x2*)(F.KK + row * DC + n4) = pack4(kk4); *(u32x2*)(F.BV + row * DC + n4) = pack4(bv4);
                    *(u32x2*)(Y + row * DM + 640 + n4) = lg;
                }
#undef C3_LOAD
            }
        }
    }
    __syncthreads();
}

__device__ __forceinline__ void rwkv_scan_item(Frame& F, const int it) {
#define SC_BAR() do { asm volatile("s_waitcnt lgkmcnt(0)" ::: "memory"); __builtin_amdgcn_s_barrier(); asm volatile("" ::: "memory"); } while (0)
    const int tid = opaque_tid();
    const int b = it / 24, h = (it % 24) >> 2, qt = it & 3;
    constexpr int CS = 16;
    constexpr int BUFF = 5 * CS * 64 + CS * 16;
    constexpr int OPF = CS * 16 * 16;
    constexpr int NCK = SEQ / CS;
    LAS float* buf = (LAS float*)F.lds;
    LAS float* opart = buf + 2 * BUFF;
    const size_t base = (size_t)b * SEQ * DC + 64 * h;
    if (tid >= 256) {
        const int lt = tid - 256, st = lt >> 4, q = lt & 15, vst = lt >> 2, vq = lt & 3;
        const size_t go = base + (size_t)st * DC + 4 * q;
        const bf16* gKK = F.KK + go; const bf16* gBV = F.BV + go; const bf16* gK = F.K + go; const bf16* gR = F.R + go; const float* gW = F.WD + go;
        const bf16* gV = F.V + base + (size_t)vst * DC + 16 * qt + 4 * vq;
        float* gO = F.O + base + 16 * qt + (size_t)(lt >> 4) * DC + (lt & 15);
        const bool ldv = lt < CS * 4;
        u32x2 kk0, bv0, k0, r0, v0 = (u32x2){0u, 0u}, kk1, bv1, k1, r1, v1 = (u32x2){0u, 0u}, kk2, bv2, k2, r2, v2 = (u32x2){0u, 0u}; f32x4 w0, w1, w2;
#define SC_LOAD(S, ck) do { const size_t _o = (size_t)(ck) * CS * DC; kk##S = *(const u32x2*)(gKK + _o); bv##S = *(const u32x2*)(gBV + _o); k##S = *(const u32x2*)(gK + _o); r##S = *(const u32x2*)(gR + _o); \
        w##S = *(const f32x4*)(gW + _o); if (ldv) v##S = *(const u32x2*)(gV + _o); } while (0)
#define SC_STORE(S, bb) do { LAS float* _b = (bb) + st * 64 + 4 * q; *(LAS f32x4*)(_b) = unpack4(kk##S); *(LAS f32x4*)(_b + CS * 64) = w##S; *(LAS f32x4*)(_b + 2 * CS * 64) = unpack4(bv##S); \
        *(LAS f32x4*)(_b + 3 * CS * 64) = unpack4(k##S); *(LAS f32x4*)(_b + 4 * CS * 64) = unpack4(r##S); if (ldv) *(LAS f32x4*)((bb) + 5 * CS * 64 + vst * 16 + 4 * vq) = unpack4(v##S); } while (0)
#define SC_FLUSH(ckf) do { const LAS f32x4* pp = (const LAS f32x4*)(opart + ((ckf) & 1) * OPF + lt * 16); const f32x4 a0 = pp[0], a1 = pp[1], a2 = pp[2], a3 = pp[3]; const f32x4 sm = (a0 + a1) + (a2 + a3); \
        gO[(size_t)(ckf) * CS * DC] = (sm[0] + sm[1]) + (sm[2] + sm[3]); } while (0)
#define SC_ITER(S, c) do { if ((c) > 0) SC_FLUSH((c) - 1); if ((c) + 1 < NCK) SC_STORE(S, buf + (((c) + 1) & 1) * BUFF); if ((c) + 4 < NCK) SC_LOAD(S, (c) + 4); SC_BAR(); } while (0)
        SC_LOAD(0, 0); SC_LOAD(1, 1); SC_LOAD(2, 2); SC_STORE(0, buf); SC_LOAD(0, 3);
        SC_BAR();
        for (int ck = 0; ck < NCK; ck += 3) {
            SC_ITER(1, ck);
            if (ck + 1 < NCK) SC_ITER(2, ck + 1);
            if (ck + 2 < NCK) SC_ITER(0, ck + 2);
        }
        SC_FLUSH(NCK - 1);
#undef SC_ITER
#undef SC_LOAD
#undef SC_STORE
#undef SC_FLUSH
    } else {
        const int gl = tid & 15, row = tid >> 4;
#define SC_READ(T, cbp, tt) do { T.kk = *(const LAS f32x4*)((cbp) + (tt) * 64 + 4 * gl); T.w = *(const LAS f32x4*)((cbp) + CS * 64 + (tt) * 64 + 4 * gl); T.bb = *(const LAS f32x4*)((cbp) + 2 * CS * 64 + (tt) * 64 + 4 * gl); \
        T.k = *(const LAS f32x4*)((cbp) + 3 * CS * 64 + (tt) * 64 + 4 * gl); T.r = *(const LAS f32x4*)((cbp) + 4 * CS * 64 + (tt) * 64 + 4 * gl); T.v = (cbp)[5 * CS * 64 + (tt) * 16 + row]; } while (0)
        struct StepIn { f32x4 kk, w, bb, k, r; float v; };
        SC_BAR();
        f32x2 sA = (f32x2){0.f, 0.f}, sB = (f32x2){0.f, 0.f};
        for (int ck = 0; ck < NCK; ++ck) {
            const LAS float* cb = buf + (ck & 1) * BUFF; LAS float* op = opart + (ck & 1) * OPF;
            StepIn sin[3];
            SC_READ(sin[0], cb, 0); SC_READ(sin[1], cb, 1);
#pragma unroll
            for (int tt = 0; tt < CS; ++tt) {
                if (tt + 2 < CS) SC_READ(sin[(tt + 2) % 3], cb, tt + 2);
                __builtin_amdgcn_sched_barrier(0);
                const StepIn& cur = sin[tt % 3];
                const f32x2 kkA = (f32x2){cur.kk[0], cur.kk[1]}, kkB = (f32x2){cur.kk[2], cur.kk[3]};
                f32x2 d2 = sA * kkA; d2 = sB * kkB + d2;
                const float p = red16(d2[0] + d2[1]);
                const f32x2 uA = (f32x2){cur.k[0], cur.k[1]} * cur.v, uB = (f32x2){cur.k[2], cur.k[3]} * cur.v;
                sA = sA * (f32x2){cur.w[0], cur.w[1]} + uA; sB = sB * (f32x2){cur.w[2], cur.w[3]} + uB;
                sA = sA - (f32x2){cur.bb[0], cur.bb[1]} * p; sB = sB - (f32x2){cur.bb[2], cur.bb[3]} * p;
                f32x2 o2 = sA * (f32x2){cur.r[0], cur.r[1]}; o2 = sB * (f32x2){cur.r[2], cur.r[3]} + o2;
                op[tt * 256 + tid] = o2[0] + o2[1];
                __builtin_amdgcn_sched_barrier(0);
            }
            SC_BAR();
        }
#undef SC_READ
    }
#undef SC_BAR
}
__device__ __forceinline__ void lru_fin_chunk(Frame& F, const int ch) {
    const int tid = opaque_tid(); if (tid >= 384) return;
    const int q = tid % 96, rs = tid / 96, b = ch >> 5, n = ch & 31;
    f32x4 hin = (f32x4){0.f, 0.f, 0.f, 0.f};
    for (int j = 0; j < n; ++j) { const f32x4 a = *(const f32x4*)(F.LRUSA + (size_t)(b * 32 + j) * DB + 4 * q), hh = *(const f32x4*)(F.LRUSH + (size_t)(b * 32 + j) * DB + 4 * q); hin = a * hin + hh; }
    bf16* Y = F.HY;
    for (int t0 = rs; t0 < 128; t0 += 32) {
        u32x2 a1[8], a2[8];
#pragma unroll
        for (int i = 0; i < 8; ++i) { const size_t row = (size_t)ch * 128 + t0 + 4 * i; a1[i] = *(const u32x2*)(Y + row * DM + 256 + 4 * q); a2[i] = *(const u32x2*)(F.Q2 + row * DB + 4 * q); }
#pragma unroll
        for (int i = 0; i < 8; ++i) { const size_t row = (size_t)ch * 128 + t0 + 4 * i; *(u32x2*)(Y + row * DM + 256 + 4 * q) = pack4(unpack4(a1[i]) + unpack4(a2[i]) * hin); }
    }
}
__device__ __forceinline__ void rwkv_fin_phase(Frame& F, const int l) {
    const int gw = F.vcu * NWAVES + F.wave, NGW = F.G * NWAVES, lane = opaque_tid() & 63, sub = lane >> 4, q = lane & 15;
    bf16* Y = F.HY;
    struct FinIn { f32x4 ov; u32x2 r, k, v, g; };
#define FIN_LOAD(T, idx_) do { const int m_ = (idx_) / 6, h_ = (idx_) - 6 * m_; const size_t o_ = (size_t)m_ * DC + 64 * h_ + 4 * q; T.ov = *(const f32x4*)(F.O + o_); T.r = *(const u32x2*)(F.R + o_); T.k = *(const u32x2*)(F.K + o_); \
        T.v = *(const u32x2*)(F.V + o_); T.g = *(const u32x2*)(Y + (size_t)m_ * DM + 640 + 64 * h_ + 4 * q); } while (0)
    FinIn fin[2];
    constexpr int NIT = (M * 6) / (256 * NWAVES * 4);
    const int idx0 = gw * 4 + sub, stride = NGW * 4;
    if (NGW * 4 * NIT != M * 6) return;
    FIN_LOAD(fin[0], idx0);
#pragma unroll 2
    for (int it = 0; it < NIT; ++it) {
        const int idx = idx0 + it * stride;
        if (it + 1 < NIT) { if (it & 1) FIN_LOAD(fin[0], idx + stride); else FIN_LOAD(fin[1], idx + stride); }
        const FinIn& T = (it & 1) ? fin[1] : fin[0];
        const int m = idx / 6, h = idx - 6 * m; const int n4 = 64 * h + 4 * q;
        const f32x4 ov = T.ov;
        const float mean = red16((ov[0] + ov[1]) + (ov[2] + ov[3])) * (1.f / 64.f);
        const f32x4 d = ov - mean;
        const float var = red16((d[0] * d[0] + d[1] * d[1]) + (d[2] * d[2] + d[3] * d[3])) * (1.f / 64.f);
        const float rstd = __builtin_amdgcn_rsqf(var + 64e-5f);
        const f32x4 lw = *(const f32x4*)(F.rwkv_ln_w + l * DC + n4), lb = *(const f32x4*)(F.rwkv_ln_b + l * DC + n4), rk = *(const f32x4*)(F.rwkv_r_k + l * DC + n4);
        const f32x4 r4 = unpack4(T.r), k4 = unpack4(T.k), v4 = unpack4(T.v);
        const f32x4 t4 = r4 * k4 * rk;
        const float bs = red16((t4[0] + t4[1]) + (t4[2] + t4[3]));
        const f32x4 g4 = unpack4(T.g);
        const f32x4 y = ((d * rstd) * lw + lb + v4 * bs) * g4;
        *(u32x2*)(Y + (size_t)m * DM + 640 + n4) = pack4(y);
    }
#undef FIN_LOAD
}
__device__ __forceinline__ void ffn_glu_phase(Frame& F, const int l) {
    constexpr int CG = DFF / 8, SEG = 32, NSEG = M / SEG;
    const int gt = F.vcu * (NWAVES * 64) + opaque_tid(), NGT = F.G * NWAVES * 64;
    for (int id = gt; id < NSEG * CG; id += NGT) {
        const int rsg = id / CG, cg8 = id - rsg * CG; const int col = 8 * cg8; const size_t row0 = (size_t)rsg * SEG;
        float w0[8], w1[8], w2[8], cb[8], x1[8], x2[8];
        { const float* cw = F.ffn_conv_w + (size_t)l * 3 * DFF + col; const float* cbp = F.ffn_conv_b + (size_t)l * DFF + col;
#pragma unroll
          for (int e = 0; e < 8; ++e) { w0[e] = cw[e]; w1[e] = cw[DFF + e]; w2[e] = cw[2 * DFF + e]; cb[e] = cbp[e]; x1[e] = 0.f; x2[e] = 0.f; } }
        if ((row0 & (SEQ - 1)) != 0) {
            const u32x4 a = *(const u32x4*)(F.UG + (row0 - 2) * DFF + col), bq = *(const u32x4*)(F.UG + (row0 - 1) * DFF + col);
            x2[0] = bflo(a.x); x2[1] = bfhi(a.x); x2[2] = bflo(a.y); x2[3] = bfhi(a.y); x2[4] = bflo(a.z); x2[5] = bfhi(a.z); x2[6] = bflo(a.w); x2[7] = bfhi(a.w);
            x1[0] = bflo(bq.x); x1[1] = bfhi(bq.x); x1[2] = bflo(bq.y); x1[3] = bfhi(bq.y); x1[4] = bflo(bq.z); x1[5] = bfhi(bq.z); x1[6] = bflo(bq.w); x1[7] = bfhi(bq.w);
        }
        u32x4 ga[4], va[4], gb[4], vb[4];
#define FF_LOAD(G_, V_, grp) do { _Pragma("unroll") for (int i_ = 0; i_ < 4; ++i_) { G_[i_] = *(const u32x4*)(F.UG + (row0 + 4 * (grp) + i_) * DFF + col); V_[i_] = *(const u32x4*)(F.UV + (row0 + 4 * (grp) + i_) * DFF + col); } } while (0)
#define FF_DO(G_, V_, grp) do { _Pragma("unroll") for (int i_ = 0; i_ < 4; ++i_) { const u32x4 gq = G_[i_], vq = V_[i_]; float x0[8], vv[8], y[8]; \
            x0[0] = bflo(gq.x); x0[1] = bfhi(gq.x); x0[2] = bflo(gq.y); x0[3] = bfhi(gq.y); x0[4] = bflo(gq.z); x0[5] = bfhi(gq.z); x0[6] = bflo(gq.w); x0[7] = bfhi(gq.w); \
            vv[0] = bflo(vq.x); vv[1] = bfhi(vq.x); vv[2] = bflo(vq.y); vv[3] = bfhi(vq.y); vv[4] = bflo(vq.z); vv[5] = bfhi(vq.z); vv[6] = bflo(vq.w); vv[7] = bfhi(vq.w); \
            _Pragma("unroll") for (int e = 0; e < 8; ++e) { const float gc = cb[e] + w0[e] * x2[e] + w1[e] * x1[e] + w2[e] * x0[e]; y[e] = fsilu(gc) * vv[e]; x2[e] = x1[e]; x1[e] = x0[e]; } \
            u32x4 o; o.x = pk2(y[0], y[1]); o.y = pk2(y[2], y[3]); o.z = pk2(y[4], y[5]); o.w = pk2(y[6], y[7]); \
            *(u32x4*)(F.UV + (row0 + 4 * (grp) + i_) * DFF + col) = o; } } while (0)
        FF_LOAD(ga, va, 0);
        for (int grp = 0; grp < SEG / 4; grp += 2) {
            FF_LOAD(gb, vb, grp + 1);
            FF_DO(ga, va, grp);
            if (grp + 2 < SEG / 4) FF_LOAD(ga, va, grp + 2);
            FF_DO(gb, vb, grp + 1);
        }
#undef FF_LOAD
#undef FF_DO
    }
}

struct Args { const float* in[35]; float* out; unsigned char* ws; int ph_lo, ph_hi; };
__device__ __forceinline__ void frame_init(Frame& F, LAS unsigned char* lds) {
    typedef const __attribute__((address_space(4))) Args* ArgP;
    ArgP ap = (ArgP)__builtin_amdgcn_kernarg_segment_ptr(); asm volatile("" : "+s"(ap));
    F.lds = lds; F.MISC = (volatile LAS unsigned*)(lds + MISC_OFF);
    F.wave = __builtin_amdgcn_readfirstlane(threadIdx.x >> 6);
    F.G = gridDim.x; { const int bx = blockIdx.x; F.vcu = (F.G % 8 == 0) ? (bx % 8) * (F.G / 8) + bx / 8 : bx; }
    unsigned char* ws = ap->ws;
    F.ctl = (gu32*)(ws + WS_CTL);
    F.x = ap->in[0]; F.c = ap->in[1]; F.w_mod = ap->in[2]; F.b_mod = ap->in[3]; F.norm_mix = ap->in[4]; F.w_in = ap->in[5]; F.w_out = ap->in[6];
    F.sgu_ln_g = ap->in[7]; F.sgu_ln_b = ap->in[8]; F.sgu_w = ap->in[9]; F.sgu_b = ap->in[10];
    F.lru_conv_w = ap->in[11]; F.lru_conv_b = ap->in[12]; F.lru_w_a = ap->in[13]; F.lru_b_a = ap->in[14]; F.lru_w_x = ap->in[15]; F.lru_b_x = ap->in[16]; F.lru_lambda = ap->in[17];
    F.rwkv_mu = ap->in[18]; F.rwkv_w0 = ap->in[19]; F.rwkv_w2 = ap->in[20]; F.rwkv_a0 = ap->in[21]; F.rwkv_a2 = ap->in[22]; F.rwkv_g2 = ap->in[23]; F.rwkv_k_k = ap->in[24]; F.rwkv_k_a = ap->in[25];
    F.rwkv_r_k = ap->in[26]; F.rwkv_ln_w = ap->in[27]; F.rwkv_ln_b = ap->in[28]; F.norm_ffn = ap->in[29]; F.ffn_w_up = ap->in[30]; F.ffn_conv_w = ap->in[31]; F.ffn_conv_b = ap->in[32];
    F.ffn_w_down = ap->in[33]; F.norm_final = ap->in[34]; F.out = ap->out;
    F.SGUW = (bf16*)(ws + WS_SMALL + SM_SGUW); F.LRUWA = (bf16*)(ws + WS_SMALL + SM_LRUWA); F.LRUWX = (bf16*)(ws + WS_SMALL + SM_LRUWX);
    F.RW2 = (bf16*)(ws + WS_SMALL + SM_RW2); F.RA2 = (bf16*)(ws + WS_SMALL + SM_RA2); F.RG2 = (bf16*)(ws + WS_SMALL + SM_RG2);
    F.MOD = (float*)(ws + WS_MOD); F.LRUSA = (float*)(ws + WS_LRUS); F.LRUSH = F.LRUSA + 256 * DB;
    F.WIN = (bf16*)(ws + WS_WIN); F.WOUT = (bf16*)(ws + WS_WOUT); F.WUP = (bf16*)(ws + WS_WUP); F.WDN = (bf16*)(ws + WS_WDN);
    F.HY = (bf16*)(ws + WS_HY); F.P = (bf16*)(ws + WS_P); F.UG = (bf16*)(ws + WS_P); F.UV = (bf16*)(ws + WS_UV); F.O = (float*)(ws + WS_P);
    F.R = (bf16*)(ws + WS_R); F.K = (bf16*)(ws + WS_K); F.V = (bf16*)(ws + WS_V); F.KK = (bf16*)(ws + WS_KK); F.BV = (bf16*)(ws + WS_BV); F.WD = (float*)(ws + WS_WD); F.Q2 = (bf16*)(ws + WS_Q2);
}
__global__ void __launch_bounds__(NWAVES * 64, 2) mk_fwd(Args args) {
    extern __shared__ __attribute__((aligned(16))) unsigned char lds_raw[];
    LAS unsigned char* const lds = (LAS unsigned char*)lds_raw;
    for (int u = threadIdx.x; u < (LDS_BYTES - LDSCTL_OFF) / 4; u += NWAVES * 64) ((LAS unsigned*)(lds + LDSCTL_OFF))[u] = 0u;
    __syncthreads();
#if MK_MODE == 2
    XcdBarrier bar = xcd_barrier_post((unsigned*)((gu32*)(args.ws + WS_CTL) + CW_BAR), (volatile LAS unsigned*)(lds + MISC_OFF) + 8);
#define GRID_BAR() xcd_barrier(bar)
#elif MK_MODE == 1
    cg::grid_group grid = cg::this_grid();
#define GRID_BAR() grid.sync()
#else
#define GRID_BAR() do { } while (0)
#endif
    const int lo = args.ph_lo, hi = args.ph_hi;
#define IN(k) (lo <= (k) && (k) < hi)
#ifndef MK_PHMASK
#define MK_PHMASK 0xFFF
#endif
#define EN(t) (((MK_PHMASK) >> (t)) & 1)
#ifndef MK_DUPMASK
#define MK_DUPMASK 0
#endif
#define REP2(t) (((MK_DUPMASK) >> (t)) & 1)
#define SEAM(k) do { if (IN(k) && IN((k) + 1)) GRID_BAR(); } while (0)
#define PH_BEGIN(t, k) if (EN(t) && IN(k)) { for (int rep = 0; rep <= REP2(t); ++rep) { if (rep) GRID_BAR(); Frame F; frame_init(F, lds); \
        const float* mod_l = F.MOD + (size_t)l * NB * NMOD; const float* Xin = (l == 0) ? F.x : F.out; (void)mod_l; (void)Xin;
#define PH_END(k) } } SEAM(k);

    { const int l = 0; PH_BEGIN(0, 0) p0_prologue(F); PH_END(0) }
    for (int l = 0; l < NL; ++l) {
        const int pb = 1 + 10 * l;
        PH_BEGIN(1, pb + 0) norm_mod_phase(F, Xin, F.norm_mix + l * DM, mod_l, 0, 1, F.HY); PH_END(pb + 0)
        PH_BEGIN(2, pb + 1) pg8::Gemm g{F.HY, F.WIN + (size_t)l * PINP * DM, M, PINP, DM}; pg8::StaticOrder S; S.init(M, PINP, F.G, (int)blockIdx.x);
            pg8::EpiBf16<0> E{F.P, PINP, nullptr, 0, 0, 1.f};
            pg8::gemm_phase<pg8::EpiBf16<0>, pg8::StaticOrder, true, true>(F.lds, g, S, E); PH_END(pb + 1)
        PH_BEGIN(3, pb + 2) for (int ch = F.vcu; ch < M / 128; ch += F.G) mix_chunk(F, l, ch); PH_END(pb + 2)
        PH_BEGIN(4, pb + 3)
            if (F.G >= 256) { if (F.vcu < 192) rwkv_scan_item(F, F.vcu); else if (rep == 0) for (int ch = F.vcu - 192; ch < M / 128; ch += F.G - 192) lru_fin_chunk(F, ch); }
            else { for (int it = F.vcu; it < 192; it += F.G) { rwkv_scan_item(F, it); __syncthreads(); } if (rep == 0) for (int ch = F.vcu; ch < M / 128; ch += F.G) lru_fin_chunk(F, ch); }
        PH_END(pb + 3)
        PH_BEGIN(5, pb + 4) rwkv_fin_phase(F, l); PH_END(pb + 4)
        PH_BEGIN(6, pb + 5) pg8::Gemm g{F.HY, F.WOUT + (size_t)l * DM * DM, M, DM, DM}; pg8::StaticOrder S; S.init(M, DM, F.G, (int)blockIdx.x);
            pg8::EpiRes E{Xin, (REP2(6) && rep == 0) ? (float*)F.P : F.out, DM, mod_l + 2 * DM, NMOD, SEQ};
            pg8::gemm_phase<pg8::EpiRes, pg8::StaticOrder, true, true>(F.lds, g, S, E); PH_END(pb + 5)
        PH_BEGIN(7, pb + 6) norm_mod_phase(F, F.out, F.norm_ffn + l * DM, mod_l, 3, 4, F.HY); PH_END(pb + 6)
        PH_BEGIN(8, pb + 7) pg8::Gemm g{F.HY, F.WUP + (size_t)l * DUP * DM, M, DUP, DM}; pg8::StaticOrder S; S.init(M, DUP, F.G, (int)blockIdx.x);
            pg8::EpiGV E{F.UG, F.UV, DFF};
            pg8::gemm_phase<pg8::EpiGV, pg8::StaticOrder, true, true>(F.lds, g, S, E); PH_END(pb + 7)
        PH_BEGIN(9, pb + 8) ffn_glu_phase(F, l); PH_END(pb + 8)
        PH_BEGIN(10, pb + 9) pg8::Gemm g{F.UV, F.WDN + (size_t)l * DM * DFF, M, DM, DFF}; pg8::StaticOrder S; S.init(M, DM, F.G, (int)blockIdx.x);
            pg8::EpiRes E{F.out, (REP2(10) && rep == 0) ? (float*)F.P : F.out, DM, mod_l + 5 * DM, NMOD, SEQ};
            pg8::gemm_phase<pg8::EpiRes, pg8::StaticOrder, true, true>(F.lds, g, S, E); PH_END(pb + 9)
    }
    { const int l = 0; PH_BEGIN(11, NPHASE - 1) final_norm_phase(F, F.out, F.norm_final); PH_END(NPHASE - 1) }
#undef IN
#undef SEAM
}

extern "C" void kernel_launch(void* const* d_in, const int* in_sizes, int n_in, void* d_out, int out_size, void* d_ws, size_t ws_size, hipStream_t stream) {
    static int grid = 0;
    if (grid == 0) {
        if (n_in != 35 || in_sizes[0] != M * DM || out_size != M * DM || ws_size < WS_END) { fprintf(stderr, "kernel_launch: unexpected shapes (n_in %d, in0 %d, out %d, ws %zu); nothing launched\n", n_in, n_in > 0 ? in_sizes[0] : -1, out_size, ws_size); grid = -1; return; }
        int dev = 0, cus = 0, per_cu = 0;
        if (hipGetDevice(&dev) != hipSuccess || hipDeviceGetAttribute(&cus, hipDeviceAttributeMultiprocessorCount, dev) != hipSuccess) { grid = -1; return; }
        if (hipFuncSetAttribute((const void*)mk_fwd, hipFuncAttributeMaxDynamicSharedMemorySize, LDS_BYTES) != hipSuccess) { fprintf(stderr, "kernel_launch: hipFuncSetAttribute failed\n"); grid = -1; return; }
        if (hipOccupancyMaxActiveBlocksPerMultiprocessor(&per_cu, (const void*)mk_fwd, NWAVES * 64, LDS_BYTES) != hipSuccess || per_cu < 1) { fprintf(stderr, "kernel_launch: occupancy query says %d blocks per CU\n", per_cu); per_cu = 1; }
        (void)hipGetLastError();
        grid = cus;
    }
    if (grid < 0) return;
    Args a{};
    for (int i = 0; i < 35; ++i) a.in[i] = (const float*)d_in[i];
    a.out = (float*)d_out; a.ws = (unsigned char*)d_ws;
#if MK_MODE == 0
    for (int ph = 0; ph < NPHASE; ++ph) { a.ph_lo = ph; a.ph_hi = ph + 1; hipLaunchKernelGGL(mk_fwd, dim3(grid), dim3(NWAVES * 64), LDS_BYTES, stream, a); }
#else
    (void)hipMemsetAsync((char*)d_ws + WS_CTL, 0, CTL_ZERO_BYTES, stream);
    a.ph_lo = 0; a.ph_hi = NPHASE;
#if MK_MODE == 1
    void* kargs[] = {&a};
    hipError_t e = hipLaunchCooperativeKernel((const void*)mk_fwd, dim3(grid), dim3(NWAVES * 64), kargs, LDS_BYTES, stream);
    if (e != hipSuccess) fprintf(stderr, "kernel_launch: cooperative launch failed: %s (grid %d)\n", hipGetErrorString(e), grid);
#else
    hipLaunchKernelGGL(mk_fwd, dim3(grid), dim3(NWAVES * 64), LDS_BYTES, stream, a);
#endif
#endif
}
```

```cpp
#include <hip/hip_runtime.h>
#include <hip/hip_cooperative_groups.h>
#include <cstdio>
#include <cstdint>
namespace pg8 {
#define PG8_LAS __attribute__((address_space(3)))
typedef unsigned short bf16_t;
typedef short bf16x8 __attribute__((ext_vector_type(8)));
typedef float f32x4 __attribute__((ext_vector_type(4)));
typedef unsigned u32x4 __attribute__((ext_vector_type(4)));
constexpr int BM = 256, BK = 64, HALF = 128, HTB = HALF * BK * 2  , STAGE_BYTES = 8 * HTB, NXCD = 8, WGM = 8;

__host__ __device__ __forceinline__ int lds_byte(int r, int c) { const int st = (r >> 4) * 2 + (c >> 5), rr = r & 15, cc = c & 31, ob = rr * 64 + cc * 2; return st * 1024 + (ob ^ (((ob >> 9) & 1) << 5)); }
__host__ __device__ __forceinline__ void stage_rc(int b, int& R, int& C) { const int st = b / 1024, sb = b % 1024, swz = sb ^ (((sb >> 9) & 1) << 5); R = (st >> 1) * 16 + swz / 64; C = (st & 1) * 32 + (swz % 64) / 2; }
__host__ __device__ __forceinline__ int perm32(int rho) { const int n = rho >> 4, i = rho & 15; return 8 * (i >> 2) + 4 * n + (i & 3); }

struct Unit { int pm, pn; };
struct Gemm { const bf16_t* A; const bf16_t* Bt; int M, N, K; };

struct StaticOrder {
    int nM, nN, nwg, G, c;
    __host__ __device__ void init(int M, int N, int G_, int c_) { nM = M / BM; nN = N / BM; nwg = nM * nN; G = G_; c = c_; }
    __host__ __device__ bool next(int i, Unit& u) const {
        const long L = (long)i * G + c; if (L >= nwg) return false;
        int wgid = (int)L; { const int q = nwg / NXCD, r = nwg % NXCD, xcd = wgid % NXCD, off = wgid / NXCD; wgid = (xcd < r ? xcd * (q + 1) : r * (q + 1) + (xcd - r) * q) + off; }
        const int nig = WGM * nN, gid = wgid / nig, fm = gid * WGM, gsz = (nM - fm) < WGM ? (nM - fm) : WGM;
        u.pm = fm + ((wgid % nig) % gsz); u.pn = (wgid % nig) / gsz; return true;
    }
    __device__ __forceinline__ void a_ready(const Unit&) const {}
    __device__ __forceinline__ void done(const Unit&) const {}
};

__device__ __forceinline__ unsigned cvt_pk_bf16(float lo, float hi) { unsigned r; asm volatile("v_cvt_pk_bf16_f32 %0, %1, %2" : "=v"(r) : "v"(lo), "v"(hi)); return r; }
typedef float f32x2 __attribute__((ext_vector_type(2)));
__device__ __forceinline__ f32x2 gelu_pk(f32x2 v) {
    const f32x2 av = __builtin_elementwise_abs(v), d = av * 0.2316418882f + 1.0f;
    f32x2 t; t.x = __builtin_amdgcn_rcpf(d.x); t.y = __builtin_amdgcn_rcpf(d.y);
    f32x2 q = t * 0.5307027145f + (-0.7265760135f); q = q * t + 0.7107068705f; q = q * t + (-0.142248368f); q = q * t + 0.127414796f; q = q * t;
    const f32x2 s = (v * v) * (-0.72134752044f);
    f32x2 e; e.x = __builtin_amdgcn_exp2f(s.x); e.y = __builtin_amdgcn_exp2f(s.y);
    const f32x2 m = v * (q * e), r = v - m;
    f32x2 o; o.x = v.x < 0.f ? m.x : r.x; o.y = v.y < 0.f ? m.y : r.y; return o;
}

template <int ACT  > struct EpiBf16 {
    static constexpr bool PERM = true, AFTER_DRAIN = false; static_assert(ACT == 0 || ACT == 1, "EpiBf16: ACT is 0 (none) or 1 (gelu_pk)");
    bf16_t* O; int ldc; const float* bias; int split_cols; size_t split_stride; float scale0;
    __device__ __forceinline__ void operator()(const f32x4 (&acc)[2][2][4][2], const Unit& u, int wr, int wc, int fr, int fq) const {
        const int row0 = u.pm * BM + wr * 64 + fr; int colt = u.pn * BM; bf16_t* base = O;
        float sc = 1.f; if (split_cols) { const int t = colt / split_cols; base += (size_t)t * split_stride; colt -= t * split_cols; if (t == 0) sc = scale0; }
        const int col0 = colt + wc * 32 + 8 * fq, bcol0 = u.pn * BM + wc * 32 + 8 * fq;
        f32x4 bv[2][2];
#pragma unroll
        for (int bj = 0; bj < 2; ++bj)
#pragma unroll
            for (int n = 0; n < 2; ++n) bv[bj][n] = bias ? *(const f32x4*)(bias + bcol0 + bj * HALF + 4 * n) : (f32x4){0.f, 0.f, 0.f, 0.f};
#pragma unroll
        for (int ai = 0; ai < 2; ++ai)
#pragma unroll
            for (int m = 0; m < 4; ++m) { bf16_t* rowp = base + (size_t)(row0 + ai * HALF + m * 16) * ldc + col0;
#pragma unroll
                for (int bj = 0; bj < 2; ++bj) { f32x4 v0 = acc[ai][bj][m][0] + bv[bj][0], v1 = acc[ai][bj][m][1] + bv[bj][1];
                    if (ACT == 1) { f32x2 a = gelu_pk((f32x2){v0[0], v0[1]}), b = gelu_pk((f32x2){v0[2], v0[3]}), c = gelu_pk((f32x2){v1[0], v1[1]}), d = gelu_pk((f32x2){v1[2], v1[3]});
                        v0 = (f32x4){a.x, a.y, b.x, b.y}; v1 = (f32x4){c.x, c.y, d.x, d.y}; }
                    v0 = v0 * sc; v1 = v1 * sc; u32x4 w; w.x = cvt_pk_bf16(v0[0], v0[1]); w.y = cvt_pk_bf16(v0[2], v0[3]); w.z = cvt_pk_bf16(v1[0], v1[1]); w.w = cvt_pk_bf16(v1[2], v1[3]);
                    *(u32x4*)(rowp + bj * HALF) = w; } }
    }
};

struct EpiRes {
    static constexpr bool PERM = false, AFTER_DRAIN = false;
    const float* base; float* out; int ldc; const float* gate; int gate_ld; int rows_per_batch;
    __device__ __forceinline__ void operator()(const f32x4 (&acc)[2][2][4][2], const Unit& u, int wr, int wc, int fr, int fq) const {
        const int row0 = u.pm * BM + wr * 64 + fr, col0 = u.pn * BM + wc * 32 + 4 * fq;
        const float* gp = gate + (size_t)((u.pm * BM) / rows_per_batch) * gate_ld + col0;
        f32x4 gv[2][2];
#pragma unroll
        for (int bj = 0; bj < 2; ++bj)
#pragma unroll
            for (int n = 0; n < 2; ++n) gv[bj][n] = *(const f32x4*)(gp + bj * HALF + n * 16);
        f32x4 pre[3][2][2];
#define ER_LOAD(slot, g_) do { const size_t off_ = (size_t)(row0 + ((g_) >> 2) * HALF + ((g_) & 3) * 16) * ldc + col0; _Pragma("unroll") for (int bj = 0; bj < 2; ++bj) _Pragma("unroll") for (int n = 0; n < 2; ++n) pre[slot][bj][n] = *(const f32x4*)(base + off_ + bj * HALF + n * 16); } while (0)
        ER_LOAD(0, 0); ER_LOAD(1, 1);
#pragma unroll
        for (int g = 0; g < 8; ++g) { const int ai = g >> 2, m = g & 3; const size_t off = (size_t)(row0 + ai * HALF + m * 16) * ldc + col0;
            if (g + 2 < 8) ER_LOAD((g + 2) % 3, g + 2);
#pragma unroll
            for (int bj = 0; bj < 2; ++bj)
#pragma unroll
                for (int n = 0; n < 2; ++n) *(f32x4*)(out + off + bj * HALF + n * 16) = pre[g % 3][bj][n] + gv[bj][n] * acc[ai][bj][m][n]; }
#undef ER_LOAD
    }
};
struct EpiGV {
    static constexpr bool PERM = true, AFTER_DRAIN = false;
    bf16_t* G; bf16_t* V; int ldc;
    __device__ __forceinline__ void operator()(const f32x4 (&acc)[2][2][4][2], const Unit& u, int wr, int wc, int fr, int fq) const {
        const int row0 = u.pm * BM + wr * 64 + fr, col0 = u.pn * HALF + wc * 32 + 8 * fq;
#pragma unroll
        for (int ai = 0; ai < 2; ++ai)
#pragma unroll
            for (int m = 0; m < 4; ++m) { const size_t off = (size_t)(row0 + ai * HALF + m * 16) * ldc + col0;
#pragma unroll
                for (int bj = 0; bj < 2; ++bj) { const f32x4 v0 = acc[ai][bj][m][0], v1 = acc[ai][bj][m][1];
                    u32x4 w; w.x = cvt_pk_bf16(v0[0], v0[1]); w.y = cvt_pk_bf16(v0[2], v0[3]); w.z = cvt_pk_bf16(v1[0], v1[1]); w.w = cvt_pk_bf16(v1[2], v1[3]);
                    *(u32x4*)((bj ? V : G) + off) = w; } }
    }
};

template <int CTRL> __device__ __forceinline__ float dpp_keep(float old, float src) {
    return __builtin_bit_cast(float, __builtin_amdgcn_update_dpp(__builtin_bit_cast(int, old), __builtin_bit_cast(int, src), CTRL, 0xf, 0xf, false)); }
template <int CTRL> __device__ __forceinline__ float dpp_mov(float src) { return __builtin_bit_cast(float, __builtin_amdgcn_mov_dpp(__builtin_bit_cast(int, src), CTRL, 0xf, 0xf, true)); }
struct EpiGLU {
    static constexpr bool PERM = true, AFTER_DRAIN = false;
    bf16_t* H; int ldc; const float* cw; const float* cb; float* TG; float* HG; float* HV; PG8_LAS float* tail;
    __device__ __forceinline__ void operator()(const f32x4 (&acc)[2][2][4][2], const Unit& u, int wr, int wc, int fr, int fq) const {
        const int row0 = u.pm * BM + wr * 64 + fr, cl = wc * 32 + 8 * fq, col0 = u.pn * HALF + cl;
        if (fr >= 14) {
#pragma unroll
            for (int ai = 0; ai < 2; ++ai)
#pragma unroll
                for (int n = 0; n < 2; ++n) *(PG8_LAS f32x4*)(tail + ((ai * 2 + wr) * 2 + (fr - 14)) * 128 + cl + 4 * n) = acc[ai][0][3][n];
            if (wr == 1) {
#pragma unroll
                for (int n = 0; n < 2; ++n) *(f32x4*)(TG + ((size_t)u.pm * 2 + (fr - 14)) * ldc + col0 + 4 * n) = acc[1][0][3][n];
            }
        }
        if (wr == 0 && fr < 2) {
#pragma unroll
            for (int n = 0; n < 2; ++n) { *(f32x4*)(HG + ((size_t)u.pm * 2 + fr) * ldc + col0 + 4 * n) = acc[0][0][0][n]; *(f32x4*)(HV + ((size_t)u.pm * 2 + fr) * ldc + col0 + 4 * n) = acc[0][1][0][n]; }
        }
        f32x4 w0[2], w1[2], w2[2], b0[2];
#pragma unroll
        for (int n = 0; n < 2; ++n) { w0[n] = *(const f32x4*)(cw + col0 + 4 * n); w1[n] = *(const f32x4*)(cw + ldc + col0 + 4 * n); w2[n] = *(const f32x4*)(cw + 2 * ldc + col0 + 4 * n); b0[n] = *(const f32x4*)(cb + col0 + 4 * n); }
        asm volatile("s_waitcnt lgkmcnt(0)" ::: "memory"); __builtin_amdgcn_s_barrier(); asm volatile("" ::: "memory");
#pragma unroll
        for (int ai = 0; ai < 2; ++ai) {
            f32x4 t0[2], t1[2];
            const bool have = (wr == 1) || (ai == 1);
            const int sa = (wr == 1) ? ai : 0, sw = (wr == 1) ? 0 : 1;
#pragma unroll
            for (int n = 0; n < 2; ++n) {
                t0[n] = have ? *(const PG8_LAS f32x4*)(tail + ((sa * 2 + sw) * 2 + 0) * 128 + cl + 4 * n) : (f32x4){0.f, 0.f, 0.f, 0.f};
                t1[n] = have ? *(const PG8_LAS f32x4*)(tail + ((sa * 2 + sw) * 2 + 1) * 128 + cl + 4 * n) : (f32x4){0.f, 0.f, 0.f, 0.f}; }
#pragma unroll
            for (int m = 0; m < 4; ++m) {
                u32x4 wout;
#pragma unroll
                for (int n = 0; n < 2; ++n) {
                    f32x4 hv;
#pragma unroll
                    for (int i = 0; i < 4; ++i) {
                        const float g0 = acc[ai][0][m][n][i];
                        float p1, p2;
                        if (m == 0) { p1 = t1[n][i]; p2 = (fr == 0) ? t0[n][i] : t1[n][i]; }
                        else { const float pv = acc[ai][0][m - 1][n][i]; p1 = dpp_mov<0x121>(pv); p2 = dpp_mov<0x122>(pv); }
                        const float g1 = dpp_keep<0x111>(p1, g0), g2 = dpp_keep<0x112>(p2, g0);
                        const float gc = b0[n][i] + w0[n][i] * g2 + w1[n][i] * g1 + w2[n][i] * g0;
                        hv[i] = gc * __builtin_amdgcn_rcpf(1.f + __builtin_amdgcn_exp2f(-1.4426950408889634f * gc)) * acc[ai][1][m][n][i];
                    }
                    if (n == 0) { wout.x = cvt_pk_bf16(hv[0], hv[1]); wout.y = cvt_pk_bf16(hv[2], hv[3]); } else { wout.z = cvt_pk_bf16(hv[0], hv[1]); wout.w = cvt_pk_bf16(hv[2], hv[3]); }
                }
                *(u32x4*)(H + (size_t)(row0 + ai * HALF + m * 16) * ldc + col0) = wout;
            }
        }
    }
};
template <class Epi, class Sched, bool ALIGN_EPI = false, bool SP2 = false>
__device__ __forceinline__ void gemm_phase(PG8_LAS unsigned char* lds, const Gemm g, const Sched& S, const Epi& E) {
    int tid_ = threadIdx.x; asm volatile("" : "+v"(tid_));
    const int tid = tid_, wid = __builtin_amdgcn_readfirstlane(tid >> 6), lane = tid & 63, wr = wid >> 2, wc = wid & 3, fr = lane & 15, fq = lane >> 4;
    const int K = g.K, nt = K / BK;
    unsigned voffA[2], voffB[2];
#pragma unroll
    for (int i = 0; i < 2; ++i) { int R, C; stage_rc(tid * 16 + i * 8192, R, C); const int Rb = Epi::PERM ? ((R & ~31) + perm32(R & 31)) : R;
        voffA[i] = (unsigned)(R * K + C) * 2u; voffB[i] = (unsigned)(Rb * K + C) * 2u; }
    const size_t kstep = (size_t)(BK * 2);
    const size_t hstep = (size_t)HALF * K * 2;
    const size_t tstep = 2 * hstep;
    const unsigned ldsw = (unsigned)wid * 1024u;
    const int aoff = lds_byte(wr * 64 + fr, fq * 8), boff = lds_byte(wc * 32 + fr, fq * 8);
#define PG8_SA(b, h) (((b) * 2 + (h)) * HTB)
#define PG8_SB(b, h) ((4 + (b) * 2 + (h)) * HTB)
#define PG8_STAGE(bufoff, gbase, voff) do { _Pragma("unroll") for (int _i = 0; _i < 2; ++_i) \
        __builtin_amdgcn_global_load_lds((const unsigned*)((const char*)(gbase) + (voff)[_i]), (PG8_LAS unsigned*)(lds + (bufoff) + ldsw + _i * 8192), 16, 0, 0); } while (0)
#define PG8_LDA(dst, b, h) do { _Pragma("unroll") for (int m = 0; m < 4; ++m) _Pragma("unroll") for (int k = 0; k < 2; ++k) dst[m][k] = *(const PG8_LAS bf16x8*)(lds + PG8_SA(b, h) + aoff + m * 2048 + k * 1024); } while (0)
#define PG8_LDB(dst, b, h) do { _Pragma("unroll") for (int n = 0; n < 2; ++n) _Pragma("unroll") for (int k = 0; k < 2; ++k) dst[n][k] = *(const PG8_LAS bf16x8*)(lds + PG8_SB(b, h) + boff + n * 2048 + k * 1024); } while (0)
#define PG8_MMA(ai, bj, At, Bt) do { __builtin_amdgcn_s_setprio(1); _Pragma("unroll") for (int m = 0; m < 4; ++m) _Pragma("unroll") for (int n = 0; n < 2; ++n) _Pragma("unroll") for (int k = 0; k < 2; ++k) \
        acc[ai][bj][m][n] = __builtin_amdgcn_mfma_f32_16x16x32_bf16(Bt[n][k], At[m][k], acc[ai][bj][m][n], 0, 0, 0); __builtin_amdgcn_s_setprio(0); } while (0)
#define PG8_WAIT_V(n) asm volatile("s_waitcnt vmcnt(" #n ")" ::: "memory")
#define PG8_WAIT_L(n) asm volatile("s_waitcnt lgkmcnt(" #n ")" ::: "memory")
#define PG8_BAR __builtin_amdgcn_s_barrier()
#define PG8_SCHED __builtin_amdgcn_sched_barrier(0)
    Unit cur, nxt; int ui = 0;
    if (!S.next(0, cur)) return;
    f32x4 acc[2][2][4][2];
#pragma unroll
    for (int a = 0; a < 2; ++a)
#pragma unroll
        for (int b = 0; b < 2; ++b)
#pragma unroll
            for (int m = 0; m < 4; ++m)
#pragma unroll
                for (int n = 0; n < 2; ++n) acc[a][b][m][n] = (f32x4){0.f, 0.f, 0.f, 0.f};
    bf16x8 At[4][2], B0[2][2], B1[2][2];
    const char* cA = (const char*)g.A + (size_t)cur.pm * tstep; const char* cB = (const char*)g.Bt + (size_t)cur.pn * tstep;
    S.a_ready(cur);
    if constexpr (SP2) {
        PG8_STAGE(PG8_SB(0, 0), cB, voffB); PG8_STAGE(PG8_SB(0, 1), cB + hstep, voffB); PG8_STAGE(PG8_SA(0, 0), cA, voffA); PG8_STAGE(PG8_SA(0, 1), cA + hstep, voffA);
        if (wr == 1) PG8_BAR;
        PG8_WAIT_V(2); PG8_BAR;
        PG8_STAGE(PG8_SB(1, 0), cB + kstep, voffB); PG8_STAGE(PG8_SA(1, 0), cA + kstep, voffA); PG8_STAGE(PG8_SB(1, 1), cB + hstep + kstep, voffB);
        PG8_WAIT_V(6); PG8_BAR;
    } else {
        PG8_STAGE(PG8_SB(0, 0), cB, voffB); PG8_STAGE(PG8_SA(0, 0), cA, voffA); PG8_STAGE(PG8_SB(0, 1), cB + hstep, voffB); PG8_STAGE(PG8_SA(0, 1), cA + hstep, voffA);
        if (wr == 1) PG8_BAR;
        PG8_WAIT_V(4); PG8_BAR;
        PG8_STAGE(PG8_SB(1, 0), cB + kstep, voffB); PG8_STAGE(PG8_SA(1, 0), cA + kstep, voffA); PG8_STAGE(PG8_SB(1, 1), cB + hstep + kstep, voffB);
        PG8_WAIT_V(6); PG8_BAR;
    }
    for (;;) {
        const bool has_next = S.next(ui + 1, nxt);
        const char* nA = has_next ? (const char*)g.A + (size_t)nxt.pm * tstep : cA; const char* nB = has_next ? (const char*)g.Bt + (size_t)nxt.pn * tstep : cB;
        for (int t = 0; t < nt; t += 2) {
            const bool last = (t == nt - 2);
            const char* a1 = cA + (size_t)(t + 1) * kstep;
            const char* a2 = last ? nA : cA + (size_t)(t + 2) * kstep; const char* b2 = last ? nB : cB + (size_t)(t + 2) * kstep;
            const char* a3 = a2 + kstep; const char* b3 = b2 + kstep;
            if (last && has_next) S.a_ready(nxt);
            if constexpr (SP2) {
            PG8_LDB(B0, 0, 0); PG8_LDB(B1, 0, 1); PG8_SCHED; PG8_LDA(At, 0, 0); PG8_STAGE(PG8_SA(1, 1), a1 + hstep, voffA);
            PG8_WAIT_V(8); PG8_WAIT_L(0); PG8_BAR; PG8_MMA(0, 0, At, B0); PG8_MMA(0, 1, At, B1); PG8_BAR; PG8_SCHED;
            PG8_LDA(At, 0, 1); PG8_STAGE(PG8_SB(0, 0), b2, voffB); PG8_STAGE(PG8_SB(0, 1), b2 + hstep, voffB); PG8_STAGE(PG8_SA(0, 0), a2, voffA);
            PG8_WAIT_V(8); PG8_WAIT_L(0); PG8_BAR; PG8_MMA(1, 0, At, B0); PG8_MMA(1, 1, At, B1); PG8_BAR; PG8_SCHED;
            PG8_LDB(B0, 1, 0); PG8_LDB(B1, 1, 1); PG8_SCHED; PG8_LDA(At, 1, 0); PG8_STAGE(PG8_SA(0, 1), a2 + hstep, voffA);
            PG8_WAIT_V(8); PG8_WAIT_L(0); PG8_BAR; PG8_MMA(0, 0, At, B0); PG8_MMA(0, 1, At, B1); PG8_BAR; PG8_SCHED;
            PG8_LDA(At, 1, 1); PG8_STAGE(PG8_SB(1, 0), b3, voffB); PG8_STAGE(PG8_SB(1, 1), b3 + hstep, voffB); PG8_STAGE(PG8_SA(1, 0), a3, voffA);
            PG8_WAIT_V(8); PG8_WAIT_L(0); PG8_BAR; PG8_MMA(1, 0, At, B0); PG8_MMA(1, 1, At, B1); PG8_BAR; PG8_SCHED;
            } else {
            PG8_LDB(B0, 0, 0); PG8_SCHED; PG8_LDA(At, 0, 0); PG8_STAGE(PG8_SA(1, 1), a1 + hstep, voffA);
            PG8_WAIT_L(8); PG8_BAR; PG8_WAIT_L(0); PG8_MMA(0, 0, At, B0); PG8_BAR; PG8_SCHED;
            PG8_LDB(B1, 0, 1); PG8_STAGE(PG8_SB(0, 0), b2, voffB);
            PG8_BAR; PG8_WAIT_L(0); PG8_MMA(0, 1, At, B1); PG8_BAR;
            PG8_LDA(At, 0, 1); PG8_STAGE(PG8_SA(0, 0), a2, voffA);
            PG8_BAR; PG8_WAIT_L(0); PG8_MMA(1, 0, At, B0); PG8_BAR; PG8_SCHED;
            PG8_STAGE(PG8_SB(0, 1), b2 + hstep, voffB);
            PG8_WAIT_V(6); PG8_BAR; PG8_MMA(1, 1, At, B1); PG8_BAR;
            PG8_LDB(B0, 1, 0); PG8_SCHED; PG8_LDA(At, 1, 0); PG8_STAGE(PG8_SA(0, 1), a2 + hstep, voffA);
            PG8_WAIT_L(8); PG8_BAR; PG8_WAIT_L(0); PG8_MMA(0, 0, At, B0); PG8_BAR; PG8_SCHED;
            PG8_LDB(B1, 1, 1); PG8_STAGE(PG8_SB(1, 0), b3, voffB);
            PG8_BAR; PG8_WAIT_L(0); PG8_MMA(0, 1, At, B1); PG8_BAR;
            PG8_LDA(At, 1, 1); PG8_STAGE(PG8_SA(1, 0), a3, voffA);
            PG8_BAR; PG8_WAIT_L(0); PG8_MMA(1, 0, At, B0); PG8_BAR; PG8_SCHED;
            PG8_STAGE(PG8_SB(1, 1), b3 + hstep, voffB);
            PG8_WAIT_V(6); PG8_BAR; PG8_MMA(1, 1, At, B1); PG8_BAR;
            }
        }
        if constexpr (ALIGN_EPI) { if (wr == 0) PG8_BAR; }
        if constexpr (!Epi::AFTER_DRAIN) { E(acc, cur, wr, wc, fr, fq); S.done(cur); }
        if (!has_next) break;
#pragma unroll
        for (int a = 0; a < 2; ++a)
#pragma unroll
            for (int b = 0; b < 2; ++b)
#pragma unroll
                for (int m = 0; m < 4; ++m)
#pragma unroll
                    for (int n = 0; n < 2; ++n) acc[a][b][m][n] = (f32x4){0.f, 0.f, 0.f, 0.f};
        cur = nxt; cA = nA; cB = nB; ++ui;
        if constexpr (ALIGN_EPI) { if (wr == 1) PG8_BAR; }
    }
    PG8_WAIT_V(0);
    if constexpr (!ALIGN_EPI) { if (wr == 0) PG8_BAR; }
    PG8_BAR;
    if constexpr (Epi::AFTER_DRAIN) { E.fused(acc, cur, wr, wc, fr, fq, lds, wid, lane); S.done(cur); }
#undef PG8_SA
#undef PG8_SB
#undef PG8_STAGE
#undef PG8_LDA
#undef PG8_LDB
#undef PG8_MMA
#undef PG8_WAIT_V
#undef PG8_WAIT_L
#undef PG8_BAR
#undef PG8_SCHED
}
}

namespace cg = cooperative_groups;
#ifndef MK_MODE
#define MK_MODE 2
#endif
constexpr int NWAVES = 8;

constexpr int NB = 8, SEQ = 4096, DM = 1024, NL = 2;
constexpr int M = NB * SEQ;
constexpr int PIN = 2688, PINP = 2816;
constexpr int DFF = 2816, DUP = 2 * DFF;
constexpr int DA = 256, DB = 384, DC = 384;
constexpr int NMOD = 6 * DM;
constexpr int PC_OFF = 1280;
constexpr int NPHASE = 22;

constexpr size_t MiB = 1u << 20;
constexpr size_t WS_CTL = 0, CTL_ZERO_BYTES = 64 * 1024;
constexpr size_t WS_SMALL = 1 * MiB;
constexpr size_t SM_SGUW = 0, SM_LRUWA = 256 * 1024, SM_LRUWX = 352 * 1024, SM_RW2 = 448 * 1024, SM_RA2 = 544 * 1024, SM_RG2 = 640 * 1024;
constexpr size_t WS_MOD = 2 * MiB;
constexpr size_t WS_LRUS = 3 * MiB;
constexpr size_t WS_WIN = 4 * MiB, WS_WOUT = 15 * MiB, WS_WUP = 19 * MiB, WS_WDN = 41 * MiB;
constexpr size_t WS_HY = 64 * MiB;
constexpr size_t WS_P = 128 * MiB;
constexpr size_t WS_UV = 304 * MiB;
constexpr size_t WS_R = 304 * MiB, WS_K = 328 * MiB, WS_V = 352 * MiB, WS_KK = 376 * MiB, WS_BV = 400 * MiB;
constexpr size_t WS_WD = 424 * MiB;
constexpr size_t WS_Q2 = 472 * MiB;
constexpr size_t WS_TG = 496 * MiB, WS_HG = 500 * MiB, WS_HV = 504 * MiB;
constexpr size_t WS_END = 512 * MiB;
static_assert(WS_Q2 + (size_t)M * 384 * 2 <= WS_END && WS_UV + (size_t)M * DFF * 2 <= WS_END && WS_P + (size_t)M * PINP * 2 <= WS_UV, "d_ws map");
static_assert(WS_WDN + (size_t)NL * DM * DFF * 2 <= WS_HY && WS_WIN + (size_t)NL * PINP * DM * 2 <= WS_WOUT && WS_WUP + (size_t)NL * DUP * DM * 2 <= WS_WDN, "weights map");
constexpr int CW_BAR = 1024;

constexpr int RING_BYTES = 131072;
constexpr int LDSCTL_OFF = RING_BYTES, MISC_OFF = LDSCTL_OFF + 320;
constexpr int TAIL_OFF = 132096;
constexpr int LDS_BYTES = 147456;

#define GAS __attribute__((address_space(1)))
#define LAS __attribute__((address_space(3)))
typedef unsigned short bf16;
typedef float f32x4 __attribute__((ext_vector_type(4)));
typedef float f32x2 __attribute__((ext_vector_type(2)));
typedef float f32x16 __attribute__((ext_vector_type(16)));
typedef short bf16x8 __attribute__((ext_vector_type(8)));
typedef unsigned u32x2 __attribute__((ext_vector_type(2)));
typedef unsigned u32x4 __attribute__((ext_vector_type(4)));
typedef GAS unsigned gu32;
#define RLX_AGENT __ATOMIC_RELAXED, __HIP_MEMORY_SCOPE_AGENT

__device__ __forceinline__ float bflo(unsigned w) { return __builtin_bit_cast(float, w << 16); }
__device__ __forceinline__ float bfhi(unsigned w) { return __builtin_bit_cast(float, w & 0xffff0000u); }
__device__ __forceinline__ float bf1(bf16 u) { return __builtin_bit_cast(float, (unsigned)u << 16); }
__device__ __forceinline__ unsigned pk2(float lo, float hi) { return pg8::cvt_pk_bf16(lo, hi); }
__device__ __forceinline__ bf16 f2bf(float f) { return (bf16)(pg8::cvt_pk_bf16(f, f) & 0xffffu); }
__device__ __forceinline__ f32x4 unpack4(u32x2 w) { return (f32x4){bflo(w.x), bfhi(w.x), bflo(w.y), bfhi(w.y)}; }
__device__ __forceinline__ u32x2 pack4(f32x4 v) { u32x2 w; w.x = pk2(v[0], v[1]); w.y = pk2(v[2], v[3]); return w; }

__device__ __forceinline__ float fexp(float x) { return __builtin_amdgcn_exp2f(x * 1.4426950408889634f); }
__device__ __forceinline__ float flog(float x) { return __builtin_amdgcn_logf(x) * 0.6931471805599453f; }
__device__ __forceinline__ float fsigmoid(float x) { return __builtin_amdgcn_rcpf(1.f + fexp(-x)); }
__device__ __forceinline__ float fgelu(float x) { const float y = 1.5957691216f * x * (1.f + 0.044715f * x * x); return x * fsigmoid(y); }
__device__ __forceinline__ float fsilu(float x) { return x * fsigmoid(x); }
__device__ __forceinline__ float fsoftplus(float x) { return fmaxf(x, 0.f) + flog(1.f + fexp(-fabsf(x))); }
__device__ __forceinline__ float fsoftplus_acc(float x) { return fmaxf(x, 0.f) + log1pf(expf(-fabsf(x))); }
__device__ __forceinline__ float ftanh(float x) { return 1.f - 2.f * __builtin_amdgcn_rcpf(1.f + fexp(2.f * x)); }
__device__ __forceinline__ float fnegexpm1(float x) {
    const float ser = -x * (1.f + x * (0.5f + x * (0.16666667f + x * (0.041666668f + x * (0.008333334f + x * 0.0013888889f)))));
    return x > -0.25f ? ser : 1.f - fexp(x);
}
__device__ __forceinline__ int opaque_tid() { int t = threadIdx.x; asm volatile("" : "+v"(t)); return t; }
template <int CTRL> __device__ __forceinline__ float dppf(float x) { return __builtin_bit_cast(float, __builtin_amdgcn_mov_dpp(__builtin_bit_cast(int, x), CTRL, 0xf, 0xf, true)); }
__device__ __forceinline__ float red16(float p) { p += dppf<0xB1>(p); p += dppf<0x4E>(p); p += dppf<0x141>(p); p += dppf<0x128>(p); return p; }
__device__ __forceinline__ float wave_sum(float v) {
#pragma unroll
    for (int o = 1; o < 64; o <<= 1) v += __shfl_xor(v, o);
    return v;
}
#define XB_TMO      128
#define XB_XCNT(j)  (256  + 64 * (j))
#define XB_XSUB(j)  (1280 + 64 * (j))
#define XB_XGEN(j)  (2304 + 64 * (j))
#define XB_TOP      3328
#define XB_TOPGEN   3392
#define XCD_BAR_WORDS 3456
#define XB_SPIN_CAP (1u << 18)

__device__ __forceinline__ unsigned xb_ld(unsigned* p)              { return __hip_atomic_load(p, __ATOMIC_RELAXED, __HIP_MEMORY_SCOPE_AGENT); }
__device__ __forceinline__ unsigned xb_add(unsigned* p, unsigned v) { return __hip_atomic_fetch_add(p, v, __ATOMIC_RELAXED, __HIP_MEMORY_SCOPE_AGENT); }
__device__ __forceinline__ unsigned xb_xcc_id() { return (unsigned)__builtin_amdgcn_s_getreg((3 << 11) | 20) & 0xFu; }
#define XB_SPIN(cond, bar) do { unsigned _sp = 0; while (cond) { __builtin_amdgcn_s_sleep(1); \
    if ((++_sp & 255u) == 0u) { if (xb_ld(&(bar)[XB_TMO])) break; if (_sp > XB_SPIN_CAP) { atomicAdd(&(bar)[XB_TMO], 1u); break; } } } } while (0)

struct XcdBarrier {
    unsigned* bar; unsigned x;
    volatile LAS unsigned* st;
};

__device__ __forceinline__ XcdBarrier xcd_barrier_post(unsigned* bar, volatile LAS unsigned* st) {
    XcdBarrier b; b.bar = bar; b.x = xb_xcc_id(); b.st = st;
    if (threadIdx.x == 0) (void)xb_add(&bar[XB_XCNT(b.x)], 1u);
    return b;
}
__device__ __forceinline__ void xcd_barrier_complete(unsigned* bar, unsigned x, unsigned& nloc, unsigned& nx) {
    const unsigned G = gridDim.x * gridDim.y * gridDim.z;
    unsigned sum, cnt, mine, sp = 0u;
    for (;;) {
        sum = 0u; cnt = 0u; mine = 0u;
#pragma unroll
        for (unsigned j = 0; j < 16; ++j) { const unsigned c = xb_ld(&bar[XB_XCNT(j)]); sum += c; cnt += (c > 0u) ? 1u : 0u; mine = (j == x) ? c : mine; }
        if (sum == G) break;
        __builtin_amdgcn_s_sleep(1);
        if ((++sp & 255u) == 0u) { if (xb_ld(&bar[XB_TMO])) break; if (sp > XB_SPIN_CAP) { atomicAdd(&bar[XB_TMO], 1u); break; } }
    }
    nloc = mine > 0u ? mine : 1u; nx = cnt > 0u ? cnt : 1u;
}

__device__ __forceinline__ void xcd_barrier(const XcdBarrier& b) {
    asm volatile("s_waitcnt vmcnt(0)" ::: "memory");
    __syncthreads();
    if (threadIdx.x == 0) {
        unsigned* bar = b.bar;
        __builtin_amdgcn_s_waitcnt(0);
        unsigned nloc = b.st[0], nx = b.st[1];
        if (nloc == 0u) { xcd_barrier_complete(bar, b.x, nloc, nx); b.st[0] = nloc; b.st[1] = nx; }
        const unsigned old = xb_add(&bar[XB_XSUB(b.x)], 1u);
        const unsigned gen = old / nloc;
        if (old + 1u == (gen + 1u) * nloc) {
            __builtin_amdgcn_fence(__ATOMIC_RELEASE, "agent");
            asm volatile("s_waitcnt vmcnt(0)" ::: "memory");
            const unsigned og = xb_add(&bar[XB_TOP], 1u);
            const unsigned tg = og / nx;
            if (og + 1u == (tg + 1u) * nx) xb_add(&bar[XB_TOPGEN], 1u);
            else XB_SPIN(xb_ld(&bar[XB_TOPGEN]) == tg, bar);
            __builtin_amdgcn_fence(__ATOMIC_ACQUIRE, "agent");
            xb_add(&bar[XB_XGEN(b.x)], 1u);
            asm volatile("s_waitcnt vmcnt(0)" ::: "memory");
        } else {
            XB_SPIN(xb_ld(&bar[XB_XGEN(b.x)]) == gen, bar);
            __builtin_amdgcn_fence(__ATOMIC_ACQUIRE, "agent");
            asm volatile("s_waitcnt vmcnt(0)" ::: "memory");
        }
    }
    __syncthreads();
}

struct Frame {
    LAS unsigned char* lds;
    volatile LAS unsigned* MISC;
    gu32* ctl;
    int wave, vcu, G;
    const float *x, *c, *w_mod, *b_mod, *norm_mix, *w_in, *w_out, *sgu_ln_g, *sgu_ln_b, *sgu_w, *sgu_b, *lru_conv_w, *lru_conv_b, *lru_w_a, *lru_b_a, *lru_w_x, *lru_b_x, *lru_lambda,
        *rwkv_mu, *rwkv_w0, *rwkv_w2, *rwkv_a0, *rwkv_a2, *rwkv_g2, *rwkv_k_k, *rwkv_k_a, *rwkv_r_k, *rwkv_ln_w, *rwkv_ln_b, *norm_ffn, *ffn_w_up, *ffn_conv_w, *ffn_conv_b, *ffn_w_down, *norm_final;
    float* out;
    bf16 *SGUW, *LRUWA, *LRUWX, *RW2, *RA2, *RG2;
    float *MOD, *LRUSA, *LRUSH;
    bf16 *WIN, *WOUT, *WUP, *WDN;
    bf16 *HY, *P, *UG, *UV, *R, *K, *V, *KK, *BV, *Q2;
    float *O, *WD;
    float *TG, *HG, *HV;
};

__device__ __forceinline__ void p0_transpose_item(const float* W, int K, int N, bf16* WT, int k0, int n0, int drow0, LAS float* scr, int lane) {
#pragma unroll 8
    for (int i = 0; i < 32; ++i) { const int kk = 2 * i + (lane >> 5); scr[kk * 33 + (lane & 31)] = W[(size_t)(k0 + kk) * N + n0 + (lane & 31)]; }
    asm volatile("s_waitcnt lgkmcnt(0)" ::: "memory");
    const int c = lane & 7;
#pragma unroll
    for (int j = 0; j < 4; ++j) { const int n = (lane >> 3) + 8 * j; const LAS float* s = scr + (8 * c) * 33 + n;
        u32x4 o; o.x = pk2(s[0 * 33], s[1 * 33]); o.y = pk2(s[2 * 33], s[3 * 33]); o.z = pk2(s[4 * 33], s[5 * 33]); o.w = pk2(s[6 * 33], s[7 * 33]);
        *(u32x4*)(WT + (size_t)(drow0 + n) * K + k0 + 8 * c) = o; }
    asm volatile("s_waitcnt lgkmcnt(0)" ::: "memory");
}
__device__ __forceinline__ void p0_prologue(Frame& F) {
    const int tid = opaque_tid(), lane = tid & 63, wave = F.wave;
    const int gw = F.vcu * NWAVES + wave, NGW = F.G * NWAVES;
    const int gt = F.vcu * (NWAVES * 64) + tid, NGT = F.G * NWAVES * 64;
    if (F.vcu < 192) {
        LAS float* cact = (LAS float*)(F.lds + 73728);
        LAS float* red = (LAS float*)(F.lds + 106496);
        for (int i = tid; i < NB * DM; i += NWAVES * 64) { const float cv = F.c[i]; cact[i] = cv * fsigmoid(cv); }
        __syncthreads();
        const int l = F.vcu / 96, n0 = (F.vcu % 96) * 64;
        const float* wm = F.w_mod + ((size_t)l * DM + 128 * wave) * NMOD + n0 + lane;
        float acc[NB];
#pragma unroll
        for (int b = 0; b < NB; ++b) acc[b] = 0.f;
        for (int k4 = 0; k4 < 128; k4 += 4) {
            const float w0 = wm[(size_t)(k4 + 0) * NMOD], w1 = wm[(size_t)(k4 + 1) * NMOD], w2 = wm[(size_t)(k4 + 2) * NMOD], w3 = wm[(size_t)(k4 + 3) * NMOD];
#pragma unroll
            for (int b = 0; b < NB; ++b) { const f32x4 cv = *(const LAS f32x4*)(cact + b * DM + 128 * wave + k4); acc[b] += cv[0] * w0 + cv[1] * w1 + cv[2] * w2 + cv[3] * w3; }
        }
#pragma unroll
        for (int b = 0; b < NB; ++b) red[(wave * NB + b) * 64 + lane] = acc[b];
        __syncthreads();
        { const int b = tid >> 6, col = tid & 63; float s = F.b_mod[l * NMOD + n0 + col];
#pragma unroll
          for (int w = 0; w < NWAVES; ++w) s += red[(w * NB + b) * 64 + col];
          F.MOD[(size_t)(l * NB + b) * NMOD + n0 + col] = s; }
        __syncthreads();
    }
    {
        LAS float* scr = (LAS float*)(F.lds + wave * 9216);
        constexpr int I_IN = (DM / 64) * (PIN / 32), I_OUT = (DM / 64) * (DM / 32), I_UP = (DM / 64) * (DUP / 32), I_DN = (DFF / 64) * (DM / 32);
        constexpr int PER_L = I_IN + I_OUT + I_UP + I_DN;
        for (int it = gw; it < NL * PER_L; it += NGW) {
            const int l = it / PER_L; int r = it % PER_L;
            if (r < I_IN) { const int nblk = PIN / 32, kb = r / nblk, nb = r % nblk; p0_transpose_item(F.w_in + (size_t)l * DM * PIN, DM, PIN, F.WIN + (size_t)l * PINP * DM, 64 * kb, 32 * nb, 32 * nb, scr, lane); continue; } r -= I_IN;
            if (r < I_OUT) { const int nblk = DM / 32, kb = r / nblk, nb = r % nblk; p0_transpose_item(F.w_out + (size_t)l * DM * DM, DM, DM, F.WOUT + (size_t)l * DM * DM, 64 * kb, 32 * nb, 32 * nb, scr, lane); continue; } r -= I_OUT;
            if (r < I_UP) { const int nblk = DUP / 32, kb = r / nblk, nb = r % nblk; const int n0 = 32 * nb, isv = n0 >= DFF ? 1 : 0, j = n0 - isv * DFF, drow = (j / 128) * 256 + isv * 128 + (j % 128);
                p0_transpose_item(F.ffn_w_up + (size_t)l * DM * DUP, DM, DUP, F.WUP + (size_t)l * DUP * DM, 64 * kb, n0, drow, scr, lane); continue; } r -= I_UP;
            { const int nblk = DM / 32, kb = r / nblk, nb = r % nblk; p0_transpose_item(F.ffn_w_down + (size_t)l * DFF * DM, DFF, DM, F.WDN + (size_t)l * DM * DFF, 64 * kb, 32 * nb, 32 * nb, scr, lane); }
        }
        for (int i = gt; i < NL * (PINP - PIN) * DM / 8; i += NGT) { const int l = i / ((PINP - PIN) * DM / 8), o = i % ((PINP - PIN) * DM / 8);
            *(u32x4*)(F.WIN + (size_t)l * PINP * DM + (size_t)PIN * DM + (size_t)o * 8) = (u32x4){0u, 0u, 0u, 0u}; }
    }
    for (int i = gt; i < NL * 4 * 128 * 128; i += NGT) { const int s = i & 127, t = (i >> 7) & 127; F.SGUW[i] = s <= t ? f2bf(F.sgu_w[i]) : (bf16)0; }
    for (int i = gt; i < NL * 6 * 64 * 64; i += NGT) { const int ii = i & 63, j = (i >> 6) & 63, lh = i >> 12;
        F.LRUWA[i] = f2bf(F.lru_w_a[(size_t)lh * 4096 + ii * 64 + j]); F.LRUWX[i] = f2bf(F.lru_w_x[(size_t)lh * 4096 + ii * 64 + j]); }
    for (int i = gt; i < NL * 384 * 64; i += NGT) { const int k = i & 63, n = (i >> 6) % 384, l = i / (384 * 64);
        F.RW2[i] = f2bf(F.rwkv_w2[(size_t)l * 64 * 384 + k * 384 + n]); F.RA2[i] = f2bf(F.rwkv_a2[(size_t)l * 64 * 384 + k * 384 + n]); }
    for (int i = gt; i < NL * 384 * 128; i += NGT) { const int k = i & 127, n = (i >> 7) % 384, l = i / (384 * 128);
        F.RG2[i] = f2bf(F.rwkv_g2[(size_t)l * 128 * 384 + k * 384 + n]); }
}

__device__ __forceinline__ void norm_mod_phase(Frame& F, const float* X, const float* gamma, const float* mod_l, int sh_idx, int sc_idx, bf16* H) {
    const int gw = F.vcu * NWAVES + F.wave, NGW = F.G * NWAVES, lane = opaque_tid() & 63;
    f32x4 g[4], nx[4];
#pragma unroll
    for (int j = 0; j < 4; ++j) g[j] = *(const f32x4*)(gamma + 4 * (lane + 64 * j));
    if (gw < M) {
#pragma unroll
        for (int j = 0; j < 4; ++j) nx[j] = ((const f32x4*)(X + (size_t)gw * DM) + lane)[64 * j];
    }
    for (int m = gw; m < M; m += NGW) {
        f32x4 v[4]; float s = 0.f;
#pragma unroll
        for (int j = 0; j < 4; ++j) { v[j] = nx[j]; s += (v[j][0] * v[j][0] + v[j][1] * v[j][1]) + (v[j][2] * v[j][2] + v[j][3] * v[j][3]); }
        if (m + NGW < M) {
#pragma unroll
            for (int j = 0; j < 4; ++j) nx[j] = ((const f32x4*)(X + (size_t)(m + NGW) * DM) + lane)[64 * j];
        }
        const float* mb = mod_l + (size_t)(m >> 12) * NMOD;
        f32x4 sc[4], sh[4];
#pragma unroll
        for (int j = 0; j < 4; ++j) { const int c = 4 * (lane + 64 * j); sc[j] = *(const f32x4*)(mb + sc_idx * DM + c); sh[j] = *(const f32x4*)(mb + sh_idx * DM + c); }
        const float rstd = __builtin_amdgcn_rsqf(wave_sum(s) * (1.f / DM) + 1e-6f);
        u32x2* o8 = (u32x2*)(H + (size_t)m * DM) + lane;
#pragma unroll
        for (int j = 0; j < 4; ++j) { const f32x4 y = (v[j] * rstd) * g[j] * (sc[j] + 1.f) + sh[j]; o8[64 * j] = pack4(y); }
    }
}
__device__ __forceinline__ void final_norm_phase(Frame& F, float* X, const float* gamma) {
    const int gw = F.vcu * NWAVES + F.wave, NGW = F.G * NWAVES, lane = opaque_tid() & 63;
    f32x4 g[4], nx[4];
#pragma unroll
    for (int j = 0; j < 4; ++j) g[j] = *(const f32x4*)(gamma + 4 * (lane + 64 * j));
    if (gw < M) {
#pragma unroll
        for (int j = 0; j < 4; ++j) nx[j] = ((const f32x4*)(X + (size_t)gw * DM) + lane)[64 * j];
    }
    for (int m = gw; m < M; m += NGW) {
        f32x4 v[4]; float s = 0.f;
#pragma unroll
        for (int j = 0; j < 4; ++j) { v[j] = nx[j]; s += (v[j][0] * v[j][0] + v[j][1] * v[j][1]) + (v[j][2] * v[j][2] + v[j][3] * v[j][3]); }
        if (m + NGW < M) {
#pragma unroll
            for (int j = 0; j < 4; ++j) nx[j] = ((const f32x4*)(X + (size_t)(m + NGW) * DM) + lane)[64 * j];
        }
        const float rstd = __builtin_amdgcn_rsqf(wave_sum(s) * (1.f / DM) + 1e-6f);
        f32x4* xr = (f32x4*)(X + (size_t)m * DM) + lane;
#pragma unroll
        for (int j = 0; j < 4; ++j) xr[64 * j] = (v[j] * rstd) * g[j];
    }
}

__device__ __forceinline__ void mix_chunk(Frame& F, const int l, const int ch) {
    const int wave = F.wave;
    const int n = ch & 31; const size_t r0 = (size_t)ch * 128;
    const bf16* P = F.P; bf16* Y = F.HY;
    LAS unsigned char* lds = F.lds;
#ifndef MK_MIXDUP
#define MK_MIXDUP 0
#endif
    for (int mrep = 0; mrep <= ((MK_MIXDUP) & 1); ++mrep) {
        if (mrep) __syncthreads();
        const int tid = opaque_tid(), lane = tid & 63, r = lane & 31, hh = lane >> 5;
        LAS bf16* VT = (LAS bf16*)lds;
        LAS f32x2* ST = (LAS f32x2*)(lds + 69632);
        const int t = tid & 127, q = __builtin_amdgcn_readfirstlane(tid >> 7);
        const bf16* src = P + (r0 + t) * PINP + 256 + 64 * q;
        float v[64]; float s = 0.f, ss = 0.f;
#pragma unroll
        for (int i = 0; i < 8; ++i) { const u32x4 w = *(const u32x4*)(src + 8 * i);
            const float e0 = fgelu(bflo(w.x)), e1 = fgelu(bfhi(w.x)), e2 = fgelu(bflo(w.y)), e3 = fgelu(bfhi(w.y)), e4 = fgelu(bflo(w.z)), e5 = fgelu(bfhi(w.z)), e6 = fgelu(bflo(w.w)), e7 = fgelu(bfhi(w.w));
            v[8 * i + 0] = e0; v[8 * i + 1] = e1; v[8 * i + 2] = e2; v[8 * i + 3] = e3; v[8 * i + 4] = e4; v[8 * i + 5] = e5; v[8 * i + 6] = e6; v[8 * i + 7] = e7;
            s += ((e0 + e1) + (e2 + e3)) + ((e4 + e5) + (e6 + e7)); ss += ((e0 * e0 + e1 * e1) + (e2 * e2 + e3 * e3)) + ((e4 * e4 + e5 * e5) + (e6 * e6 + e7 * e7)); }
        ST[q * 128 + t] = (f32x2){s, ss};
        __syncthreads();
        const f32x2 a0 = ST[t], a1 = ST[128 + t], a2 = ST[256 + t], a3 = ST[384 + t];
        const float mean = ((a0.x + a1.x) + (a2.x + a3.x)) * (1.f / 256.f), ex2 = ((a0.y + a1.y) + (a2.y + a3.y)) * (1.f / 256.f);
        const float rstd = __builtin_amdgcn_rsqf(fmaxf(ex2 - mean * mean, 0.f) + 1e-5f);
        const float* lg = F.sgu_ln_g + l * DA + 64 * q; const float* lb = F.sgu_ln_b + l * DA + 64 * q;
#pragma unroll
        for (int i = 0; i < 64; ++i) VT[(64 * q + i) * 136 + t] = f2bf((v[i] - mean) * rstd * lg[i] + lb[i]);
        __syncthreads();
        const int h = wave >> 1, dh = wave & 1;
        const bf16* Wg = F.SGUW + (size_t)(l * 4 + h) * 128 * 128;
        const LAS bf16* vrow = VT + (64 * h + 32 * dh + r) * 136 + 8 * hh;
#pragma unroll 1
        for (int tb = 0; tb < 4; ++tb) {
            f32x16 acc;
#pragma unroll
            for (int i = 0; i < 16; ++i) acc[i] = 0.f;
            const bf16* wrow = Wg + (size_t)(32 * tb + r) * 128 + 8 * hh;
#pragma unroll 2
            for (int ks = 0; ks < 2 * (tb + 1); ++ks) {
                const bf16x8 a = *(const LAS bf16x8*)(vrow + 16 * ks);
                const bf16x8 b = *(const bf16x8*)(wrow + 16 * ks);
                acc = __builtin_amdgcn_mfma_f32_32x32x16_bf16(a, b, acc, 0, 0, 0);
            }
            const int tt = 32 * tb + r; const size_t row = r0 + tt;
            const float bias = F.sgu_b[(l * 4 + h) * 128 + tt];
            u32x2 uq[4];
#pragma unroll
            for (int g = 0; g < 4; ++g) uq[g] = *(const u32x2*)(P + row * PINP + 64 * h + 32 * dh + 8 * g + 4 * hh);
#pragma unroll
            for (int g = 0; g < 4; ++g) { const int c4 = 64 * h + 32 * dh + 8 * g + 4 * hh;
                const f32x4 u = unpack4(uq[g]);
                f32x4 y; y[0] = fgelu(u[0]) * (acc[4 * g + 0] + bias); y[1] = fgelu(u[1]) * (acc[4 * g + 1] + bias); y[2] = fgelu(u[2]) * (acc[4 * g + 2] + bias); y[3] = fgelu(u[3]) * (acc[4 * g + 3] + bias);
                *(u32x2*)(Y + row * DM + c4) = pack4(y); }
        }
    }
    __syncthreads();
    for (int mrep = 0; mrep <= (((MK_MIXDUP) >> 1) & 1); ++mrep) {
        if (mrep) __syncthreads();
        const int tid = opaque_tid(), lane = tid & 63, r = lane & 31, hh = lane >> 5;
        LAS bf16* XC = (LAS bf16*)lds;
        LAS float* LA = (LAS float*)(lds + 25088);
        LAS float* BT = (LAS float*)(lds + 25088 + 49152);
        const int q = tid % 96, rs = tid / 96, c4 = 4 * q; const bool act = tid < DB;
        f32x4 cw0, cw1, cw2, cw3, cb, bra, bix, sp8;
        { cw0 = *(const f32x4*)(F.lru_conv_w + (l * 4 + 0) * DB + c4); cw1 = *(const f32x4*)(F.lru_conv_w + (l * 4 + 1) * DB + c4); cw2 = *(const f32x4*)(F.lru_conv_w + (l * 4 + 2) * DB + c4); cw3 = *(const f32x4*)(F.lru_conv_w + (l * 4 + 3) * DB + c4);
          cb = *(const f32x4*)(F.lru_conv_b + l * DB + c4); bra = *(const f32x4*)(F.lru_b_a + l * DB + c4); bix = *(const f32x4*)(F.lru_b_x + l * DB + c4);
          const f32x4 lam = *(const f32x4*)(F.lru_lambda + l * DB + c4);
#pragma unroll
          for (int e = 0; e < 4; ++e) sp8[e] = -8.f * fsoftplus_acc(-lam[e]); }
        float hst = 0.f, ca = 1.f;
        for (int tq = 0; tq < 4; ++tq) {
            if (act) {
                const bf16* src = P + (r0 + 32 * tq + 8 * rs) * PINP + 512 + c4;
                u32x2 raw[11];
                const bool hashalo = (n > 0) || (tq > 0) || (rs > 0);
#pragma unroll
                for (int i = 0; i < 11; ++i) raw[i] = (i >= 3 || hashalo) ? *(const u32x2*)(src + (ptrdiff_t)(i - 3) * PINP) : (u32x2){0u, 0u};
                f32x4 x3 = unpack4(raw[0]), x2 = unpack4(raw[1]), x1 = unpack4(raw[2]);
#pragma unroll
                for (int i = 0; i < 8; ++i) { const f32x4 x0 = unpack4(raw[3 + i]);
                    const f32x4 xc = cb + cw0 * x3 + cw1 * x2 + cw2 * x1 + cw3 * x0; x3 = x2; x2 = x1; x1 = x0;
                    *(LAS u32x2*)(XC + (8 * rs + i) * 392 + c4) = pack4(xc); }
            }
            __syncthreads();
            for (int k = 0; k < 3; ++k) {
                const int id = wave + 8 * k, mat = id / 12, hb = (id % 12) >> 1, jt = id & 1;
                const bf16* Wt = (mat ? F.LRUWX : F.LRUWA) + (size_t)((l * 6 + hb) * 64 + 32 * jt + r) * 64 + 8 * hh;
                const LAS bf16* xrow = XC + r * 392 + 64 * hb + 8 * hh;
                f32x16 acc;
#pragma unroll
                for (int i = 0; i < 16; ++i) acc[i] = 0.f;
#pragma unroll
                for (int ks = 0; ks < 4; ++ks) { const bf16x8 a = *(const LAS bf16x8*)(xrow + 16 * ks); const bf16x8 b = *(const bf16x8*)(Wt + 16 * ks);
                    acc = __builtin_amdgcn_mfma_f32_32x32x16_bf16(a, b, acc, 0, 0, 0); }
                LAS float* dst = (mat ? BT : LA) + 64 * hb + 32 * jt + r;
#pragma unroll
                for (int rg = 0; rg < 16; ++rg) dst[((rg & 3) + 8 * (rg >> 2) + 4 * hh) * DB] = acc[rg];
            }
            __syncthreads();
            if (act) {
#pragma unroll 2
                for (int i = 0; i < 8; ++i) { const int tl = rs + 4 * i;
                    const f32x4 rp = *(const LAS f32x4*)(LA + tl * DB + c4) + bra, ip = *(const LAS f32x4*)(BT + tl * DB + c4) + bix;
                    const f32x4 xc = unpack4(*(const LAS u32x2*)(XC + tl * 392 + c4));
                    f32x4 av, bv;
#pragma unroll
                    for (int e = 0; e < 4; ++e) { const float la = sp8[e] * fsigmoid(rp[e]); av[e] = fexp(la);
                        bv[e] = __builtin_amdgcn_sqrtf(fmaxf(fnegexpm1(2.f * la), 0.f)) * (fsigmoid(ip[e]) * xc[e]); }
                    *(LAS f32x4*)(LA + tl * DB + c4) = av; *(LAS f32x4*)(BT + tl * DB + c4) = bv; }
            }
            __syncthreads();
            if (act) {
#pragma unroll 8
                for (int i = 0; i < 32; ++i) { const float a = LA[i * DB + tid], bt = BT[i * DB + tid]; hst = a * hst + bt; ca *= a; LA[i * DB + tid] = hst; BT[i * DB + tid] = ca; }
            }
            __syncthreads();
            if (act) {
                u32x2 yg[8];
#pragma unroll
                for (int i = 0; i < 8; ++i) yg[i] = *(const u32x2*)(P + (r0 + 32 * tq + rs + 4 * i) * PINP + 896 + c4);
#pragma unroll
                for (int i = 0; i < 8; ++i) { const int tl = rs + 4 * i; const size_t row = r0 + 32 * tq + tl;
                    const f32x4 h4 = *(const LAS f32x4*)(LA + tl * DB + c4), ca4 = *(const LAS f32x4*)(BT + tl * DB + c4), y4 = unpack4(yg[i]);
                    f32x4 gl; gl[0] = fgelu(y4[0]); gl[1] = fgelu(y4[1]); gl[2] = fgelu(y4[2]); gl[3] = fgelu(y4[3]);
                    *(u32x2*)(Y + row * DM + 256 + c4) = pack4(gl * h4); *(u32x2*)(F.Q2 + row * DB + c4) = pack4(gl * ca4); }
            }
        }
        if (act) { F.LRUSA[(size_t)ch * DB + tid] = ca; F.LRUSH[(size_t)ch * DB + tid] = hst; }
    }
    __syncthreads();
    for (int mrep = 0; mrep <= (((MK_MIXDUP) >> 2) & 1); ++mrep) {
        if (mrep) __syncthreads();
        const int tid = opaque_tid(), lane = tid & 63, r = lane & 31, hh = lane >> 5;
        LAS bf16* TW = (LAS bf16*)lds;
        LAS bf16* XA = TW + 32 * 72;
        LAS bf16* SG = XA + 32 * 72;
        LAS float* LW = (LAS float*)(lds + 17920);
        LAS bf16* LAa = (LAS bf16*)(lds + 67072);
        LAS bf16* LG = (LAS bf16*)(lds + 91648);
        const float* mu = F.rwkv_mu + l * 1408;
        const int q = tid % 96, rs = tid / 96, n4 = 4 * q; const bool act3 = tid < 384;
        f32x4 p_mr, p_mk, p_mv, p_w0, p_a0, p_kk, p_ka;
        { p_mr = *(const f32x4*)(mu + n4); p_mk = *(const f32x4*)(mu + 384 + n4); p_mv = *(const f32x4*)(mu + 768 + n4);
          p_w0 = *(const f32x4*)(F.rwkv_w0 + l * DC + n4); p_a0 = *(const f32x4*)(F.rwkv_a0 + l * DC + n4); p_kk = *(const f32x4*)(F.rwkv_k_k + l * DC + n4); p_ka = *(const f32x4*)(F.rwkv_k_a + l * DC + n4); }
        const bf16* pc = P + PC_OFF + 1152 + 4 * lane; const f32x4 mu4 = *(const f32x4*)(mu + 1152 + 4 * lane);
        LAS bf16* c1dst = lane < 16 ? TW + 4 * lane : (lane < 32 ? XA + 4 * (lane - 16) : SG + 4 * (lane - 32));
        const int c1stride = lane < 32 ? 72 : 136;
#ifndef MK_CDUP
#define MK_CDUP 0
#endif
        for (int tb = 0; tb < 4; ++tb) {
            for (int c12 = 0; c12 <= ((MK_CDUP) & 1); ++c12) {
            if (c12) __syncthreads();
            {
                const int t0 = 32 * tb + 4 * wave;
                f32x4 prev = (f32x4){0.f, 0.f, 0.f, 0.f};
                if (t0 > 0 || n > 0) prev = unpack4(*(const u32x2*)(pc + (r0 + t0 - 1) * PINP));
#pragma unroll
                for (int i = 0; i < 4; ++i) {
                    const f32x4 cur = unpack4(*(const u32x2*)(pc + (r0 + t0 + i) * PINP));
                    const f32x4 xs = cur + (prev - cur) * mu4; prev = cur;
                    f32x4 y;
#pragma unroll
                    for (int e = 0; e < 4; ++e) y[e] = lane < 16 ? ftanh(xs[e]) : (lane < 32 ? xs[e] : fsigmoid(xs[e]));
                    *(LAS u32x2*)(c1dst + (4 * wave + i) * c1stride) = pack4(y); }
            }
            __syncthreads();
            for (int u = wave; u < 36; u += 8) {
                const int lora = u < 12 ? 0 : (u < 24 ? 1 : 2), nt = u - 12 * lora;
                f32x16 acc;
#pragma unroll
                for (int i = 0; i < 16; ++i) acc[i] = 0.f;
                const int nrow = 32 * nt + r;
                if (lora == 0) { const bf16* wr = F.RG2 + ((size_t)l * 384 + nrow) * 128 + 8 * hh; const LAS bf16* xr = SG + r * 136 + 8 * hh;
#pragma unroll
                    for (int ks = 0; ks < 8; ++ks) acc = __builtin_amdgcn_mfma_f32_32x32x16_bf16(*(const LAS bf16x8*)(xr + 16 * ks), *(const bf16x8*)(wr + 16 * ks), acc, 0, 0, 0);
                } else { const bf16* wr = (lora == 1 ? F.RW2 : F.RA2) + ((size_t)l * 384 + nrow) * 64 + 8 * hh; const LAS bf16* xr = (lora == 1 ? TW : XA) + r * 72 + 8 * hh;
#pragma unroll
                    for (int ks = 0; ks < 4; ++ks) acc = __builtin_amdgcn_mfma_f32_32x32x16_bf16(*(const LAS bf16x8*)(xr + 16 * ks), *(const bf16x8*)(wr + 16 * ks), acc, 0, 0, 0);
                }
                if (lora == 1) { LAS float* d = LW + 32 * nt + r;
#pragma unroll
                    for (int rg = 0; rg < 16; ++rg) d[((rg & 3) + 8 * (rg >> 2) + 4 * hh) * 384] = acc[rg];
                } else { LAS bf16* d = (lora == 0 ? LG : LAa) + 32 * nt + r;
#pragma unroll
                    for (int rg = 0; rg < 16; ++rg) d[((rg & 3) + 8 * (rg >> 2) + 4 * hh) * 384] = f2bf(acc[rg]); }
            }
            __syncthreads();
            }
            for (int c3r = 0; c3r <= (((MK_CDUP) >> 1) & 1); ++c3r)
            if (act3) {
                struct RowIn { u32x2 rc, kc, vc, rp, kp, vp; };
#define C3_LOAD(T, i) do { const int t_ = 32 * tb + rs + 4 * (i); const bf16* prow_ = P + (r0 + t_) * PINP + PC_OFF + n4; T.rc = *(const u32x2*)(prow_); T.kc = *(const u32x2*)(prow_ + 384); T.vc = *(const u32x2*)(prow_ + 768); \
        if (t_ > 0 || n > 0) { T.rp = *(const u32x2*)(prow_ - PINP); T.kp = *(const u32x2*)(prow_ - PINP + 384); T.vp = *(const u32x2*)(prow_ - PINP + 768); } else { T.rp = (u32x2){0u, 0u}; T.kp = T.rp; T.vp = T.rp; } } while (0)
                RowIn rin[2];
                C3_LOAD(rin[0], 0);
#pragma unroll
                for (int i = 0; i < 8; ++i) {
                    if (i + 1 < 8) C3_LOAD(rin[(i + 1) & 1], i + 1);
                    const RowIn& T = rin[i & 1];
                    const int tl = rs + 4 * i; const size_t row = r0 + 32 * tb + tl;
                    f32x4 rc = unpack4(T.rc), kc = unpack4(T.kc), vc = unpack4(T.vc);
                    const f32x4 rp = unpack4(T.rp), kp = unpack4(T.kp), vp = unpack4(T.vp);
                    rc = rc + (rp - rc) * p_mr; kc = kc + (kp - kc) * p_mk; vc = vc + (vp - vc) * p_mv;
                    const f32x4 lw = *(const LAS f32x4*)(LW + tl * 384 + n4), la = unpack4(*(const LAS u32x2*)(LAa + tl * 384 + n4));
                    const u32x2 lg = *(const LAS u32x2*)(LG + tl * 384 + n4);
                    const f32x4 kr = kc * p_kk;
                    const float ss = red16((kr[0] * kr[0] + kr[1] * kr[1]) + (kr[2] * kr[2] + kr[3] * kr[3]));
                    const float rn = __builtin_amdgcn_rsqf(fmaxf(ss, 1e-24f));
                    f32x4 dec, km, kk4, bv4;
#pragma unroll
                    for (int e = 0; e < 4; ++e) {
                        const float wv = -fsoftplus(-(p_w0[e] + lw[e])) - 0.5f; dec[e] = fexp(-fexp(wv));
                        const float a = fsigmoid(p_a0[e] + la[e]);
                        kk4[e] = kr[e] * rn; bv4[e] = kk4[e] * a;
                        km[e] = kc[e] * (1.f + (a - 1.f) * p_ka[e]); }
                    *(u32x2*)(F.R + row * DC + n4) = pack4(rc); *(u32x2*)(F.K + row * DC + n4) = pack4(km); *(u32x2*)(F.V + row * DC + n4) = pack4(vc);
                    *(f32x4*)(F.WD + row * DC + n4) = dec; *(u32x2*)(F.KK + row * DC + n4) = pack4(kk4); *(u32x2*)(F.BV + row * DC + n4) = pack4(bv4);
                    *(u32x2*)(Y + row * DM + 640 + n4) = lg;
                }
#undef C3_LOAD
            }
        }
    }
    __syncthreads();
}

__device__ __forceinline__ void rwkv_scan_item(Frame& F, const int it) {
#define SC_BAR() do { asm volatile("s_waitcnt lgkmcnt(0)" ::: "memory"); __builtin_amdgcn_s_barrier(); asm volatile("" ::: "memory"); } while (0)
    const int tid = opaque_tid();
    const int b = it / 24, h = (it % 24) >> 2, qt = it & 3;
    constexpr int CS = 16;
    constexpr int BUFF = 5 * CS * 64 + CS * 16;
    constexpr int OPF = CS * 16 * 16;
    constexpr int NCK = SEQ / CS;
    LAS float* buf = (LAS float*)F.lds;
    LAS float* opart = buf + 2 * BUFF;
    const size_t base = (size_t)b * SEQ * DC + 64 * h;
    if (tid >= 256) {
        const int lt = tid - 256, st = lt >> 4, q = lt & 15, vst = lt >> 2, vq = lt & 3;
        const size_t go = base + (size_t)st * DC + 4 * q;
        const bf16* gKK = F.KK + go; const bf16* gBV = F.BV + go; const bf16* gK = F.K + go; const bf16* gR = F.R + go; const float* gW = F.WD + go;
        const bf16* gV = F.V + base + (size_t)vst * DC + 16 * qt + 4 * vq;
        float* gO = F.O + base + 16 * qt + (size_t)(lt >> 4) * DC + (lt & 15);
        const bool ldv = lt < CS * 4;
        u32x2 kk0, bv0, k0, r0, v0 = (u32x2){0u, 0u}, kk1, bv1, k1, r1, v1 = (u32x2){0u, 0u}, kk2, bv2, k2, r2, v2 = (u32x2){0u, 0u}; f32x4 w0, w1, w2;
#define SC_LOAD(S, ck) do { const size_t _o = (size_t)(ck) * CS * DC; kk##S = *(const u32x2*)(gKK + _o); bv##S = *(const u32x2*)(gBV + _o); k##S = *(const u32x2*)(gK + _o); r##S = *(const u32x2*)(gR + _o); \
        w##S = *(const f32x4*)(gW + _o); if (ldv) v##S = *(const u32x2*)(gV + _o); } while (0)
#define SC_STORE(S, bb) do { LAS float* _b = (bb) + st * 64 + 4 * q; *(LAS f32x4*)(_b) = unpack4(kk##S); *(LAS f32x4*)(_b + CS * 64) = w##S; *(LAS f32x4*)(_b + 2 * CS * 64) = unpack4(bv##S); \
        *(LAS f32x4*)(_b + 3 * CS * 64) = unpack4(k##S); *(LAS f32x4*)(_b + 4 * CS * 64) = unpack4(r##S); if (ldv) *(LAS f32x4*)((bb) + 5 * CS * 64 + vst * 16 + 4 * vq) = unpack4(v##S); } while (0)
#define SC_FLUSH(ckf) do { const LAS f32x4* pp = (const LAS f32x4*)(opart + ((ckf) & 1) * OPF + lt * 16); const f32x4 a0 = pp[0], a1 = pp[1], a2 = pp[2], a3 = pp[3]; const f32x4 sm = (a0 + a1) + (a2 + a3); \
        gO[(size_t)(ckf) * CS * DC] = (sm[0] + sm[1]) + (sm[2] + sm[3]); } while (0)
#define SC_ITER(S, c) do { if ((c) > 0) SC_FLUSH((c) - 1); if ((c) + 1 < NCK) SC_STORE(S, buf + (((c) + 1) & 1) * BUFF); if ((c) + 4 < NCK) SC_LOAD(S, (c) + 4); SC_BAR(); } while (0)
        SC_LOAD(0, 0); SC_LOAD(1, 1); SC_LOAD(2, 2); SC_STORE(0, buf); SC_LOAD(0, 3);
        SC_BAR();
        for (int ck = 0; ck < NCK; ck += 3) {
            SC_ITER(1, ck);
            if (ck + 1 < NCK) SC_ITER(2, ck + 1);
            if (ck + 2 < NCK) SC_ITER(0, ck + 2);
        }
        SC_FLUSH(NCK - 1);
#undef SC_ITER
#undef SC_LOAD
#undef SC_STORE
#undef SC_FLUSH
    } else {
        const int gl = tid & 15, row = tid >> 4;
#define SC_READ(T, cbp, tt) do { T.kk = *(const LAS f32x4*)((cbp) + (tt) * 64 + 4 * gl); T.w = *(const LAS f32x4*)((cbp) + CS * 64 + (tt) * 64 + 4 * gl); T.bb = *(const LAS f32x4*)((cbp) + 2 * CS * 64 + (tt) * 64 + 4 * gl); \
        T.k = *(const LAS f32x4*)((cbp) + 3 * CS * 64 + (tt) * 64 + 4 * gl); T.r = *(const LAS f32x4*)((cbp) + 4 * CS * 64 + (tt) * 64 + 4 * gl); T.v = (cbp)[5 * CS * 64 + (tt) * 16 + row]; } while (0)
        struct StepIn { f32x4 kk, w, bb, k, r; float v; };
        SC_BAR();
        f32x2 sA = (f32x2){0.f, 0.f}, sB = (f32x2){0.f, 0.f};
        for (int ck = 0; ck < NCK; ++ck) {
            const LAS float* cb = buf + (ck & 1) * BUFF; LAS float* op = opart + (ck & 1) * OPF;
            StepIn sin[3];
            SC_READ(sin[0], cb, 0); SC_READ(sin[1], cb, 1);
#pragma unroll
            for (int tt = 0; tt < CS; ++tt) {
                if (tt + 2 < CS) SC_READ(sin[(tt + 2) % 3], cb, tt + 2);
                __builtin_amdgcn_sched_barrier(0);
                const StepIn& cur = sin[tt % 3];
                const f32x2 kkA = (f32x2){cur.kk[0], cur.kk[1]}, kkB = (f32x2){cur.kk[2], cur.kk[3]};
                f32x2 d2 = sA * kkA; d2 = sB * kkB + d2;
                const float p = red16(d2[0] + d2[1]);
                const f32x2 uA = (f32x2){cur.k[0], cur.k[1]} * cur.v, uB = (f32x2){cur.k[2], cur.k[3]} * cur.v;
                sA = sA * (f32x2){cur.w[0], cur.w[1]} + uA; sB = sB * (f32x2){cur.w[2], cur.w[3]} + uB;
                sA = sA - (f32x2){cur.bb[0], cur.bb[1]} * p; sB = sB - (f32x2){cur.bb[2], cur.bb[3]} * p;
                f32x2 o2 = sA * (f32x2){cur.r[0], cur.r[1]}; o2 = sB * (f32x2){cur.r[2], cur.r[3]} + o2;
                op[tt * 256 + tid] = o2[0] + o2[1];
                __builtin_amdgcn_sched_barrier(0);
            }
            SC_BAR();
        }
#undef SC_READ
    }
#undef SC_BAR
}
__device__ __forceinline__ void lru_fin_chunk(Frame& F, const int ch) {
    const int tid = opaque_tid(); if (tid >= 384) return;
    const int q = tid % 96, rs = tid / 96, b = ch >> 5, n = ch & 31;
    f32x4 hin = (f32x4){0.f, 0.f, 0.f, 0.f};
    for (int j = 0; j < n; ++j) { const f32x4 a = *(const f32x4*)(F.LRUSA + (size_t)(b * 32 + j) * DB + 4 * q), hh = *(const f32x4*)(F.LRUSH + (size_t)(b * 32 + j) * DB + 4 * q); hin = a * hin + hh; }
    bf16* Y = F.HY;
    for (int t0 = rs; t0 < 128; t0 += 32) {
        u32x2 a1[8], a2[8];
#pragma unroll
        for (int i = 0; i < 8; ++i) { const size_t row = (size_t)ch * 128 + t0 + 4 * i; a1[i] = *(const u32x2*)(Y + row * DM + 256 + 4 * q); a2[i] = *(const u32x2*)(F.Q2 + row * DB + 4 * q); }
#pragma unroll
        for (int i = 0; i < 8; ++i) { const size_t row = (size_t)ch * 128 + t0 + 4 * i; *(u32x2*)(Y + row * DM + 256 + 4 * q) = pack4(unpack4(a1[i]) + unpack4(a2[i]) * hin); }
    }
}
__device__ __forceinline__ void rwkv_fin_phase(Frame& F, const int l) {
    const int gw = F.vcu * NWAVES + F.wave, NGW = F.G * NWAVES, lane = opaque_tid() & 63, sub = lane >> 4, q = lane & 15;
    bf16* Y = F.HY;
    struct FinIn { f32x4 ov; u32x2 r, k, v, g; };
#define FIN_LOAD(T, idx_) do { const int m_ = (idx_) / 6, h_ = (idx_) - 6 * m_; const size_t o_ = (size_t)m_ * DC + 64 * h_ + 4 * q; T.ov = *(const f32x4*)(F.O + o_); T.r = *(const u32x2*)(F.R + o_); T.k = *(const u32x2*)(F.K + o_); \
        T.v = *(const u32x2*)(F.V + o_); T.g = *(const u32x2*)(Y + (size_t)m_ * DM + 640 + 64 * h_ + 4 * q); } while (0)
    FinIn fin[2];
    constexpr int NIT = (M * 6) / (256 * NWAVES * 4);
    const int idx0 = gw * 4 + sub, stride = NGW * 4;
    if (NGW * 4 * NIT != M * 6) return;
    FIN_LOAD(fin[0], idx0);
#pragma unroll 2
    for (int it = 0; it < NIT; ++it) {
        const int idx = idx0 + it * stride;
        if (it + 1 < NIT) { if (it & 1) FIN_LOAD(fin[0], idx + stride); else FIN_LOAD(fin[1], idx + stride); }
        const FinIn& T = (it & 1) ? fin[1] : fin[0];
        const int m = idx / 6, h = idx - 6 * m; const int n4 = 64 * h + 4 * q;
        const f32x4 ov = T.ov;
        const float mean = red16((ov[0] + ov[1]) + (ov[2] + ov[3])) * (1.f / 64.f);
        const f32x4 d = ov - mean;
        const float var = red16((d[0] * d[0] + d[1] * d[1]) + (d[2] * d[2] + d[3] * d[3])) * (1.f / 64.f);
        const float rstd = __builtin_amdgcn_rsqf(var + 64e-5f);
        const f32x4 lw = *(const f32x4*)(F.rwkv_ln_w + l * DC + n4), lb = *(const f32x4*)(F.rwkv_ln_b + l * DC + n4), rk = *(const f32x4*)(F.rwkv_r_k + l * DC + n4);
        const f32x4 r4 = unpack4(T.r), k4 = unpack4(T.k), v4 = unpack4(T.v);
        const f32x4 t4 = r4 * k4 * rk;
        const float bs = red16((t4[0] + t4[1]) + (t4[2] + t4[3]));
        const f32x4 g4 = unpack4(T.g);
        const f32x4 y = ((d * rstd) * lw + lb + v4 * bs) * g4;
        *(u32x2*)(Y + (size_t)m * DM + 640 + n4) = pack4(y);
    }
#undef FIN_LOAD
}
__device__ __forceinline__ void ffn_glu_phase(Frame& F, const int l) {
    constexpr int CG = DFF / 8, SEG = 32, NSEG = M / SEG;
    const int gt = F.vcu * (NWAVES * 64) + opaque_tid(), NGT = F.G * NWAVES * 64;
    for (int id = gt; id < NSEG * CG; id += NGT) {
        const int rsg = id / CG, cg8 = id - rsg * CG; const int col = 8 * cg8; const size_t row0 = (size_t)rsg * SEG;
        float w0[8], w1[8], w2[8], cb[8], x1[8], x2[8];
        { const float* cw = F.ffn_conv_w + (size_t)l * 3 * DFF + col; const float* cbp = F.ffn_conv_b + (size_t)l * DFF + col;
#pragma unroll
          for (int e = 0; e < 8; ++e) { w0[e] = cw[e]; w1[e] = cw[DFF + e]; w2[e] = cw[2 * DFF + e]; cb[e] = cbp[e]; x1[e] = 0.f; x2[e] = 0.f; } }
        if ((row0 & (SEQ - 1)) != 0) {
            const u32x4 a = *(const u32x4*)(F.UG + (row0 - 2) * DFF + col), bq = *(const u32x4*)(F.UG + (row0 - 1) * DFF + col);
            x2[0] = bflo(a.x); x2[1] = bfhi(a.x); x2[2] = bflo(a.y); x2[3] = bfhi(a.y); x2[4] = bflo(a.z); x2[5] = bfhi(a.z); x2[6] = bflo(a.w); x2[7] = bfhi(a.w);
            x1[0] = bflo(bq.x); x1[1] = bfhi(bq.x); x1[2] = bflo(bq.y); x1[3] = bfhi(bq.y); x1[4] = bflo(bq.z); x1[5] = bfhi(bq.z); x1[6] = bflo(bq.w); x1[7] = bfhi(bq.w);
        }
        u32x4 ga[4], va[4], gb[4], vb[4];
#define FF_LOAD(G_, V_, grp) do { _Pragma("unroll") for (int i_ = 0; i_ < 4; ++i_) { G_[i_] = *(const u32x4*)(F.UG + (row0 + 4 * (grp) + i_) * DFF + col); V_[i_] = *(const u32x4*)(F.UV + (row0 + 4 * (grp) + i_) * DFF + col); } } while (0)
#define FF_DO(G_, V_, grp) do { _Pragma("unroll") for (int i_ = 0; i_ < 4; ++i_) { const u32x4 gq = G_[i_], vq = V_[i_]; float x0[8], vv[8], y[8]; \
            x0[0] = bflo(gq.x); x0[1] = bfhi(gq.x); x0[2] = bflo(gq.y); x0[3] = bfhi(gq.y); x0[4] = bflo(gq.z); x0[5] = bfhi(gq.z); x0[6] = bflo(gq.w); x0[7] = bfhi(gq.w); \
            vv[0] = bflo(vq.x); vv[1] = bfhi(vq.x); vv[2] = bflo(vq.y); vv[3] = bfhi(vq.y); vv[4] = bflo(vq.z); vv[5] = bfhi(vq.z); vv[6] = bflo(vq.w); vv[7] = bfhi(vq.w); \
            _Pragma("unroll") for (int e = 0; e < 8; ++e) { const float gc = cb[e] + w0[e] * x2[e] + w1[e] * x1[e] + w2[e] * x0[e]; y[e] = fsilu(gc) * vv[e]; x2[e] = x1[e]; x1[e] = x0[e]; } \
            u32x4 o; o.x = pk2(y[0], y[1]); o.y = pk2(y[2], y[3]); o.z = pk2(y[4], y[5]); o.w = pk2(y[6], y[7]); \
            *(u32x4*)(F.UV + (row0 + 4 * (grp) + i_) * DFF + col) = o; } } while (0)
        FF_LOAD(ga, va, 0);
        for (int grp = 0; grp < SEG / 4; grp += 2) {
            FF_LOAD(gb, vb, grp + 1);
            FF_DO(ga, va, grp);
            if (grp + 2 < SEG / 4) FF_LOAD(ga, va, grp + 2);
            FF_DO(gb, vb, grp + 1);
        }
#undef FF_LOAD
#undef FF_DO
    }
}

__device__ __forceinline__ void ffn_fix_phase(Frame& F, const int l) {
    const int gt = F.vcu * (NWAVES * 64) + opaque_tid(), NGT = F.G * NWAVES * 64;
    constexpr int C4 = DFF / 4, NT = M / 256;
    const float* cw = F.ffn_conv_w + (size_t)l * 3 * DFF; const float* cbp = F.ffn_conv_b + (size_t)l * DFF;
    for (int id = gt; id < NT * C4; id += NGT) {
        const int pm = id / C4, c = 4 * (id - pm * C4);
        if ((pm & 15) == 0) continue;
        const f32x4 w0 = *(const f32x4*)(cw + c), w1 = *(const f32x4*)(cw + DFF + c), w2 = *(const f32x4*)(cw + 2 * DFF + c), cb = *(const f32x4*)(cbp + c);
        const f32x4 gm2 = *(const f32x4*)(F.TG + ((size_t)(pm - 1) * 2 + 0) * DFF + c), gm1 = *(const f32x4*)(F.TG + ((size_t)(pm - 1) * 2 + 1) * DFF + c);
        const f32x4 g0 = *(const f32x4*)(F.HG + ((size_t)pm * 2 + 0) * DFF + c), g1 = *(const f32x4*)(F.HG + ((size_t)pm * 2 + 1) * DFF + c);
        const f32x4 v0 = *(const f32x4*)(F.HV + ((size_t)pm * 2 + 0) * DFF + c), v1 = *(const f32x4*)(F.HV + ((size_t)pm * 2 + 1) * DFF + c);
        f32x4 h0, h1;
#pragma unroll
        for (int e = 0; e < 4; ++e) { const float a = cb[e] + w0[e] * gm2[e] + w1[e] * gm1[e] + w2[e] * g0[e], b = cb[e] + w0[e] * gm1[e] + w1[e] * g0[e] + w2[e] * g1[e];
            h0[e] = fsilu(a) * v0[e]; h1[e] = fsilu(b) * v1[e]; }
        *(u32x2*)(F.UV + ((size_t)pm * 256 + 0) * DFF + c) = pack4(h0); *(u32x2*)(F.UV + ((size_t)pm * 256 + 1) * DFF + c) = pack4(h1);
    }
}

struct Args { const float* in[35]; float* out; unsigned char* ws; int ph_lo, ph_hi; };
__device__ __forceinline__ void frame_init(Frame& F, LAS unsigned char* lds) {
    typedef const __attribute__((address_space(4))) Args* ArgP;
    ArgP ap = (ArgP)__builtin_amdgcn_kernarg_segment_ptr(); asm volatile("" : "+s"(ap));
    F.lds = lds; F.MISC = (volatile LAS unsigned*)(lds + MISC_OFF);
    F.wave = __builtin_amdgcn_readfirstlane(threadIdx.x >> 6);
    F.G = gridDim.x; { const int bx = blockIdx.x; F.vcu = (F.G % 8 == 0) ? (bx % 8) * (F.G / 8) + bx / 8 : bx; }
    unsigned char* ws = ap->ws;
    F.ctl = (gu32*)(ws + WS_CTL);
    F.x = ap->in[0]; F.c = ap->in[1]; F.w_mod = ap->in[2]; F.b_mod = ap->in[3]; F.norm_mix = ap->in[4]; F.w_in = ap->in[5]; F.w_out = ap->in[6];
    F.sgu_ln_g = ap->in[7]; F.sgu_ln_b = ap->in[8]; F.sgu_w = ap->in[9]; F.sgu_b = ap->in[10];
    F.lru_conv_w = ap->in[11]; F.lru_conv_b = ap->in[12]; F.lru_w_a = ap->in[13]; F.lru_b_a = ap->in[14]; F.lru_w_x = ap->in[15]; F.lru_b_x = ap->in[16]; F.lru_lambda = ap->in[17];
    F.rwkv_mu = ap->in[18]; F.rwkv_w0 = ap->in[19]; F.rwkv_w2 = ap->in[20]; F.rwkv_a0 = ap->in[21]; F.rwkv_a2 = ap->in[22]; F.rwkv_g2 = ap->in[23]; F.rwkv_k_k = ap->in[24]; F.rwkv_k_a = ap->in[25];
    F.rwkv_r_k = ap->in[26]; F.rwkv_ln_w = ap->in[27]; F.rwkv_ln_b = ap->in[28]; F.norm_ffn = ap->in[29]; F.ffn_w_up = ap->in[30]; F.ffn_conv_w = ap->in[31]; F.ffn_conv_b = ap->in[32];
    F.ffn_w_down = ap->in[33]; F.norm_final = ap->in[34]; F.out = ap->out;
    F.SGUW = (bf16*)(ws + WS_SMALL + SM_SGUW); F.LRUWA = (bf16*)(ws + WS_SMALL + SM_LRUWA); F.LRUWX = (bf16*)(ws + WS_SMALL + SM_LRUWX);
    F.RW2 = (bf16*)(ws + WS_SMALL + SM_RW2); F.RA2 = (bf16*)(ws + WS_SMALL + SM_RA2); F.RG2 = (bf16*)(ws + WS_SMALL + SM_RG2);
    F.MOD = (float*)(ws + WS_MOD); F.LRUSA = (float*)(ws + WS_LRUS); F.LRUSH = F.LRUSA + 256 * DB;
    F.WIN = (bf16*)(ws + WS_WIN); F.WOUT = (bf16*)(ws + WS_WOUT); F.WUP = (bf16*)(ws + WS_WUP); F.WDN = (bf16*)(ws + WS_WDN);
    F.HY = (bf16*)(ws + WS_HY); F.P = (bf16*)(ws + WS_P); F.UG = (bf16*)(ws + WS_P); F.UV = (bf16*)(ws + WS_UV); F.O = (float*)(ws + WS_P);
    F.R = (bf16*)(ws + WS_R); F.K = (bf16*)(ws + WS_K); F.V = (bf16*)(ws + WS_V); F.KK = (bf16*)(ws + WS_KK); F.BV = (bf16*)(ws + WS_BV); F.WD = (float*)(ws + WS_WD); F.Q2 = (bf16*)(ws + WS_Q2);
    F.TG = (float*)(ws + WS_TG); F.HG = (float*)(ws + WS_HG); F.HV = (float*)(ws + WS_HV);
}
__global__ void __launch_bounds__(NWAVES * 64, 2) mk_fwd(Args args) {
    extern __shared__ __attribute__((aligned(16))) unsigned char lds_raw[];
    LAS unsigned char* const lds = (LAS unsigned char*)lds_raw;
    for (int u = threadIdx.x; u < (LDS_BYTES - LDSCTL_OFF) / 4; u += NWAVES * 64) ((LAS unsigned*)(lds + LDSCTL_OFF))[u] = 0u;
    __syncthreads();
#if MK_MODE == 2
    XcdBarrier bar = xcd_barrier_post((unsigned*)((gu32*)(args.ws + WS_CTL) + CW_BAR), (volatile LAS unsigned*)(lds + MISC_OFF) + 8);
#define GRID_BAR() xcd_barrier(bar)
#elif MK_MODE == 1
    cg::grid_group grid = cg::this_grid();
#define GRID_BAR() grid.sync()
#else
#define GRID_BAR() do { } while (0)
#endif
    const int lo = args.ph_lo, hi = args.ph_hi;
#define IN(k) (lo <= (k) && (k) < hi)
#ifndef MK_PHMASK
#define MK_PHMASK 0xFFF
#endif
#define EN(t) (((MK_PHMASK) >> (t)) & 1)
#ifndef MK_DUPMASK
#define MK_DUPMASK 0
#endif
#define REP2(t) (((MK_DUPMASK) >> (t)) & 1)
#define SEAM(k) do { if (IN(k) && IN((k) + 1)) GRID_BAR(); } while (0)
#define PH_BEGIN(t, k) if (EN(t) && IN(k)) { for (int rep = 0; rep <= REP2(t); ++rep) { if (rep) GRID_BAR(); Frame F; frame_init(F, lds); \
        const float* mod_l = F.MOD + (size_t)l * NB * NMOD; const float* Xin = (l == 0) ? F.x : F.out; (void)mod_l; (void)Xin;
#define PH_END(k) } } SEAM(k);

    { const int l = 0; PH_BEGIN(0, 0) p0_prologue(F); PH_END(0) }
    for (int l = 0; l < NL; ++l) {
        const int pb = 1 + 10 * l;
        PH_BEGIN(1, pb + 0) norm_mod_phase(F, Xin, F.norm_mix + l * DM, mod_l, 0, 1, F.HY); PH_END(pb + 0)
        PH_BEGIN(2, pb + 1) pg8::Gemm g{F.HY, F.WIN + (size_t)l * PINP * DM, M, PINP, DM}; pg8::StaticOrder S; S.init(M, PINP, F.G, (int)blockIdx.x);
            pg8::EpiBf16<0> E{F.P, PINP, nullptr, 0, 0, 1.f};
            pg8::gemm_phase<pg8::EpiBf16<0>, pg8::StaticOrder, true, true>(F.lds, g, S, E); PH_END(pb + 1)
        PH_BEGIN(3, pb + 2) for (int ch = F.vcu; ch < M / 128; ch += F.G) mix_chunk(F, l, ch); PH_END(pb + 2)
        PH_BEGIN(4, pb + 3)
            if (F.G >= 256) { if (F.vcu < 192) rwkv_scan_item(F, F.vcu); else if (rep == 0) for (int ch = F.vcu - 192; ch < M / 128; ch += F.G - 192) lru_fin_chunk(F, ch); }
            else { for (int it = F.vcu; it < 192; it += F.G) { rwkv_scan_item(F, it); __syncthreads(); } if (rep == 0) for (int ch = F.vcu; ch < M / 128; ch += F.G) lru_fin_chunk(F, ch); }
        PH_END(pb + 3)
        PH_BEGIN(5, pb + 4) rwkv_fin_phase(F, l); PH_END(pb + 4)
        PH_BEGIN(6, pb + 5) pg8::Gemm g{F.HY, F.WOUT + (size_t)l * DM * DM, M, DM, DM}; pg8::StaticOrder S; S.init(M, DM, F.G, (int)blockIdx.x);
            pg8::EpiRes E{Xin, (REP2(6) && rep == 0) ? (float*)F.P : F.out, DM, mod_l + 2 * DM, NMOD, SEQ};
            pg8::gemm_phase<pg8::EpiRes, pg8::StaticOrder, true, true>(F.lds, g, S, E); PH_END(pb + 5)
        PH_BEGIN(7, pb + 6) norm_mod_phase(F, F.out, F.norm_ffn + l * DM, mod_l, 3, 4, F.HY); PH_END(pb + 6)
        PH_BEGIN(8, pb + 7) pg8::Gemm g{F.HY, F.WUP + (size_t)l * DUP * DM, M, DUP, DM}; pg8::StaticOrder S; S.init(M, DUP, F.G, (int)blockIdx.x);
            pg8::EpiGLU E{F.UV, DFF, F.ffn_conv_w + (size_t)l * 3 * DFF, F.ffn_conv_b + (size_t)l * DFF, F.TG, F.HG, F.HV, (LAS float*)(F.lds + TAIL_OFF)};
            pg8::gemm_phase<pg8::EpiGLU, pg8::StaticOrder, true, true>(F.lds, g, S, E); PH_END(pb + 7)
        PH_BEGIN(9, pb + 8) ffn_fix_phase(F, l); PH_END(pb + 8)
        PH_BEGIN(10, pb + 9) pg8::Gemm g{F.UV, F.WDN + (size_t)l * DM * DFF, M, DM, DFF}; pg8::StaticOrder S; S.init(M, DM, F.G, (int)blockIdx.x);
            pg8::EpiRes E{F.out, (REP2(10) && rep == 0) ? (float*)F.P : F.out, DM, mod_l + 5 * DM, NMOD, SEQ};
            pg8::gemm_phase<pg8::EpiRes, pg8::StaticOrder, true, true>(F.lds, g, S, E); PH_END(pb + 9)
    }
    { const int l = 0; PH_BEGIN(11, NPHASE - 1) final_norm_phase(F, F.out, F.norm_final); PH_END(NPHASE - 1) }
#undef IN
#undef SEAM
}

extern "C" void kernel_launch(void* const* d_in, const int* in_sizes, int n_in, void* d_out, int out_size, void* d_ws, size_t ws_size, hipStream_t stream) {
    static int grid = 0;
    if (grid == 0) {
        if (n_in != 35 || in_sizes[0] != M * DM || out_size != M * DM || ws_size < WS_END) { fprintf(stderr, "kernel_launch: unexpected shapes (n_in %d, in0 %d, out %d, ws %zu); nothing launched\n", n_in, n_in > 0 ? in_sizes[0] : -1, out_size, ws_size); grid = -1; return; }
        int dev = 0, cus = 0, per_cu = 0;
        if (hipGetDevice(&dev) != hipSuccess || hipDeviceGetAttribute(&cus, hipDeviceAttributeMultiprocessorCount, dev) != hipSuccess) { grid = -1; return; }
        if (hipFuncSetAttribute((const void*)mk_fwd, hipFuncAttributeMaxDynamicSharedMemorySize, LDS_BYTES) != hipSuccess) { fprintf(stderr, "kernel_launch: hipFuncSetAttribute failed\n"); grid = -1; return; }
        if (hipOccupancyMaxActiveBlocksPerMultiprocessor(&per_cu, (const void*)mk_fwd, NWAVES * 64, LDS_BYTES) != hipSuccess || per_cu < 1) { fprintf(stderr, "kernel_launch: occupancy query says %d blocks per CU\n", per_cu); per_cu = 1; }
        (void)hipGetLastError();
        grid = cus;
    }
    if (grid < 0) return;
    Args a{};
    for (int i = 0; i < 35; ++i) a.in[i] = (const float*)d_in[i];
    a.out = (float*)d_out; a.ws = (unsigned char*)d_ws;
#if MK_MODE == 0
    for (int ph = 0; ph < NPHASE; ++ph) { a.ph_lo = ph; a.ph_hi = ph + 1; hipLaunchKernelGGL(mk_fwd, dim3(grid), dim3(NWAVES * 64), LDS_BYTES, stream, a); }
#else
    (void)hipMemsetAsync((char*)d_ws + WS_CTL, 0, CTL_ZERO_BYTES, stream);
    a.ph_lo = 0; a.ph_hi = NPHASE;
#if MK_MODE == 1
    void* kargs[] = {&a};
    hipError_t e = hipLaunchCooperativeKernel((const void*)mk_fwd, dim3(grid), dim3(NWAVES * 64), kargs, LDS_BYTES, stream);
    if (e != hipSuccess) fprintf(stderr, "kernel_launch: cooperative launch failed: %s (grid %d)\n", hipGetErrorString(e), grid);
#else
    hipLaunchKernelGGL(mk_fwd, dim3(grid), dim3(NWAVES * 64), LDS_BYTES, stream, a);
#endif
#endif
}
```

```cpp
#include <hip/hip_runtime.h>
#include <hip/hip_cooperative_groups.h>
#include <cstdio>
#include <cstdint>
namespace pg8 {
#define PG8_LAS __attribute__((address_space(3)))
typedef unsigned short bf16_t;
typedef short bf16x8 __attribute__((ext_vector_type(8)));
typedef float f32x4 __attribute__((ext_vector_type(4)));
typedef unsigned u32x4 __attribute__((ext_vector_type(4)));
constexpr int BM = 256, BK = 64, HALF = 128, HTB = HALF * BK * 2  , STAGE_BYTES = 8 * HTB, NXCD = 8, WGM = 8;

__host__ __device__ __forceinline__ int lds_byte(int r, int c) { const int st = (r >> 4) * 2 + (c >> 5), rr = r & 15, cc = c & 31, ob = rr * 64 + cc * 2; return st * 1024 + (ob ^ (((ob >> 9) & 1) << 5)); }
__host__ __device__ __forceinline__ void stage_rc(int b, int& R, int& C) { const int st = b / 1024, sb = b % 1024, swz = sb ^ (((sb >> 9) & 1) << 5); R = (st >> 1) * 16 + swz / 64; C = (st & 1) * 32 + (swz % 64) / 2; }
__host__ __device__ __forceinline__ int perm32(int rho) { const int n = rho >> 4, i = rho & 15; return 8 * (i >> 2) + 4 * n + (i & 3); }

struct Unit { int pm, pn; };
struct Gemm { const bf16_t* A; const bf16_t* Bt; int M, N, K; };

struct StaticOrder {
    int nM, nN, nwg, G, c;
    __host__ __device__ void init(int M, int N, int G_, int c_) { nM = M / BM; nN = N / BM; nwg = nM * nN; G = G_; c = c_; }
    __host__ __device__ bool next(int i, Unit& u) const {
        const long L = (long)i * G + c; if (L >= nwg) return false;
        int wgid = (int)L; { const int q = nwg / NXCD, r = nwg % NXCD, xcd = wgid % NXCD, off = wgid / NXCD; wgid = (xcd < r ? xcd * (q + 1) : r * (q + 1) + (xcd - r) * q) + off; }
        const int nig = WGM * nN, gid = wgid / nig, fm = gid * WGM, gsz = (nM - fm) < WGM ? (nM - fm) : WGM;
        u.pm = fm + ((wgid % nig) % gsz); u.pn = (wgid % nig) / gsz; return true;
    }
    __device__ __forceinline__ void a_ready(const Unit&) const {}
    __device__ __forceinline__ void done(const Unit&) const {}
};

__device__ __forceinline__ unsigned cvt_pk_bf16(float lo, float hi) { unsigned r; asm volatile("v_cvt_pk_bf16_f32 %0, %1, %2" : "=v"(r) : "v"(lo), "v"(hi)); return r; }
typedef float f32x2 __attribute__((ext_vector_type(2)));
__device__ __forceinline__ f32x2 gelu_pk(f32x2 v) {
    const f32x2 av = __builtin_elementwise_abs(v), d = av * 0.2316418882f + 1.0f;
    f32x2 t; t.x = __builtin_amdgcn_rcpf(d.x); t.y = __builtin_amdgcn_rcpf(d.y);
    f32x2 q = t * 0.5307027145f + (-0.7265760135f); q = q * t + 0.7107068705f; q = q * t + (-0.142248368f); q = q * t + 0.127414796f; q = q * t;
    const f32x2 s = (v * v) * (-0.72134752044f);
    f32x2 e; e.x = __builtin_amdgcn_exp2f(s.x); e.y = __builtin_amdgcn_exp2f(s.y);
    const f32x2 m = v * (q * e), r = v - m;
    f32x2 o; o.x = v.x < 0.f ? m.x : r.x; o.y = v.y < 0.f ? m.y : r.y; return o;
}

template <int ACT  > struct EpiBf16 {
    static constexpr bool PERM = true, AFTER_DRAIN = false; static_assert(ACT == 0 || ACT == 1, "EpiBf16: ACT is 0 (none) or 1 (gelu_pk)");
    bf16_t* O; int ldc; const float* bias; int split_cols; size_t split_stride; float scale0;
    __device__ __forceinline__ void operator()(const f32x4 (&acc)[2][2][4][2], const Unit& u, int wr, int wc, int fr, int fq) const {
        const int row0 = u.pm * BM + wr * 64 + fr; int colt = u.pn * BM; bf16_t* base = O;
        float sc = 1.f; if (split_cols) { const int t = colt / split_cols; base += (size_t)t * split_stride; colt -= t * split_cols; if (t == 0) sc = scale0; }
        const int col0 = colt + wc * 32 + 8 * fq, bcol0 = u.pn * BM + wc * 32 + 8 * fq;
        f32x4 bv[2][2];
#pragma unroll
        for (int bj = 0; bj < 2; ++bj)
#pragma unroll
            for (int n = 0; n < 2; ++n) bv[bj][n] = bias ? *(const f32x4*)(bias + bcol0 + bj * HALF + 4 * n) : (f32x4){0.f, 0.f, 0.f, 0.f};
#pragma unroll
        for (int ai = 0; ai < 2; ++ai)
#pragma unroll
            for (int m = 0; m < 4; ++m) { bf16_t* rowp = base + (size_t)(row0 + ai * HALF + m * 16) * ldc + col0;
#pragma unroll
                for (int bj = 0; bj < 2; ++bj) { f32x4 v0 = acc[ai][bj][m][0] + bv[bj][0], v1 = acc[ai][bj][m][1] + bv[bj][1];
                    if (ACT == 1) { f32x2 a = gelu_pk((f32x2){v0[0], v0[1]}), b = gelu_pk((f32x2){v0[2], v0[3]}), c = gelu_pk((f32x2){v1[0], v1[1]}), d = gelu_pk((f32x2){v1[2], v1[3]});
                        v0 = (f32x4){a.x, a.y, b.x, b.y}; v1 = (f32x4){c.x, c.y, d.x, d.y}; }
                    v0 = v0 * sc; v1 = v1 * sc; u32x4 w; w.x = cvt_pk_bf16(v0[0], v0[1]); w.y = cvt_pk_bf16(v0[2], v0[3]); w.z = cvt_pk_bf16(v1[0], v1[1]); w.w = cvt_pk_bf16(v1[2], v1[3]);
                    *(u32x4*)(rowp + bj * HALF) = w; } }
    }
};

typedef unsigned u32x2v __attribute__((ext_vector_type(2)));

struct EpiRes {
    static constexpr bool PERM = false, AFTER_DRAIN = false;
    const float* base; float* out; int ldc; const float* gate; int gate_ld; int rows_per_batch;
    __device__ __forceinline__ void operator()(const f32x4 (&acc)[2][2][4][2], const Unit& u, int wr, int wc, int fr, int fq) const {
        const int row0 = u.pm * BM + wr * 64 + fr, col0 = u.pn * BM + wc * 32 + 4 * fq;
        const float* gp = gate + (size_t)((u.pm * BM) / rows_per_batch) * gate_ld + col0;
        f32x4 gv[2][2];
#pragma unroll
        for (int bj = 0; bj < 2; ++bj)
#pragma unroll
            for (int n = 0; n < 2; ++n) gv[bj][n] = *(const f32x4*)(gp + bj * HALF + n * 16);
        f32x4 pre[3][2][2];
#define ER_LOAD(slot, g_) do { const size_t off_ = (size_t)(row0 + ((g_) >> 2) * HALF + ((g_) & 3) * 16) * ldc + col0; _Pragma("unroll") for (int bj = 0; bj < 2; ++bj) _Pragma("unroll") for (int n = 0; n < 2; ++n) pre[slot][bj][n] = *(const f32x4*)(base + off_ + bj * HALF + n * 16); } while (0)
        ER_LOAD(0, 0); ER_LOAD(1, 1);
#pragma unroll
        for (int g = 0; g < 8; ++g) { const int ai = g >> 2, m = g & 3; const size_t off = (size_t)(row0 + ai * HALF + m * 16) * ldc + col0;
            if (g + 2 < 8) ER_LOAD((g + 2) % 3, g + 2);
#pragma unroll
            for (int bj = 0; bj < 2; ++bj)
#pragma unroll
                for (int n = 0; n < 2; ++n) *(f32x4*)(out + off + bj * HALF + n * 16) = pre[g % 3][bj][n] + gv[bj][n] * acc[ai][bj][m][n]; }
#undef ER_LOAD
    }
};
struct EpiGV {
    static constexpr bool PERM = true, AFTER_DRAIN = false;
    bf16_t* G; bf16_t* V; int ldc;
    __device__ __forceinline__ void operator()(const f32x4 (&acc)[2][2][4][2], const Unit& u, int wr, int wc, int fr, int fq) const {
        const int row0 = u.pm * BM + wr * 64 + fr, col0 = u.pn * HALF + wc * 32 + 8 * fq;
#pragma unroll
        for (int ai = 0; ai < 2; ++ai)
#pragma unroll
            for (int m = 0; m < 4; ++m) { const size_t off = (size_t)(row0 + ai * HALF + m * 16) * ldc + col0;
#pragma unroll
                for (int bj = 0; bj < 2; ++bj) { const f32x4 v0 = acc[ai][bj][m][0], v1 = acc[ai][bj][m][1];
                    u32x4 w; w.x = cvt_pk_bf16(v0[0], v0[1]); w.y = cvt_pk_bf16(v0[2], v0[3]); w.z = cvt_pk_bf16(v1[0], v1[1]); w.w = cvt_pk_bf16(v1[2], v1[3]);
                    *(u32x4*)((bj ? V : G) + off) = w; } }
    }
};

__device__ __forceinline__ float xrow16_sum(float x) {
    auto s = __builtin_amdgcn_permlane16_swap(__float_as_uint(x), __float_as_uint(x), false, false);
    x = __uint_as_float(s[0]) + __uint_as_float(s[1]);
    auto t = __builtin_amdgcn_permlane32_swap(__float_as_uint(x), __float_as_uint(x), false, false);
    return __uint_as_float(t[0]) + __uint_as_float(t[1]);
}
__device__ __forceinline__ void load_rstd8(const float* SS, int row0, int fq, float inv_n, float eps, float (&rstd)[8]) {
    f32x4 p[8];
#pragma unroll
    for (int g = 0; g < 8; ++g) p[g] = *(const f32x4*)(SS + (size_t)(row0 + (g >> 2) * HALF + (g & 3) * 16) * 16 + 4 * fq);
#pragma unroll
    for (int g = 0; g < 8; ++g) rstd[g] = __builtin_amdgcn_rsqf(xrow16_sum((p[g][0] + p[g][1]) + (p[g][2] + p[g][3])) * inv_n + eps);
}
struct EpiResNorm {
    static constexpr bool PERM = false, AFTER_DRAIN = false;
    const float* base; float* out; int ldc; const float* gate; int gate_ld; int rows_per_batch; bf16_t* XS; const float* gamma; const float* sc; float* SS;
    __device__ __forceinline__ void operator()(const f32x4 (&acc)[2][2][4][2], const Unit& u, int wr, int wc, int fr, int fq) const {
        const int row0 = u.pm * BM + wr * 64 + fr, col0 = u.pn * BM + wc * 32 + 4 * fq;
        const int b = (u.pm * BM) / rows_per_batch;
        const float* gp = gate + (size_t)b * gate_ld + col0; const float* sp = sc + (size_t)b * gate_ld + col0;
        f32x4 gv[2][2], gs[2][2];
#pragma unroll
        for (int bj = 0; bj < 2; ++bj)
#pragma unroll
            for (int n = 0; n < 2; ++n) { gv[bj][n] = *(const f32x4*)(gp + bj * HALF + n * 16); gs[bj][n] = *(const f32x4*)(gamma + col0 + bj * HALF + n * 16) * (*(const f32x4*)(sp + bj * HALF + n * 16) + 1.f); }
        f32x4 pre[3][2][2];
#define ER_LOAD(slot, g_) do { const size_t off_ = (size_t)(row0 + ((g_) >> 2) * HALF + ((g_) & 3) * 16) * ldc + col0; _Pragma("unroll") for (int bj = 0; bj < 2; ++bj) _Pragma("unroll") for (int n = 0; n < 2; ++n) pre[slot][bj][n] = *(const f32x4*)(base + off_ + bj * HALF + n * 16); } while (0)
        ER_LOAD(0, 0); ER_LOAD(1, 1);
#pragma unroll
        for (int g = 0; g < 8; ++g) { const int ai = g >> 2, m = g & 3; const size_t off = (size_t)(row0 + ai * HALF + m * 16) * ldc + col0;
            if (g + 2 < 8) ER_LOAD((g + 2) % 3, g + 2);
            float ssq = 0.f;
#pragma unroll
            for (int bj = 0; bj < 2; ++bj)
#pragma unroll
                for (int n = 0; n < 2; ++n) { const f32x4 o = pre[g % 3][bj][n] + gv[bj][n] * acc[ai][bj][m][n];
                    *(f32x4*)(out + off + bj * HALF + n * 16) = o;
                    const f32x4 xs = o * gs[bj][n]; u32x2v w; w.x = cvt_pk_bf16(xs[0], xs[1]); w.y = cvt_pk_bf16(xs[2], xs[3]);
                    *(u32x2v*)(XS + off + bj * HALF + n * 16) = w;
                    ssq += (o[0] * o[0] + o[1] * o[1]) + (o[2] * o[2] + o[3] * o[3]); }
            ssq = xrow16_sum(ssq);
            if (fq == 0) SS[(size_t)(row0 + ai * HALF + m * 16) * 16 + 4 * u.pn + wc] = ssq; }
#undef ER_LOAD
    }
};
struct EpiBf16N {
    static constexpr bool PERM = true, AFTER_DRAIN = false;
    bf16_t* O; int ldc; const float* SS; const float* SW; int sw_ld; int rows_per_batch;
    __device__ __forceinline__ void operator()(const f32x4 (&acc)[2][2][4][2], const Unit& u, int wr, int wc, int fr, int fq) const {
        const int row0 = u.pm * BM + wr * 64 + fr, col0 = u.pn * BM + wc * 32 + 8 * fq;
        float rstd[8]; load_rstd8(SS, row0, fq, 1.f / 1024.f, 1e-6f, rstd);
        const float* swp = SW + (size_t)((u.pm * BM) / rows_per_batch) * sw_ld + col0;
        f32x4 sw[2][2];
#pragma unroll
        for (int bj = 0; bj < 2; ++bj)
#pragma unroll
            for (int n = 0; n < 2; ++n) sw[bj][n] = *(const f32x4*)(swp + bj * HALF + 4 * n);
#pragma unroll
        for (int ai = 0; ai < 2; ++ai)
#pragma unroll
            for (int m = 0; m < 4; ++m) { bf16_t* rowp = O + (size_t)(row0 + ai * HALF + m * 16) * ldc + col0; const float rs = rstd[ai * 4 + m];
#pragma unroll
                for (int bj = 0; bj < 2; ++bj) { const f32x4 v0 = acc[ai][bj][m][0] * rs + sw[bj][0], v1 = acc[ai][bj][m][1] * rs + sw[bj][1];
                    u32x4 w; w.x = cvt_pk_bf16(v0[0], v0[1]); w.y = cvt_pk_bf16(v0[2], v0[3]); w.z = cvt_pk_bf16(v1[0], v1[1]); w.w = cvt_pk_bf16(v1[2], v1[3]);
                    *(u32x4*)(rowp + bj * HALF) = w; } }
    }
};

template <int CTRL> __device__ __forceinline__ float dpp_keep(float old, float src) {
    return __builtin_bit_cast(float, __builtin_amdgcn_update_dpp(__builtin_bit_cast(int, old), __builtin_bit_cast(int, src), CTRL, 0xf, 0xf, false)); }
template <int CTRL> __device__ __forceinline__ float dpp_mov(float src) { return __builtin_bit_cast(float, __builtin_amdgcn_mov_dpp(__builtin_bit_cast(int, src), CTRL, 0xf, 0xf, true)); }
struct EpiGLU {
    static constexpr bool PERM = true, AFTER_DRAIN = false;
    bf16_t* H; int ldc; const float* cw; const float* cb; float* TG; float* HG; float* HV; PG8_LAS float* tail;
    const float* SS; const float* SW; int sw_ld; int rows_per_batch;
    __device__ __forceinline__ void operator()(const f32x4 (&acc)[2][2][4][2], const Unit& u, int wr, int wc, int fr, int fq) const {
        asm volatile("" : "+v"(fr), "+v"(fq));
        const int row0 = u.pm * BM + wr * 64 + fr, cl = wc * 32 + 8 * fq, col0 = u.pn * HALF + cl;
        f32x4 (&ac)[2][2][4][2] = const_cast<f32x4 (&)[2][2][4][2]>(acc);
        { float rstd[8]; load_rstd8(SS, row0, fq, 1.f / 1024.f, 1e-6f, rstd);
          const float* swp = SW + (size_t)((u.pm * BM) / rows_per_batch) * sw_ld + u.pn * BM + cl;
#pragma unroll
          for (int bj = 0; bj < 2; ++bj)
#pragma unroll
              for (int n = 0; n < 2; ++n) { const f32x4 swv = *(const f32x4*)(swp + bj * HALF + 4 * n);
#pragma unroll
                  for (int ai = 0; ai < 2; ++ai)
#pragma unroll
                      for (int m = 0; m < 4; ++m) ac[ai][bj][m][n] = ac[ai][bj][m][n] * rstd[ai * 4 + m] + swv; } }
#define GN(ai_, m_, n_) (acc[ai_][0][m_][n_])
#define VN(ai_, m_, n_) (acc[ai_][1][m_][n_])
        if (fr >= 14) {
#pragma unroll
            for (int ai = 0; ai < 2; ++ai)
#pragma unroll
                for (int n = 0; n < 2; ++n) *(PG8_LAS f32x4*)(tail + ((ai * 2 + wr) * 2 + (fr - 14)) * 128 + cl + 4 * n) = GN(ai, 3, n);
            if (wr == 1) {
#pragma unroll
                for (int n = 0; n < 2; ++n) *(f32x4*)(TG + ((size_t)u.pm * 2 + (fr - 14)) * ldc + col0 + 4 * n) = GN(1, 3, n);
            }
        }
        if (wr == 0 && fr < 2) {
#pragma unroll
            for (int n = 0; n < 2; ++n) { *(f32x4*)(HG + ((size_t)u.pm * 2 + fr) * ldc + col0 + 4 * n) = GN(0, 0, n); *(f32x4*)(HV + ((size_t)u.pm * 2 + fr) * ldc + col0 + 4 * n) = VN(0, 0, n); }
        }
        f32x4 w0[2], w1[2], w2[2], b0[2];
#pragma unroll
        for (int n = 0; n < 2; ++n) { w0[n] = *(const f32x4*)(cw + col0 + 4 * n); w1[n] = *(const f32x4*)(cw + ldc + col0 + 4 * n); w2[n] = *(const f32x4*)(cw + 2 * ldc + col0 + 4 * n); b0[n] = *(const f32x4*)(cb + col0 + 4 * n); }
        asm volatile("s_waitcnt lgkmcnt(0)" ::: "memory"); __builtin_amdgcn_s_barrier(); asm volatile("" ::: "memory");
#pragma unroll
        for (int ai = 0; ai < 2; ++ai) {
            f32x4 t0[2], t1[2];
            const bool have = (wr == 1) || (ai == 1);
            const int sa = (wr == 1) ? ai : 0, sw = (wr == 1) ? 0 : 1;
#pragma unroll
            for (int n = 0; n < 2; ++n) {
                t0[n] = have ? *(const PG8_LAS f32x4*)(tail + ((sa * 2 + sw) * 2 + 0) * 128 + cl + 4 * n) : (f32x4){0.f, 0.f, 0.f, 0.f};
                t1[n] = have ? *(const PG8_LAS f32x4*)(tail + ((sa * 2 + sw) * 2 + 1) * 128 + cl + 4 * n) : (f32x4){0.f, 0.f, 0.f, 0.f}; }
#pragma unroll
            for (int m = 0; m < 4; ++m) {
                u32x4 wout;
#pragma unroll
                for (int n = 0; n < 2; ++n) {
                    f32x4 hv; const f32x4 gcur = GN(ai, m, n), vcur = VN(ai, m, n); const f32x4 gprev = m > 0 ? GN(ai, (m > 0 ? m - 1 : 0), n) : gcur;
#pragma unroll
                    for (int i = 0; i < 4; ++i) {
                        const float g0 = gcur[i];
                        float p1, p2;
                        if (m == 0) { p1 = t1[n][i]; p2 = (fr == 0) ? t0[n][i] : t1[n][i]; }
                        else { const float pv = gprev[i]; p1 = dpp_mov<0x121>(pv); p2 = dpp_mov<0x122>(pv); }
                        const float g1 = dpp_keep<0x111>(p1, g0), g2 = dpp_keep<0x112>(p2, g0);
                        const float gc = b0[n][i] + w0[n][i] * g2 + w1[n][i] * g1 + w2[n][i] * g0;
                        hv[i] = gc * __builtin_amdgcn_rcpf(1.f + __builtin_amdgcn_exp2f(-1.4426950408889634f * gc)) * vcur[i];
                    }
                    if (n == 0) { wout.x = cvt_pk_bf16(hv[0], hv[1]); wout.y = cvt_pk_bf16(hv[2], hv[3]); } else { wout.z = cvt_pk_bf16(hv[0], hv[1]); wout.w = cvt_pk_bf16(hv[2], hv[3]); }
                }
                *(u32x4*)(H + (size_t)(row0 + ai * HALF + m * 16) * ldc + col0) = wout;
            }
        }
#undef GN
#undef VN
    }
};
template <class Epi, class Sched, bool ALIGN_EPI = false, bool SP2 = false>
__device__ __forceinline__ void gemm_phase(PG8_LAS unsigned char* lds, const Gemm g, const Sched& S, const Epi& E) {
    int tid_ = threadIdx.x; asm volatile("" : "+v"(tid_));
    const int tid = tid_, wid = __builtin_amdgcn_readfirstlane(tid >> 6), lane = tid & 63, wr = wid >> 2, wc = wid & 3, fr = lane & 15, fq = lane >> 4;
    const int K = g.K, nt = K / BK;
    unsigned voffA[2], voffB[2];
#pragma unroll
    for (int i = 0; i < 2; ++i) { int R, C; stage_rc(tid * 16 + i * 8192, R, C); const int Rb = Epi::PERM ? ((R & ~31) + perm32(R & 31)) : R;
        voffA[i] = (unsigned)(R * K + C) * 2u; voffB[i] = (unsigned)(Rb * K + C) * 2u; }
    const size_t kstep = (size_t)(BK * 2);
    const size_t hstep = (size_t)HALF * K * 2;
    const size_t tstep = 2 * hstep;
    const unsigned ldsw = (unsigned)wid * 1024u;
    const int aoff = lds_byte(wr * 64 + fr, fq * 8), boff = lds_byte(wc * 32 + fr, fq * 8);
#define PG8_SA(b, h) (((b) * 2 + (h)) * HTB)
#define PG8_SB(b, h) ((4 + (b) * 2 + (h)) * HTB)
#define PG8_STAGE(bufoff, gbase, voff) do { _Pragma("unroll") for (int _i = 0; _i < 2; ++_i) \
        __builtin_amdgcn_global_load_lds((const unsigned*)((const char*)(gbase) + (voff)[_i]), (PG8_LAS unsigned*)(lds + (bufoff) + ldsw + _i * 8192), 16, 0, 0); } while (0)
#define PG8_LDA(dst, b, h) do { _Pragma("unroll") for (int m = 0; m < 4; ++m) _Pragma("unroll") for (int k = 0; k < 2; ++k) dst[m][k] = *(const PG8_LAS bf16x8*)(lds + PG8_SA(b, h) + aoff + m * 2048 + k * 1024); } while (0)
#define PG8_LDB(dst, b, h) do { _Pragma("unroll") for (int n = 0; n < 2; ++n) _Pragma("unroll") for (int k = 0; k < 2; ++k) dst[n][k] = *(const PG8_LAS bf16x8*)(lds + PG8_SB(b, h) + boff + n * 2048 + k * 1024); } while (0)
#define PG8_MMA(ai, bj, At, Bt) do { __builtin_amdgcn_s_setprio(1); _Pragma("unroll") for (int m = 0; m < 4; ++m) _Pragma("unroll") for (int n = 0; n < 2; ++n) _Pragma("unroll") for (int k = 0; k < 2; ++k) \
        acc[ai][bj][m][n] = __builtin_amdgcn_mfma_f32_16x16x32_bf16(Bt[n][k], At[m][k], acc[ai][bj][m][n], 0, 0, 0); __builtin_amdgcn_s_setprio(0); } while (0)
#define PG8_WAIT_V(n) asm volatile("s_waitcnt vmcnt(" #n ")" ::: "memory")
#define PG8_WAIT_L(n) asm volatile("s_waitcnt lgkmcnt(" #n ")" ::: "memory")
#define PG8_BAR __builtin_amdgcn_s_barrier()
#define PG8_SCHED __builtin_amdgcn_sched_barrier(0)
    Unit cur, nxt; int ui = 0;
    if (!S.next(0, cur)) return;
    f32x4 acc[2][2][4][2];
#pragma unroll
    for (int a = 0; a < 2; ++a)
#pragma unroll
        for (int b = 0; b < 2; ++b)
#pragma unroll
            for (int m = 0; m < 4; ++m)
#pragma unroll
                for (int n = 0; n < 2; ++n) acc[a][b][m][n] = (f32x4){0.f, 0.f, 0.f, 0.f};
    bf16x8 At[4][2], B0[2][2], B1[2][2];
    const char* cA = (const char*)g.A + (size_t)cur.pm * tstep; const char* cB = (const char*)g.Bt + (size_t)cur.pn * tstep;
    S.a_ready(cur);
    if constexpr (SP2) {
        PG8_STAGE(PG8_SB(0, 0), cB, voffB); PG8_STAGE(PG8_SB(0, 1), cB + hstep, voffB); PG8_STAGE(PG8_SA(0, 0), cA, voffA); PG8_STAGE(PG8_SA(0, 1), cA + hstep, voffA);
        if (wr == 1) PG8_BAR;
        PG8_WAIT_V(2); PG8_BAR;
        PG8_STAGE(PG8_SB(1, 0), cB + kstep, voffB); PG8_STAGE(PG8_SA(1, 0), cA + kstep, voffA); PG8_STAGE(PG8_SB(1, 1), cB + hstep + kstep, voffB);
        PG8_WAIT_V(6); PG8_BAR;
    } else {
        PG8_STAGE(PG8_SB(0, 0), cB, voffB); PG8_STAGE(PG8_SA(0, 0), cA, voffA); PG8_STAGE(PG8_SB(0, 1), cB + hstep, voffB); PG8_STAGE(PG8_SA(0, 1), cA + hstep, voffA);
        if (wr == 1) PG8_BAR;
        PG8_WAIT_V(4); PG8_BAR;
        PG8_STAGE(PG8_SB(1, 0), cB + kstep, voffB); PG8_STAGE(PG8_SA(1, 0), cA + kstep, voffA); PG8_STAGE(PG8_SB(1, 1), cB + hstep + kstep, voffB);
        PG8_WAIT_V(6); PG8_BAR;
    }
    for (;;) {
        const bool has_next = S.next(ui + 1, nxt);
        const char* nA = has_next ? (const char*)g.A + (size_t)nxt.pm * tstep : cA; const char* nB = has_next ? (const char*)g.Bt + (size_t)nxt.pn * tstep : cB;
        for (int t = 0; t < nt; t += 2) {
            const bool last = (t == nt - 2);
            const char* a1 = cA + (size_t)(t + 1) * kstep;
            const char* a2 = last ? nA : cA + (size_t)(t + 2) * kstep; const char* b2 = last ? nB : cB + (size_t)(t + 2) * kstep;
            const char* a3 = a2 + kstep; const char* b3 = b2 + kstep;
            if (last && has_next) S.a_ready(nxt);
            if constexpr (SP2) {
            PG8_LDB(B0, 0, 0); PG8_LDB(B1, 0, 1); PG8_SCHED; PG8_LDA(At, 0, 0); PG8_STAGE(PG8_SA(1, 1), a1 + hstep, voffA);
            PG8_WAIT_V(8); PG8_WAIT_L(0); PG8_BAR; PG8_MMA(0, 0, At, B0); PG8_MMA(0, 1, At, B1); PG8_BAR; PG8_SCHED;
            PG8_LDA(At, 0, 1); PG8_STAGE(PG8_SB(0, 0), b2, voffB); PG8_STAGE(PG8_SB(0, 1), b2 + hstep, voffB); PG8_STAGE(PG8_SA(0, 0), a2, voffA);
            PG8_WAIT_V(8); PG8_WAIT_L(0); PG8_BAR; PG8_MMA(1, 0, At, B0); PG8_MMA(1, 1, At, B1); PG8_BAR; PG8_SCHED;
            PG8_LDB(B0, 1, 0); PG8_LDB(B1, 1, 1); PG8_SCHED; PG8_LDA(At, 1, 0); PG8_STAGE(PG8_SA(0, 1), a2 + hstep, voffA);
            PG8_WAIT_V(8); PG8_WAIT_L(0); PG8_BAR; PG8_MMA(0, 0, At, B0); PG8_MMA(0, 1, At, B1); PG8_BAR; PG8_SCHED;
            PG8_LDA(At, 1, 1); PG8_STAGE(PG8_SB(1, 0), b3, voffB); PG8_STAGE(PG8_SB(1, 1), b3 + hstep, voffB); PG8_STAGE(PG8_SA(1, 0), a3, voffA);
            PG8_WAIT_V(8); PG8_WAIT_L(0); PG8_BAR; PG8_MMA(1, 0, At, B0); PG8_MMA(1, 1, At, B1); PG8_BAR; PG8_SCHED;
            } else {
            PG8_LDB(B0, 0, 0); PG8_SCHED; PG8_LDA(At, 0, 0); PG8_STAGE(PG8_SA(1, 1), a1 + hstep, voffA);
            PG8_WAIT_L(8); PG8_BAR; PG8_WAIT_L(0); PG8_MMA(0, 0, At, B0); PG8_BAR; PG8_SCHED;
            PG8_LDB(B1, 0, 1); PG8_STAGE(PG8_SB(0, 0), b2, voffB);
            PG8_BAR; PG8_WAIT_L(0); PG8_MMA(0, 1, At, B1); PG8_BAR;
            PG8_LDA(At, 0, 1); PG8_STAGE(PG8_SA(0, 0), a2, voffA);
            PG8_BAR; PG8_WAIT_L(0); PG8_MMA(1, 0, At, B0); PG8_BAR; PG8_SCHED;
            PG8_STAGE(PG8_SB(0, 1), b2 + hstep, voffB);
            PG8_WAIT_V(6); PG8_BAR; PG8_MMA(1, 1, At, B1); PG8_BAR;
            PG8_LDB(B0, 1, 0); PG8_SCHED; PG8_LDA(At, 1, 0); PG8_STAGE(PG8_SA(0, 1), a2 + hstep, voffA);
            PG8_WAIT_L(8); PG8_BAR; PG8_WAIT_L(0); PG8_MMA(0, 0, At, B0); PG8_BAR; PG8_SCHED;
            PG8_LDB(B1, 1, 1); PG8_STAGE(PG8_SB(1, 0), b3, voffB);
            PG8_BAR; PG8_WAIT_L(0); PG8_MMA(0, 1, At, B1); PG8_BAR;
            PG8_LDA(At, 1, 1); PG8_STAGE(PG8_SA(1, 0), a3, voffA);
            PG8_BAR; PG8_WAIT_L(0); PG8_MMA(1, 0, At, B0); PG8_BAR; PG8_SCHED;
            PG8_STAGE(PG8_SB(1, 1), b3 + hstep, voffB);
            PG8_WAIT_V(6); PG8_BAR; PG8_MMA(1, 1, At, B1); PG8_BAR;
            }
        }
        if constexpr (ALIGN_EPI) { if (wr == 0) PG8_BAR; }
        if constexpr (!Epi::AFTER_DRAIN) { E(acc, cur, wr, wc, fr, fq); S.done(cur); }
        if (!has_next) break;
#pragma unroll
        for (int a = 0; a < 2; ++a)
#pragma unroll
            for (int b = 0; b < 2; ++b)
#pragma unroll
                for (int m = 0; m < 4; ++m)
#pragma unroll
                    for (int n = 0; n < 2; ++n) acc[a][b][m][n] = (f32x4){0.f, 0.f, 0.f, 0.f};
        cur = nxt; cA = nA; cB = nB; ++ui;
        if constexpr (ALIGN_EPI) { if (wr == 1) PG8_BAR; }
    }
    PG8_WAIT_V(0);
    if constexpr (!ALIGN_EPI) { if (wr == 0) PG8_BAR; }
    PG8_BAR;
    if constexpr (Epi::AFTER_DRAIN) { E.fused(acc, cur, wr, wc, fr, fq, lds, wid, lane); S.done(cur); }
#undef PG8_SA
#undef PG8_SB
#undef PG8_STAGE
#undef PG8_LDA
#undef PG8_LDB
#undef PG8_MMA
#undef PG8_WAIT_V
#undef PG8_WAIT_L
#undef PG8_BAR
#undef PG8_SCHED
}
}

namespace cg = cooperative_groups;
#ifndef MK_MODE
#define MK_MODE 2
#endif
constexpr int NWAVES = 8;

constexpr int NB = 8, SEQ = 4096, DM = 1024, NL = 2;
constexpr int M = NB * SEQ;
constexpr int PIN = 2688, PINP = 2816;
constexpr int DFF = 2816, DUP = 2 * DFF;
constexpr int DA = 256, DB = 384, DC = 384;
constexpr int NMOD = 6 * DM;
constexpr int PC_OFF = 1280;
constexpr int NPHASE = 22;

constexpr size_t MiB = 1u << 20;
constexpr size_t WS_CTL = 0, CTL_ZERO_BYTES = 64 * 1024;
constexpr size_t WS_SMALL = 1 * MiB;
constexpr size_t SM_SGUW = 0, SM_LRUWA = 256 * 1024, SM_LRUWX = 352 * 1024, SM_RW2 = 448 * 1024, SM_RA2 = 544 * 1024, SM_RG2 = 640 * 1024;
constexpr size_t WS_MOD = 2 * MiB;
constexpr size_t WS_LRUS = 3 * MiB;
constexpr size_t WS_WIN = 4 * MiB, WS_WOUT = 15 * MiB, WS_WUP = 19 * MiB, WS_WDN = 41 * MiB;
constexpr size_t WS_SS = 57 * MiB, WS_SW1 = 60 * MiB, WS_SW2 = 61 * MiB;
constexpr size_t WS_HY = 64 * MiB;
constexpr size_t WS_P = 128 * MiB;
constexpr size_t WS_UV = 304 * MiB;
constexpr size_t WS_R = 304 * MiB, WS_K = 328 * MiB, WS_V = 352 * MiB, WS_KK = 376 * MiB, WS_BV = 400 * MiB;
constexpr size_t WS_WD = 424 * MiB;
constexpr size_t WS_Q2 = 472 * MiB;
constexpr size_t WS_TG = 496 * MiB, WS_HG = 500 * MiB, WS_HV = 504 * MiB;
constexpr size_t WS_END = 512 * MiB;
static_assert(WS_Q2 + (size_t)M * 384 * 2 <= WS_END && WS_UV + (size_t)M * DFF * 2 <= WS_END && WS_P + (size_t)M * PINP * 2 <= WS_UV, "d_ws map");
static_assert(WS_WDN + (size_t)NL * DM * DFF * 2 <= WS_HY && WS_WIN + (size_t)NL * PINP * DM * 2 <= WS_WOUT && WS_WUP + (size_t)NL * DUP * DM * 2 <= WS_WDN, "weights map");
constexpr int CW_BAR = 1024;

constexpr int RING_BYTES = 131072;
constexpr int LDSCTL_OFF = RING_BYTES, MISC_OFF = LDSCTL_OFF + 320;
constexpr int TAIL_OFF = 132096;
constexpr int LDS_BYTES = 147456;

#define GAS __attribute__((address_space(1)))
#define LAS __attribute__((address_space(3)))
typedef unsigned short bf16;
typedef float f32x4 __attribute__((ext_vector_type(4)));
typedef float f32x2 __attribute__((ext_vector_type(2)));
typedef float f32x16 __attribute__((ext_vector_type(16)));
typedef short bf16x8 __attribute__((ext_vector_type(8)));
typedef unsigned u32x2 __attribute__((ext_vector_type(2)));
typedef unsigned u32x4 __attribute__((ext_vector_type(4)));
typedef GAS unsigned gu32;
#define RLX_AGENT __ATOMIC_RELAXED, __HIP_MEMORY_SCOPE_AGENT

__device__ __forceinline__ float bflo(unsigned w) { return __builtin_bit_cast(float, w << 16); }
__device__ __forceinline__ float bfhi(unsigned w) { return __builtin_bit_cast(float, w & 0xffff0000u); }
__device__ __forceinline__ float bf1(bf16 u) { return __builtin_bit_cast(float, (unsigned)u << 16); }
__device__ __forceinline__ unsigned pk2(float lo, float hi) { return pg8::cvt_pk_bf16(lo, hi); }
__device__ __forceinline__ bf16 f2bf(float f) { return (bf16)(pg8::cvt_pk_bf16(f, f) & 0xffffu); }
__device__ __forceinline__ f32x4 unpack4(u32x2 w) { return (f32x4){bflo(w.x), bfhi(w.x), bflo(w.y), bfhi(w.y)}; }
__device__ __forceinline__ u32x2 pack4(f32x4 v) { u32x2 w; w.x = pk2(v[0], v[1]); w.y = pk2(v[2], v[3]); return w; }

__device__ __forceinline__ float fexp(float x) { return __builtin_amdgcn_exp2f(x * 1.4426950408889634f); }
__device__ __forceinline__ float flog(float x) { return __builtin_amdgcn_logf(x) * 0.6931471805599453f; }
__device__ __forceinline__ float fsigmoid(float x) { return __builtin_amdgcn_rcpf(1.f + fexp(-x)); }
__device__ __forceinline__ float fgelu(float x) { const float y = 1.5957691216f * x * (1.f + 0.044715f * x * x); return x * fsigmoid(y); }
__device__ __forceinline__ float fsilu(float x) { return x * fsigmoid(x); }
__device__ __forceinline__ float fsoftplus(float x) { return fmaxf(x, 0.f) + flog(1.f + fexp(-fabsf(x))); }
__device__ __forceinline__ float fsoftplus_acc(float x) { return fmaxf(x, 0.f) + log1pf(expf(-fabsf(x))); }
__device__ __forceinline__ float ftanh(float x) { return 1.f - 2.f * __builtin_amdgcn_rcpf(1.f + fexp(2.f * x)); }
__device__ __forceinline__ float fnegexpm1(float x) {
    const float ser = -x * (1.f + x * (0.5f + x * (0.16666667f + x * (0.041666668f + x * (0.008333334f + x * 0.0013888889f)))));
    return x > -0.25f ? ser : 1.f - fexp(x);
}
__device__ __forceinline__ int opaque_tid() { int t = threadIdx.x; asm volatile("" : "+v"(t)); return t; }
template <int CTRL> __device__ __forceinline__ float dppf(float x) { return __builtin_bit_cast(float, __builtin_amdgcn_mov_dpp(__builtin_bit_cast(int, x), CTRL, 0xf, 0xf, true)); }
__device__ __forceinline__ float red16(float p) { p += dppf<0xB1>(p); p += dppf<0x4E>(p); p += dppf<0x141>(p); p += dppf<0x128>(p); return p; }
__device__ __forceinline__ float wave_sum(float v) { return pg8::xrow16_sum(red16(v)); }
#define XB_TMO      128
#define XB_XCNT(j)  (256  + 64 * (j))
#define XB_XSUB(j)  (1280 + 64 * (j))
#define XB_XGEN(j)  (2304 + 64 * (j))
#define XB_TOP      3328
#define XB_TOPGEN   3392
#define XCD_BAR_WORDS 3456
#define XB_SPIN_CAP (1u << 18)

__device__ __forceinline__ unsigned xb_ld(unsigned* p)              { return __hip_atomic_load(p, __ATOMIC_RELAXED, __HIP_MEMORY_SCOPE_AGENT); }
__device__ __forceinline__ unsigned xb_add(unsigned* p, unsigned v) { return __hip_atomic_fetch_add(p, v, __ATOMIC_RELAXED, __HIP_MEMORY_SCOPE_AGENT); }
__device__ __forceinline__ unsigned xb_xcc_id() { return (unsigned)__builtin_amdgcn_s_getreg((3 << 11) | 20) & 0xFu; }
#define XB_SPIN(cond, bar) do { unsigned _sp = 0; while (cond) { __builtin_amdgcn_s_sleep(1); \
    if ((++_sp & 255u) == 0u) { if (xb_ld(&(bar)[XB_TMO])) break; if (_sp > XB_SPIN_CAP) { atomicAdd(&(bar)[XB_TMO], 1u); break; } } } } while (0)

struct XcdBarrier {
    unsigned* bar; unsigned x;
    volatile LAS unsigned* st;
};

__device__ __forceinline__ XcdBarrier xcd_barrier_post(unsigned* bar, volatile LAS unsigned* st) {
    XcdBarrier b; b.bar = bar; b.x = xb_xcc_id(); b.st = st;
    if (threadIdx.x == 0) (void)xb_add(&bar[XB_XCNT(b.x)], 1u);
    return b;
}
__device__ __forceinline__ void xcd_barrier_complete(unsigned* bar, unsigned x, unsigned& nloc, unsigned& nx) {
    const unsigned G = gridDim.x * gridDim.y * gridDim.z;
    unsigned sum, cnt, mine, sp = 0u;
    for (;;) {
        sum = 0u; cnt = 0u; mine = 0u;
#pragma unroll
        for (unsigned j = 0; j < 16; ++j) { const unsigned c = xb_ld(&bar[XB_XCNT(j)]); sum += c; cnt += (c > 0u) ? 1u : 0u; mine = (j == x) ? c : mine; }
        if (sum == G) break;
        __builtin_amdgcn_s_sleep(1);
        if ((++sp & 255u) == 0u) { if (xb_ld(&bar[XB_TMO])) break; if (sp > XB_SPIN_CAP) { atomicAdd(&bar[XB_TMO], 1u); break; } }
    }
    nloc = mine > 0u ? mine : 1u; nx = cnt > 0u ? cnt : 1u;
}

__device__ __forceinline__ void xcd_barrier(const XcdBarrier& b) {
    asm volatile("s_waitcnt vmcnt(0)" ::: "memory");
    __syncthreads();
    if (threadIdx.x == 0) {
        unsigned* bar = b.bar;
        __builtin_amdgcn_s_waitcnt(0);
        unsigned nloc = b.st[0], nx = b.st[1];
        if (nloc == 0u) { xcd_barrier_complete(bar, b.x, nloc, nx); b.st[0] = nloc; b.st[1] = nx; }
        const unsigned old = xb_add(&bar[XB_XSUB(b.x)], 1u);
        const unsigned gen = old / nloc;
        if (old + 1u == (gen + 1u) * nloc) {
            __builtin_amdgcn_fence(__ATOMIC_RELEASE, "agent");
            asm volatile("s_waitcnt vmcnt(0)" ::: "memory");
            const unsigned og = xb_add(&bar[XB_TOP], 1u);
            const unsigned tg = og / nx;
            if (og + 1u == (tg + 1u) * nx) xb_add(&bar[XB_TOPGEN], 1u);
            else XB_SPIN(xb_ld(&bar[XB_TOPGEN]) == tg, bar);
            __builtin_amdgcn_fence(__ATOMIC_ACQUIRE, "agent");
            xb_add(&bar[XB_XGEN(b.x)], 1u);
            asm volatile("s_waitcnt vmcnt(0)" ::: "memory");
        } else {
            XB_SPIN(xb_ld(&bar[XB_XGEN(b.x)]) == gen, bar);
            __builtin_amdgcn_fence(__ATOMIC_ACQUIRE, "agent");
            asm volatile("s_waitcnt vmcnt(0)" ::: "memory");
        }
    }
    __syncthreads();
}

struct Frame {
    LAS unsigned char* lds;
    volatile LAS unsigned* MISC;
    gu32* ctl;
    int wave, vcu, G;
    const float *x, *c, *w_mod, *b_mod, *norm_mix, *w_in, *w_out, *sgu_ln_g, *sgu_ln_b, *sgu_w, *sgu_b, *lru_conv_w, *lru_conv_b, *lru_w_a, *lru_b_a, *lru_w_x, *lru_b_x, *lru_lambda,
        *rwkv_mu, *rwkv_w0, *rwkv_w2, *rwkv_a0, *rwkv_a2, *rwkv_g2, *rwkv_k_k, *rwkv_k_a, *rwkv_r_k, *rwkv_ln_w, *rwkv_ln_b, *norm_ffn, *ffn_w_up, *ffn_conv_w, *ffn_conv_b, *ffn_w_down, *norm_final;
    float* out;
    bf16 *SGUW, *LRUWA, *LRUWX, *RW2, *RA2, *RG2;
    float *MOD, *LRUSA, *LRUSH;
    bf16 *WIN, *WOUT, *WUP, *WDN;
    bf16 *HY, *P, *UG, *UV, *R, *K, *V, *KK, *BV, *Q2;
    float *O, *WD;
    float *TG, *HG, *HV;
    float *SS, *SW1, *SW2;
};

__device__ __forceinline__ void p0_transpose_item(const float* W, int K, int N, bf16* WT, int k0, int n0, int drow0, LAS float* scr, int lane) {
#pragma unroll 8
    for (int i = 0; i < 32; ++i) { const int kk = 2 * i + (lane >> 5); scr[kk * 33 + (lane & 31)] = W[(size_t)(k0 + kk) * N + n0 + (lane & 31)]; }
    asm volatile("s_waitcnt lgkmcnt(0)" ::: "memory");
    const int c = lane & 7;
#pragma unroll
    for (int j = 0; j < 4; ++j) { const int n = (lane >> 3) + 8 * j; const LAS float* s = scr + (8 * c) * 33 + n;
        u32x4 o; o.x = pk2(s[0 * 33], s[1 * 33]); o.y = pk2(s[2 * 33], s[3 * 33]); o.z = pk2(s[4 * 33], s[5 * 33]); o.w = pk2(s[6 * 33], s[7 * 33]);
        *(u32x4*)(WT + (size_t)(drow0 + n) * K + k0 + 8 * c) = o; }
    asm volatile("s_waitcnt lgkmcnt(0)" ::: "memory");
}
__device__ __forceinline__ void p0_prologue(Frame& F) {
    const int tid = opaque_tid(), lane = tid & 63, wave = F.wave;
    const int gw = F.vcu * NWAVES + wave, NGW = F.G * NWAVES;
    const int gt = F.vcu * (NWAVES * 64) + tid, NGT = F.G * NWAVES * 64;
    if (F.vcu < 192) {
        LAS float* cact = (LAS float*)(F.lds + 73728);
        LAS float* red = (LAS float*)(F.lds + 106496);
        for (int i = tid; i < NB * DM; i += NWAVES * 64) { const float cv = F.c[i]; cact[i] = cv * fsigmoid(cv); }
        __syncthreads();
        const int l = F.vcu / 96, n0 = (F.vcu % 96) * 64;
        const float* wm = F.w_mod + ((size_t)l * DM + 128 * wave) * NMOD + n0 + lane;
        float acc[NB];
#pragma unroll
        for (int b = 0; b < NB; ++b) acc[b] = 0.f;
        for (int k4 = 0; k4 < 128; k4 += 4) {
            const float w0 = wm[(size_t)(k4 + 0) * NMOD], w1 = wm[(size_t)(k4 + 1) * NMOD], w2 = wm[(size_t)(k4 + 2) * NMOD], w3 = wm[(size_t)(k4 + 3) * NMOD];
#pragma unroll
            for (int b = 0; b < NB; ++b) { const f32x4 cv = *(const LAS f32x4*)(cact + b * DM + 128 * wave + k4); acc[b] += cv[0] * w0 + cv[1] * w1 + cv[2] * w2 + cv[3] * w3; }
        }
#pragma unroll
        for (int b = 0; b < NB; ++b) red[(wave * NB + b) * 64 + lane] = acc[b];
        __syncthreads();
        { const int b = tid >> 6, col = tid & 63; float s = F.b_mod[l * NMOD + n0 + col];
#pragma unroll
          for (int w = 0; w < NWAVES; ++w) s += red[(w * NB + b) * 64 + col];
          F.MOD[(size_t)(l * NB + b) * NMOD + n0 + col] = s; }
        __syncthreads();
    }
    {
        LAS float* scr = (LAS float*)(F.lds + wave * 9216);
        constexpr int I_IN = (DM / 64) * (PIN / 32), I_OUT = (DM / 64) * (DM / 32), I_UP = (DM / 64) * (DUP / 32), I_DN = (DFF / 64) * (DM / 32);
        constexpr int PER_L = I_IN + I_OUT + I_UP + I_DN;
        for (int it = gw; it < NL * PER_L; it += NGW) {
            const int l = it / PER_L; int r = it % PER_L;
            if (r < I_IN) { const int nblk = PIN / 32, kb = r / nblk, nb = r % nblk; p0_transpose_item(F.w_in + (size_t)l * DM * PIN, DM, PIN, F.WIN + (size_t)l * PINP * DM, 64 * kb, 32 * nb, 32 * nb, scr, lane); continue; } r -= I_IN;
            if (r < I_OUT) { const int nblk = DM / 32, kb = r / nblk, nb = r % nblk; p0_transpose_item(F.w_out + (size_t)l * DM * DM, DM, DM, F.WOUT + (size_t)l * DM * DM, 64 * kb, 32 * nb, 32 * nb, scr, lane); continue; } r -= I_OUT;
            if (r < I_UP) { const int nblk = DUP / 32, kb = r / nblk, nb = r % nblk; const int n0 = 32 * nb, isv = n0 >= DFF ? 1 : 0, j = n0 - isv * DFF, drow = (j / 128) * 256 + isv * 128 + (j % 128);
                p0_transpose_item(F.ffn_w_up + (size_t)l * DM * DUP, DM, DUP, F.WUP + (size_t)l * DUP * DM, 64 * kb, n0, drow, scr, lane); continue; } r -= I_UP;
            { const int nblk = DM / 32, kb = r / nblk, nb = r % nblk; p0_transpose_item(F.ffn_w_down + (size_t)l * DFF * DM, DFF, DM, F.WDN + (size_t)l * DM * DFF, 64 * kb, 32 * nb, 32 * nb, scr, lane); }
        }
        for (int i = gt; i < NL * (PINP - PIN) * DM / 8; i += NGT) { const int l = i / ((PINP - PIN) * DM / 8), o = i % ((PINP - PIN) * DM / 8);
            *(u32x4*)(F.WIN + (size_t)l * PINP * DM + (size_t)PIN * DM + (size_t)o * 8) = (u32x4){0u, 0u, 0u, 0u}; }
    }
    for (int i = gt; i < NL * 4 * 128 * 128; i += NGT) { const int s = i & 127, t = (i >> 7) & 127; F.SGUW[i] = s <= t ? f2bf(F.sgu_w[i]) : (bf16)0; }
    for (int i = gt; i < NL * 6 * 64 * 64; i += NGT) { const int ii = i & 63, j = (i >> 6) & 63, lh = i >> 12;
        F.LRUWA[i] = f2bf(F.lru_w_a[(size_t)lh * 4096 + ii * 64 + j]); F.LRUWX[i] = f2bf(F.lru_w_x[(size_t)lh * 4096 + ii * 64 + j]); }
    for (int i = gt; i < NL * 384 * 64; i += NGT) { const int k = i & 63, n = (i >> 6) % 384, l = i / (384 * 64);
        F.RW2[i] = f2bf(F.rwkv_w2[(size_t)l * 64 * 384 + k * 384 + n]); F.RA2[i] = f2bf(F.rwkv_a2[(size_t)l * 64 * 384 + k * 384 + n]); }
    for (int i = gt; i < NL * 384 * 128; i += NGT) { const int k = i & 127, n = (i >> 7) % 384, l = i / (384 * 128);
        F.RG2[i] = f2bf(F.rwkv_g2[(size_t)l * 128 * 384 + k * 384 + n]); }
}

__device__ __forceinline__ void norm_mod_phase(Frame& F, const float* X, const float* gamma, const float* mod_l, int sh_idx, int sc_idx, bf16* H) {
    const int gw = F.vcu * NWAVES + F.wave, NGW = F.G * NWAVES, lane = opaque_tid() & 63;
    f32x4 g[4], nx[4];
#pragma unroll
    for (int j = 0; j < 4; ++j) g[j] = *(const f32x4*)(gamma + 4 * (lane + 64 * j));
    if (gw < M) {
#pragma unroll
        for (int j = 0; j < 4; ++j) nx[j] = ((const f32x4*)(X + (size_t)gw * DM) + lane)[64 * j];
    }
    for (int m = gw; m < M; m += NGW) {
        f32x4 v[4]; float s = 0.f;
#pragma unroll
        for (int j = 0; j < 4; ++j) { v[j] = nx[j]; s += (v[j][0] * v[j][0] + v[j][1] * v[j][1]) + (v[j][2] * v[j][2] + v[j][3] * v[j][3]); }
        if (m + NGW < M) {
#pragma unroll
            for (int j = 0; j < 4; ++j) nx[j] = ((const f32x4*)(X + (size_t)(m + NGW) * DM) + lane)[64 * j];
        }
        const float* mb = mod_l + (size_t)(m >> 12) * NMOD;
        f32x4 sc[4], sh[4];
#pragma unroll
        for (int j = 0; j < 4; ++j) { const int c = 4 * (lane + 64 * j); sc[j] = *(const f32x4*)(mb + sc_idx * DM + c); sh[j] = *(const f32x4*)(mb + sh_idx * DM + c); }
        const float rstd = __builtin_amdgcn_rsqf(wave_sum(s) * (1.f / DM) + 1e-6f);
        u32x2* o8 = (u32x2*)(H + (size_t)m * DM) + lane;
#pragma unroll
        for (int j = 0; j < 4; ++j) { const f32x4 y = (v[j] * rstd) * g[j] * (sc[j] + 1.f) + sh[j]; o8[64 * j] = pack4(y); }
    }
}
__device__ __forceinline__ void final_norm_phase(Frame& F, float* X, const float* gamma) {
    const int gw = F.vcu * NWAVES + F.wave, NGW = F.G * NWAVES, lane = opaque_tid() & 63;
    f32x4 g[4], nx[4];
#pragma unroll
    for (int j = 0; j < 4; ++j) g[j] = *(const f32x4*)(gamma + 4 * (lane + 64 * j));
    if (gw < M) {
#pragma unroll
        for (int j = 0; j < 4; ++j) nx[j] = ((const f32x4*)(X + (size_t)gw * DM) + lane)[64 * j];
    }
    for (int m = gw; m < M; m += NGW) {
        f32x4 v[4]; float s = 0.f;
#pragma unroll
        for (int j = 0; j < 4; ++j) { v[j] = nx[j]; s += (v[j][0] * v[j][0] + v[j][1] * v[j][1]) + (v[j][2] * v[j][2] + v[j][3] * v[j][3]); }
        if (m + NGW < M) {
#pragma unroll
            for (int j = 0; j < 4; ++j) nx[j] = ((const f32x4*)(X + (size_t)(m + NGW) * DM) + lane)[64 * j];
        }
        const float rstd = __builtin_amdgcn_rsqf(wave_sum(s) * (1.f / DM) + 1e-6f);
        f32x4* xr = (f32x4*)(X + (size_t)m * DM) + lane;
#pragma unroll
        for (int j = 0; j < 4; ++j) xr[64 * j] = (v[j] * rstd) * g[j];
    }
}

__device__ __forceinline__ void norm0_phase(Frame& F, const float* X, const float* gamma, const float* mod_l, int sc_idx, bf16* XS) {
    const int gw = F.vcu * NWAVES + F.wave, NGW = F.G * NWAVES, lane = opaque_tid() & 63;
    f32x4 g[4], nx[4];
#pragma unroll
    for (int j = 0; j < 4; ++j) g[j] = *(const f32x4*)(gamma + 4 * (lane + 64 * j));
    if (gw < M) {
#pragma unroll
        for (int j = 0; j < 4; ++j) nx[j] = ((const f32x4*)(X + (size_t)gw * DM) + lane)[64 * j];
    }
    for (int m = gw; m < M; m += NGW) {
        f32x4 v[4]; float s = 0.f;
#pragma unroll
        for (int j = 0; j < 4; ++j) { v[j] = nx[j]; s += (v[j][0] * v[j][0] + v[j][1] * v[j][1]) + (v[j][2] * v[j][2] + v[j][3] * v[j][3]); }
        if (m + NGW < M) {
#pragma unroll
            for (int j = 0; j < 4; ++j) nx[j] = ((const f32x4*)(X + (size_t)(m + NGW) * DM) + lane)[64 * j];
        }
        const float* mb = mod_l + (size_t)(m >> 12) * NMOD + sc_idx * DM;
        f32x4 sc[4];
#pragma unroll
        for (int j = 0; j < 4; ++j) sc[j] = *(const f32x4*)(mb + 4 * (lane + 64 * j));
        const float tot = wave_sum(s);
        u32x2* o8 = (u32x2*)(XS + (size_t)m * DM) + lane;
#pragma unroll
        for (int j = 0; j < 4; ++j) o8[64 * j] = pack4(v[j] * g[j] * (sc[j] + 1.f));
        if (lane < 4) *(f32x4*)(F.SS + (size_t)m * 16 + 4 * lane) = (f32x4){lane == 0 ? tot : 0.f, 0.f, 0.f, 0.f};
    }
}
__device__ __forceinline__ void sw_phase(Frame& F) {
    const int tid = opaque_tid(), lane = tid & 63;
    const int gw = F.vcu * NWAVES + F.wave, NGW = F.G * NWAVES;
    LAS float* shl = (LAS float*)F.lds;
    for (int i = tid; i < NL * 2 * NB * DM / 4; i += NWAVES * 64) { const int e = 4 * i, k = e & 1023, b = (e >> 10) & 7, wh = (e >> 13) & 1, l = e >> 14;
        *(LAS f32x4*)(shl + e) = *(const f32x4*)(F.MOD + (size_t)(l * NB + b) * NMOD + (wh ? 3 : 0) * DM + k); }
    __syncthreads();
    constexpr int NT = NL * (PINP + DUP);
    for (int t = gw; t < NT; t += NGW) {
        const int l = t / (PINP + DUP), r = t - l * (PINP + DUP), wh = r >= PINP ? 1 : 0, n = r - wh * PINP;
        const bf16* wrow = (wh ? F.WUP + ((size_t)l * DUP + n) * DM : F.WIN + ((size_t)l * PINP + n) * DM) + 16 * lane;
        const u32x4 wa = *(const u32x4*)(wrow), wb = *(const u32x4*)(wrow + 8);
        float w[16] = {bflo(wa.x), bfhi(wa.x), bflo(wa.y), bfhi(wa.y), bflo(wa.z), bfhi(wa.z), bflo(wa.w), bfhi(wa.w), bflo(wb.x), bfhi(wb.x), bflo(wb.y), bfhi(wb.y), bflo(wb.z), bfhi(wb.z), bflo(wb.w), bfhi(wb.w)};
        float res = 0.f;
#pragma unroll
        for (int b = 0; b < NB; ++b) { const LAS float* sp = shl + ((l * 2 + wh) * NB + b) * DM + 16 * lane; float a = 0.f;
#pragma unroll
            for (int j = 0; j < 4; ++j) { const f32x4 sv = *(const LAS f32x4*)(sp + 4 * j); a += (sv[0] * w[4 * j] + sv[1] * w[4 * j + 1]) + (sv[2] * w[4 * j + 2] + sv[3] * w[4 * j + 3]); }
            a = wave_sum(a); if (lane == b) res = a; }
        if (lane < NB) { float* dst = wh ? F.SW2 + ((size_t)(l * NB + lane)) * DUP + n : F.SW1 + ((size_t)(l * NB + lane)) * PINP + n; *dst = res; }
    }
    __syncthreads();
}

__device__ __forceinline__ void mix_chunk(Frame& F, const int l, const int ch) {
    const int wave = F.wave;
    const int n = ch & 31; const size_t r0 = (size_t)ch * 128;
    const bf16* P = F.P; bf16* Y = F.HY;
    LAS unsigned char* lds = F.lds;
#ifndef MK_MIXDUP
#define MK_MIXDUP 0
#endif
    for (int mrep = 0; mrep <= ((MK_MIXDUP) & 1); ++mrep) {
        if (mrep) __syncthreads();
        const int tid = opaque_tid(), lane = tid & 63, r = lane & 31, hh = lane >> 5;
        LAS bf16* VT = (LAS bf16*)lds;
        LAS f32x2* ST = (LAS f32x2*)(lds + 69632);
        const int t = tid & 127, q = __builtin_amdgcn_readfirstlane(tid >> 7);
        const bf16* src = P + (r0 + t) * PINP + 256 + 64 * q;
        float v[64]; float s = 0.f, ss = 0.f;
#pragma unroll
        for (int i = 0; i < 8; ++i) { const u32x4 w = *(const u32x4*)(src + 8 * i);
            const float e0 = fgelu(bflo(w.x)), e1 = fgelu(bfhi(w.x)), e2 = fgelu(bflo(w.y)), e3 = fgelu(bfhi(w.y)), e4 = fgelu(bflo(w.z)), e5 = fgelu(bfhi(w.z)), e6 = fgelu(bflo(w.w)), e7 = fgelu(bfhi(w.w));
            v[8 * i + 0] = e0; v[8 * i + 1] = e1; v[8 * i + 2] = e2; v[8 * i + 3] = e3; v[8 * i + 4] = e4; v[8 * i + 5] = e5; v[8 * i + 6] = e6; v[8 * i + 7] = e7;
            s += ((e0 + e1) + (e2 + e3)) + ((e4 + e5) + (e6 + e7)); ss += ((e0 * e0 + e1 * e1) + (e2 * e2 + e3 * e3)) + ((e4 * e4 + e5 * e5) + (e6 * e6 + e7 * e7)); }
        ST[q * 128 + t] = (f32x2){s, ss};
        __syncthreads();
        const f32x2 a0 = ST[t], a1 = ST[128 + t], a2 = ST[256 + t], a3 = ST[384 + t];
        const float mean = ((a0.x + a1.x) + (a2.x + a3.x)) * (1.f / 256.f), ex2 = ((a0.y + a1.y) + (a2.y + a3.y)) * (1.f / 256.f);
        const float rstd = __builtin_amdgcn_rsqf(fmaxf(ex2 - mean * mean, 0.f) + 1e-5f);
        const float* lg = F.sgu_ln_g + l * DA + 64 * q; const float* lb = F.sgu_ln_b + l * DA + 64 * q;
#pragma unroll
        for (int i = 0; i < 64; ++i) VT[(64 * q + i) * 136 + t] = f2bf((v[i] - mean) * rstd * lg[i] + lb[i]);
        __syncthreads();
        const int h = wave >> 1, dh = wave & 1;
        const bf16* Wg = F.SGUW + (size_t)(l * 4 + h) * 128 * 128;
        const LAS bf16* vrow = VT + (64 * h + 32 * dh + r) * 136 + 8 * hh;
#pragma unroll 1
        for (int tb = 0; tb < 4; ++tb) {
            f32x16 acc;
#pragma unroll
            for (int i = 0; i < 16; ++i) acc[i] = 0.f;
            const bf16* wrow = Wg + (size_t)(32 * tb + r) * 128 + 8 * hh;
#pragma unroll 2
            for (int ks = 0; ks < 2 * (tb + 1); ++ks) {
                const bf16x8 a = *(const LAS bf16x8*)(vrow + 16 * ks);
                const bf16x8 b = *(const bf16x8*)(wrow + 16 * ks);
                acc = __builtin_amdgcn_mfma_f32_32x32x16_bf16(a, b, acc, 0, 0, 0);
            }
            const int tt = 32 * tb + r; const size_t row = r0 + tt;
            const float bias = F.sgu_b[(l * 4 + h) * 128 + tt];
            u32x2 uq[4];
#pragma unroll
            for (int g = 0; g < 4; ++g) uq[g] = *(const u32x2*)(P + row * PINP + 64 * h + 32 * dh + 8 * g + 4 * hh);
#pragma unroll
            for (int g = 0; g < 4; ++g) { const int c4 = 64 * h + 32 * dh + 8 * g + 4 * hh;
                const f32x4 u = unpack4(uq[g]);
                f32x4 y; y[0] = fgelu(u[0]) * (acc[4 * g + 0] + bias); y[1] = fgelu(u[1]) * (acc[4 * g + 1] + bias); y[2] = fgelu(u[2]) * (acc[4 * g + 2] + bias); y[3] = fgelu(u[3]) * (acc[4 * g + 3] + bias);
                *(u32x2*)(Y + row * DM + c4) = pack4(y); }
        }
    }
    __syncthreads();
    for (int mrep = 0; mrep <= (((MK_MIXDUP) >> 1) & 1); ++mrep) {
        if (mrep) __syncthreads();
        const int tid = opaque_tid(), lane = tid & 63, r = lane & 31, hh = lane >> 5;
        LAS bf16* XC = (LAS bf16*)lds;
        LAS float* LA = (LAS float*)(lds + 25088);
        LAS float* BT = (LAS float*)(lds + 25088 + 49152);
        const int q = tid % 96, rs = tid / 96, c4 = 4 * q; const bool act = tid < DB;
        f32x4 cw0, cw1, cw2, cw3, cb, bra, bix, sp8;
        { cw0 = *(const f32x4*)(F.lru_conv_w + (l * 4 + 0) * DB + c4); cw1 = *(const f32x4*)(F.lru_conv_w + (l * 4 + 1) * DB + c4); cw2 = *(const f32x4*)(F.lru_conv_w + (l * 4 + 2) * DB + c4); cw3 = *(const f32x4*)(F.lru_conv_w + (l * 4 + 3) * DB + c4);
          cb = *(const f32x4*)(F.lru_conv_b + l * DB + c4); bra = *(const f32x4*)(F.lru_b_a + l * DB + c4); bix = *(const f32x4*)(F.lru_b_x + l * DB + c4);
          const f32x4 lam = *(const f32x4*)(F.lru_lambda + l * DB + c4);
#pragma unroll
          for (int e = 0; e < 4; ++e) sp8[e] = -8.f * fsoftplus_acc(-lam[e]); }
        float hst = 0.f, ca = 1.f;
        for (int tq = 0; tq < 4; ++tq) {
            if (act) {
                const bf16* src = P + (r0 + 32 * tq + 8 * rs) * PINP + 512 + c4;
                u32x2 raw[11];
                const bool hashalo = (n > 0) || (tq > 0) || (rs > 0);
#pragma unroll
                for (int i = 0; i < 11; ++i) raw[i] = (i >= 3 || hashalo) ? *(const u32x2*)(src + (ptrdiff_t)(i - 3) * PINP) : (u32x2){0u, 0u};
                f32x4 x3 = unpack4(raw[0]), x2 = unpack4(raw[1]), x1 = unpack4(raw[2]);
#pragma unroll
                for (int i = 0; i < 8; ++i) { const f32x4 x0 = unpack4(raw[3 + i]);
                    const f32x4 xc = cb + cw0 * x3 + cw1 * x2 + cw2 * x1 + cw3 * x0; x3 = x2; x2 = x1; x1 = x0;
                    *(LAS u32x2*)(XC + (8 * rs + i) * 392 + c4) = pack4(xc); }
            }
            __syncthreads();
            for (int k = 0; k < 3; ++k) {
                const int id = wave + 8 * k, mat = id / 12, hb = (id % 12) >> 1, jt = id & 1;
                const bf16* Wt = (mat ? F.LRUWX : F.LRUWA) + (size_t)((l * 6 + hb) * 64 + 32 * jt + r) * 64 + 8 * hh;
                const LAS bf16* xrow = XC + r * 392 + 64 * hb + 8 * hh;
                f32x16 acc;
#pragma unroll
                for (int i = 0; i < 16; ++i) acc[i] = 0.f;
#pragma unroll
                for (int ks = 0; ks < 4; ++ks) { const bf16x8 a = *(const LAS bf16x8*)(xrow + 16 * ks); const bf16x8 b = *(const bf16x8*)(Wt + 16 * ks);
                    acc = __builtin_amdgcn_mfma_f32_32x32x16_bf16(a, b, acc, 0, 0, 0); }
                LAS float* dst = (mat ? BT : LA) + 64 * hb + 32 * jt + r;
#pragma unroll
                for (int rg = 0; rg < 16; ++rg) dst[((rg & 3) + 8 * (rg >> 2) + 4 * hh) * DB] = acc[rg];
            }
            __syncthreads();
            if (act) {
#pragma unroll 2
                for (int i = 0; i < 8; ++i) { const int tl = rs + 4 * i;
                    const f32x4 rp = *(const LAS f32x4*)(LA + tl * DB + c4) + bra, ip = *(const LAS f32x4*)(BT + tl * DB + c4) + bix;
                    const f32x4 xc = unpack4(*(const LAS u32x2*)(XC + tl * 392 + c4));
                    f32x4 av, bv;
#pragma unroll
                    for (int e = 0; e < 4; ++e) { const float la = sp8[e] * fsigmoid(rp[e]); av[e] = fexp(la);
                        bv[e] = __builtin_amdgcn_sqrtf(fmaxf(fnegexpm1(2.f * la), 0.f)) * (fsigmoid(ip[e]) * xc[e]); }
                    *(LAS f32x4*)(LA + tl * DB + c4) = av; *(LAS f32x4*)(BT + tl * DB + c4) = bv; }
            }
            __syncthreads();
            if (act) {
#pragma unroll 8
                for (int i = 0; i < 32; ++i) { const float a = LA[i * DB + tid], bt = BT[i * DB + tid]; hst = a * hst + bt; ca *= a; LA[i * DB + tid] = hst; BT[i * DB + tid] = ca; }
            }
            __syncthreads();
            if (act) {
                u32x2 yg[8];
#pragma unroll
                for (int i = 0; i < 8; ++i) yg[i] = *(const u32x2*)(P + (r0 + 32 * tq + rs + 4 * i) * PINP + 896 + c4);
#pragma unroll
                for (int i = 0; i < 8; ++i) { const int tl = rs + 4 * i; const size_t row = r0 + 32 * tq + tl;
                    const f32x4 h4 = *(const LAS f32x4*)(LA + tl * DB + c4), ca4 = *(const LAS f32x4*)(BT + tl * DB + c4), y4 = unpack4(yg[i]);
                    f32x4 gl; gl[0] = fgelu(y4[0]); gl[1] = fgelu(y4[1]); gl[2] = fgelu(y4[2]); gl[3] = fgelu(y4[3]);
                    *(u32x2*)(Y + row * DM + 256 + c4) = pack4(gl * h4); *(u32x2*)(F.Q2 + row * DB + c4) = pack4(gl * ca4); }
            }
        }
        if (act) { F.LRUSA[(size_t)ch * DB + tid] = ca; F.LRUSH[(size_t)ch * DB + tid] = hst; }
    }
    __syncthreads();
    for (int mrep = 0; mrep <= (((MK_MIXDUP) >> 2) & 1); ++mrep) {
        if (mrep) __syncthreads();
        const int tid = opaque_tid(), lane = tid & 63, r = lane & 31, hh = lane >> 5;
        LAS bf16* TW = (LAS bf16*)lds;
        LAS bf16* XA = TW + 32 * 72;
        LAS bf16* SG = XA + 32 * 72;
        LAS float* LW = (LAS float*)(lds + 17920);
        LAS bf16* LAa = (LAS bf16*)(lds + 67072);
        LAS bf16* LG = (LAS bf16*)(lds + 91648);
        const float* mu = F.rwkv_mu + l * 1408;
        const int q = tid % 96, rs = tid / 96, n4 = 4 * q; const bool act3 = tid < 384;
        f32x4 p_mr, p_mk, p_mv, p_w0, p_a0, p_kk, p_ka;
        { p_mr = *(const f32x4*)(mu + n4); p_mk = *(const f32x4*)(mu + 384 + n4); p_mv = *(const f32x4*)(mu + 768 + n4);
          p_w0 = *(const f32x4*)(F.rwkv_w0 + l * DC + n4); p_a0 = *(const f32x4*)(F.rwkv_a0 + l * DC + n4); p_kk = *(const f32x4*)(F.rwkv_k_k + l * DC + n4); p_ka = *(const f32x4*)(F.rwkv_k_a + l * DC + n4); }
        const bf16* pc = P + PC_OFF + 1152 + 4 * lane; const f32x4 mu4 = *(const f32x4*)(mu + 1152 + 4 * lane);
        LAS bf16* c1dst = lane < 16 ? TW + 4 * lane : (lane < 32 ? XA + 4 * (lane - 16) : SG + 4 * (lane - 32));
        const int c1stride = lane < 32 ? 72 : 136;
#ifndef MK_CDUP
#define MK_CDUP 0
#endif
        for (int tb = 0; tb < 4; ++tb) {
            for (int c12 = 0; c12 <= ((MK_CDUP) & 1); ++c12) {
            if (c12) __syncthreads();
            {
                const int t0 = 32 * tb + 4 * wave;
                f32x4 prev = (f32x4){0.f, 0.f, 0.f, 0.f};
                if (t0 > 0 || n > 0) prev = unpack4(*(const u32x2*)(pc + (r0 + t0 - 1) * PINP));
#pragma unroll
                for (int i = 0; i < 4; ++i) {
                    const f32x4 cur = unpack4(*(const u32x2*)(pc + (r0 + t0 + i) * PINP));
                    const f32x4 xs = cur + (prev - cur) * mu4; prev = cur;
                    f32x4 y;
#pragma unroll
                    for (int e = 0; e < 4; ++e) y[e] = lane < 16 ? ftanh(xs[e]) : (lane < 32 ? xs[e] : fsigmoid(xs[e]));
                    *(LAS u32x2*)(c1dst + (4 * wave + i) * c1stride) = pack4(y); }
            }
            __syncthreads();
            for (int u = wave; u < 36; u += 8) {
                const int lora = u < 12 ? 0 : (u < 24 ? 1 : 2), nt = u - 12 * lora;
                f32x16 acc;
#pragma unroll
                for (int i = 0; i < 16; ++i) acc[i] = 0.f;
                const int nrow = 32 * nt + r;
                if (lora == 0) { const bf16* wr = F.RG2 + ((size_t)l * 384 + nrow) * 128 + 8 * hh; const LAS bf16* xr = SG + r * 136 + 8 * hh;
#pragma unroll
                    for (int ks = 0; ks < 8; ++ks) acc = __builtin_amdgcn_mfma_f32_32x32x16_bf16(*(const LAS bf16x8*)(xr + 16 * ks), *(const bf16x8*)(wr + 16 * ks), acc, 0, 0, 0);
                } else { const bf16* wr = (lora == 1 ? F.RW2 : F.RA2) + ((size_t)l * 384 + nrow) * 64 + 8 * hh; const LAS bf16* xr = (lora == 1 ? TW : XA) + r * 72 + 8 * hh;
#pragma unroll
                    for (int ks = 0; ks < 4; ++ks) acc = __builtin_amdgcn_mfma_f32_32x32x16_bf16(*(const LAS bf16x8*)(xr + 16 * ks), *(const bf16x8*)(wr + 16 * ks), acc, 0, 0, 0);
                }
                if (lora == 1) { LAS float* d = LW + 32 * nt + r;
#pragma unroll
                    for (int rg = 0; rg < 16; ++rg) d[((rg & 3) + 8 * (rg >> 2) + 4 * hh) * 384] = acc[rg];
                } else { LAS bf16* d = (lora == 0 ? LG : LAa) + 32 * nt + r;
#pragma unroll
                    for (int rg = 0; rg < 16; ++rg) d[((rg & 3) + 8 * (rg >> 2) + 4 * hh) * 384] = f2bf(acc[rg]); }
            }
            __syncthreads();
            }
            for (int c3r = 0; c3r <= (((MK_CDUP) >> 1) & 1); ++c3r)
            if (act3) {
                struct RowIn { u32x2 rc, kc, vc, rp, kp, vp; };
#define C3_LOAD(T, i) do { const int t_ = 32 * tb + rs + 4 * (i); const bf16* prow_ = P + (r0 + t_) * PINP + PC_OFF + n4; T.rc = *(const u32x2*)(prow_); T.kc = *(const u32x2*)(prow_ + 384); T.vc = *(const u32x2*)(prow_ + 768); \
        if (t_ > 0 || n > 0) { T.rp = *(const u32x2*)(prow_ - PINP); T.kp = *(const u32x2*)(prow_ - PINP + 384); T.vp = *(const u32x2*)(prow_ - PINP + 768); } else { T.rp = (u32x2){0u, 0u}; T.kp = T.rp; T.vp = T.rp; } } while (0)
                RowIn rin[2];
                C3_LOAD(rin[0], 0);
#pragma unroll
                for (int i = 0; i < 8; ++i) {
                    if (i + 1 < 8) C3_LOAD(rin[(i + 1) & 1], i + 1);
                    const RowIn& T = rin[i & 1];
                    const int tl = rs + 4 * i; const size_t row = r0 + 32 * tb + tl;
                    f32x4 rc = unpack4(T.rc), kc = unpack4(T.kc), vc = unpack4(T.vc);
                    const f32x4 rp = unpack4(T.rp), kp = unpack4(T.kp), vp = unpack4(T.vp);
                    rc = rc + (rp - rc) * p_mr; kc = kc + (kp - kc) * p_mk; vc = vc + (vp - vc) * p_mv;
                    const f32x4 lw = *(const LAS f32x4*)(LW + tl * 384 + n4), la = unpack4(*(const LAS u32x2*)(LAa + tl * 384 + n4));
                    const u32x2 lg = *(const LAS u32x2*)(LG + tl * 384 + n4);
                    const f32x4 kr = kc * p_kk;
                    const float ss = red16((kr[0] * kr[0] + kr[1] * kr[1]) + (kr[2] * kr[2] + kr[3] * kr[3]));
                    const float rn = __builtin_amdgcn_rsqf(fmaxf(ss, 1e-24f));
                    f32x4 dec, km, kk4, bv4;
#pragma unroll
                    for (int e = 0; e < 4; ++e) {
                        const float wv = -fsoftplus(-(p_w0[e] + lw[e])) - 0.5f; dec[e] = fexp(-fexp(wv));
                        const float a = fsigmoid(p_a0[e] + la[e]);
                        kk4[e] = kr[e] * rn; bv4[e] = kk4[e] * a;
                        km[e] = kc[e] * (1.f + (a - 1.f) * p_ka[e]); }
                    *(u32x2*)(F.R + row * DC + n4) = pack4(rc); *(u32x2*)(F.K + row * DC + n4) = pack4(km); *(u32x2*)(F.V + row * DC + n4) = pack4(vc);
                    *(f32x4*)(F.WD + row * DC + n4) = dec; *(u32x2*)(F.KK + row * DC + n4) = pack4(kk4); *(u32x2*)(F.BV + row * DC + n4) = pack4(bv4);
                    *(u32x2*)(Y + row * DM + 640 + n4) = lg;
                }
#undef C3_LOAD
            }
        }
    }
    __syncthreads();
}

__device__ __forceinline__ void rwkv_scan_item(Frame& F, const int it) {
#define SC_BAR() do { asm volatile("s_waitcnt lgkmcnt(0)" ::: "memory"); __builtin_amdgcn_s_barrier(); asm volatile("" ::: "memory"); } while (0)
    const int tid = opaque_tid();
    const int b = it / 24, h = (it % 24) >> 2, qt = it & 3;
    constexpr int CS = 16;
    constexpr int BUFF = 5 * CS * 64 + CS * 16;
    constexpr int OPF = CS * 16 * 16;
    constexpr int NCK = SEQ / CS;
    LAS float* buf = (LAS float*)F.lds;
    LAS float* opart = buf + 2 * BUFF;
    const size_t base = (size_t)b * SEQ * DC + 64 * h;
    if (tid >= 256) {
        const int lt = tid - 256, st = lt >> 4, q = lt & 15, vst = lt >> 2, vq = lt & 3;
        const size_t go = base + (size_t)st * DC + 4 * q;
        const bf16* gKK = F.KK + go; const bf16* gBV = F.BV + go; const bf16* gK = F.K + go; const bf16* gR = F.R + go; const float* gW = F.WD + go;
        const bf16* gV = F.V + base + (size_t)vst * DC + 16 * qt + 4 * vq;
        float* gO = F.O + base + 16 * qt + (size_t)(lt >> 4) * DC + (lt & 15);
        const bool ldv = lt < CS * 4;
        u32x2 kk0, bv0, k0, r0, v0 = (u32x2){0u, 0u}, kk1, bv1, k1, r1, v1 = (u32x2){0u, 0u}, kk2, bv2, k2, r2, v2 = (u32x2){0u, 0u}; f32x4 w0, w1, w2;
#define SC_LOAD(S, ck) do { const size_t _o = (size_t)(ck) * CS * DC; kk##S = *(const u32x2*)(gKK + _o); bv##S = *(const u32x2*)(gBV + _o); k##S = *(const u32x2*)(gK + _o); r##S = *(const u32x2*)(gR + _o); \
        w##S = *(const f32x4*)(gW + _o); if (ldv) v##S = *(const u32x2*)(gV + _o); } while (0)
#define SC_STORE(S, bb) do { LAS float* _b = (bb) + st * 64 + 4 * q; *(LAS f32x4*)(_b) = unpack4(kk##S); *(LAS f32x4*)(_b + CS * 64) = w##S; *(LAS f32x4*)(_b + 2 * CS * 64) = unpack4(bv##S); \
        *(LAS f32x4*)(_b + 3 * CS * 64) = unpack4(k##S); *(LAS f32x4*)(_b + 4 * CS * 64) = unpack4(r##S); if (ldv) *(LAS f32x4*)((bb) + 5 * CS * 64 + vst * 16 + 4 * vq) = unpack4(v##S); } while (0)
#define SC_FLUSH(ckf) do { const LAS f32x4* pp = (const LAS f32x4*)(opart + ((ckf) & 1) * OPF + lt * 16); const f32x4 a0 = pp[0], a1 = pp[1], a2 = pp[2], a3 = pp[3]; const f32x4 sm = (a0 + a1) + (a2 + a3); \
        gO[(size_t)(ckf) * CS * DC] = (sm[0] + sm[1]) + (sm[2] + sm[3]); } while (0)
#define SC_ITER(S, c) do { if ((c) > 0) SC_FLUSH((c) - 1); if ((c) + 1 < NCK) SC_STORE(S, buf + (((c) + 1) & 1) * BUFF); if ((c) + 4 < NCK) SC_LOAD(S, (c) + 4); SC_BAR(); } while (0)
        SC_LOAD(0, 0); SC_LOAD(1, 1); SC_LOAD(2, 2); SC_STORE(0, buf); SC_LOAD(0, 3);
        SC_BAR();
        for (int ck = 0; ck < NCK; ck += 3) {
            SC_ITER(1, ck);
            if (ck + 1 < NCK) SC_ITER(2, ck + 1);
            if (ck + 2 < NCK) SC_ITER(0, ck + 2);
        }
        SC_FLUSH(NCK - 1);
#undef SC_ITER
#undef SC_LOAD
#undef SC_STORE
#undef SC_FLUSH
    } else {
        const int gl = tid & 15, row = tid >> 4;
#define SC_READ(T, cbp, tt) do { T.kk = *(const LAS f32x4*)((cbp) + (tt) * 64 + 4 * gl); T.w = *(const LAS f32x4*)((cbp) + CS * 64 + (tt) * 64 + 4 * gl); T.bb = *(const LAS f32x4*)((cbp) + 2 * CS * 64 + (tt) * 64 + 4 * gl); \
        T.k = *(const LAS f32x4*)((cbp) + 3 * CS * 64 + (tt) * 64 + 4 * gl); T.r = *(const LAS f32x4*)((cbp) + 4 * CS * 64 + (tt) * 64 + 4 * gl); T.v = (cbp)[5 * CS * 64 + (tt) * 16 + row]; } while (0)
        struct StepIn { f32x4 kk, w, bb, k, r; float v; };
        SC_BAR();
        f32x2 sA = (f32x2){0.f, 0.f}, sB = (f32x2){0.f, 0.f};
        for (int ck = 0; ck < NCK; ++ck) {
            const LAS float* cb = buf + (ck & 1) * BUFF; LAS float* op = opart + (ck & 1) * OPF;
            StepIn sin[3];
            SC_READ(sin[0], cb, 0); SC_READ(sin[1], cb, 1);
#pragma unroll
            for (int tt = 0; tt < CS; ++tt) {
                if (tt + 2 < CS) SC_READ(sin[(tt + 2) % 3], cb, tt + 2);
                __builtin_amdgcn_sched_barrier(0);
                const StepIn& cur = sin[tt % 3];
                const f32x2 kkA = (f32x2){cur.kk[0], cur.kk[1]}, kkB = (f32x2){cur.kk[2], cur.kk[3]};
                f32x2 d2 = sA * kkA; d2 = sB * kkB + d2;
                const float p = red16(d2[0] + d2[1]);
                const f32x2 uA = (f32x2){cur.k[0], cur.k[1]} * cur.v, uB = (f32x2){cur.k[2], cur.k[3]} * cur.v;
                sA = sA * (f32x2){cur.w[0], cur.w[1]} + uA; sB = sB * (f32x2){cur.w[2], cur.w[3]} + uB;
                sA = sA - (f32x2){cur.bb[0], cur.bb[1]} * p; sB = sB - (f32x2){cur.bb[2], cur.bb[3]} * p;
                f32x2 o2 = sA * (f32x2){cur.r[0], cur.r[1]}; o2 = sB * (f32x2){cur.r[2], cur.r[3]} + o2;
                op[tt * 256 + tid] = o2[0] + o2[1];
                __builtin_amdgcn_sched_barrier(0);
            }
            SC_BAR();
        }
#undef SC_READ
    }
#undef SC_BAR
}
__device__ __forceinline__ void lru_fin_chunk(Frame& F, const int ch) {
    const int tid = opaque_tid(); if (tid >= 384) return;
    const int q = tid % 96, rs = tid / 96, b = ch >> 5, n = ch & 31;
    f32x4 hin = (f32x4){0.f, 0.f, 0.f, 0.f};
    for (int j = 0; j < n; ++j) { const f32x4 a = *(const f32x4*)(F.LRUSA + (size_t)(b * 32 + j) * DB + 4 * q), hh = *(const f32x4*)(F.LRUSH + (size_t)(b * 32 + j) * DB + 4 * q); hin = a * hin + hh; }
    bf16* Y = F.HY;
    for (int t0 = rs; t0 < 128; t0 += 32) {
        u32x2 a1[8], a2[8];
#pragma unroll
        for (int i = 0; i < 8; ++i) { const size_t row = (size_t)ch * 128 + t0 + 4 * i; a1[i] = *(const u32x2*)(Y + row * DM + 256 + 4 * q); a2[i] = *(const u32x2*)(F.Q2 + row * DB + 4 * q); }
#pragma unroll
        for (int i = 0; i < 8; ++i) { const size_t row = (size_t)ch * 128 + t0 + 4 * i; *(u32x2*)(Y + row * DM + 256 + 4 * q) = pack4(unpack4(a1[i]) + unpack4(a2[i]) * hin); }
    }
}
__device__ __forceinline__ void rwkv_fin_phase(Frame& F, const int l) {
    const int gw = F.vcu * NWAVES + F.wave, NGW = F.G * NWAVES, lane = opaque_tid() & 63, sub = lane >> 4, q = lane & 15;
    bf16* Y = F.HY;
    struct FinIn { f32x4 ov; u32x2 r, k, v, g; };
#define FIN_LOAD(T, idx_) do { const int m_ = (idx_) / 6, h_ = (idx_) - 6 * m_; const size_t o_ = (size_t)m_ * DC + 64 * h_ + 4 * q; T.ov = *(const f32x4*)(F.O + o_); T.r = *(const u32x2*)(F.R + o_); T.k = *(const u32x2*)(F.K + o_); \
        T.v = *(const u32x2*)(F.V + o_); T.g = *(const u32x2*)(Y + (size_t)m_ * DM + 640 + 64 * h_ + 4 * q); } while (0)
    FinIn fin[2];
    constexpr int NIT = (M * 6) / (256 * NWAVES * 4);
    const int idx0 = gw * 4 + sub, stride = NGW * 4;
    if (NGW * 4 * NIT != M * 6) return;
    FIN_LOAD(fin[0], idx0);
#pragma unroll 2
    for (int it = 0; it < NIT; ++it) {
        const int idx = idx0 + it * stride;
        if (it + 1 < NIT) { if (it & 1) FIN_LOAD(fin[0], idx + stride); else FIN_LOAD(fin[1], idx + stride); }
        const FinIn& T = (it & 1) ? fin[1] : fin[0];
        const int m = idx / 6, h = idx - 6 * m; const int n4 = 64 * h + 4 * q;
        const f32x4 ov = T.ov;
        const float mean = red16((ov[0] + ov[1]) + (ov[2] + ov[3])) * (1.f / 64.f);
        const f32x4 d = ov - mean;
        const float var = red16((d[0] * d[0] + d[1] * d[1]) + (d[2] * d[2] + d[3] * d[3])) * (1.f / 64.f);
        const float rstd = __builtin_amdgcn_rsqf(var + 64e-5f);
        const f32x4 lw = *(const f32x4*)(F.rwkv_ln_w + l * DC + n4), lb = *(const f32x4*)(F.rwkv_ln_b + l * DC + n4), rk = *(const f32x4*)(F.rwkv_r_k + l * DC + n4);
        const f32x4 r4 = unpack4(T.r), k4 = unpack4(T.k), v4 = unpack4(T.v);
        const f32x4 t4 = r4 * k4 * rk;
        const float bs = red16((t4[0] + t4[1]) + (t4[2] + t4[3]));
        const f32x4 g4 = unpack4(T.g);
        const f32x4 y = ((d * rstd) * lw + lb + v4 * bs) * g4;
        *(u32x2*)(Y + (size_t)m * DM + 640 + n4) = pack4(y);
    }
#undef FIN_LOAD
}
__device__ __forceinline__ void ffn_glu_phase(Frame& F, const int l) {
    constexpr int CG = DFF / 8, SEG = 32, NSEG = M / SEG;
    const int gt = F.vcu * (NWAVES * 64) + opaque_tid(), NGT = F.G * NWAVES * 64;
    for (int id = gt; id < NSEG * CG; id += NGT) {
        const int rsg = id / CG, cg8 = id - rsg * CG; const int col = 8 * cg8; const size_t row0 = (size_t)rsg * SEG;
        float w0[8], w1[8], w2[8], cb[8], x1[8], x2[8];
        { const float* cw = F.ffn_conv_w + (size_t)l * 3 * DFF + col; const float* cbp = F.ffn_conv_b + (size_t)l * DFF + col;
#pragma unroll
          for (int e = 0; e < 8; ++e) { w0[e] = cw[e]; w1[e] = cw[DFF + e]; w2[e] = cw[2 * DFF + e]; cb[e] = cbp[e]; x1[e] = 0.f; x2[e] = 0.f; } }
        if ((row0 & (SEQ - 1)) != 0) {
            const u32x4 a = *(const u32x4*)(F.UG + (row0 - 2) * DFF + col), bq = *(const u32x4*)(F.UG + (row0 - 1) * DFF + col);
            x2[0] = bflo(a.x); x2[1] = bfhi(a.x); x2[2] = bflo(a.y); x2[3] = bfhi(a.y); x2[4] = bflo(a.z); x2[5] = bfhi(a.z); x2[6] = bflo(a.w); x2[7] = bfhi(a.w);
            x1[0] = bflo(bq.x); x1[1] = bfhi(bq.x); x1[2] = bflo(bq.y); x1[3] = bfhi(bq.y); x1[4] = bflo(bq.z); x1[5] = bfhi(bq.z); x1[6] = bflo(bq.w); x1[7] = bfhi(bq.w);
        }
        u32x4 ga[4], va[4], gb[4], vb[4];
#define FF_LOAD(G_, V_, grp) do { _Pragma("unroll") for (int i_ = 0; i_ < 4; ++i_) { G_[i_] = *(const u32x4*)(F.UG + (row0 + 4 * (grp) + i_) * DFF + col); V_[i_] = *(const u32x4*)(F.UV + (row0 + 4 * (grp) + i_) * DFF + col); } } while (0)
#define FF_DO(G_, V_, grp) do { _Pragma("unroll") for (int i_ = 0; i_ < 4; ++i_) { const u32x4 gq = G_[i_], vq = V_[i_]; float x0[8], vv[8], y[8]; \
            x0[0] = bflo(gq.x); x0[1] = bfhi(gq.x); x0[2] = bflo(gq.y); x0[3] = bfhi(gq.y); x0[4] = bflo(gq.z); x0[5] = bfhi(gq.z); x0[6] = bflo(gq.w); x0[7] = bfhi(gq.w); \
            vv[0] = bflo(vq.x); vv[1] = bfhi(vq.x); vv[2] = bflo(vq.y); vv[3] = bfhi(vq.y); vv[4] = bflo(vq.z); vv[5] = bfhi(vq.z); vv[6] = bflo(vq.w); vv[7] = bfhi(vq.w); \
            _Pragma("unroll") for (int e = 0; e < 8; ++e) { const float gc = cb[e] + w0[e] * x2[e] + w1[e] * x1[e] + w2[e] * x0[e]; y[e] = fsilu(gc) * vv[e]; x2[e] = x1[e]; x1[e] = x0[e]; } \
            u32x4 o; o.x = pk2(y[0], y[1]); o.y = pk2(y[2], y[3]); o.z = pk2(y[4], y[5]); o.w = pk2(y[6], y[7]); \
            *(u32x4*)(F.UV + (row0 + 4 * (grp) + i_) * DFF + col) = o; } } while (0)
        FF_LOAD(ga, va, 0);
        for (int grp = 0; grp < SEG / 4; grp += 2) {
            FF_LOAD(gb, vb, grp + 1);
            FF_DO(ga, va, grp);
            if (grp + 2 < SEG / 4) FF_LOAD(ga, va, grp + 2);
            FF_DO(gb, vb, grp + 1);
        }
#undef FF_LOAD
#undef FF_DO
    }
}

__device__ __forceinline__ void ffn_fix_phase(Frame& F, const int l) {
    const int gt = F.vcu * (NWAVES * 64) + opaque_tid(), NGT = F.G * NWAVES * 64;
    constexpr int C4 = DFF / 4, NT = M / 256;
    const float* cw = F.ffn_conv_w + (size_t)l * 3 * DFF; const float* cbp = F.ffn_conv_b + (size_t)l * DFF;
    for (int id = gt; id < NT * C4; id += NGT) {
        const int pm = id / C4, c = 4 * (id - pm * C4);
        if ((pm & 15) == 0) continue;
        const f32x4 w0 = *(const f32x4*)(cw + c), w1 = *(const f32x4*)(cw + DFF + c), w2 = *(const f32x4*)(cw + 2 * DFF + c), cb = *(const f32x4*)(cbp + c);
        const f32x4 gm2 = *(const f32x4*)(F.TG + ((size_t)(pm - 1) * 2 + 0) * DFF + c), gm1 = *(const f32x4*)(F.TG + ((size_t)(pm - 1) * 2 + 1) * DFF + c);
        const f32x4 g0 = *(const f32x4*)(F.HG + ((size_t)pm * 2 + 0) * DFF + c), g1 = *(const f32x4*)(F.HG + ((size_t)pm * 2 + 1) * DFF + c);
        const f32x4 v0 = *(const f32x4*)(F.HV + ((size_t)pm * 2 + 0) * DFF + c), v1 = *(const f32x4*)(F.HV + ((size_t)pm * 2 + 1) * DFF + c);
        f32x4 h0, h1;
#pragma unroll
        for (int e = 0; e < 4; ++e) { const float a = cb[e] + w0[e] * gm2[e] + w1[e] * gm1[e] + w2[e] * g0[e], b = cb[e] + w0[e] * gm1[e] + w1[e] * g0[e] + w2[e] * g1[e];
            h0[e] = fsilu(a) * v0[e]; h1[e] = fsilu(b) * v1[e]; }
        *(u32x2*)(F.UV + ((size_t)pm * 256 + 0) * DFF + c) = pack4(h0); *(u32x2*)(F.UV + ((size_t)pm * 256 + 1) * DFF + c) = pack4(h1);
    }
}

struct Args { const float* in[35]; float* out; unsigned char* ws; int ph_lo, ph_hi; };
__device__ __forceinline__ void frame_init(Frame& F, LAS unsigned char* lds) {
    typedef const __attribute__((address_space(4))) Args* ArgP;
    ArgP ap = (ArgP)__builtin_amdgcn_kernarg_segment_ptr(); asm volatile("" : "+s"(ap));
    F.lds = lds; F.MISC = (volatile LAS unsigned*)(lds + MISC_OFF);
    F.wave = __builtin_amdgcn_readfirstlane(threadIdx.x >> 6);
    F.G = gridDim.x; { const int bx = blockIdx.x; F.vcu = (F.G % 8 == 0) ? (bx % 8) * (F.G / 8) + bx / 8 : bx; }
    unsigned char* ws = ap->ws;
    F.ctl = (gu32*)(ws + WS_CTL);
    F.x = ap->in[0]; F.c = ap->in[1]; F.w_mod = ap->in[2]; F.b_mod = ap->in[3]; F.norm_mix = ap->in[4]; F.w_in = ap->in[5]; F.w_out = ap->in[6];
    F.sgu_ln_g = ap->in[7]; F.sgu_ln_b = ap->in[8]; F.sgu_w = ap->in[9]; F.sgu_b = ap->in[10];
    F.lru_conv_w = ap->in[11]; F.lru_conv_b = ap->in[12]; F.lru_w_a = ap->in[13]; F.lru_b_a = ap->in[14]; F.lru_w_x = ap->in[15]; F.lru_b_x = ap->in[16]; F.lru_lambda = ap->in[17];
    F.rwkv_mu = ap->in[18]; F.rwkv_w0 = ap->in[19]; F.rwkv_w2 = ap->in[20]; F.rwkv_a0 = ap->in[21]; F.rwkv_a2 = ap->in[22]; F.rwkv_g2 = ap->in[23]; F.rwkv_k_k = ap->in[24]; F.rwkv_k_a = ap->in[25];
    F.rwkv_r_k = ap->in[26]; F.rwkv_ln_w = ap->in[27]; F.rwkv_ln_b = ap->in[28]; F.norm_ffn = ap->in[29]; F.ffn_w_up = ap->in[30]; F.ffn_conv_w = ap->in[31]; F.ffn_conv_b = ap->in[32];
    F.ffn_w_down = ap->in[33]; F.norm_final = ap->in[34]; F.out = ap->out;
    F.SGUW = (bf16*)(ws + WS_SMALL + SM_SGUW); F.LRUWA = (bf16*)(ws + WS_SMALL + SM_LRUWA); F.LRUWX = (bf16*)(ws + WS_SMALL + SM_LRUWX);
    F.RW2 = (bf16*)(ws + WS_SMALL + SM_RW2); F.RA2 = (bf16*)(ws + WS_SMALL + SM_RA2); F.RG2 = (bf16*)(ws + WS_SMALL + SM_RG2);
    F.MOD = (float*)(ws + WS_MOD); F.LRUSA = (float*)(ws + WS_LRUS); F.LRUSH = F.LRUSA + 256 * DB;
    F.WIN = (bf16*)(ws + WS_WIN); F.WOUT = (bf16*)(ws + WS_WOUT); F.WUP = (bf16*)(ws + WS_WUP); F.WDN = (bf16*)(ws + WS_WDN);
    F.HY = (bf16*)(ws + WS_HY); F.P = (bf16*)(ws + WS_P); F.UG = (bf16*)(ws + WS_P); F.UV = (bf16*)(ws + WS_UV); F.O = (float*)(ws + WS_P);
    F.R = (bf16*)(ws + WS_R); F.K = (bf16*)(ws + WS_K); F.V = (bf16*)(ws + WS_V); F.KK = (bf16*)(ws + WS_KK); F.BV = (bf16*)(ws + WS_BV); F.WD = (float*)(ws + WS_WD); F.Q2 = (bf16*)(ws + WS_Q2);
    F.SS = (float*)(ws + WS_SS); F.SW1 = (float*)(ws + WS_SW1); F.SW2 = (float*)(ws + WS_SW2);
    F.TG = (float*)(ws + WS_TG); F.HG = (float*)(ws + WS_HG); F.HV = (float*)(ws + WS_HV);
}
__global__ void __launch_bounds__(NWAVES * 64, 2) mk_fwd(Args args) {
    extern __shared__ __attribute__((aligned(16))) unsigned char lds_raw[];
    LAS unsigned char* const lds = (LAS unsigned char*)lds_raw;
    for (int u = threadIdx.x; u < (LDS_BYTES - LDSCTL_OFF) / 4; u += NWAVES * 64) ((LAS unsigned*)(lds + LDSCTL_OFF))[u] = 0u;
    __syncthreads();
#if MK_MODE == 2
    XcdBarrier bar = xcd_barrier_post((unsigned*)((gu32*)(args.ws + WS_CTL) + CW_BAR), (volatile LAS unsigned*)(lds + MISC_OFF) + 8);
#define GRID_BAR() xcd_barrier(bar)
#elif MK_MODE == 1
    cg::grid_group grid = cg::this_grid();
#define GRID_BAR() grid.sync()
#else
#define GRID_BAR() do { } while (0)
#endif
    const int lo = args.ph_lo, hi = args.ph_hi;
#define IN(k) (lo <= (k) && (k) < hi)
#ifndef MK_PHMASK
#define MK_PHMASK 0xFFF
#endif
#define EN(t) (((MK_PHMASK) >> (t)) & 1)
#ifndef MK_DUPMASK
#define MK_DUPMASK 0
#endif
#define REP2(t) (((MK_DUPMASK) >> (t)) & 1)
#define SEAM(k) do { if (IN(k) && IN((k) + 1)) GRID_BAR(); } while (0)
#define PH_BEGIN(t, k) if (EN(t) && IN(k)) { for (int rep = 0; rep <= REP2(t); ++rep) { if (rep) GRID_BAR(); Frame F; frame_init(F, lds); \
        const float* mod_l = F.MOD + (size_t)l * NB * NMOD; const float* Xin = (l == 0) ? F.x : F.out; (void)mod_l; (void)Xin;
#define PH_END(k) } } SEAM(k);

    { const int l = 0; PH_BEGIN(0, 0) p0_prologue(F); PH_END(0) }
    for (int l = 0; l < NL; ++l) {
        const int pb = 1 + 10 * l;
        if (l == 0) { PH_BEGIN(1, pb + 0) sw_phase(F); norm0_phase(F, F.x, F.norm_mix, mod_l, 1, F.HY); PH_END(pb + 0) }
        PH_BEGIN(2, pb + 1) pg8::Gemm g{F.HY, F.WIN + (size_t)l * PINP * DM, M, PINP, DM}; pg8::StaticOrder S; S.init(M, PINP, F.G, (int)blockIdx.x);
            pg8::EpiBf16N E{F.P, PINP, F.SS, F.SW1 + (size_t)l * NB * PINP, PINP, SEQ};
            pg8::gemm_phase<pg8::EpiBf16N, pg8::StaticOrder, true, true>(F.lds, g, S, E); PH_END(pb + 1)
        PH_BEGIN(3, pb + 2) for (int ch = F.vcu; ch < M / 128; ch += F.G) mix_chunk(F, l, ch); PH_END(pb + 2)
        PH_BEGIN(4, pb + 3)
            if (F.G >= 256) { if (F.vcu < 192) rwkv_scan_item(F, F.vcu); else if (rep == 0) for (int ch = F.vcu - 192; ch < M / 128; ch += F.G - 192) lru_fin_chunk(F, ch); }
            else { for (int it = F.vcu; it < 192; it += F.G) { rwkv_scan_item(F, it); __syncthreads(); } if (rep == 0) for (int ch = F.vcu; ch < M / 128; ch += F.G) lru_fin_chunk(F, ch); }
        PH_END(pb + 3)
        PH_BEGIN(5, pb + 4) rwkv_fin_phase(F, l); PH_END(pb + 4)
        PH_BEGIN(6, pb + 5) pg8::Gemm g{F.HY, F.WOUT + (size_t)l * DM * DM, M, DM, DM}; pg8::StaticOrder S; S.init(M, DM, F.G, (int)blockIdx.x);
            pg8::EpiResNorm E{Xin, F.out, DM, mod_l + 2 * DM, NMOD, SEQ, F.P, F.norm_ffn + l * DM, mod_l + 4 * DM, F.SS};
            pg8::gemm_phase<pg8::EpiResNorm, pg8::StaticOrder, true, true>(F.lds, g, S, E); PH_END(pb + 5)
        PH_BEGIN(8, pb + 7) pg8::Gemm g{F.P, F.WUP + (size_t)l * DUP * DM, M, DUP, DM}; pg8::StaticOrder S; S.init(M, DUP, F.G, (int)blockIdx.x);
            pg8::EpiGLU E{F.UV, DFF, F.ffn_conv_w + (size_t)l * 3 * DFF, F.ffn_conv_b + (size_t)l * DFF, F.TG, F.HG, F.HV, (LAS float*)(F.lds + TAIL_OFF), F.SS, F.SW2 + (size_t)l * NB * DUP, DUP, SEQ};
            pg8::gemm_phase<pg8::EpiGLU, pg8::StaticOrder, true, true>(F.lds, g, S, E); PH_END(pb + 7)
        PH_BEGIN(9, pb + 8) ffn_fix_phase(F, l); PH_END(pb + 8)
        PH_BEGIN(10, pb + 9) pg8::Gemm g{F.UV, F.WDN + (size_t)l * DM * DFF, M, DM, DFF}; pg8::StaticOrder S; S.init(M, DM, F.G, (int)blockIdx.x);
            if (l + 1 < NL) { pg8::EpiResNorm E{F.out, F.out, DM, mod_l + 5 * DM, NMOD, SEQ, F.HY, F.norm_mix + (l + 1) * DM, mod_l + (size_t)NB * NMOD + 1 * DM, F.SS};
                pg8::gemm_phase<pg8::EpiResNorm, pg8::StaticOrder, true, true>(F.lds, g, S, E); }
            else { pg8::EpiRes E{F.out, F.out, DM, mod_l + 5 * DM, NMOD, SEQ};
                pg8::gemm_phase<pg8::EpiRes, pg8::StaticOrder, true, true>(F.lds, g, S, E); } PH_END(pb + 9)
    }
    { const int l = 0; PH_BEGIN(11, NPHASE - 1) final_norm_phase(F, F.out, F.norm_final); PH_END(NPHASE - 1) }
#undef IN
#undef SEAM
}

extern "C" void kernel_launch(void* const* d_in, const int* in_sizes, int n_in, void* d_out, int out_size, void* d_ws, size_t ws_size, hipStream_t stream) {
    static int grid = 0;
    if (grid == 0) {
        if (n_in != 35 || in_sizes[0] != M * DM || out_size != M * DM || ws_size < WS_END) { fprintf(stderr, "kernel_launch: unexpected shapes (n_in %d, in0 %d, out %d, ws %zu); nothing launched\n", n_in, n_in > 0 ? in_sizes[0] : -1, out_size, ws_size); grid = -1; return; }
        int dev = 0, cus = 0, per_cu = 0;
        if (hipGetDevice(&dev) != hipSuccess || hipDeviceGetAttribute(&cus, hipDeviceAttributeMultiprocessorCount, dev) != hipSuccess) { grid = -1; return; }
        if (hipFuncSetAttribute((const void*)mk_fwd, hipFuncAttributeMaxDynamicSharedMemorySize, LDS_BYTES) != hipSuccess) { fprintf(stderr, "kernel_launch: hipFuncSetAttribute failed\n"); grid = -1; return; }
        if (hipOccupancyMaxActiveBlocksPerMultiprocessor(&per_cu, (const void*)mk_fwd, NWAVES * 64, LDS_BYTES) != hipSuccess || per_cu < 1) { fprintf(stderr, "kernel_launch: occupancy query says %d blocks per CU\n", per_cu); per_cu = 1; }
        (void)hipGetLastError();
        grid = cus;
    }
    if (grid < 0) return;
    Args a{};
    for (int i = 0; i < 35; ++i) a.in[i] = (const float*)d_in[i];
    a.out = (float*)d_out; a.ws = (unsigned char*)d_ws;
#if MK_MODE == 0
    for (int ph = 0; ph < NPHASE; ++ph) { a.ph_lo = ph; a.ph_hi = ph + 1; hipLaunchKernelGGL(mk_fwd, dim3(grid), dim3(NWAVES * 64), LDS_BYTES, stream, a); }
#else
    (void)hipMemsetAsync((char*)d_ws + WS_CTL, 0, CTL_ZERO_BYTES, stream);
    a.ph_lo = 0; a.ph_hi = NPHASE;
#if MK_MODE == 1
    void* kargs[] = {&a};
    hipError_t e = hipLaunchCooperativeKernel((const void*)mk_fwd, dim3(grid), dim3(NWAVES * 64), kargs, LDS_BYTES, stream);
    if (e != hipSuccess) fprintf(stderr, "kernel_launch: cooperative launch failed: %s (grid %d)\n", hipGetErrorString(e), grid);
#else
    hipLaunchKernelGGL(mk_fwd, dim3(grid), dim3(NWAVES * 64), LDS_BYTES, stream, a);
#endif
#endif
}
```

```cpp
#include <hip/hip_runtime.h>
#include <hip/hip_cooperative_groups.h>
#include <cstdio>
#include <cstdint>
namespace pg8 {
#define PG8_LAS __attribute__((address_space(3)))
typedef unsigned short bf16_t;
typedef short bf16x8 __attribute__((ext_vector_type(8)));
typedef float f32x4 __attribute__((ext_vector_type(4)));
typedef unsigned u32x4 __attribute__((ext_vector_type(4)));
constexpr int BM = 256, BK = 64, HALF = 128, HTB = HALF * BK * 2  , STAGE_BYTES = 8 * HTB, NXCD = 8, WGM = 8;

__host__ __device__ __forceinline__ int lds_byte(int r, int c) { const int st = (r >> 4) * 2 + (c >> 5), rr = r & 15, cc = c & 31, ob = rr * 64 + cc * 2; return st * 1024 + (ob ^ (((ob >> 9) & 1) << 5)); }
__host__ __device__ __forceinline__ void stage_rc(int b, int& R, int& C) { const int st = b / 1024, sb = b % 1024, swz = sb ^ (((sb >> 9) & 1) << 5); R = (st >> 1) * 16 + swz / 64; C = (st & 1) * 32 + (swz % 64) / 2; }
__host__ __device__ __forceinline__ int perm32(int rho) { const int n = rho >> 4, i = rho & 15; return 8 * (i >> 2) + 4 * n + (i & 3); }

struct Unit { int pm, pn; };
struct Gemm { const bf16_t* A; const bf16_t* Bt; int M, N, K; };

struct StaticOrder {
    int nM, nN, nwg, G, c;
    __host__ __device__ void init(int M, int N, int G_, int c_) { nM = M / BM; nN = N / BM; nwg = nM * nN; G = G_; c = c_; }
    __host__ __device__ bool next(int i, Unit& u) const {
        const long L = (long)i * G + c; if (L >= nwg) return false;
        int wgid = (int)L; { const int q = nwg / NXCD, r = nwg % NXCD, xcd = wgid % NXCD, off = wgid / NXCD; wgid = (xcd < r ? xcd * (q + 1) : r * (q + 1) + (xcd - r) * q) + off; }
        const int nig = WGM * nN, gid = wgid / nig, fm = gid * WGM, gsz = (nM - fm) < WGM ? (nM - fm) : WGM;
        u.pm = fm + ((wgid % nig) % gsz); u.pn = (wgid % nig) / gsz; return true;
    }
    __device__ __forceinline__ void a_ready(const Unit&) const {}
    __device__ __forceinline__ void done(const Unit&) const {}
};

__device__ __forceinline__ unsigned cvt_pk_bf16(float lo, float hi) { unsigned r; asm volatile("v_cvt_pk_bf16_f32 %0, %1, %2" : "=v"(r) : "v"(lo), "v"(hi)); return r; }
typedef float f32x2 __attribute__((ext_vector_type(2)));
__device__ __forceinline__ f32x2 gelu_pk(f32x2 v) {
    const f32x2 av = __builtin_elementwise_abs(v), d = av * 0.2316418882f + 1.0f;
    f32x2 t; t.x = __builtin_amdgcn_rcpf(d.x); t.y = __builtin_amdgcn_rcpf(d.y);
    f32x2 q = t * 0.5307027145f + (-0.7265760135f); q = q * t + 0.7107068705f; q = q * t + (-0.142248368f); q = q * t + 0.127414796f; q = q * t;
    const f32x2 s = (v * v) * (-0.72134752044f);
    f32x2 e; e.x = __builtin_amdgcn_exp2f(s.x); e.y = __builtin_amdgcn_exp2f(s.y);
    const f32x2 m = v * (q * e), r = v - m;
    f32x2 o; o.x = v.x < 0.f ? m.x : r.x; o.y = v.y < 0.f ? m.y : r.y; return o;
}

template <int ACT  > struct EpiBf16 {
    static constexpr bool PERM = true, AFTER_DRAIN = false; static_assert(ACT == 0 || ACT == 1, "EpiBf16: ACT is 0 (none) or 1 (gelu_pk)");
    bf16_t* O; int ldc; const float* bias; int split_cols; size_t split_stride; float scale0;
    __device__ __forceinline__ void operator()(const f32x4 (&acc)[2][2][4][2], const Unit& u, int wr, int wc, int fr, int fq) const {
        const int row0 = u.pm * BM + wr * 64 + fr; int colt = u.pn * BM; bf16_t* base = O;
        float sc = 1.f; if (split_cols) { const int t = colt / split_cols; base += (size_t)t * split_stride; colt -= t * split_cols; if (t == 0) sc = scale0; }
        const int col0 = colt + wc * 32 + 8 * fq, bcol0 = u.pn * BM + wc * 32 + 8 * fq;
        f32x4 bv[2][2];
#pragma unroll
        for (int bj = 0; bj < 2; ++bj)
#pragma unroll
            for (int n = 0; n < 2; ++n) bv[bj][n] = bias ? *(const f32x4*)(bias + bcol0 + bj * HALF + 4 * n) : (f32x4){0.f, 0.f, 0.f, 0.f};
#pragma unroll
        for (int ai = 0; ai < 2; ++ai)
#pragma unroll
            for (int m = 0; m < 4; ++m) { bf16_t* rowp = base + (size_t)(row0 + ai * HALF + m * 16) * ldc + col0;
#pragma unroll
                for (int bj = 0; bj < 2; ++bj) { f32x4 v0 = acc[ai][bj][m][0] + bv[bj][0], v1 = acc[ai][bj][m][1] + bv[bj][1];
                    if (ACT == 1) { f32x2 a = gelu_pk((f32x2){v0[0], v0[1]}), b = gelu_pk((f32x2){v0[2], v0[3]}), c = gelu_pk((f32x2){v1[0], v1[1]}), d = gelu_pk((f32x2){v1[2], v1[3]});
                        v0 = (f32x4){a.x, a.y, b.x, b.y}; v1 = (f32x4){c.x, c.y, d.x, d.y}; }
                    v0 = v0 * sc; v1 = v1 * sc; u32x4 w; w.x = cvt_pk_bf16(v0[0], v0[1]); w.y = cvt_pk_bf16(v0[2], v0[3]); w.z = cvt_pk_bf16(v1[0], v1[1]); w.w = cvt_pk_bf16(v1[2], v1[3]);
                    *(u32x4*)(rowp + bj * HALF) = w; } }
    }
};

typedef unsigned u32x2v __attribute__((ext_vector_type(2)));

struct EpiRes {
    static constexpr bool PERM = false, AFTER_DRAIN = false;
    const float* base; float* out; int ldc; const float* gate; int gate_ld; int rows_per_batch;
    __device__ __forceinline__ void operator()(const f32x4 (&acc)[2][2][4][2], const Unit& u, int wr, int wc, int fr, int fq) const {
        const int row0 = u.pm * BM + wr * 64 + fr, col0 = u.pn * BM + wc * 32 + 4 * fq;
        const float* gp = gate + (size_t)((u.pm * BM) / rows_per_batch) * gate_ld + col0;
        f32x4 gv[2][2];
#pragma unroll
        for (int bj = 0; bj < 2; ++bj)
#pragma unroll
            for (int n = 0; n < 2; ++n) gv[bj][n] = *(const f32x4*)(gp + bj * HALF + n * 16);
        f32x4 pre[3][2][2];
#define ER_LOAD(slot, g_) do { const size_t off_ = (size_t)(row0 + ((g_) >> 2) * HALF + ((g_) & 3) * 16) * ldc + col0; _Pragma("unroll") for (int bj = 0; bj < 2; ++bj) _Pragma("unroll") for (int n = 0; n < 2; ++n) pre[slot][bj][n] = *(const f32x4*)(base + off_ + bj * HALF + n * 16); } while (0)
        ER_LOAD(0, 0); ER_LOAD(1, 1);
#pragma unroll
        for (int g = 0; g < 8; ++g) { const int ai = g >> 2, m = g & 3; const size_t off = (size_t)(row0 + ai * HALF + m * 16) * ldc + col0;
            if (g + 2 < 8) ER_LOAD((g + 2) % 3, g + 2);
#pragma unroll
            for (int bj = 0; bj < 2; ++bj)
#pragma unroll
                for (int n = 0; n < 2; ++n) *(f32x4*)(out + off + bj * HALF + n * 16) = pre[g % 3][bj][n] + gv[bj][n] * acc[ai][bj][m][n]; }
#undef ER_LOAD
    }
};
struct EpiGV {
    static constexpr bool PERM = true, AFTER_DRAIN = false;
    bf16_t* G; bf16_t* V; int ldc;
    __device__ __forceinline__ void operator()(const f32x4 (&acc)[2][2][4][2], const Unit& u, int wr, int wc, int fr, int fq) const {
        const int row0 = u.pm * BM + wr * 64 + fr, col0 = u.pn * HALF + wc * 32 + 8 * fq;
#pragma unroll
        for (int ai = 0; ai < 2; ++ai)
#pragma unroll
            for (int m = 0; m < 4; ++m) { const size_t off = (size_t)(row0 + ai * HALF + m * 16) * ldc + col0;
#pragma unroll
                for (int bj = 0; bj < 2; ++bj) { const f32x4 v0 = acc[ai][bj][m][0], v1 = acc[ai][bj][m][1];
                    u32x4 w; w.x = cvt_pk_bf16(v0[0], v0[1]); w.y = cvt_pk_bf16(v0[2], v0[3]); w.z = cvt_pk_bf16(v1[0], v1[1]); w.w = cvt_pk_bf16(v1[2], v1[3]);
                    *(u32x4*)((bj ? V : G) + off) = w; } }
    }
};

__device__ __forceinline__ float xrow16_sum(float x) {
    auto s = __builtin_amdgcn_permlane16_swap(__float_as_uint(x), __float_as_uint(x), false, false);
    x = __uint_as_float(s[0]) + __uint_as_float(s[1]);
    auto t = __builtin_amdgcn_permlane32_swap(__float_as_uint(x), __float_as_uint(x), false, false);
    return __uint_as_float(t[0]) + __uint_as_float(t[1]);
}
__device__ __forceinline__ void load_rstd8(const float* SS, int row0, int fq, float inv_n, float eps, float (&rstd)[8]) {
    f32x4 p[8];
#pragma unroll
    for (int g = 0; g < 8; ++g) p[g] = *(const f32x4*)(SS + (size_t)(row0 + (g >> 2) * HALF + (g & 3) * 16) * 16 + 4 * fq);
#pragma unroll
    for (int g = 0; g < 8; ++g) rstd[g] = __builtin_amdgcn_rsqf(xrow16_sum((p[g][0] + p[g][1]) + (p[g][2] + p[g][3])) * inv_n + eps);
}
struct EpiResNorm {
    static constexpr bool PERM = false, AFTER_DRAIN = false;
    const float* base; float* out; int ldc; const float* gate; int gate_ld; int rows_per_batch; bf16_t* XS; const float* gamma; const float* sc; float* SS;
    __device__ __forceinline__ void operator()(const f32x4 (&acc)[2][2][4][2], const Unit& u, int wr, int wc, int fr, int fq) const {
        const int row0 = u.pm * BM + wr * 64 + fr, col0 = u.pn * BM + wc * 32 + 4 * fq;
        const int b = (u.pm * BM) / rows_per_batch;
        const float* gp = gate + (size_t)b * gate_ld + col0; const float* sp = sc + (size_t)b * gate_ld + col0;
        f32x4 gv[2][2], gs[2][2];
#pragma unroll
        for (int bj = 0; bj < 2; ++bj)
#pragma unroll
            for (int n = 0; n < 2; ++n) { gv[bj][n] = *(const f32x4*)(gp + bj * HALF + n * 16); gs[bj][n] = *(const f32x4*)(gamma + col0 + bj * HALF + n * 16) * (*(const f32x4*)(sp + bj * HALF + n * 16) + 1.f); }
        f32x4 pre[3][2][2];
#define ER_LOAD(slot, g_) do { const size_t off_ = (size_t)(row0 + ((g_) >> 2) * HALF + ((g_) & 3) * 16) * ldc + col0; _Pragma("unroll") for (int bj = 0; bj < 2; ++bj) _Pragma("unroll") for (int n = 0; n < 2; ++n) pre[slot][bj][n] = *(const f32x4*)(base + off_ + bj * HALF + n * 16); } while (0)
        ER_LOAD(0, 0); ER_LOAD(1, 1);
#pragma unroll
        for (int g = 0; g < 8; ++g) { const int ai = g >> 2, m = g & 3; const size_t off = (size_t)(row0 + ai * HALF + m * 16) * ldc + col0;
            if (g + 2 < 8) ER_LOAD((g + 2) % 3, g + 2);
            float ssq = 0.f;
#pragma unroll
            for (int bj = 0; bj < 2; ++bj)
#pragma unroll
                for (int n = 0; n < 2; ++n) { const f32x4 o = pre[g % 3][bj][n] + gv[bj][n] * acc[ai][bj][m][n];
                    *(f32x4*)(out + off + bj * HALF + n * 16) = o;
                    const f32x4 xs = o * gs[bj][n]; u32x2v w; w.x = cvt_pk_bf16(xs[0], xs[1]); w.y = cvt_pk_bf16(xs[2], xs[3]);
                    *(u32x2v*)(XS + off + bj * HALF + n * 16) = w;
                    ssq += (o[0] * o[0] + o[1] * o[1]) + (o[2] * o[2] + o[3] * o[3]); }
            ssq = xrow16_sum(ssq);
            if (fq == 0) SS[(size_t)(row0 + ai * HALF + m * 16) * 16 + 4 * u.pn + wc] = ssq; }
#undef ER_LOAD
    }
};
struct EpiBf16N {
    static constexpr bool PERM = true, AFTER_DRAIN = false;
    bf16_t* O; int ldc; const float* SS; const float* SW; int sw_ld; int rows_per_batch;
    __device__ __forceinline__ void operator()(const f32x4 (&acc)[2][2][4][2], const Unit& u, int wr, int wc, int fr, int fq) const {
        const int row0 = u.pm * BM + wr * 64 + fr, col0 = u.pn * BM + wc * 32 + 8 * fq;
        float rstd[8]; load_rstd8(SS, row0, fq, 1.f / 1024.f, 1e-6f, rstd);
        const float* swp = SW + (size_t)((u.pm * BM) / rows_per_batch) * sw_ld + col0;
        f32x4 sw[2][2];
#pragma unroll
        for (int bj = 0; bj < 2; ++bj)
#pragma unroll
            for (int n = 0; n < 2; ++n) sw[bj][n] = *(const f32x4*)(swp + bj * HALF + 4 * n);
#pragma unroll
        for (int ai = 0; ai < 2; ++ai)
#pragma unroll
            for (int m = 0; m < 4; ++m) { bf16_t* rowp = O + (size_t)(row0 + ai * HALF + m * 16) * ldc + col0; const float rs = rstd[ai * 4 + m];
#pragma unroll
                for (int bj = 0; bj < 2; ++bj) { const f32x4 v0 = acc[ai][bj][m][0] * rs + sw[bj][0], v1 = acc[ai][bj][m][1] * rs + sw[bj][1];
                    u32x4 w; w.x = cvt_pk_bf16(v0[0], v0[1]); w.y = cvt_pk_bf16(v0[2], v0[3]); w.z = cvt_pk_bf16(v1[0], v1[1]); w.w = cvt_pk_bf16(v1[2], v1[3]);
                    *(u32x4*)(rowp + bj * HALF) = w; } }
    }
};

template <int CTRL> __device__ __forceinline__ float dpp_keep(float old, float src) {
    return __builtin_bit_cast(float, __builtin_amdgcn_update_dpp(__builtin_bit_cast(int, old), __builtin_bit_cast(int, src), CTRL, 0xf, 0xf, false)); }
template <int CTRL> __device__ __forceinline__ float dpp_mov(float src) { return __builtin_bit_cast(float, __builtin_amdgcn_mov_dpp(__builtin_bit_cast(int, src), CTRL, 0xf, 0xf, true)); }
struct EpiGLU {
    static constexpr bool PERM = true, AFTER_DRAIN = false;
    bf16_t* H; int ldc; const float* cw; const float* cb; float* TG; float* HG; float* HV; PG8_LAS float* tail;
    const float* SS; const float* SW; int sw_ld; int rows_per_batch;
    __device__ __forceinline__ void operator()(const f32x4 (&acc)[2][2][4][2], const Unit& u, int wr, int wc, int fr, int fq) const {
        asm volatile("" : "+v"(fr), "+v"(fq));
        const int row0 = u.pm * BM + wr * 64 + fr, cl = wc * 32 + 8 * fq, col0 = u.pn * HALF + cl;
        f32x4 (&ac)[2][2][4][2] = const_cast<f32x4 (&)[2][2][4][2]>(acc);
        { float rstd[8]; load_rstd8(SS, row0, fq, 1.f / 1024.f, 1e-6f, rstd);
          const float* swp = SW + (size_t)((u.pm * BM) / rows_per_batch) * sw_ld + u.pn * BM + cl;
#pragma unroll
          for (int bj = 0; bj < 2; ++bj)
#pragma unroll
              for (int n = 0; n < 2; ++n) { const f32x4 swv = *(const f32x4*)(swp + bj * HALF + 4 * n);
#pragma unroll
                  for (int ai = 0; ai < 2; ++ai)
#pragma unroll
                      for (int m = 0; m < 4; ++m) ac[ai][bj][m][n] = ac[ai][bj][m][n] * rstd[ai * 4 + m] + swv; } }
#define GN(ai_, m_, n_) (acc[ai_][0][m_][n_])
#define VN(ai_, m_, n_) (acc[ai_][1][m_][n_])
        if (fr >= 14) {
#pragma unroll
            for (int ai = 0; ai < 2; ++ai)
#pragma unroll
                for (int n = 0; n < 2; ++n) *(PG8_LAS f32x4*)(tail + ((ai * 2 + wr) * 2 + (fr - 14)) * 128 + cl + 4 * n) = GN(ai, 3, n);
            if (wr == 1) {
#pragma unroll
                for (int n = 0; n < 2; ++n) *(f32x4*)(TG + ((size_t)u.pm * 2 + (fr - 14)) * ldc + col0 + 4 * n) = GN(1, 3, n);
            }
        }
        if (wr == 0 && fr < 2) {
#pragma unroll
            for (int n = 0; n < 2; ++n) { *(f32x4*)(HG + ((size_t)u.pm * 2 + fr) * ldc + col0 + 4 * n) = GN(0, 0, n); *(f32x4*)(HV + ((size_t)u.pm * 2 + fr) * ldc + col0 + 4 * n) = VN(0, 0, n); }
        }
        f32x4 w0[2], w1[2], w2[2], b0[2];
#pragma unroll
        for (int n = 0; n < 2; ++n) { w0[n] = *(const f32x4*)(cw + col0 + 4 * n); w1[n] = *(const f32x4*)(cw + ldc + col0 + 4 * n); w2[n] = *(const f32x4*)(cw + 2 * ldc + col0 + 4 * n); b0[n] = *(const f32x4*)(cb + col0 + 4 * n); }
        asm volatile("s_waitcnt lgkmcnt(0)" ::: "memory"); __builtin_amdgcn_s_barrier(); asm volatile("" ::: "memory");
#pragma unroll
        for (int ai = 0; ai < 2; ++ai) {
            f32x4 t0[2], t1[2];
            const bool have = (wr == 1) || (ai == 1);
            const int sa = (wr == 1) ? ai : 0, sw = (wr == 1) ? 0 : 1;
#pragma unroll
            for (int n = 0; n < 2; ++n) {
                t0[n] = have ? *(const PG8_LAS f32x4*)(tail + ((sa * 2 + sw) * 2 + 0) * 128 + cl + 4 * n) : (f32x4){0.f, 0.f, 0.f, 0.f};
                t1[n] = have ? *(const PG8_LAS f32x4*)(tail + ((sa * 2 + sw) * 2 + 1) * 128 + cl + 4 * n) : (f32x4){0.f, 0.f, 0.f, 0.f}; }
#pragma unroll
            for (int m = 0; m < 4; ++m) {
                u32x4 wout;
#pragma unroll
                for (int n = 0; n < 2; ++n) {
                    f32x4 hv; const f32x4 gcur = GN(ai, m, n), vcur = VN(ai, m, n); const f32x4 gprev = m > 0 ? GN(ai, (m > 0 ? m - 1 : 0), n) : gcur;
#pragma unroll
                    for (int i = 0; i < 4; ++i) {
                        const float g0 = gcur[i];
                        float p1, p2;
                        if (m == 0) { p1 = t1[n][i]; p2 = (fr == 0) ? t0[n][i] : t1[n][i]; }
                        else { const float pv = gprev[i]; p1 = dpp_mov<0x121>(pv); p2 = dpp_mov<0x122>(pv); }
                        const float g1 = dpp_keep<0x111>(p1, g0), g2 = dpp_keep<0x112>(p2, g0);
                        const float gc = b0[n][i] + w0[n][i] * g2 + w1[n][i] * g1 + w2[n][i] * g0;
                        hv[i] = gc * __builtin_amdgcn_rcpf(1.f + __builtin_amdgcn_exp2f(-1.4426950408889634f * gc)) * vcur[i];
                    }
                    if (n == 0) { wout.x = cvt_pk_bf16(hv[0], hv[1]); wout.y = cvt_pk_bf16(hv[2], hv[3]); } else { wout.z = cvt_pk_bf16(hv[0], hv[1]); wout.w = cvt_pk_bf16(hv[2], hv[3]); }
                }
                *(u32x4*)(H + (size_t)(row0 + ai * HALF + m * 16) * ldc + col0) = wout;
            }
        }
#undef GN
#undef VN
    }
};
template <class Epi, class Sched, bool ALIGN_EPI = false, bool SP2 = false>
__device__ __forceinline__ void gemm_phase(PG8_LAS unsigned char* lds, const Gemm g, const Sched& S, const Epi& E) {
    int tid_ = threadIdx.x; asm volatile("" : "+v"(tid_));
    const int tid = tid_, wid = __builtin_amdgcn_readfirstlane(tid >> 6), lane = tid & 63, wr = wid >> 2, wc = wid & 3, fr = lane & 15, fq = lane >> 4;
    const int K = g.K, nt = K / BK;
    unsigned voffA[2], voffB[2];
#pragma unroll
    for (int i = 0; i < 2; ++i) { int R, C; stage_rc(tid * 16 + i * 8192, R, C); const int Rb = Epi::PERM ? ((R & ~31) + perm32(R & 31)) : R;
        voffA[i] = (unsigned)(R * K + C) * 2u; voffB[i] = (unsigned)(Rb * K + C) * 2u; }
    const size_t kstep = (size_t)(BK * 2);
    const size_t hstep = (size_t)HALF * K * 2;
    const size_t tstep = 2 * hstep;
    const unsigned ldsw = (unsigned)wid * 1024u;
    const int aoff = lds_byte(wr * 64 + fr, fq * 8), boff = lds_byte(wc * 32 + fr, fq * 8);
#define PG8_SA(b, h) (((b) * 2 + (h)) * HTB)
#define PG8_SB(b, h) ((4 + (b) * 2 + (h)) * HTB)
#define PG8_STAGE(bufoff, gbase, voff) do { _Pragma("unroll") for (int _i = 0; _i < 2; ++_i) \
        __builtin_amdgcn_global_load_lds((const unsigned*)((const char*)(gbase) + (voff)[_i]), (PG8_LAS unsigned*)(lds + (bufoff) + ldsw + _i * 8192), 16, 0, 0); } while (0)
#define PG8_LDA(dst, b, h) do { _Pragma("unroll") for (int m = 0; m < 4; ++m) _Pragma("unroll") for (int k = 0; k < 2; ++k) dst[m][k] = *(const PG8_LAS bf16x8*)(lds + PG8_SA(b, h) + aoff + m * 2048 + k * 1024); } while (0)
#define PG8_LDB(dst, b, h) do { _Pragma("unroll") for (int n = 0; n < 2; ++n) _Pragma("unroll") for (int k = 0; k < 2; ++k) dst[n][k] = *(const PG8_LAS bf16x8*)(lds + PG8_SB(b, h) + boff + n * 2048 + k * 1024); } while (0)
#define PG8_MMA(ai, bj, At, Bt) do { __builtin_amdgcn_s_setprio(1); _Pragma("unroll") for (int m = 0; m < 4; ++m) _Pragma("unroll") for (int n = 0; n < 2; ++n) _Pragma("unroll") for (int k = 0; k < 2; ++k) \
        acc[ai][bj][m][n] = __builtin_amdgcn_mfma_f32_16x16x32_bf16(Bt[n][k], At[m][k], acc[ai][bj][m][n], 0, 0, 0); __builtin_amdgcn_s_setprio(0); } while (0)
#define PG8_WAIT_V(n) asm volatile("s_waitcnt vmcnt(" #n ")" ::: "memory")
#define PG8_WAIT_L(n) asm volatile("s_waitcnt lgkmcnt(" #n ")" ::: "memory")
#define PG8_BAR __builtin_amdgcn_s_barrier()
#define PG8_SCHED __builtin_amdgcn_sched_barrier(0)
    Unit cur, nxt; int ui = 0;
    if (!S.next(0, cur)) return;
    f32x4 acc[2][2][4][2];
#pragma unroll
    for (int a = 0; a < 2; ++a)
#pragma unroll
        for (int b = 0; b < 2; ++b)
#pragma unroll
            for (int m = 0; m < 4; ++m)
#pragma unroll
                for (int n = 0; n < 2; ++n) acc[a][b][m][n] = (f32x4){0.f, 0.f, 0.f, 0.f};
    bf16x8 At[4][2], B0[2][2], B1[2][2];
    const char* cA = (const char*)g.A + (size_t)cur.pm * tstep; const char* cB = (const char*)g.Bt + (size_t)cur.pn * tstep;
    S.a_ready(cur);
    if constexpr (SP2) {
        PG8_STAGE(PG8_SB(0, 0), cB, voffB); PG8_STAGE(PG8_SB(0, 1), cB + hstep, voffB); PG8_STAGE(PG8_SA(0, 0), cA, voffA); PG8_STAGE(PG8_SA(0, 1), cA + hstep, voffA);
        if (wr == 1) PG8_BAR;
        PG8_WAIT_V(2); PG8_BAR;
        PG8_STAGE(PG8_SB(1, 0), cB + kstep, voffB); PG8_STAGE(PG8_SA(1, 0), cA + kstep, voffA); PG8_STAGE(PG8_SB(1, 1), cB + hstep + kstep, voffB);
        PG8_WAIT_V(6); PG8_BAR;
    } else {
        PG8_STAGE(PG8_SB(0, 0), cB, voffB); PG8_STAGE(PG8_SA(0, 0), cA, voffA); PG8_STAGE(PG8_SB(0, 1), cB + hstep, voffB); PG8_STAGE(PG8_SA(0, 1), cA + hstep, voffA);
        if (wr == 1) PG8_BAR;
        PG8_WAIT_V(4); PG8_BAR;
        PG8_STAGE(PG8_SB(1, 0), cB + kstep, voffB); PG8_STAGE(PG8_SA(1, 0), cA + kstep, voffA); PG8_STAGE(PG8_SB(1, 1), cB + hstep + kstep, voffB);
        PG8_WAIT_V(6); PG8_BAR;
    }
    for (;;) {
        const bool has_next = S.next(ui + 1, nxt);
        const char* nA = has_next ? (const char*)g.A + (size_t)nxt.pm * tstep : cA; const char* nB = has_next ? (const char*)g.Bt + (size_t)nxt.pn * tstep : cB;
        for (int t = 0; t < nt; t += 2) {
            const bool last = (t == nt - 2);
            const char* a1 = cA + (size_t)(t + 1) * kstep;
            const char* a2 = last ? nA : cA + (size_t)(t + 2) * kstep; const char* b2 = last ? nB : cB + (size_t)(t + 2) * kstep;
            const char* a3 = a2 + kstep; const char* b3 = b2 + kstep;
            if (last && has_next) S.a_ready(nxt);
            if constexpr (SP2) {
            PG8_LDB(B0, 0, 0); PG8_LDB(B1, 0, 1); PG8_SCHED; PG8_LDA(At, 0, 0); PG8_STAGE(PG8_SA(1, 1), a1 + hstep, voffA);
            PG8_WAIT_V(8); PG8_WAIT_L(0); PG8_BAR; PG8_MMA(0, 0, At, B0); PG8_MMA(0, 1, At, B1); PG8_BAR; PG8_SCHED;
            PG8_LDA(At, 0, 1); PG8_STAGE(PG8_SB(0, 0), b2, voffB); PG8_STAGE(PG8_SB(0, 1), b2 + hstep, voffB); PG8_STAGE(PG8_SA(0, 0), a2, voffA);
            PG8_WAIT_V(8); PG8_WAIT_L(0); PG8_BAR; PG8_MMA(1, 0, At, B0); PG8_MMA(1, 1, At, B1); PG8_BAR; PG8_SCHED;
            PG8_LDB(B0, 1, 0); PG8_LDB(B1, 1, 1); PG8_SCHED; PG8_LDA(At, 1, 0); PG8_STAGE(PG8_SA(0, 1), a2 + hstep, voffA);
            PG8_WAIT_V(8); PG8_WAIT_L(0); PG8_BAR; PG8_MMA(0, 0, At, B0); PG8_MMA(0, 1, At, B1); PG8_BAR; PG8_SCHED;
            PG8_LDA(At, 1, 1); PG8_STAGE(PG8_SB(1, 0), b3, voffB); PG8_STAGE(PG8_SB(1, 1), b3 + hstep, voffB); PG8_STAGE(PG8_SA(1, 0), a3, voffA);
            PG8_WAIT_V(8); PG8_WAIT_L(0); PG8_BAR; PG8_MMA(1, 0, At, B0); PG8_MMA(1, 1, At, B1); PG8_BAR; PG8_SCHED;
            } else {
            PG8_LDB(B0, 0, 0); PG8_SCHED; PG8_LDA(At, 0, 0); PG8_STAGE(PG8_SA(1, 1), a1 + hstep, voffA);
            PG8_WAIT_L(8); PG8_BAR; PG8_WAIT_L(0); PG8_MMA(0, 0, At, B0); PG8_BAR; PG8_SCHED;
            PG8_LDB(B1, 0, 1); PG8_STAGE(PG8_SB(0, 0), b2, voffB);
            PG8_BAR; PG8_WAIT_L(0); PG8_MMA(0, 1, At, B1); PG8_BAR;
            PG8_LDA(At, 0, 1); PG8_STAGE(PG8_SA(0, 0), a2, voffA);
            PG8_BAR; PG8_WAIT_L(0); PG8_MMA(1, 0, At, B0); PG8_BAR; PG8_SCHED;
            PG8_STAGE(PG8_SB(0, 1), b2 + hstep, voffB);
            PG8_WAIT_V(6); PG8_BAR; PG8_MMA(1, 1, At, B1); PG8_BAR;
            PG8_LDB(B0, 1, 0); PG8_SCHED; PG8_LDA(At, 1, 0); PG8_STAGE(PG8_SA(0, 1), a2 + hstep, voffA);
            PG8_WAIT_L(8); PG8_BAR; PG8_WAIT_L(0); PG8_MMA(0, 0, At, B0); PG8_BAR; PG8_SCHED;
            PG8_LDB(B1, 1, 1); PG8_STAGE(PG8_SB(1, 0), b3, voffB);
            PG8_BAR; PG8_WAIT_L(0); PG8_MMA(0, 1, At, B1); PG8_BAR;
            PG8_LDA(At, 1, 1); PG8_STAGE(PG8_SA(1, 0), a3, voffA);
            PG8_BAR; PG8_WAIT_L(0); PG8_MMA(1, 0, At, B0); PG8_BAR; PG8_SCHED;
            PG8_STAGE(PG8_SB(1, 1), b3 + hstep, voffB);
            PG8_WAIT_V(6); PG8_BAR; PG8_MMA(1, 1, At, B1); PG8_BAR;
            }
        }
        if constexpr (ALIGN_EPI) { if (wr == 0) PG8_BAR; }
        if constexpr (!Epi::AFTER_DRAIN) { E(acc, cur, wr, wc, fr, fq); S.done(cur); }
        if (!has_next) break;
#pragma unroll
        for (int a = 0; a < 2; ++a)
#pragma unroll
            for (int b = 0; b < 2; ++b)
#pragma unroll
                for (int m = 0; m < 4; ++m)
#pragma unroll
                    for (int n = 0; n < 2; ++n) acc[a][b][m][n] = (f32x4){0.f, 0.f, 0.f, 0.f};
        cur = nxt; cA = nA; cB = nB; ++ui;
        if constexpr (ALIGN_EPI) { if (wr == 1) PG8_BAR; }
    }
    PG8_WAIT_V(0);
    if constexpr (!ALIGN_EPI) { if (wr == 0) PG8_BAR; }
    PG8_BAR;
    if constexpr (Epi::AFTER_DRAIN) { E.fused(acc, cur, wr, wc, fr, fq, lds, wid, lane); S.done(cur); }
#undef PG8_SA
#undef PG8_SB
#undef PG8_STAGE
#undef PG8_LDA
#undef PG8_LDB
#undef PG8_MMA
#undef PG8_WAIT_V
#undef PG8_WAIT_L
#undef PG8_BAR
#undef PG8_SCHED
}
}

namespace cg = cooperative_groups;
#ifndef MK_MODE
#define MK_MODE 2
#endif
constexpr int NWAVES = 8;

constexpr int NB = 8, SEQ = 4096, DM = 1024, NL = 2;
constexpr int M = NB * SEQ;
constexpr int PIN = 2688, PINP = 2816;
constexpr int DFF = 2816, DUP = 2 * DFF;
constexpr int DA = 256, DB = 384, DC = 384;
constexpr int NMOD = 6 * DM;
constexpr int PC_OFF = 1280;
constexpr int NPHASE = 22;

constexpr size_t MiB = 1u << 20;
constexpr size_t WS_CTL = 0, CTL_ZERO_BYTES = 64 * 1024;
constexpr size_t WS_SMALL = 1 * MiB;
constexpr size_t SM_SGUW = 0, SM_LRUWA = 256 * 1024, SM_LRUWX = 352 * 1024, SM_RW2 = 448 * 1024, SM_RA2 = 544 * 1024, SM_RG2 = 640 * 1024;
constexpr size_t WS_MOD = 2 * MiB;
constexpr size_t WS_LRUS = 3 * MiB;
constexpr size_t WS_WIN = 4 * MiB, WS_WOUT = 15 * MiB, WS_WUP = 19 * MiB, WS_WDN = 41 * MiB;
constexpr size_t WS_SS = 57 * MiB, WS_SW1 = 60 * MiB, WS_SW2 = 61 * MiB;
constexpr size_t WS_HY = 64 * MiB;
constexpr size_t WS_P = 128 * MiB;
constexpr size_t WS_UV = 304 * MiB;
constexpr size_t WS_R = 304 * MiB, WS_K = 328 * MiB, WS_V = 352 * MiB, WS_KK = 376 * MiB, WS_BV = 400 * MiB;
constexpr size_t WS_LD = 424 * MiB;
constexpr size_t WS_O = 448 * MiB;
constexpr size_t WS_Q2 = 472 * MiB;
constexpr size_t WS_TG = 496 * MiB, WS_HG = 500 * MiB, WS_HV = 504 * MiB;
constexpr size_t WS_END = 512 * MiB;
static_assert(WS_Q2 + (size_t)M * 384 * 2 <= WS_END && WS_UV + (size_t)M * DFF * 2 <= WS_END && WS_P + (size_t)M * PINP * 2 <= WS_UV, "d_ws map");
static_assert(WS_WDN + (size_t)NL * DM * DFF * 2 <= WS_HY && WS_WIN + (size_t)NL * PINP * DM * 2 <= WS_WOUT && WS_WUP + (size_t)NL * DUP * DM * 2 <= WS_WDN, "weights map");
constexpr int CW_BAR = 1024;

constexpr int RING_BYTES = 131072;
constexpr int LDSCTL_OFF = RING_BYTES, MISC_OFF = LDSCTL_OFF + 320;
constexpr int TAIL_OFF = 132096;
constexpr int LDS_BYTES = 147456;

#define GAS __attribute__((address_space(1)))
#define LAS __attribute__((address_space(3)))
typedef unsigned short bf16;
typedef float f32x4 __attribute__((ext_vector_type(4)));
typedef float f32x2 __attribute__((ext_vector_type(2)));
typedef float f32x16 __attribute__((ext_vector_type(16)));
typedef short bf16x8 __attribute__((ext_vector_type(8)));
typedef unsigned u32x2 __attribute__((ext_vector_type(2)));
typedef unsigned u32x4 __attribute__((ext_vector_type(4)));
typedef GAS unsigned gu32;
#define RLX_AGENT __ATOMIC_RELAXED, __HIP_MEMORY_SCOPE_AGENT

__device__ __forceinline__ float bflo(unsigned w) { return __builtin_bit_cast(float, w << 16); }
__device__ __forceinline__ float bfhi(unsigned w) { return __builtin_bit_cast(float, w & 0xffff0000u); }
__device__ __forceinline__ float bf1(bf16 u) { return __builtin_bit_cast(float, (unsigned)u << 16); }
__device__ __forceinline__ unsigned pk2(float lo, float hi) { return pg8::cvt_pk_bf16(lo, hi); }
__device__ __forceinline__ bf16 f2bf(float f) { return (bf16)(pg8::cvt_pk_bf16(f, f) & 0xffffu); }
__device__ __forceinline__ f32x4 unpack4(u32x2 w) { return (f32x4){bflo(w.x), bfhi(w.x), bflo(w.y), bfhi(w.y)}; }
__device__ __forceinline__ u32x2 pack4(f32x4 v) { u32x2 w; w.x = pk2(v[0], v[1]); w.y = pk2(v[2], v[3]); return w; }

__device__ __forceinline__ float fexp(float x) { return __builtin_amdgcn_exp2f(x * 1.4426950408889634f); }
__device__ __forceinline__ float flog(float x) { return __builtin_amdgcn_logf(x) * 0.6931471805599453f; }
__device__ __forceinline__ float fsigmoid(float x) { return __builtin_amdgcn_rcpf(1.f + fexp(-x)); }
__device__ __forceinline__ float fgelu(float x) { const float y = 1.5957691216f * x * (1.f + 0.044715f * x * x); return x * fsigmoid(y); }
__device__ __forceinline__ float fsilu(float x) { return x * fsigmoid(x); }
__device__ __forceinline__ float fsoftplus(float x) { return fmaxf(x, 0.f) + flog(1.f + fexp(-fabsf(x))); }
__device__ __forceinline__ float fsoftplus_acc(float x) { return fmaxf(x, 0.f) + log1pf(expf(-fabsf(x))); }
__device__ __forceinline__ float ftanh(float x) { return 1.f - 2.f * __builtin_amdgcn_rcpf(1.f + fexp(2.f * x)); }
__device__ __forceinline__ float fnegexpm1(float x) {
    const float ser = -x * (1.f + x * (0.5f + x * (0.16666667f + x * (0.041666668f + x * (0.008333334f + x * 0.0013888889f)))));
    return x > -0.25f ? ser : 1.f - fexp(x);
}
__device__ __forceinline__ int opaque_tid() { int t = threadIdx.x; asm volatile("" : "+v"(t)); return t; }
template <int CTRL> __device__ __forceinline__ float dppf(float x) { return __builtin_bit_cast(float, __builtin_amdgcn_mov_dpp(__builtin_bit_cast(int, x), CTRL, 0xf, 0xf, true)); }
__device__ __forceinline__ float red16(float p) { p += dppf<0xB1>(p); p += dppf<0x4E>(p); p += dppf<0x141>(p); p += dppf<0x128>(p); return p; }
__device__ __forceinline__ float wave_sum(float v) { return pg8::xrow16_sum(red16(v)); }
#define XB_TMO      128
#define XB_XCNT(j)  (256  + 64 * (j))
#define XB_XSUB(j)  (1280 + 64 * (j))
#define XB_XGEN(j)  (2304 + 64 * (j))
#define XB_TOP      3328
#define XB_TOPGEN   3392
#define XCD_BAR_WORDS 3456
#define XB_SPIN_CAP (1u << 18)

__device__ __forceinline__ unsigned xb_ld(unsigned* p)              { return __hip_atomic_load(p, __ATOMIC_RELAXED, __HIP_MEMORY_SCOPE_AGENT); }
__device__ __forceinline__ unsigned xb_add(unsigned* p, unsigned v) { return __hip_atomic_fetch_add(p, v, __ATOMIC_RELAXED, __HIP_MEMORY_SCOPE_AGENT); }
__device__ __forceinline__ unsigned xb_xcc_id() { return (unsigned)__builtin_amdgcn_s_getreg((3 << 11) | 20) & 0xFu; }
#define XB_SPIN(cond, bar) do { unsigned _sp = 0; while (cond) { __builtin_amdgcn_s_sleep(1); \
    if ((++_sp & 255u) == 0u) { if (xb_ld(&(bar)[XB_TMO])) break; if (_sp > XB_SPIN_CAP) { atomicAdd(&(bar)[XB_TMO], 1u); break; } } } } while (0)

struct XcdBarrier {
    unsigned* bar; unsigned x;
    volatile LAS unsigned* st;
};

__device__ __forceinline__ XcdBarrier xcd_barrier_post(unsigned* bar, volatile LAS unsigned* st) {
    XcdBarrier b; b.bar = bar; b.x = xb_xcc_id(); b.st = st;
    if (threadIdx.x == 0) (void)xb_add(&bar[XB_XCNT(b.x)], 1u);
    return b;
}
__device__ __forceinline__ void xcd_barrier_complete(unsigned* bar, unsigned x, unsigned& nloc, unsigned& nx) {
    const unsigned G = gridDim.x * gridDim.y * gridDim.z;
    unsigned sum, cnt, mine, sp = 0u;
    for (;;) {
        sum = 0u; cnt = 0u; mine = 0u;
#pragma unroll
        for (unsigned j = 0; j < 16; ++j) { const unsigned c = xb_ld(&bar[XB_XCNT(j)]); sum += c; cnt += (c > 0u) ? 1u : 0u; mine = (j == x) ? c : mine; }
        if (sum == G) break;
        __builtin_amdgcn_s_sleep(1);
        if ((++sp & 255u) == 0u) { if (xb_ld(&bar[XB_TMO])) break; if (sp > XB_SPIN_CAP) { atomicAdd(&bar[XB_TMO], 1u); break; } }
    }
    nloc = mine > 0u ? mine : 1u; nx = cnt > 0u ? cnt : 1u;
}

__device__ __forceinline__ void xcd_barrier(const XcdBarrier& b) {
    asm volatile("s_waitcnt vmcnt(0)" ::: "memory");
    __syncthreads();
    if (threadIdx.x == 0) {
        unsigned* bar = b.bar;
        __builtin_amdgcn_s_waitcnt(0);
        unsigned nloc = b.st[0], nx = b.st[1];
        if (nloc == 0u) { xcd_barrier_complete(bar, b.x, nloc, nx); b.st[0] = nloc; b.st[1] = nx; }
        const unsigned old = xb_add(&bar[XB_XSUB(b.x)], 1u);
        const unsigned gen = old / nloc;
        if (old + 1u == (gen + 1u) * nloc) {
            __builtin_amdgcn_fence(__ATOMIC_RELEASE, "agent");
            asm volatile("s_waitcnt vmcnt(0)" ::: "memory");
            const unsigned og = xb_add(&bar[XB_TOP], 1u);
            const unsigned tg = og / nx;
            if (og + 1u == (tg + 1u) * nx) xb_add(&bar[XB_TOPGEN], 1u);
            else XB_SPIN(xb_ld(&bar[XB_TOPGEN]) == tg, bar);
            __builtin_amdgcn_fence(__ATOMIC_ACQUIRE, "agent");
            xb_add(&bar[XB_XGEN(b.x)], 1u);
            asm volatile("s_waitcnt vmcnt(0)" ::: "memory");
        } else {
            XB_SPIN(xb_ld(&bar[XB_XGEN(b.x)]) == gen, bar);
            __builtin_amdgcn_fence(__ATOMIC_ACQUIRE, "agent");
            asm volatile("s_waitcnt vmcnt(0)" ::: "memory");
        }
    }
    __syncthreads();
}

struct Frame {
    LAS unsigned char* lds;
    volatile LAS unsigned* MISC;
    gu32* ctl;
    int wave, vcu, G;
    const float *x, *c, *w_mod, *b_mod, *norm_mix, *w_in, *w_out, *sgu_ln_g, *sgu_ln_b, *sgu_w, *sgu_b, *lru_conv_w, *lru_conv_b, *lru_w_a, *lru_b_a, *lru_w_x, *lru_b_x, *lru_lambda,
        *rwkv_mu, *rwkv_w0, *rwkv_w2, *rwkv_a0, *rwkv_a2, *rwkv_g2, *rwkv_k_k, *rwkv_k_a, *rwkv_r_k, *rwkv_ln_w, *rwkv_ln_b, *norm_ffn, *ffn_w_up, *ffn_conv_w, *ffn_conv_b, *ffn_w_down, *norm_final;
    float* out;
    bf16 *SGUW, *LRUWA, *LRUWX, *RW2, *RA2, *RG2;
    float *MOD, *LRUSA, *LRUSH;
    bf16 *WIN, *WOUT, *WUP, *WDN;
    bf16 *HY, *P, *UG, *UV, *R, *K, *V, *KK, *BV, *Q2, *O, *LD;
    float *TG, *HG, *HV;
    float *SS, *SW1, *SW2;
};

__device__ __forceinline__ void p0_transpose_item(const float* W, int K, int N, bf16* WT, int k0, int n0, int drow0, LAS float* scr, int lane) {
#pragma unroll 8
    for (int i = 0; i < 32; ++i) { const int kk = 2 * i + (lane >> 5); scr[kk * 33 + (lane & 31)] = W[(size_t)(k0 + kk) * N + n0 + (lane & 31)]; }
    asm volatile("s_waitcnt lgkmcnt(0)" ::: "memory");
    const int c = lane & 7;
#pragma unroll
    for (int j = 0; j < 4; ++j) { const int n = (lane >> 3) + 8 * j; const LAS float* s = scr + (8 * c) * 33 + n;
        u32x4 o; o.x = pk2(s[0 * 33], s[1 * 33]); o.y = pk2(s[2 * 33], s[3 * 33]); o.z = pk2(s[4 * 33], s[5 * 33]); o.w = pk2(s[6 * 33], s[7 * 33]);
        *(u32x4*)(WT + (size_t)(drow0 + n) * K + k0 + 8 * c) = o; }
    asm volatile("s_waitcnt lgkmcnt(0)" ::: "memory");
}
__device__ __forceinline__ void p0_prologue(Frame& F) {
    const int tid = opaque_tid(), lane = tid & 63, wave = F.wave;
    const int gw = F.vcu * NWAVES + wave, NGW = F.G * NWAVES;
    const int gt = F.vcu * (NWAVES * 64) + tid, NGT = F.G * NWAVES * 64;
    if (F.vcu < 192) {
        LAS float* cact = (LAS float*)(F.lds + 73728);
        LAS float* red = (LAS float*)(F.lds + 106496);
        for (int i = tid; i < NB * DM; i += NWAVES * 64) { const float cv = F.c[i]; cact[i] = cv * fsigmoid(cv); }
        __syncthreads();
        const int l = F.vcu / 96, n0 = (F.vcu % 96) * 64;
        const float* wm = F.w_mod + ((size_t)l * DM + 128 * wave) * NMOD + n0 + lane;
        float acc[NB];
#pragma unroll
        for (int b = 0; b < NB; ++b) acc[b] = 0.f;
        for (int k4 = 0; k4 < 128; k4 += 4) {
            const float w0 = wm[(size_t)(k4 + 0) * NMOD], w1 = wm[(size_t)(k4 + 1) * NMOD], w2 = wm[(size_t)(k4 + 2) * NMOD], w3 = wm[(size_t)(k4 + 3) * NMOD];
#pragma unroll
            for (int b = 0; b < NB; ++b) { const f32x4 cv = *(const LAS f32x4*)(cact + b * DM + 128 * wave + k4); acc[b] += cv[0] * w0 + cv[1] * w1 + cv[2] * w2 + cv[3] * w3; }
        }
#pragma unroll
        for (int b = 0; b < NB; ++b) red[(wave * NB + b) * 64 + lane] = acc[b];
        __syncthreads();
        { const int b = tid >> 6, col = tid & 63; float s = F.b_mod[l * NMOD + n0 + col];
#pragma unroll
          for (int w = 0; w < NWAVES; ++w) s += red[(w * NB + b) * 64 + col];
          F.MOD[(size_t)(l * NB + b) * NMOD + n0 + col] = s; }
        __syncthreads();
    }
    {
        LAS float* scr = (LAS float*)(F.lds + wave * 9216);
        constexpr int I_IN = (DM / 64) * (PIN / 32), I_OUT = (DM / 64) * (DM / 32), I_UP = (DM / 64) * (DUP / 32), I_DN = (DFF / 64) * (DM / 32);
        constexpr int PER_L = I_IN + I_OUT + I_UP + I_DN;
        for (int it = gw; it < NL * PER_L; it += NGW) {
            const int l = it / PER_L; int r = it % PER_L;
            if (r < I_IN) { const int nblk = PIN / 32, kb = r / nblk, nb = r % nblk; p0_transpose_item(F.w_in + (size_t)l * DM * PIN, DM, PIN, F.WIN + (size_t)l * PINP * DM, 64 * kb, 32 * nb, 32 * nb, scr, lane); continue; } r -= I_IN;
            if (r < I_OUT) { const int nblk = DM / 32, kb = r / nblk, nb = r % nblk; p0_transpose_item(F.w_out + (size_t)l * DM * DM, DM, DM, F.WOUT + (size_t)l * DM * DM, 64 * kb, 32 * nb, 32 * nb, scr, lane); continue; } r -= I_OUT;
            if (r < I_UP) { const int nblk = DUP / 32, kb = r / nblk, nb = r % nblk; const int n0 = 32 * nb, isv = n0 >= DFF ? 1 : 0, j = n0 - isv * DFF, drow = (j / 128) * 256 + isv * 128 + (j % 128);
                p0_transpose_item(F.ffn_w_up + (size_t)l * DM * DUP, DM, DUP, F.WUP + (size_t)l * DUP * DM, 64 * kb, n0, drow, scr, lane); continue; } r -= I_UP;
            { const int nblk = DM / 32, kb = r / nblk, nb = r % nblk; p0_transpose_item(F.ffn_w_down + (size_t)l * DFF * DM, DFF, DM, F.WDN + (size_t)l * DM * DFF, 64 * kb, 32 * nb, 32 * nb, scr, lane); }
        }
        for (int i = gt; i < NL * (PINP - PIN) * DM / 8; i += NGT) { const int l = i / ((PINP - PIN) * DM / 8), o = i % ((PINP - PIN) * DM / 8);
            *(u32x4*)(F.WIN + (size_t)l * PINP * DM + (size_t)PIN * DM + (size_t)o * 8) = (u32x4){0u, 0u, 0u, 0u}; }
    }
    for (int i = gt; i < NL * 4 * 128 * 128; i += NGT) { const int s = i & 127, t = (i >> 7) & 127; F.SGUW[i] = s <= t ? f2bf(F.sgu_w[i]) : (bf16)0; }
    for (int i = gt; i < NL * 6 * 64 * 64; i += NGT) { const int ii = i & 63, j = (i >> 6) & 63, lh = i >> 12;
        F.LRUWA[i] = f2bf(F.lru_w_a[(size_t)lh * 4096 + ii * 64 + j]); F.LRUWX[i] = f2bf(F.lru_w_x[(size_t)lh * 4096 + ii * 64 + j]); }
    for (int i = gt; i < NL * 384 * 64; i += NGT) { const int k = i & 63, n = (i >> 6) % 384, l = i / (384 * 64);
        F.RW2[i] = f2bf(F.rwkv_w2[(size_t)l * 64 * 384 + k * 384 + n]); F.RA2[i] = f2bf(F.rwkv_a2[(size_t)l * 64 * 384 + k * 384 + n]); }
    for (int i = gt; i < NL * 384 * 128; i += NGT) { const int k = i & 127, n = (i >> 7) % 384, l = i / (384 * 128);
        F.RG2[i] = f2bf(F.rwkv_g2[(size_t)l * 128 * 384 + k * 384 + n]); }
}

__device__ __forceinline__ void norm_mod_phase(Frame& F, const float* X, const float* gamma, const float* mod_l, int sh_idx, int sc_idx, bf16* H) {
    const int gw = F.vcu * NWAVES + F.wave, NGW = F.G * NWAVES, lane = opaque_tid() & 63;
    f32x4 g[4], nx[4];
#pragma unroll
    for (int j = 0; j < 4; ++j) g[j] = *(const f32x4*)(gamma + 4 * (lane + 64 * j));
    if (gw < M) {
#pragma unroll
        for (int j = 0; j < 4; ++j) nx[j] = ((const f32x4*)(X + (size_t)gw * DM) + lane)[64 * j];
    }
    for (int m = gw; m < M; m += NGW) {
        f32x4 v[4]; float s = 0.f;
#pragma unroll
        for (int j = 0; j < 4; ++j) { v[j] = nx[j]; s += (v[j][0] * v[j][0] + v[j][1] * v[j][1]) + (v[j][2] * v[j][2] + v[j][3] * v[j][3]); }
        if (m + NGW < M) {
#pragma unroll
            for (int j = 0; j < 4; ++j) nx[j] = ((const f32x4*)(X + (size_t)(m + NGW) * DM) + lane)[64 * j];
        }
        const float* mb = mod_l + (size_t)(m >> 12) * NMOD;
        f32x4 sc[4], sh[4];
#pragma unroll
        for (int j = 0; j < 4; ++j) { const int c = 4 * (lane + 64 * j); sc[j] = *(const f32x4*)(mb + sc_idx * DM + c); sh[j] = *(const f32x4*)(mb + sh_idx * DM + c); }
        const float rstd = __builtin_amdgcn_rsqf(wave_sum(s) * (1.f / DM) + 1e-6f);
        u32x2* o8 = (u32x2*)(H + (size_t)m * DM) + lane;
#pragma unroll
        for (int j = 0; j < 4; ++j) { const f32x4 y = (v[j] * rstd) * g[j] * (sc[j] + 1.f) + sh[j]; o8[64 * j] = pack4(y); }
    }
}
__device__ __forceinline__ void final_norm_phase(Frame& F, float* X, const float* gamma) {
    const int gw = F.vcu * NWAVES + F.wave, NGW = F.G * NWAVES, lane = opaque_tid() & 63;
    f32x4 g[4], nx[4];
#pragma unroll
    for (int j = 0; j < 4; ++j) g[j] = *(const f32x4*)(gamma + 4 * (lane + 64 * j));
    if (gw < M) {
#pragma unroll
        for (int j = 0; j < 4; ++j) nx[j] = ((const f32x4*)(X + (size_t)gw * DM) + lane)[64 * j];
    }
    for (int m = gw; m < M; m += NGW) {
        f32x4 v[4]; float s = 0.f;
#pragma unroll
        for (int j = 0; j < 4; ++j) { v[j] = nx[j]; s += (v[j][0] * v[j][0] + v[j][1] * v[j][1]) + (v[j][2] * v[j][2] + v[j][3] * v[j][3]); }
        if (m + NGW < M) {
#pragma unroll
            for (int j = 0; j < 4; ++j) nx[j] = ((const f32x4*)(X + (size_t)(m + NGW) * DM) + lane)[64 * j];
        }
        const float rstd = __builtin_amdgcn_rsqf(wave_sum(s) * (1.f / DM) + 1e-6f);
        f32x4* xr = (f32x4*)(X + (size_t)m * DM) + lane;
#pragma unroll
        for (int j = 0; j < 4; ++j) xr[64 * j] = (v[j] * rstd) * g[j];
    }
}

__device__ __forceinline__ void norm0_phase(Frame& F, const float* X, const float* gamma, const float* mod_l, int sc_idx, bf16* XS) {
    const int gw = F.vcu * NWAVES + F.wave, NGW = F.G * NWAVES, lane = opaque_tid() & 63;
    f32x4 g[4], nx[4];
#pragma unroll
    for (int j = 0; j < 4; ++j) g[j] = *(const f32x4*)(gamma + 4 * (lane + 64 * j));
    if (gw < M) {
#pragma unroll
        for (int j = 0; j < 4; ++j) nx[j] = ((const f32x4*)(X + (size_t)gw * DM) + lane)[64 * j];
    }
    for (int m = gw; m < M; m += NGW) {
        f32x4 v[4]; float s = 0.f;
#pragma unroll
        for (int j = 0; j < 4; ++j) { v[j] = nx[j]; s += (v[j][0] * v[j][0] + v[j][1] * v[j][1]) + (v[j][2] * v[j][2] + v[j][3] * v[j][3]); }
        if (m + NGW < M) {
#pragma unroll
            for (int j = 0; j < 4; ++j) nx[j] = ((const f32x4*)(X + (size_t)(m + NGW) * DM) + lane)[64 * j];
        }
        const float* mb = mod_l + (size_t)(m >> 12) * NMOD + sc_idx * DM;
        f32x4 sc[4];
#pragma unroll
        for (int j = 0; j < 4; ++j) sc[j] = *(const f32x4*)(mb + 4 * (lane + 64 * j));
        const float tot = wave_sum(s);
        u32x2* o8 = (u32x2*)(XS + (size_t)m * DM) + lane;
#pragma unroll
        for (int j = 0; j < 4; ++j) o8[64 * j] = pack4(v[j] * g[j] * (sc[j] + 1.f));
        if (lane < 4) *(f32x4*)(F.SS + (size_t)m * 16 + 4 * lane) = (f32x4){lane == 0 ? tot : 0.f, 0.f, 0.f, 0.f};
    }
}
__device__ __forceinline__ void sw_phase(Frame& F) {
    const int tid = opaque_tid(), lane = tid & 63;
    const int gw = F.vcu * NWAVES + F.wave, NGW = F.G * NWAVES;
    LAS float* shl = (LAS float*)F.lds;
    for (int i = tid; i < NL * 2 * NB * DM / 4; i += NWAVES * 64) { const int e = 4 * i, k = e & 1023, b = (e >> 10) & 7, wh = (e >> 13) & 1, l = e >> 14;
        *(LAS f32x4*)(shl + e) = *(const f32x4*)(F.MOD + (size_t)(l * NB + b) * NMOD + (wh ? 3 : 0) * DM + k); }
    __syncthreads();
    constexpr int NT = NL * (PINP + DUP);
    for (int t = gw; t < NT; t += NGW) {
        const int l = t / (PINP + DUP), r = t - l * (PINP + DUP), wh = r >= PINP ? 1 : 0, n = r - wh * PINP;
        const bf16* wrow = (wh ? F.WUP + ((size_t)l * DUP + n) * DM : F.WIN + ((size_t)l * PINP + n) * DM) + 16 * lane;
        const u32x4 wa = *(const u32x4*)(wrow), wb = *(const u32x4*)(wrow + 8);
        float w[16] = {bflo(wa.x), bfhi(wa.x), bflo(wa.y), bfhi(wa.y), bflo(wa.z), bfhi(wa.z), bflo(wa.w), bfhi(wa.w), bflo(wb.x), bfhi(wb.x), bflo(wb.y), bfhi(wb.y), bflo(wb.z), bfhi(wb.z), bflo(wb.w), bfhi(wb.w)};
        float res = 0.f;
#pragma unroll
        for (int b = 0; b < NB; ++b) { const LAS float* sp = shl + ((l * 2 + wh) * NB + b) * DM + 16 * lane; float a = 0.f;
#pragma unroll
            for (int j = 0; j < 4; ++j) { const f32x4 sv = *(const LAS f32x4*)(sp + 4 * j); a += (sv[0] * w[4 * j] + sv[1] * w[4 * j + 1]) + (sv[2] * w[4 * j + 2] + sv[3] * w[4 * j + 3]); }
            a = wave_sum(a); if (lane == b) res = a; }
        if (lane < NB) { float* dst = wh ? F.SW2 + ((size_t)(l * NB + lane)) * DUP + n : F.SW1 + ((size_t)(l * NB + lane)) * PINP + n; *dst = res; }
    }
    __syncthreads();
}

#define LDS_BAR() do { asm volatile("s_waitcnt lgkmcnt(0)" ::: "memory"); __builtin_amdgcn_s_barrier(); asm volatile("" ::: "memory"); } while (0)
template <int PARTS  >
__device__ __forceinline__ void mix_chunk(Frame& F, const int l, const int ch) {
    const int wave = F.wave;
    const int n = ch & 31; const size_t r0 = (size_t)ch * 128;
    const bf16* P = F.P; bf16* Y = F.HY;
    LAS unsigned char* lds = F.lds;
#ifndef MK_MIXDUP
#define MK_MIXDUP 0
#endif
    if (PARTS & 1) for (int mrep = 0; mrep <= ((MK_MIXDUP) & 1); ++mrep) {
        if (mrep) LDS_BAR();
        const int tid = opaque_tid(), lane = tid & 63, r = lane & 31, hh = lane >> 5;
        LAS bf16* VT = (LAS bf16*)lds;
        LAS f32x2* ST = (LAS f32x2*)(lds + 69632);
        const int t = tid & 127, q = __builtin_amdgcn_readfirstlane(tid >> 7);
        const bf16* src = P + (r0 + t) * PINP + 256 + 64 * q;
        float v[64]; float s = 0.f, ss = 0.f;
#pragma unroll
        for (int i = 0; i < 8; ++i) { const u32x4 w = *(const u32x4*)(src + 8 * i);
            const float e0 = fgelu(bflo(w.x)), e1 = fgelu(bfhi(w.x)), e2 = fgelu(bflo(w.y)), e3 = fgelu(bfhi(w.y)), e4 = fgelu(bflo(w.z)), e5 = fgelu(bfhi(w.z)), e6 = fgelu(bflo(w.w)), e7 = fgelu(bfhi(w.w));
            v[8 * i + 0] = e0; v[8 * i + 1] = e1; v[8 * i + 2] = e2; v[8 * i + 3] = e3; v[8 * i + 4] = e4; v[8 * i + 5] = e5; v[8 * i + 6] = e6; v[8 * i + 7] = e7;
            s += ((e0 + e1) + (e2 + e3)) + ((e4 + e5) + (e6 + e7)); ss += ((e0 * e0 + e1 * e1) + (e2 * e2 + e3 * e3)) + ((e4 * e4 + e5 * e5) + (e6 * e6 + e7 * e7)); }
        ST[q * 128 + t] = (f32x2){s, ss};
        LDS_BAR();
        const f32x2 a0 = ST[t], a1 = ST[128 + t], a2 = ST[256 + t], a3 = ST[384 + t];
        const float mean = ((a0.x + a1.x) + (a2.x + a3.x)) * (1.f / 256.f), ex2 = ((a0.y + a1.y) + (a2.y + a3.y)) * (1.f / 256.f);
        const float rstd = __builtin_amdgcn_rsqf(fmaxf(ex2 - mean * mean, 0.f) + 1e-5f);
        const float* lg = F.sgu_ln_g + l * DA + 64 * q; const float* lb = F.sgu_ln_b + l * DA + 64 * q;
#pragma unroll
        for (int i = 0; i < 64; ++i) VT[(64 * q + i) * 136 + t] = f2bf((v[i] - mean) * rstd * lg[i] + lb[i]);
        LDS_BAR();
        const int h = wave >> 1, dh = wave & 1;
        const bf16* Wg = F.SGUW + (size_t)(l * 4 + h) * 128 * 128;
        const LAS bf16* vrow = VT + (64 * h + 32 * dh + r) * 136 + 8 * hh;
#pragma unroll 1
        for (int tb = 0; tb < 4; ++tb) {
            f32x16 acc;
#pragma unroll
            for (int i = 0; i < 16; ++i) acc[i] = 0.f;
            const bf16* wrow = Wg + (size_t)(32 * tb + r) * 128 + 8 * hh;
#pragma unroll 2
            for (int ks = 0; ks < 2 * (tb + 1); ++ks) {
                const bf16x8 a = *(const LAS bf16x8*)(vrow + 16 * ks);
                const bf16x8 b = *(const bf16x8*)(wrow + 16 * ks);
                acc = __builtin_amdgcn_mfma_f32_32x32x16_bf16(a, b, acc, 0, 0, 0);
            }
            const int tt = 32 * tb + r; const size_t row = r0 + tt;
            const float bias = F.sgu_b[(l * 4 + h) * 128 + tt];
            u32x2 uq[4];
#pragma unroll
            for (int g = 0; g < 4; ++g) uq[g] = *(const u32x2*)(P + row * PINP + 64 * h + 32 * dh + 8 * g + 4 * hh);
#pragma unroll
            for (int g = 0; g < 4; ++g) { const int c4 = 64 * h + 32 * dh + 8 * g + 4 * hh;
                const f32x4 u = unpack4(uq[g]);
                f32x4 y; y[0] = fgelu(u[0]) * (acc[4 * g + 0] + bias); y[1] = fgelu(u[1]) * (acc[4 * g + 1] + bias); y[2] = fgelu(u[2]) * (acc[4 * g + 2] + bias); y[3] = fgelu(u[3]) * (acc[4 * g + 3] + bias);
                *(u32x2*)(Y + row * DM + c4) = pack4(y); }
        }
    }
    LDS_BAR();
    if (PARTS & 2) for (int mrep = 0; mrep <= (((MK_MIXDUP) >> 1) & 1); ++mrep) {
        if (mrep) LDS_BAR();
        const int tid = opaque_tid(), lane = tid & 63, r = lane & 31, hh = lane >> 5;
        LAS bf16* XC = (LAS bf16*)lds;
        LAS float* LA = (LAS float*)(lds + 25088);
        LAS float* BT = (LAS float*)(lds + 25088 + 49152);
        const int q = tid % 96, rs = tid / 96, c4 = 4 * q; const bool act = tid < DB;
        f32x4 cw0, cw1, cw2, cw3, cb, bra, bix, sp8;
        { cw0 = *(const f32x4*)(F.lru_conv_w + (l * 4 + 0) * DB + c4); cw1 = *(const f32x4*)(F.lru_conv_w + (l * 4 + 1) * DB + c4); cw2 = *(const f32x4*)(F.lru_conv_w + (l * 4 + 2) * DB + c4); cw3 = *(const f32x4*)(F.lru_conv_w + (l * 4 + 3) * DB + c4);
          cb = *(const f32x4*)(F.lru_conv_b + l * DB + c4); bra = *(const f32x4*)(F.lru_b_a + l * DB + c4); bix = *(const f32x4*)(F.lru_b_x + l * DB + c4);
          const f32x4 lam = *(const f32x4*)(F.lru_lambda + l * DB + c4);
#pragma unroll
          for (int e = 0; e < 4; ++e) sp8[e] = -8.f * fsoftplus_acc(-lam[e]); }
        float hst = 0.f, ca = 1.f;
        for (int tq = 0; tq < 4; ++tq) {
            if (act) {
                const bf16* src = P + (r0 + 32 * tq + 8 * rs) * PINP + 512 + c4;
                u32x2 raw[11];
                const bool hashalo = (n > 0) || (tq > 0) || (rs > 0);
#pragma unroll
                for (int i = 0; i < 11; ++i) raw[i] = (i >= 3 || hashalo) ? *(const u32x2*)(src + (ptrdiff_t)(i - 3) * PINP) : (u32x2){0u, 0u};
                f32x4 x3 = unpack4(raw[0]), x2 = unpack4(raw[1]), x1 = unpack4(raw[2]);
#pragma unroll
                for (int i = 0; i < 8; ++i) { const f32x4 x0 = unpack4(raw[3 + i]);
                    const f32x4 xc = cb + cw0 * x3 + cw1 * x2 + cw2 * x1 + cw3 * x0; x3 = x2; x2 = x1; x1 = x0;
                    *(LAS u32x2*)(XC + (8 * rs + i) * 392 + c4) = pack4(xc); }
            }
            LDS_BAR();
            for (int k = 0; k < 3; ++k) {
                const int id = wave + 8 * k, mat = id / 12, hb = (id % 12) >> 1, jt = id & 1;
                const bf16* Wt = (mat ? F.LRUWX : F.LRUWA) + (size_t)((l * 6 + hb) * 64 + 32 * jt + r) * 64 + 8 * hh;
                const LAS bf16* xrow = XC + r * 392 + 64 * hb + 8 * hh;
                f32x16 acc;
#pragma unroll
                for (int i = 0; i < 16; ++i) acc[i] = 0.f;
#pragma unroll
                for (int ks = 0; ks < 4; ++ks) { const bf16x8 a = *(const LAS bf16x8*)(xrow + 16 * ks); const bf16x8 b = *(const bf16x8*)(Wt + 16 * ks);
                    acc = __builtin_amdgcn_mfma_f32_32x32x16_bf16(a, b, acc, 0, 0, 0); }
                LAS float* dst = (mat ? BT : LA) + 64 * hb + 32 * jt + r;
#pragma unroll
                for (int rg = 0; rg < 16; ++rg) dst[((rg & 3) + 8 * (rg >> 2) + 4 * hh) * DB] = acc[rg];
            }
            LDS_BAR();
            if (act) {
#pragma unroll 2
                for (int i = 0; i < 8; ++i) { const int tl = rs + 4 * i;
                    const f32x4 rp = *(const LAS f32x4*)(LA + tl * DB + c4) + bra, ip = *(const LAS f32x4*)(BT + tl * DB + c4) + bix;
                    const f32x4 xc = unpack4(*(const LAS u32x2*)(XC + tl * 392 + c4));
                    f32x4 av, bv;
#pragma unroll
                    for (int e = 0; e < 4; ++e) { const float la = sp8[e] * fsigmoid(rp[e]); av[e] = fexp(la);
                        bv[e] = __builtin_amdgcn_sqrtf(fmaxf(fnegexpm1(2.f * la), 0.f)) * (fsigmoid(ip[e]) * xc[e]); }
                    *(LAS f32x4*)(LA + tl * DB + c4) = av; *(LAS f32x4*)(BT + tl * DB + c4) = bv; }
            }
            LDS_BAR();
            if (act) {
#pragma unroll 8
                for (int i = 0; i < 32; ++i) { const float a = LA[i * DB + tid], bt = BT[i * DB + tid]; hst = a * hst + bt; ca *= a; LA[i * DB + tid] = hst; BT[i * DB + tid] = ca; }
            }
            LDS_BAR();
            if (act) {
                u32x2 yg[8];
#pragma unroll
                for (int i = 0; i < 8; ++i) yg[i] = *(const u32x2*)(P + (r0 + 32 * tq + rs + 4 * i) * PINP + 896 + c4);
#pragma unroll
                for (int i = 0; i < 8; ++i) { const int tl = rs + 4 * i; const size_t row = r0 + 32 * tq + tl;
                    const f32x4 h4 = *(const LAS f32x4*)(LA + tl * DB + c4), ca4 = *(const LAS f32x4*)(BT + tl * DB + c4), y4 = unpack4(yg[i]);
                    f32x4 gl; gl[0] = fgelu(y4[0]); gl[1] = fgelu(y4[1]); gl[2] = fgelu(y4[2]); gl[3] = fgelu(y4[3]);
                    *(u32x2*)(Y + row * DM + 256 + c4) = pack4(gl * h4); *(u32x2*)(F.Q2 + row * DB + c4) = pack4(gl * ca4); }
            }
        }
        if (act) { F.LRUSA[(size_t)ch * DB + tid] = ca; F.LRUSH[(size_t)ch * DB + tid] = hst; }
    }
    LDS_BAR();
    if (PARTS & 4) for (int mrep = 0; mrep <= (((MK_MIXDUP) >> 2) & 1); ++mrep) {
        if (mrep) LDS_BAR();
        const int tid = opaque_tid(), lane = tid & 63, r = lane & 31, hh = lane >> 5;
        LAS bf16* TW = (LAS bf16*)lds;
        LAS bf16* XA = TW + 32 * 72;
        LAS bf16* SG = XA + 32 * 72;
        LAS float* LW = (LAS float*)(lds + 17920);
        LAS bf16* LAa = (LAS bf16*)(lds + 67072);
        LAS bf16* LG = (LAS bf16*)(lds + 91648);
        const float* mu = F.rwkv_mu + l * 1408;
        const int q = tid % 96, rs = tid / 96, n4 = 4 * q; const bool act3 = tid < 384;
        f32x4 p_mr, p_mk, p_mv, p_w0, p_a0, p_kk, p_ka;
        { p_mr = *(const f32x4*)(mu + n4); p_mk = *(const f32x4*)(mu + 384 + n4); p_mv = *(const f32x4*)(mu + 768 + n4);
          p_w0 = *(const f32x4*)(F.rwkv_w0 + l * DC + n4); p_a0 = *(const f32x4*)(F.rwkv_a0 + l * DC + n4); p_kk = *(const f32x4*)(F.rwkv_k_k + l * DC + n4); p_ka = *(const f32x4*)(F.rwkv_k_a + l * DC + n4); }
        const bf16* pc = P + PC_OFF + 1152 + 4 * lane; const f32x4 mu4 = *(const f32x4*)(mu + 1152 + 4 * lane);
        LAS bf16* c1dst = lane < 16 ? TW + 4 * lane : (lane < 32 ? XA + 4 * (lane - 16) : SG + 4 * (lane - 32));
        const int c1stride = lane < 32 ? 72 : 136;
#ifndef MK_CDUP
#define MK_CDUP 0
#endif
        for (int tb = 0; tb < 4; ++tb) {
            for (int c12 = 0; c12 <= ((MK_CDUP) & 1); ++c12) {
            if (c12) LDS_BAR();
            {
                const int t0 = 32 * tb + 4 * wave;
                f32x4 prev = (f32x4){0.f, 0.f, 0.f, 0.f};
                if (t0 > 0 || n > 0) prev = unpack4(*(const u32x2*)(pc + (r0 + t0 - 1) * PINP));
#pragma unroll
                for (int i = 0; i < 4; ++i) {
                    const f32x4 cur = unpack4(*(const u32x2*)(pc + (r0 + t0 + i) * PINP));
                    const f32x4 xs = cur + (prev - cur) * mu4; prev = cur;
                    f32x4 y;
#pragma unroll
                    for (int e = 0; e < 4; ++e) y[e] = lane < 16 ? ftanh(xs[e]) : (lane < 32 ? xs[e] : fsigmoid(xs[e]));
                    *(LAS u32x2*)(c1dst + (4 * wave + i) * c1stride) = pack4(y); }
            }
            LDS_BAR();
            for (int u = wave; u < 36; u += 8) {
                const int lora = u < 12 ? 0 : (u < 24 ? 1 : 2), nt = u - 12 * lora;
                f32x16 acc;
#pragma unroll
                for (int i = 0; i < 16; ++i) acc[i] = 0.f;
                const int nrow = 32 * nt + r;
                if (lora == 0) { const bf16* wr = F.RG2 + ((size_t)l * 384 + nrow) * 128 + 8 * hh; const LAS bf16* xr = SG + r * 136 + 8 * hh;
#pragma unroll
                    for (int ks = 0; ks < 8; ++ks) acc = __builtin_amdgcn_mfma_f32_32x32x16_bf16(*(const LAS bf16x8*)(xr + 16 * ks), *(const bf16x8*)(wr + 16 * ks), acc, 0, 0, 0);
                } else { const bf16* wr = (lora == 1 ? F.RW2 : F.RA2) + ((size_t)l * 384 + nrow) * 64 + 8 * hh; const LAS bf16* xr = (lora == 1 ? TW : XA) + r * 72 + 8 * hh;
#pragma unroll
                    for (int ks = 0; ks < 4; ++ks) acc = __builtin_amdgcn_mfma_f32_32x32x16_bf16(*(const LAS bf16x8*)(xr + 16 * ks), *(const bf16x8*)(wr + 16 * ks), acc, 0, 0, 0);
                }
                if (lora == 1) { LAS float* d = LW + 32 * nt + r;
#pragma unroll
                    for (int rg = 0; rg < 16; ++rg) d[((rg & 3) + 8 * (rg >> 2) + 4 * hh) * 384] = acc[rg];
                } else { LAS bf16* d = (lora == 0 ? LG : LAa) + 32 * nt + r;
#pragma unroll
                    for (int rg = 0; rg < 16; ++rg) d[((rg & 3) + 8 * (rg >> 2) + 4 * hh) * 384] = f2bf(acc[rg]); }
            }
            LDS_BAR();
            }
            for (int c3r = 0; c3r <= (((MK_CDUP) >> 1) & 1); ++c3r)
            if (act3) {
                struct RowIn { u32x2 rc, kc, vc, rp, kp, vp; };
#define C3_LOAD(T, i) do { const int t_ = 32 * tb + rs + 4 * (i); const bf16* prow_ = P + (r0 + t_) * PINP + PC_OFF + n4; T.rc = *(const u32x2*)(prow_); T.kc = *(const u32x2*)(prow_ + 384); T.vc = *(const u32x2*)(prow_ + 768); \
        if (t_ > 0 || n > 0) { T.rp = *(const u32x2*)(prow_ - PINP); T.kp = *(const u32x2*)(prow_ - PINP + 384); T.vp = *(const u32x2*)(prow_ - PINP + 768); } else { T.rp = (u32x2){0u, 0u}; T.kp = T.rp; T.vp = T.rp; } } while (0)
                RowIn rin[2];
                C3_LOAD(rin[0], 0);
#pragma unroll
                for (int i = 0; i < 8; ++i) {
                    if (i + 1 < 8) C3_LOAD(rin[(i + 1) & 1], i + 1);
                    const RowIn& T = rin[i & 1];
                    const int tl = rs + 4 * i; const size_t row = r0 + 32 * tb + tl;
                    f32x4 rc = unpack4(T.rc), kc = unpack4(T.kc), vc = unpack4(T.vc);
                    const f32x4 rp = unpack4(T.rp), kp = unpack4(T.kp), vp = unpack4(T.vp);
                    rc = rc + (rp - rc) * p_mr; kc = kc + (kp - kc) * p_mk; vc = vc + (vp - vc) * p_mv;
                    const f32x4 lw = *(const LAS f32x4*)(LW + tl * 384 + n4), la = unpack4(*(const LAS u32x2*)(LAa + tl * 384 + n4));
                    const u32x2 lg = *(const LAS u32x2*)(LG + tl * 384 + n4);
                    const f32x4 kr = kc * p_kk;
                    const float ss = red16((kr[0] * kr[0] + kr[1] * kr[1]) + (kr[2] * kr[2] + kr[3] * kr[3]));
                    const float rn = __builtin_amdgcn_rsqf(fmaxf(ss, 1e-24f));
                    f32x4 dec, km, kk4, bv4;
#pragma unroll
                    for (int e = 0; e < 4; ++e) {
                        const float wv = -fsoftplus(-(p_w0[e] + lw[e])) - 0.5f; dec[e] = -fexp(wv);
                        const float a = fsigmoid(p_a0[e] + la[e]);
                        kk4[e] = kr[e] * rn; bv4[e] = kk4[e] * a;
                        km[e] = kc[e] * (1.f + (a - 1.f) * p_ka[e]); }
                    *(u32x2*)(F.R + row * DC + n4) = pack4(rc); *(u32x2*)(F.K + row * DC + n4) = pack4(km); *(u32x2*)(F.V + row * DC + n4) = pack4(vc);
                    *(u32x2*)(F.LD + row * DC + n4) = pack4(dec); *(u32x2*)(F.KK + row * DC + n4) = pack4(kk4); *(u32x2*)(F.BV + row * DC + n4) = pack4(bv4);
                    *(u32x2*)(Y + row * DM + 640 + n4) = lg;
                }
#undef C3_LOAD
            }
        }
    }
    LDS_BAR();
}

__device__ __forceinline__ void rwkv_scan_item(Frame& F, const int it) {
#define SC_BAR() do { asm volatile("s_waitcnt lgkmcnt(0)" ::: "memory"); __builtin_amdgcn_s_barrier(); asm volatile("" ::: "memory"); } while (0)
    const int tid = opaque_tid();
    const int b = it / 24, h = (it % 24) >> 2, qt = it & 3;
    constexpr int CS = 16;
    constexpr int BUFF = 5 * CS * 64 + CS * 16;
    constexpr int OPF = CS * 16 * 16;
    constexpr int NCK = SEQ / CS;
    LAS float* buf = (LAS float*)F.lds;
    LAS float* opart = buf + 2 * BUFF;
    const size_t base = (size_t)b * SEQ * DC + 64 * h;
    if (tid >= 256) {
        const int lt = tid - 256, st = lt >> 4, q = lt & 15, vst = lt >> 2, vq = lt & 3;
        const size_t go = base + (size_t)st * DC + 4 * q;
        const bf16* gKK = F.KK + go; const bf16* gBV = F.BV + go; const bf16* gK = F.K + go; const bf16* gR = F.R + go; const bf16* gW = F.LD + go;
        const bf16* gV = F.V + base + (size_t)vst * DC + 16 * qt + 4 * vq;
        const int fg = lt >> 6, frow = (lt >> 2) & 15, fqd = lt & 3;
        bf16* gO = F.O + base + 16 * qt + (size_t)(4 * fg + fqd) * DC + frow;
        const bool ldv = lt < CS * 4;
        u32x2 kk0, bv0, k0, r0, v0 = (u32x2){0u, 0u}, kk1, bv1, k1, r1, v1 = (u32x2){0u, 0u}, kk2, bv2, k2, r2, v2 = (u32x2){0u, 0u}, w0, w1, w2;
#define SC_LOAD(S, ck) do { const size_t _o = (size_t)(ck) * CS * DC; kk##S = *(const u32x2*)(gKK + _o); bv##S = *(const u32x2*)(gBV + _o); k##S = *(const u32x2*)(gK + _o); r##S = *(const u32x2*)(gR + _o); \
        w##S = *(const u32x2*)(gW + _o); if (ldv) v##S = *(const u32x2*)(gV + _o); } while (0)
#define SC_STORE(S, bb) do { LAS float* _b = (bb) + st * 64 + 4 * q; *(LAS f32x4*)(_b) = unpack4(kk##S); { const f32x4 ld_ = unpack4(w##S); *(LAS f32x4*)(_b + CS * 64) = (f32x4){fexp(ld_[0]), fexp(ld_[1]), fexp(ld_[2]), fexp(ld_[3])}; } *(LAS f32x4*)(_b + 2 * CS * 64) = unpack4(bv##S); \
        *(LAS f32x4*)(_b + 3 * CS * 64) = unpack4(k##S); *(LAS f32x4*)(_b + 4 * CS * 64) = unpack4(r##S); if (ldv) { const f32x4 vv_ = unpack4(v##S); LAS float* _v = (bb) + 5 * CS * 64 + (4 * vq) * CS + vst; _v[0] = vv_[0]; _v[CS] = vv_[1]; _v[2 * CS] = vv_[2]; _v[3 * CS] = vv_[3]; } } while (0)
#define SC_FLUSH(ckf) do { const LAS f32x4* pp = (const LAS f32x4*)(opart + ((ckf) & 1) * OPF + fg * 1024 + 64 * frow + 16 * fqd); \
        f32x4 sm = (pp[0] + pp[1]) + (pp[2] + pp[3]); \
        _Pragma("unroll") for (int e_ = 0; e_ < 4; ++e_) { float x_ = sm[e_]; x_ += dppf<0xB1>(x_); x_ += dppf<0x4E>(x_); sm[e_] = x_; } \
        gO[(size_t)(ckf) * CS * DC] = f2bf(fqd == 0 ? sm[0] : (fqd == 1 ? sm[1] : (fqd == 2 ? sm[2] : sm[3]))); } while (0)
#define SC_ITER(S, c) do { if ((c) > 0) SC_FLUSH((c) - 1); if ((c) + 1 < NCK) SC_STORE(S, buf + (((c) + 1) & 1) * BUFF); if ((c) + 4 < NCK) SC_LOAD(S, (c) + 4); SC_BAR(); } while (0)
        SC_LOAD(0, 0); SC_LOAD(1, 1); SC_LOAD(2, 2); SC_STORE(0, buf); SC_LOAD(0, 3);
        SC_BAR();
        for (int ck = 0; ck < NCK; ck += 3) {
            SC_ITER(1, ck);
            if (ck + 1 < NCK) SC_ITER(2, ck + 1);
            if (ck + 2 < NCK) SC_ITER(0, ck + 2);
        }
        SC_FLUSH(NCK - 1);
#undef SC_ITER
#undef SC_LOAD
#undef SC_STORE
#undef SC_FLUSH
    } else {
        const int gl = tid & 15, row = tid >> 4;
#define SC_READ(T, cbp, tt) do { T.kk = *(const LAS f32x4*)((cbp) + (tt) * 64 + 4 * gl); T.w = *(const LAS f32x4*)((cbp) + CS * 64 + (tt) * 64 + 4 * gl); T.bb = *(const LAS f32x4*)((cbp) + 2 * CS * 64 + (tt) * 64 + 4 * gl); \
        T.k = *(const LAS f32x4*)((cbp) + 3 * CS * 64 + (tt) * 64 + 4 * gl); T.r = *(const LAS f32x4*)((cbp) + 4 * CS * 64 + (tt) * 64 + 4 * gl); } while (0)
        struct StepIn { f32x4 kk, w, bb, k, r; };
        SC_BAR();
        f32x2 sA = (f32x2){0.f, 0.f}, sB = (f32x2){0.f, 0.f};
        for (int ck = 0; ck < NCK; ++ck) {
            const LAS float* cb = buf + (ck & 1) * BUFF; LAS float* op = opart + (ck & 1) * OPF;
            StepIn sin[3];
            f32x4 vr[4], oq;
#pragma unroll
            for (int j = 0; j < 4; ++j) vr[j] = *(const LAS f32x4*)(cb + 5 * CS * 64 + row * CS + 4 * j);
            SC_READ(sin[0], cb, 0); SC_READ(sin[1], cb, 1);
#pragma unroll
            for (int tt = 0; tt < CS; ++tt) {
                if (tt + 2 < CS) SC_READ(sin[(tt + 2) % 3], cb, tt + 2);
                __builtin_amdgcn_sched_barrier(0);
                const StepIn& cur = sin[tt % 3];
                const f32x2 kkA = (f32x2){cur.kk[0], cur.kk[1]}, kkB = (f32x2){cur.kk[2], cur.kk[3]};
                f32x2 d2 = sA * kkA; d2 = sB * kkB + d2;
                const float p = red16(d2[0] + d2[1]);
                const float vv = vr[tt >> 2][tt & 3];
                const f32x2 uA = (f32x2){cur.k[0], cur.k[1]} * vv, uB = (f32x2){cur.k[2], cur.k[3]} * vv;
                sA = sA * (f32x2){cur.w[0], cur.w[1]} + uA; sB = sB * (f32x2){cur.w[2], cur.w[3]} + uB;
                sA = sA - (f32x2){cur.bb[0], cur.bb[1]} * p; sB = sB - (f32x2){cur.bb[2], cur.bb[3]} * p;
                f32x2 o2 = sA * (f32x2){cur.r[0], cur.r[1]}; o2 = sB * (f32x2){cur.r[2], cur.r[3]} + o2;
                oq[tt & 3] = o2[0] + o2[1];
                if ((tt & 3) == 3) *(LAS f32x4*)(op + (tt >> 2) * 1024 + 4 * tid) = oq;
            }
            SC_BAR();
        }
#undef SC_READ
    }
#undef SC_BAR
}
__device__ __forceinline__ void lru_fin_chunk(Frame& F, const int ch) {
    const int tid = opaque_tid(); if (tid >= 384) return;
    const int q = tid % 96, rs = tid / 96, b = ch >> 5, n = ch & 31;
    f32x4 hin = (f32x4){0.f, 0.f, 0.f, 0.f};
    for (int j = 0; j < n; ++j) { const f32x4 a = *(const f32x4*)(F.LRUSA + (size_t)(b * 32 + j) * DB + 4 * q), hh = *(const f32x4*)(F.LRUSH + (size_t)(b * 32 + j) * DB + 4 * q); hin = a * hin + hh; }
    bf16* Y = F.HY;
    for (int t0 = rs; t0 < 128; t0 += 32) {
        u32x2 a1[8], a2[8];
#pragma unroll
        for (int i = 0; i < 8; ++i) { const size_t row = (size_t)ch * 128 + t0 + 4 * i; a1[i] = *(const u32x2*)(Y + row * DM + 256 + 4 * q); a2[i] = *(const u32x2*)(F.Q2 + row * DB + 4 * q); }
#pragma unroll
        for (int i = 0; i < 8; ++i) { const size_t row = (size_t)ch * 128 + t0 + 4 * i; *(u32x2*)(Y + row * DM + 256 + 4 * q) = pack4(unpack4(a1[i]) + unpack4(a2[i]) * hin); }
    }
}
__device__ __forceinline__ void rwkv_fin_phase(Frame& F, const int l) {
    const int gw = F.vcu * NWAVES + F.wave, NGW = F.G * NWAVES, lane = opaque_tid() & 63, sub = lane >> 4, q = lane & 15;
    bf16* Y = F.HY;
    struct FinIn { u32x2 ov, r, k, v, g; };
#define FIN_LOAD(T, idx_) do { const int m_ = (idx_) / 6, h_ = (idx_) - 6 * m_; const size_t o_ = (size_t)m_ * DC + 64 * h_ + 4 * q; T.ov = *(const u32x2*)(F.O + o_); T.r = *(const u32x2*)(F.R + o_); T.k = *(const u32x2*)(F.K + o_); \
        T.v = *(const u32x2*)(F.V + o_); T.g = *(const u32x2*)(Y + (size_t)m_ * DM + 640 + 64 * h_ + 4 * q); } while (0)
    FinIn fin[2];
    constexpr int NIT = (M * 6) / (256 * NWAVES * 4);
    const int idx0 = gw * 4 + sub, stride = NGW * 4;
    if (NGW * 4 * NIT != M * 6) return;
    FIN_LOAD(fin[0], idx0);
#pragma unroll 2
    for (int it = 0; it < NIT; ++it) {
        const int idx = idx0 + it * stride;
        if (it + 1 < NIT) { if (it & 1) FIN_LOAD(fin[0], idx + stride); else FIN_LOAD(fin[1], idx + stride); }
        const FinIn& T = (it & 1) ? fin[1] : fin[0];
        const int m = idx / 6, h = idx - 6 * m; const int n4 = 64 * h + 4 * q;
        const f32x4 ov = unpack4(T.ov);
        const float mean = red16((ov[0] + ov[1]) + (ov[2] + ov[3])) * (1.f / 64.f);
        const f32x4 d = ov - mean;
        const float var = red16((d[0] * d[0] + d[1] * d[1]) + (d[2] * d[2] + d[3] * d[3])) * (1.f / 64.f);
        const float rstd = __builtin_amdgcn_rsqf(var + 64e-5f);
        const f32x4 lw = *(const f32x4*)(F.rwkv_ln_w + l * DC + n4), lb = *(const f32x4*)(F.rwkv_ln_b + l * DC + n4), rk = *(const f32x4*)(F.rwkv_r_k + l * DC + n4);
        const f32x4 r4 = unpack4(T.r), k4 = unpack4(T.k), v4 = unpack4(T.v);
        const f32x4 t4 = r4 * k4 * rk;
        const float bs = red16((t4[0] + t4[1]) + (t4[2] + t4[3]));
        const f32x4 g4 = unpack4(T.g);
        const f32x4 y = ((d * rstd) * lw + lb + v4 * bs) * g4;
        *(u32x2*)(Y + (size_t)m * DM + 640 + n4) = pack4(y);
    }
#undef FIN_LOAD
}
__device__ __forceinline__ void ffn_glu_phase(Frame& F, const int l) {
    constexpr int CG = DFF / 8, SEG = 32, NSEG = M / SEG;
    const int gt = F.vcu * (NWAVES * 64) + opaque_tid(), NGT = F.G * NWAVES * 64;
    for (int id = gt; id < NSEG * CG; id += NGT) {
        const int rsg = id / CG, cg8 = id - rsg * CG; const int col = 8 * cg8; const size_t row0 = (size_t)rsg * SEG;
        float w0[8], w1[8], w2[8], cb[8], x1[8], x2[8];
        { const float* cw = F.ffn_conv_w + (size_t)l * 3 * DFF + col; const float* cbp = F.ffn_conv_b + (size_t)l * DFF + col;
#pragma unroll
          for (int e = 0; e < 8; ++e) { w0[e] = cw[e]; w1[e] = cw[DFF + e]; w2[e] = cw[2 * DFF + e]; cb[e] = cbp[e]; x1[e] = 0.f; x2[e] = 0.f; } }
        if ((row0 & (SEQ - 1)) != 0) {
            const u32x4 a = *(const u32x4*)(F.UG + (row0 - 2) * DFF + col), bq = *(const u32x4*)(F.UG + (row0 - 1) * DFF + col);
            x2[0] = bflo(a.x); x2[1] = bfhi(a.x); x2[2] = bflo(a.y); x2[3] = bfhi(a.y); x2[4] = bflo(a.z); x2[5] = bfhi(a.z); x2[6] = bflo(a.w); x2[7] = bfhi(a.w);
            x1[0] = bflo(bq.x); x1[1] = bfhi(bq.x); x1[2] = bflo(bq.y); x1[3] = bfhi(bq.y); x1[4] = bflo(bq.z); x1[5] = bfhi(bq.z); x1[6] = bflo(bq.w); x1[7] = bfhi(bq.w);
        }
        u32x4 ga[4], va[4], gb[4], vb[4];
#define FF_LOAD(G_, V_, grp) do { _Pragma("unroll") for (int i_ = 0; i_ < 4; ++i_) { G_[i_] = *(const u32x4*)(F.UG + (row0 + 4 * (grp) + i_) * DFF + col); V_[i_] = *(const u32x4*)(F.UV + (row0 + 4 * (grp) + i_) * DFF + col); } } while (0)
#define FF_DO(G_, V_, grp) do { _Pragma("unroll") for (int i_ = 0; i_ < 4; ++i_) { const u32x4 gq = G_[i_], vq = V_[i_]; float x0[8], vv[8], y[8]; \
            x0[0] = bflo(gq.x); x0[1] = bfhi(gq.x); x0[2] = bflo(gq.y); x0[3] = bfhi(gq.y); x0[4] = bflo(gq.z); x0[5] = bfhi(gq.z); x0[6] = bflo(gq.w); x0[7] = bfhi(gq.w); \
            vv[0] = bflo(vq.x); vv[1] = bfhi(vq.x); vv[2] = bflo(vq.y); vv[3] = bfhi(vq.y); vv[4] = bflo(vq.z); vv[5] = bfhi(vq.z); vv[6] = bflo(vq.w); vv[7] = bfhi(vq.w); \
            _Pragma("unroll") for (int e = 0; e < 8; ++e) { const float gc = cb[e] + w0[e] * x2[e] + w1[e] * x1[e] + w2[e] * x0[e]; y[e] = fsilu(gc) * vv[e]; x2[e] = x1[e]; x1[e] = x0[e]; } \
            u32x4 o; o.x = pk2(y[0], y[1]); o.y = pk2(y[2], y[3]); o.z = pk2(y[4], y[5]); o.w = pk2(y[6], y[7]); \
            *(u32x4*)(F.UV + (row0 + 4 * (grp) + i_) * DFF + col) = o; } } while (0)
        FF_LOAD(ga, va, 0);
        for (int grp = 0; grp < SEG / 4; grp += 2) {
            FF_LOAD(gb, vb, grp + 1);
            FF_DO(ga, va, grp);
            if (grp + 2 < SEG / 4) FF_LOAD(ga, va, grp + 2);
            FF_DO(gb, vb, grp + 1);
        }
#undef FF_LOAD
#undef FF_DO
    }
}

__device__ __forceinline__ void ffn_fix_phase(Frame& F, const int l) {
    const int gt = F.vcu * (NWAVES * 64) + opaque_tid(), NGT = F.G * NWAVES * 64;
    constexpr int C4 = DFF / 4, NT = M / 256;
    const float* cw = F.ffn_conv_w + (size_t)l * 3 * DFF; const float* cbp = F.ffn_conv_b + (size_t)l * DFF;
    for (int id = gt; id < NT * C4; id += NGT) {
        const int pm = id / C4, c = 4 * (id - pm * C4);
        if ((pm & 15) == 0) continue;
        const f32x4 w0 = *(const f32x4*)(cw + c), w1 = *(const f32x4*)(cw + DFF + c), w2 = *(const f32x4*)(cw + 2 * DFF + c), cb = *(const f32x4*)(cbp + c);
        const f32x4 gm2 = *(const f32x4*)(F.TG + ((size_t)(pm - 1) * 2 + 0) * DFF + c), gm1 = *(const f32x4*)(F.TG + ((size_t)(pm - 1) * 2 + 1) * DFF + c);
        const f32x4 g0 = *(const f32x4*)(F.HG + ((size_t)pm * 2 + 0) * DFF + c), g1 = *(const f32x4*)(F.HG + ((size_t)pm * 2 + 1) * DFF + c);
        const f32x4 v0 = *(const f32x4*)(F.HV + ((size_t)pm * 2 + 0) * DFF + c), v1 = *(const f32x4*)(F.HV + ((size_t)pm * 2 + 1) * DFF + c);
        f32x4 h0, h1;
#pragma unroll
        for (int e = 0; e < 4; ++e) { const float a = cb[e] + w0[e] * gm2[e] + w1[e] * gm1[e] + w2[e] * g0[e], b = cb[e] + w0[e] * gm1[e] + w1[e] * g0[e] + w2[e] * g1[e];
            h0[e] = fsilu(a) * v0[e]; h1[e] = fsilu(b) * v1[e]; }
        *(u32x2*)(F.UV + ((size_t)pm * 256 + 0) * DFF + c) = pack4(h0); *(u32x2*)(F.UV + ((size_t)pm * 256 + 1) * DFF + c) = pack4(h1);
    }
}

struct Args { const float* in[35]; float* out; unsigned char* ws; int ph_lo, ph_hi; };
__device__ __forceinline__ void frame_init(Frame& F, LAS unsigned char* lds) {
    typedef const __attribute__((address_space(4))) Args* ArgP;
    ArgP ap = (ArgP)__builtin_amdgcn_kernarg_segment_ptr(); asm volatile("" : "+s"(ap));
    F.lds = lds; F.MISC = (volatile LAS unsigned*)(lds + MISC_OFF);
    F.wave = __builtin_amdgcn_readfirstlane(threadIdx.x >> 6);
    F.G = gridDim.x; { const int bx = blockIdx.x; F.vcu = (F.G % 8 == 0) ? (bx % 8) * (F.G / 8) + bx / 8 : bx; }
    unsigned char* ws = ap->ws;
    F.ctl = (gu32*)(ws + WS_CTL);
    F.x = ap->in[0]; F.c = ap->in[1]; F.w_mod = ap->in[2]; F.b_mod = ap->in[3]; F.norm_mix = ap->in[4]; F.w_in = ap->in[5]; F.w_out = ap->in[6];
    F.sgu_ln_g = ap->in[7]; F.sgu_ln_b = ap->in[8]; F.sgu_w = ap->in[9]; F.sgu_b = ap->in[10];
    F.lru_conv_w = ap->in[11]; F.lru_conv_b = ap->in[12]; F.lru_w_a = ap->in[13]; F.lru_b_a = ap->in[14]; F.lru_w_x = ap->in[15]; F.lru_b_x = ap->in[16]; F.lru_lambda = ap->in[17];
    F.rwkv_mu = ap->in[18]; F.rwkv_w0 = ap->in[19]; F.rwkv_w2 = ap->in[20]; F.rwkv_a0 = ap->in[21]; F.rwkv_a2 = ap->in[22]; F.rwkv_g2 = ap->in[23]; F.rwkv_k_k = ap->in[24]; F.rwkv_k_a = ap->in[25];
    F.rwkv_r_k = ap->in[26]; F.rwkv_ln_w = ap->in[27]; F.rwkv_ln_b = ap->in[28]; F.norm_ffn = ap->in[29]; F.ffn_w_up = ap->in[30]; F.ffn_conv_w = ap->in[31]; F.ffn_conv_b = ap->in[32];
    F.ffn_w_down = ap->in[33]; F.norm_final = ap->in[34]; F.out = ap->out;
    F.SGUW = (bf16*)(ws + WS_SMALL + SM_SGUW); F.LRUWA = (bf16*)(ws + WS_SMALL + SM_LRUWA); F.LRUWX = (bf16*)(ws + WS_SMALL + SM_LRUWX);
    F.RW2 = (bf16*)(ws + WS_SMALL + SM_RW2); F.RA2 = (bf16*)(ws + WS_SMALL + SM_RA2); F.RG2 = (bf16*)(ws + WS_SMALL + SM_RG2);
    F.MOD = (float*)(ws + WS_MOD); F.LRUSA = (float*)(ws + WS_LRUS); F.LRUSH = F.LRUSA + 256 * DB;
    F.WIN = (bf16*)(ws + WS_WIN); F.WOUT = (bf16*)(ws + WS_WOUT); F.WUP = (bf16*)(ws + WS_WUP); F.WDN = (bf16*)(ws + WS_WDN);
    F.HY = (bf16*)(ws + WS_HY); F.P = (bf16*)(ws + WS_P); F.UG = (bf16*)(ws + WS_P); F.UV = (bf16*)(ws + WS_UV); F.O = (bf16*)(ws + WS_O);
    F.R = (bf16*)(ws + WS_R); F.K = (bf16*)(ws + WS_K); F.V = (bf16*)(ws + WS_V); F.KK = (bf16*)(ws + WS_KK); F.BV = (bf16*)(ws + WS_BV); F.LD = (bf16*)(ws + WS_LD); F.Q2 = (bf16*)(ws + WS_Q2);
    F.SS = (float*)(ws + WS_SS); F.SW1 = (float*)(ws + WS_SW1); F.SW2 = (float*)(ws + WS_SW2);
    F.TG = (float*)(ws + WS_TG); F.HG = (float*)(ws + WS_HG); F.HV = (float*)(ws + WS_HV);
}
__global__ void __launch_bounds__(NWAVES * 64, 2) mk_fwd(Args args) {
    extern __shared__ __attribute__((aligned(16))) unsigned char lds_raw[];
    LAS unsigned char* const lds = (LAS unsigned char*)lds_raw;
    for (int u = threadIdx.x; u < (LDS_BYTES - LDSCTL_OFF) / 4; u += NWAVES * 64) ((LAS unsigned*)(lds + LDSCTL_OFF))[u] = 0u;
    __syncthreads();
#if MK_MODE == 2
    XcdBarrier bar = xcd_barrier_post((unsigned*)((gu32*)(args.ws + WS_CTL) + CW_BAR), (volatile LAS unsigned*)(lds + MISC_OFF) + 8);
#define GRID_BAR() xcd_barrier(bar)
#elif MK_MODE == 1
    cg::grid_group grid = cg::this_grid();
#define GRID_BAR() grid.sync()
#else
#define GRID_BAR() do { } while (0)
#endif
    const int lo = args.ph_lo, hi = args.ph_hi;
#define IN(k) (lo <= (k) && (k) < hi)
#ifndef MK_PHMASK
#define MK_PHMASK 0xFFF
#endif
#define EN(t) (((MK_PHMASK) >> (t)) & 1)
#ifndef MK_DUPMASK
#define MK_DUPMASK 0
#endif
#define REP2(t) (((MK_DUPMASK) >> (t)) & 1)
#define SEAM(k) do { if (IN(k) && IN((k) + 1)) GRID_BAR(); } while (0)
#define PH_BEGIN(t, k) if (EN(t) && IN(k)) { for (int rep = 0; rep <= REP2(t); ++rep) { if (rep) GRID_BAR(); Frame F; frame_init(F, lds); \
        const float* mod_l = F.MOD + (size_t)l * NB * NMOD; const float* Xin = (l == 0) ? F.x : F.out; (void)mod_l; (void)Xin;
#define PH_END(k) } } SEAM(k);

    { const int l = 0; PH_BEGIN(0, 0) p0_prologue(F); PH_END(0) }
    for (int l = 0; l < NL; ++l) {
        const int pb = 1 + 10 * l;
        if (l == 0) { PH_BEGIN(1, pb + 0) sw_phase(F); norm0_phase(F, F.x, F.norm_mix, mod_l, 1, F.HY); PH_END(pb + 0) }
        PH_BEGIN(2, pb + 1) pg8::Gemm g{F.HY, F.WIN + (size_t)l * PINP * DM, M, PINP, DM}; pg8::StaticOrder S; S.init(M, PINP, F.G, (int)blockIdx.x);
            pg8::EpiBf16N E{F.P, PINP, F.SS, F.SW1 + (size_t)l * NB * PINP, PINP, SEQ};
            pg8::gemm_phase<pg8::EpiBf16N, pg8::StaticOrder, true, true>(F.lds, g, S, E); PH_END(pb + 1)
        PH_BEGIN(3, pb + 2) for (int ch = F.vcu; ch < M / 128; ch += F.G) mix_chunk<4>(F, l, ch); PH_END(pb + 2)
        PH_BEGIN(4, pb + 3)
            if (F.G >= 256) { if (F.vcu < 192) rwkv_scan_item(F, F.vcu); else if (rep == 0) for (int ch = F.vcu - 192; ch < M / 128; ch += F.G - 192) mix_chunk<3>(F, l, ch); }
            else { for (int it = F.vcu; it < 192; it += F.G) { rwkv_scan_item(F, it); __syncthreads(); } if (rep == 0) for (int ch = F.vcu; ch < M / 128; ch += F.G) mix_chunk<3>(F, l, ch); }
        PH_END(pb + 3)
        PH_BEGIN(5, pb + 4) for (int ch = F.vcu; ch < M / 128; ch += F.G) lru_fin_chunk(F, ch); rwkv_fin_phase(F, l); PH_END(pb + 4)
        PH_BEGIN(6, pb + 5) pg8::Gemm g{F.HY, F.WOUT + (size_t)l * DM * DM, M, DM, DM}; pg8::StaticOrder S; S.init(M, DM, F.G, (int)blockIdx.x);
            pg8::EpiResNorm E{Xin, F.out, DM, mod_l + 2 * DM, NMOD, SEQ, F.P, F.norm_ffn + l * DM, mod_l + 4 * DM, F.SS};
            pg8::gemm_phase<pg8::EpiResNorm, pg8::StaticOrder, true, true>(F.lds, g, S, E); PH_END(pb + 5)
        PH_BEGIN(8, pb + 7) pg8::Gemm g{F.P, F.WUP + (size_t)l * DUP * DM, M, DUP, DM}; pg8::StaticOrder S; S.init(M, DUP, F.G, (int)blockIdx.x);
            pg8::EpiGLU E{F.UV, DFF, F.ffn_conv_w + (size_t)l * 3 * DFF, F.ffn_conv_b + (size_t)l * DFF, F.TG, F.HG, F.HV, (LAS float*)(F.lds + TAIL_OFF), F.SS, F.SW2 + (size_t)l * NB * DUP, DUP, SEQ};
            pg8::gemm_phase<pg8::EpiGLU, pg8::StaticOrder, true, true>(F.lds, g, S, E); PH_END(pb + 7)
        PH_BEGIN(9, pb + 8) ffn_fix_phase(F, l); PH_END(pb + 8)
        PH_BEGIN(10, pb + 9) pg8::Gemm g{F.UV, F.WDN + (size_t)l * DM * DFF, M, DM, DFF}; pg8::StaticOrder S; S.init(M, DM, F.G, (int)blockIdx.x);
            if (l + 1 < NL) { pg8::EpiResNorm E{F.out, F.out, DM, mod_l + 5 * DM, NMOD, SEQ, F.HY, F.norm_mix + (l + 1) * DM, mod_l + (size_t)NB * NMOD + 1 * DM, F.SS};
                pg8::gemm_phase<pg8::EpiResNorm, pg8::StaticOrder, true, true>(F.lds, g, S, E); }
            else { pg8::EpiRes E{F.out, F.out, DM, mod_l + 5 * DM, NMOD, SEQ};
                pg8::gemm_phase<pg8::EpiRes, pg8::StaticOrder, true, true>(F.lds, g, S, E); } PH_END(pb + 9)
    }
    { const int l = 0; PH_BEGIN(11, NPHASE - 1) final_norm_phase(F, F.out, F.norm_final); PH_END(NPHASE - 1) }
#undef IN
#undef SEAM
}

extern "C" void kernel_launch(void* const* d_in, const int* in_sizes, int n_in, void* d_out, int out_size, void* d_ws, size_t ws_size, hipStream_t stream) {
    static int grid = 0;
    if (grid == 0) {
        if (n_in != 35 || in_sizes[0] != M * DM || out_size != M * DM || ws_size < WS_END) { fprintf(stderr, "kernel_launch: unexpected shapes (n_in %d, in0 %d, out %d, ws %zu); nothing launched\n", n_in, n_in > 0 ? in_sizes[0] : -1, out_size, ws_size); grid = -1; return; }
        int dev = 0, cus = 0, per_cu = 0;
        if (hipGetDevice(&dev) != hipSuccess || hipDeviceGetAttribute(&cus, hipDeviceAttributeMultiprocessorCount, dev) != hipSuccess) { grid = -1; return; }
        if (hipFuncSetAttribute((const void*)mk_fwd, hipFuncAttributeMaxDynamicSharedMemorySize, LDS_BYTES) != hipSuccess) { fprintf(stderr, "kernel_launch: hipFuncSetAttribute failed\n"); grid = -1; return; }
        if (hipOccupancyMaxActiveBlocksPerMultiprocessor(&per_cu, (const void*)mk_fwd, NWAVES * 64, LDS_BYTES) != hipSuccess || per_cu < 1) { fprintf(stderr, "kernel_launch: occupancy query says %d blocks per CU\n", per_cu); per_cu = 1; }
        (void)hipGetLastError();
        grid = cus;
    }
    if (grid < 0) return;
    Args a{};
    for (int i = 0; i < 35; ++i) a.in[i] = (const float*)d_in[i];
    a.out = (float*)d_out; a.ws = (unsigned char*)d_ws;
#if MK_MODE == 0
    for (int ph = 0; ph < NPHASE; ++ph) { a.ph_lo = ph; a.ph_hi = ph + 1; hipLaunchKernelGGL(mk_fwd, dim3(grid), dim3(NWAVES * 64), LDS_BYTES, stream, a); }
#else
    (void)hipMemsetAsync((char*)d_ws + WS_CTL, 0, CTL_ZERO_BYTES, stream);
    a.ph_lo = 0; a.ph_hi = NPHASE;
#if MK_MODE == 1
    void* kargs[] = {&a};
    hipError_t e = hipLaunchCooperativeKernel((const void*)mk_fwd, dim3(grid), dim3(NWAVES * 64), kargs, LDS_BYTES, stream);
    if (e != hipSuccess) fprintf(stderr, "kernel_launch: cooperative launch failed: %s (grid %d)\n", hipGetErrorString(e), grid);
#else
    hipLaunchKernelGGL(mk_fwd, dim3(grid), dim3(NWAVES * 64), LDS_BYTES, stream, a);
#endif
#endif
}
```

```cpp
#include <hip/hip_runtime.h>
#include <hip/hip_cooperative_groups.h>
#include <cstdio>
#include <cstdint>
namespace pg8 {
#define PG8_LAS __attribute__((address_space(3)))
typedef unsigned short bf16_t;
typedef short bf16x8 __attribute__((ext_vector_type(8)));
typedef float f32x4 __attribute__((ext_vector_type(4)));
typedef unsigned u32x4 __attribute__((ext_vector_type(4)));
constexpr int BM = 256, BK = 64, HALF = 128, HTB = HALF * BK * 2  , STAGE_BYTES = 8 * HTB, NXCD = 8, WGM = 8;

__host__ __device__ __forceinline__ int lds_byte(int r, int c) { const int st = (r >> 4) * 2 + (c >> 5), rr = r & 15, cc = c & 31, ob = rr * 64 + cc * 2; return st * 1024 + (ob ^ (((ob >> 9) & 1) << 5)); }
__host__ __device__ __forceinline__ void stage_rc(int b, int& R, int& C) { const int st = b / 1024, sb = b % 1024, swz = sb ^ (((sb >> 9) & 1) << 5); R = (st >> 1) * 16 + swz / 64; C = (st & 1) * 32 + (swz % 64) / 2; }
__host__ __device__ __forceinline__ int perm32(int rho) { const int n = rho >> 4, i = rho & 15; return 8 * (i >> 2) + 4 * n + (i & 3); }

struct Unit { int pm, pn; };
struct Gemm { const bf16_t* A; const bf16_t* Bt; int M, N, K; };

struct StaticOrder {
    int nM, nN, nwg, G, c;
    __host__ __device__ void init(int M, int N, int G_, int c_) { nM = M / BM; nN = N / BM; nwg = nM * nN; G = G_; c = c_; }
    __host__ __device__ bool next(int i, Unit& u) const {
        const long L = (long)i * G + c; if (L >= nwg) return false;
        int wgid = (int)L; { const int q = nwg / NXCD, r = nwg % NXCD, xcd = wgid % NXCD, off = wgid / NXCD; wgid = (xcd < r ? xcd * (q + 1) : r * (q + 1) + (xcd - r) * q) + off; }
        const int nig = WGM * nN, gid = wgid / nig, fm = gid * WGM, gsz = (nM - fm) < WGM ? (nM - fm) : WGM;
        u.pm = fm + ((wgid % nig) % gsz); u.pn = (wgid % nig) / gsz; return true;
    }
    __device__ __forceinline__ void a_ready(const Unit&) const {}
    __device__ __forceinline__ void done(const Unit&) const {}
};

__device__ __forceinline__ unsigned cvt_pk_bf16(float lo, float hi) { unsigned r; asm volatile("v_cvt_pk_bf16_f32 %0, %1, %2" : "=v"(r) : "v"(lo), "v"(hi)); return r; }
typedef float f32x2 __attribute__((ext_vector_type(2)));
__device__ __forceinline__ f32x2 gelu_pk(f32x2 v) {
    const f32x2 av = __builtin_elementwise_abs(v), d = av * 0.2316418882f + 1.0f;
    f32x2 t; t.x = __builtin_amdgcn_rcpf(d.x); t.y = __builtin_amdgcn_rcpf(d.y);
    f32x2 q = t * 0.5307027145f + (-0.7265760135f); q = q * t + 0.7107068705f; q = q * t + (-0.142248368f); q = q * t + 0.127414796f; q = q * t;
    const f32x2 s = (v * v) * (-0.72134752044f);
    f32x2 e; e.x = __builtin_amdgcn_exp2f(s.x); e.y = __builtin_amdgcn_exp2f(s.y);
    const f32x2 m = v * (q * e), r = v - m;
    f32x2 o; o.x = v.x < 0.f ? m.x : r.x; o.y = v.y < 0.f ? m.y : r.y; return o;
}

template <int ACT  > struct EpiBf16 {
    static constexpr bool PERM = true, AFTER_DRAIN = false; static_assert(ACT == 0 || ACT == 1, "EpiBf16: ACT is 0 (none) or 1 (gelu_pk)");
    bf16_t* O; int ldc; const float* bias; int split_cols; size_t split_stride; float scale0;
    __device__ __forceinline__ void operator()(const f32x4 (&acc)[2][2][4][2], const Unit& u, int wr, int wc, int fr, int fq) const {
        const int row0 = u.pm * BM + wr * 64 + fr; int colt = u.pn * BM; bf16_t* base = O;
        float sc = 1.f; if (split_cols) { const int t = colt / split_cols; base += (size_t)t * split_stride; colt -= t * split_cols; if (t == 0) sc = scale0; }
        const int col0 = colt + wc * 32 + 8 * fq, bcol0 = u.pn * BM + wc * 32 + 8 * fq;
        f32x4 bv[2][2];
#pragma unroll
        for (int bj = 0; bj < 2; ++bj)
#pragma unroll
            for (int n = 0; n < 2; ++n) bv[bj][n] = bias ? *(const f32x4*)(bias + bcol0 + bj * HALF + 4 * n) : (f32x4){0.f, 0.f, 0.f, 0.f};
#pragma unroll
        for (int ai = 0; ai < 2; ++ai)
#pragma unroll
            for (int m = 0; m < 4; ++m) { bf16_t* rowp = base + (size_t)(row0 + ai * HALF + m * 16) * ldc + col0;
#pragma unroll
                for (int bj = 0; bj < 2; ++bj) { f32x4 v0 = acc[ai][bj][m][0] + bv[bj][0], v1 = acc[ai][bj][m][1] + bv[bj][1];
                    if (ACT == 1) { f32x2 a = gelu_pk((f32x2){v0[0], v0[1]}), b = gelu_pk((f32x2){v0[2], v0[3]}), c = gelu_pk((f32x2){v1[0], v1[1]}), d = gelu_pk((f32x2){v1[2], v1[3]});
                        v0 = (f32x4){a.x, a.y, b.x, b.y}; v1 = (f32x4){c.x, c.y, d.x, d.y}; }
                    v0 = v0 * sc; v1 = v1 * sc; u32x4 w; w.x = cvt_pk_bf16(v0[0], v0[1]); w.y = cvt_pk_bf16(v0[2], v0[3]); w.z = cvt_pk_bf16(v1[0], v1[1]); w.w = cvt_pk_bf16(v1[2], v1[3]);
                    *(u32x4*)(rowp + bj * HALF) = w; } }
    }
};

typedef unsigned u32x2v __attribute__((ext_vector_type(2)));

struct EpiRes {
    static constexpr bool PERM = false, AFTER_DRAIN = false;
    const float* base; float* out; int ldc; const float* gate; int gate_ld; int rows_per_batch;
    __device__ __forceinline__ void operator()(const f32x4 (&acc)[2][2][4][2], const Unit& u, int wr, int wc, int fr, int fq) const {
        asm volatile("" : "+v"(fr), "+v"(fq));
        const int row0 = u.pm * BM + wr * 64 + fr, col0 = u.pn * BM + wc * 32 + 4 * fq;
        const float* gp = gate + (size_t)((u.pm * BM) / rows_per_batch) * gate_ld + col0;
        f32x4 gv[2][2];
#pragma unroll
        for (int bj = 0; bj < 2; ++bj)
#pragma unroll
            for (int n = 0; n < 2; ++n) gv[bj][n] = *(const f32x4*)(gp + bj * HALF + n * 16);
        f32x4 pre[3][2][2];
#define ER_LOAD(slot, g_) do { const size_t off_ = (size_t)(row0 + ((g_) >> 2) * HALF + ((g_) & 3) * 16) * ldc + col0; _Pragma("unroll") for (int bj = 0; bj < 2; ++bj) _Pragma("unroll") for (int n = 0; n < 2; ++n) pre[slot][bj][n] = *(const f32x4*)(base + off_ + bj * HALF + n * 16); } while (0)
        ER_LOAD(0, 0); ER_LOAD(1, 1);
#pragma unroll
        for (int g = 0; g < 8; ++g) { const int ai = g >> 2, m = g & 3; const size_t off = (size_t)(row0 + ai * HALF + m * 16) * ldc + col0;
            if (g + 2 < 8) ER_LOAD((g + 2) % 3, g + 2);
#pragma unroll
            for (int bj = 0; bj < 2; ++bj)
#pragma unroll
                for (int n = 0; n < 2; ++n) *(f32x4*)(out + off + bj * HALF + n * 16) = pre[g % 3][bj][n] + gv[bj][n] * acc[ai][bj][m][n]; }
#undef ER_LOAD
    }
};
struct EpiGV {
    static constexpr bool PERM = true, AFTER_DRAIN = false;
    bf16_t* G; bf16_t* V; int ldc;
    __device__ __forceinline__ void operator()(const f32x4 (&acc)[2][2][4][2], const Unit& u, int wr, int wc, int fr, int fq) const {
        const int row0 = u.pm * BM + wr * 64 + fr, col0 = u.pn * HALF + wc * 32 + 8 * fq;
#pragma unroll
        for (int ai = 0; ai < 2; ++ai)
#pragma unroll
            for (int m = 0; m < 4; ++m) { const size_t off = (size_t)(row0 + ai * HALF + m * 16) * ldc + col0;
#pragma unroll
                for (int bj = 0; bj < 2; ++bj) { const f32x4 v0 = acc[ai][bj][m][0], v1 = acc[ai][bj][m][1];
                    u32x4 w; w.x = cvt_pk_bf16(v0[0], v0[1]); w.y = cvt_pk_bf16(v0[2], v0[3]); w.z = cvt_pk_bf16(v1[0], v1[1]); w.w = cvt_pk_bf16(v1[2], v1[3]);
                    *(u32x4*)((bj ? V : G) + off) = w; } }
    }
};

__device__ __forceinline__ float xrow16_sum(float x) {
    auto s = __builtin_amdgcn_permlane16_swap(__float_as_uint(x), __float_as_uint(x), false, false);
    x = __uint_as_float(s[0]) + __uint_as_float(s[1]);
    auto t = __builtin_amdgcn_permlane32_swap(__float_as_uint(x), __float_as_uint(x), false, false);
    return __uint_as_float(t[0]) + __uint_as_float(t[1]);
}
__device__ __forceinline__ void load_rstd8(const float* SS, int row0, int fq, float inv_n, float eps, float (&rstd)[8]) {
    f32x4 p[8];
#pragma unroll
    for (int g = 0; g < 8; ++g) p[g] = *(const f32x4*)(SS + (size_t)(row0 + (g >> 2) * HALF + (g & 3) * 16) * 16 + 4 * fq);
#pragma unroll
    for (int g = 0; g < 8; ++g) rstd[g] = __builtin_amdgcn_rsqf(xrow16_sum((p[g][0] + p[g][1]) + (p[g][2] + p[g][3])) * inv_n + eps);
}
struct EpiResNorm {
    static constexpr bool PERM = false, AFTER_DRAIN = false;
    const float* base; float* out; int ldc; const float* gate; int gate_ld; int rows_per_batch; bf16_t* XS; const float* gamma; const float* sc; float* SS;
    __device__ __forceinline__ void operator()(const f32x4 (&acc)[2][2][4][2], const Unit& u, int wr, int wc, int fr, int fq) const {
        asm volatile("" : "+v"(fr), "+v"(fq));
        const int row0 = u.pm * BM + wr * 64 + fr, col0 = u.pn * BM + wc * 32 + 4 * fq;
        const int b = (u.pm * BM) / rows_per_batch;
        const float* gp = gate + (size_t)b * gate_ld + col0; const float* sp = sc + (size_t)b * gate_ld + col0;
        f32x4 gv[2][2], gs[2][2];
#pragma unroll
        for (int bj = 0; bj < 2; ++bj)
#pragma unroll
            for (int n = 0; n < 2; ++n) { gv[bj][n] = *(const f32x4*)(gp + bj * HALF + n * 16); gs[bj][n] = *(const f32x4*)(gamma + col0 + bj * HALF + n * 16); if (sc) gs[bj][n] = gs[bj][n] * (*(const f32x4*)(sp + bj * HALF + n * 16) + 1.f); }
        f32x4 pre[2][2][2];
#define ER_LOAD(slot, g_) do { const size_t off_ = (size_t)(row0 + ((g_) >> 2) * HALF + ((g_) & 3) * 16) * ldc + col0; _Pragma("unroll") for (int bj = 0; bj < 2; ++bj) _Pragma("unroll") for (int n = 0; n < 2; ++n) pre[slot][bj][n] = *(const f32x4*)(base + off_ + bj * HALF + n * 16); } while (0)
        ER_LOAD(0, 0);
#pragma unroll
        for (int g = 0; g < 8; ++g) { const int ai = g >> 2, m = g & 3; const size_t off = (size_t)(row0 + ai * HALF + m * 16) * ldc + col0;
            if (g + 1 < 8) ER_LOAD((g + 1) & 1, g + 1);
            float ssq = 0.f;
#pragma unroll
            for (int bj = 0; bj < 2; ++bj)
#pragma unroll
                for (int n = 0; n < 2; ++n) { const f32x4 o = pre[g & 1][bj][n] + gv[bj][n] * acc[ai][bj][m][n];
                    if (out) *(f32x4*)(out + off + bj * HALF + n * 16) = o;
                    const f32x4 xs = o * gs[bj][n]; u32x2v w; w.x = cvt_pk_bf16(xs[0], xs[1]); w.y = cvt_pk_bf16(xs[2], xs[3]);
                    *(u32x2v*)(XS + off + bj * HALF + n * 16) = w;
                    ssq += (o[0] * o[0] + o[1] * o[1]) + (o[2] * o[2] + o[3] * o[3]); }
            ssq = xrow16_sum(ssq);
            if (fq == 0) SS[(size_t)(row0 + ai * HALF + m * 16) * 16 + 4 * u.pn + wc] = ssq; }
#undef ER_LOAD
    }
};
struct EpiBf16N {
    static constexpr bool PERM = true, AFTER_DRAIN = false;
    bf16_t* O; int ldc; const float* SS; const float* SW; int sw_ld; int rows_per_batch;
    __device__ __forceinline__ void operator()(const f32x4 (&acc)[2][2][4][2], const Unit& u, int wr, int wc, int fr, int fq) const {
        asm volatile("" : "+v"(fr), "+v"(fq));
        const int row0 = u.pm * BM + wr * 64 + fr, col0 = u.pn * BM + wc * 32 + 8 * fq;
        float rstd[8]; load_rstd8(SS, row0, fq, 1.f / 1024.f, 1e-6f, rstd);
        const float* swp = SW + (size_t)((u.pm * BM) / rows_per_batch) * sw_ld + col0;
        f32x4 sw[2][2];
#pragma unroll
        for (int bj = 0; bj < 2; ++bj)
#pragma unroll
            for (int n = 0; n < 2; ++n) sw[bj][n] = *(const f32x4*)(swp + bj * HALF + 4 * n);
#pragma unroll
        for (int ai = 0; ai < 2; ++ai)
#pragma unroll
            for (int m = 0; m < 4; ++m) { bf16_t* rowp = O + (size_t)(row0 + ai * HALF + m * 16) * ldc + col0; const float rs = rstd[ai * 4 + m];
#pragma unroll
                for (int bj = 0; bj < 2; ++bj) { const f32x4 v0 = acc[ai][bj][m][0] * rs + sw[bj][0], v1 = acc[ai][bj][m][1] * rs + sw[bj][1];
                    u32x4 w; w.x = cvt_pk_bf16(v0[0], v0[1]); w.y = cvt_pk_bf16(v0[2], v0[3]); w.z = cvt_pk_bf16(v1[0], v1[1]); w.w = cvt_pk_bf16(v1[2], v1[3]);
                    *(u32x4*)(rowp + bj * HALF) = w; } }
    }
};

template <int CTRL> __device__ __forceinline__ float dpp_keep(float old, float src) {
    return __builtin_bit_cast(float, __builtin_amdgcn_update_dpp(__builtin_bit_cast(int, old), __builtin_bit_cast(int, src), CTRL, 0xf, 0xf, false)); }
template <int CTRL> __device__ __forceinline__ float dpp_mov(float src) { return __builtin_bit_cast(float, __builtin_amdgcn_mov_dpp(__builtin_bit_cast(int, src), CTRL, 0xf, 0xf, true)); }
struct EpiGLU {
    static constexpr bool PERM = true, AFTER_DRAIN = false;
    bf16_t* H; int ldc; const float* cw; const float* cb; float* TG; float* HG; float* HV; PG8_LAS float* tail;
    const float* SS; const float* SW; int sw_ld; int rows_per_batch;
    __device__ __forceinline__ void operator()(const f32x4 (&acc)[2][2][4][2], const Unit& u, int wr, int wc, int fr, int fq) const {
        asm volatile("" : "+v"(fr), "+v"(fq));
        const int row0 = u.pm * BM + wr * 64 + fr, cl = wc * 32 + 8 * fq, col0 = u.pn * HALF + cl;
        f32x4 (&ac)[2][2][4][2] = const_cast<f32x4 (&)[2][2][4][2]>(acc);
        { float rstd[8]; load_rstd8(SS, row0, fq, 1.f / 1024.f, 1e-6f, rstd);
          const float* swp = SW + (size_t)((u.pm * BM) / rows_per_batch) * sw_ld + u.pn * BM + cl;
#pragma unroll
          for (int bj = 0; bj < 2; ++bj)
#pragma unroll
              for (int n = 0; n < 2; ++n) { const f32x4 swv = *(const f32x4*)(swp + bj * HALF + 4 * n);
#pragma unroll
                  for (int ai = 0; ai < 2; ++ai)
#pragma unroll
                      for (int m = 0; m < 4; ++m) ac[ai][bj][m][n] = ac[ai][bj][m][n] * rstd[ai * 4 + m] + swv; } }
#define GN(ai_, m_, n_) (acc[ai_][0][m_][n_])
#define VN(ai_, m_, n_) (acc[ai_][1][m_][n_])
        if (fr >= 14) {
#pragma unroll
            for (int ai = 0; ai < 2; ++ai)
#pragma unroll
                for (int n = 0; n < 2; ++n) *(PG8_LAS f32x4*)(tail + ((ai * 2 + wr) * 2 + (fr - 14)) * 128 + cl + 4 * n) = GN(ai, 3, n);
            if (wr == 1) {
#pragma unroll
                for (int n = 0; n < 2; ++n) *(f32x4*)(TG + ((size_t)u.pm * 2 + (fr - 14)) * ldc + col0 + 4 * n) = GN(1, 3, n);
            }
        }
        if (wr == 0 && fr < 2) {
#pragma unroll
            for (int n = 0; n < 2; ++n) { *(f32x4*)(HG + ((size_t)u.pm * 2 + fr) * ldc + col0 + 4 * n) = GN(0, 0, n); *(f32x4*)(HV + ((size_t)u.pm * 2 + fr) * ldc + col0 + 4 * n) = VN(0, 0, n); }
        }
        f32x4 w0[2], w1[2], w2[2], b0[2];
#pragma unroll
        for (int n = 0; n < 2; ++n) { w0[n] = *(const f32x4*)(cw + col0 + 4 * n); w1[n] = *(const f32x4*)(cw + ldc + col0 + 4 * n); w2[n] = *(const f32x4*)(cw + 2 * ldc + col0 + 4 * n); b0[n] = *(const f32x4*)(cb + col0 + 4 * n); }
        asm volatile("s_waitcnt lgkmcnt(0)" ::: "memory"); __builtin_amdgcn_s_barrier(); asm volatile("" ::: "memory");
#pragma unroll
        for (int ai = 0; ai < 2; ++ai) {
            f32x4 t0[2], t1[2];
            const bool have = (wr == 1) || (ai == 1);
            const int sa = (wr == 1) ? ai : 0, sw = (wr == 1) ? 0 : 1;
#pragma unroll
            for (int n = 0; n < 2; ++n) {
                t0[n] = have ? *(const PG8_LAS f32x4*)(tail + ((sa * 2 + sw) * 2 + 0) * 128 + cl + 4 * n) : (f32x4){0.f, 0.f, 0.f, 0.f};
                t1[n] = have ? *(const PG8_LAS f32x4*)(tail + ((sa * 2 + sw) * 2 + 1) * 128 + cl + 4 * n) : (f32x4){0.f, 0.f, 0.f, 0.f}; }
#pragma unroll
            for (int m = 0; m < 4; ++m) {
                u32x4 wout;
#pragma unroll
                for (int n = 0; n < 2; ++n) {
                    f32x4 hv; const f32x4 gcur = GN(ai, m, n), vcur = VN(ai, m, n); const f32x4 gprev = m > 0 ? GN(ai, (m > 0 ? m - 1 : 0), n) : gcur;
#pragma unroll
                    for (int i = 0; i < 4; ++i) {
                        const float g0 = gcur[i];
                        float p1, p2;
                        if (m == 0) { p1 = t1[n][i]; p2 = (fr == 0) ? t0[n][i] : t1[n][i]; }
                        else { const float pv = gprev[i]; p1 = dpp_mov<0x121>(pv); p2 = dpp_mov<0x122>(pv); }
                        const float g1 = dpp_keep<0x111>(p1, g0), g2 = dpp_keep<0x112>(p2, g0);
                        const float gc = b0[n][i] + w0[n][i] * g2 + w1[n][i] * g1 + w2[n][i] * g0;
                        hv[i] = gc * __builtin_amdgcn_rcpf(1.f + __builtin_amdgcn_exp2f(-1.4426950408889634f * gc)) * vcur[i];
                    }
                    if (n == 0) { wout.x = cvt_pk_bf16(hv[0], hv[1]); wout.y = cvt_pk_bf16(hv[2], hv[3]); } else { wout.z = cvt_pk_bf16(hv[0], hv[1]); wout.w = cvt_pk_bf16(hv[2], hv[3]); }
                }
                *(u32x4*)(H + (size_t)(row0 + ai * HALF + m * 16) * ldc + col0) = wout;
            }
        }
#undef GN
#undef VN
    }
};
template <class Epi, class Sched, bool ALIGN_EPI = false, bool SP2 = false>
__device__ __forceinline__ void gemm_phase(PG8_LAS unsigned char* lds, const Gemm g, const Sched& S, const Epi& E) {
    int tid_ = threadIdx.x; asm volatile("" : "+v"(tid_));
    const int tid = tid_, wid = __builtin_amdgcn_readfirstlane(tid >> 6), lane = tid & 63, wr = wid >> 2, wc = wid & 3, fr = lane & 15, fq = lane >> 4;
    const int K = g.K, nt = K / BK;
    unsigned voffA[2], voffB[2];
#pragma unroll
    for (int i = 0; i < 2; ++i) { int R, C; stage_rc(tid * 16 + i * 8192, R, C); const int Rb = Epi::PERM ? ((R & ~31) + perm32(R & 31)) : R;
        voffA[i] = (unsigned)(R * K + C) * 2u; voffB[i] = (unsigned)(Rb * K + C) * 2u; }
    const size_t kstep = (size_t)(BK * 2);
    const size_t hstep = (size_t)HALF * K * 2;
    const size_t tstep = 2 * hstep;
    const unsigned ldsw = (unsigned)wid * 1024u;
    const int aoff = lds_byte(wr * 64 + fr, fq * 8), boff = lds_byte(wc * 32 + fr, fq * 8);
#define PG8_SA(b, h) (((b) * 2 + (h)) * HTB)
#define PG8_SB(b, h) ((4 + (b) * 2 + (h)) * HTB)
#define PG8_STAGE(bufoff, gbase, voff) do { _Pragma("unroll") for (int _i = 0; _i < 2; ++_i) \
        __builtin_amdgcn_global_load_lds((const unsigned*)((const char*)(gbase) + (voff)[_i]), (PG8_LAS unsigned*)(lds + (bufoff) + ldsw + _i * 8192), 16, 0, 0); } while (0)
#define PG8_LDA(dst, b, h) do { _Pragma("unroll") for (int m = 0; m < 4; ++m) _Pragma("unroll") for (int k = 0; k < 2; ++k) dst[m][k] = *(const PG8_LAS bf16x8*)(lds + PG8_SA(b, h) + aoff + m * 2048 + k * 1024); } while (0)
#define PG8_LDB(dst, b, h) do { _Pragma("unroll") for (int n = 0; n < 2; ++n) _Pragma("unroll") for (int k = 0; k < 2; ++k) dst[n][k] = *(const PG8_LAS bf16x8*)(lds + PG8_SB(b, h) + boff + n * 2048 + k * 1024); } while (0)
#define PG8_MMA(ai, bj, At, Bt) do { __builtin_amdgcn_s_setprio(1); _Pragma("unroll") for (int m = 0; m < 4; ++m) _Pragma("unroll") for (int n = 0; n < 2; ++n) _Pragma("unroll") for (int k = 0; k < 2; ++k) \
        acc[ai][bj][m][n] = __builtin_amdgcn_mfma_f32_16x16x32_bf16(Bt[n][k], At[m][k], acc[ai][bj][m][n], 0, 0, 0); __builtin_amdgcn_s_setprio(0); } while (0)
#define PG8_WAIT_V(n) asm volatile("s_waitcnt vmcnt(" #n ")" ::: "memory")
#define PG8_WAIT_L(n) asm volatile("s_waitcnt lgkmcnt(" #n ")" ::: "memory")
#define PG8_BAR __builtin_amdgcn_s_barrier()
#define PG8_SCHED __builtin_amdgcn_sched_barrier(0)
    Unit cur, nxt; int ui = 0;
    if (!S.next(0, cur)) return;
    f32x4 acc[2][2][4][2];
#pragma unroll
    for (int a = 0; a < 2; ++a)
#pragma unroll
        for (int b = 0; b < 2; ++b)
#pragma unroll
            for (int m = 0; m < 4; ++m)
#pragma unroll
                for (int n = 0; n < 2; ++n) acc[a][b][m][n] = (f32x4){0.f, 0.f, 0.f, 0.f};
    bf16x8 At[4][2], B0[2][2], B1[2][2];
    const char* cA = (const char*)g.A + (size_t)cur.pm * tstep; const char* cB = (const char*)g.Bt + (size_t)cur.pn * tstep;
    S.a_ready(cur);
    if constexpr (SP2) {
        PG8_STAGE(PG8_SB(0, 0), cB, voffB); PG8_STAGE(PG8_SB(0, 1), cB + hstep, voffB); PG8_STAGE(PG8_SA(0, 0), cA, voffA); PG8_STAGE(PG8_SA(0, 1), cA + hstep, voffA);
        if (wr == 1) PG8_BAR;
        PG8_WAIT_V(2); PG8_BAR;
        PG8_STAGE(PG8_SB(1, 0), cB + kstep, voffB); PG8_STAGE(PG8_SA(1, 0), cA + kstep, voffA); PG8_STAGE(PG8_SB(1, 1), cB + hstep + kstep, voffB);
        PG8_WAIT_V(6); PG8_BAR;
    } else {
        PG8_STAGE(PG8_SB(0, 0), cB, voffB); PG8_STAGE(PG8_SA(0, 0), cA, voffA); PG8_STAGE(PG8_SB(0, 1), cB + hstep, voffB); PG8_STAGE(PG8_SA(0, 1), cA + hstep, voffA);
        if (wr == 1) PG8_BAR;
        PG8_WAIT_V(4); PG8_BAR;
        PG8_STAGE(PG8_SB(1, 0), cB + kstep, voffB); PG8_STAGE(PG8_SA(1, 0), cA + kstep, voffA); PG8_STAGE(PG8_SB(1, 1), cB + hstep + kstep, voffB);
        PG8_WAIT_V(6); PG8_BAR;
    }
    for (;;) {
        const bool has_next = S.next(ui + 1, nxt);
        const char* nA = has_next ? (const char*)g.A + (size_t)nxt.pm * tstep : cA; const char* nB = has_next ? (const char*)g.Bt + (size_t)nxt.pn * tstep : cB;
        for (int t = 0; t < nt; t += 2) {
            const bool last = (t == nt - 2);
            const char* a1 = cA + (size_t)(t + 1) * kstep;
            const char* a2 = last ? nA : cA + (size_t)(t + 2) * kstep; const char* b2 = last ? nB : cB + (size_t)(t + 2) * kstep;
            const char* a3 = a2 + kstep; const char* b3 = b2 + kstep;
            if (last && has_next) S.a_ready(nxt);
            if constexpr (SP2) {
            PG8_LDB(B0, 0, 0); PG8_LDB(B1, 0, 1); PG8_SCHED; PG8_LDA(At, 0, 0); PG8_STAGE(PG8_SA(1, 1), a1 + hstep, voffA);
            PG8_WAIT_V(8); PG8_WAIT_L(0); PG8_BAR; PG8_MMA(0, 0, At, B0); PG8_MMA(0, 1, At, B1); PG8_BAR; PG8_SCHED;
            PG8_LDA(At, 0, 1); PG8_STAGE(PG8_SB(0, 0), b2, voffB); PG8_STAGE(PG8_SB(0, 1), b2 + hstep, voffB); PG8_STAGE(PG8_SA(0, 0), a2, voffA);
            PG8_WAIT_V(8); PG8_WAIT_L(0); PG8_BAR; PG8_MMA(1, 0, At, B0); PG8_MMA(1, 1, At, B1); PG8_BAR; PG8_SCHED;
            PG8_LDB(B0, 1, 0); PG8_LDB(B1, 1, 1); PG8_SCHED; PG8_LDA(At, 1, 0); PG8_STAGE(PG8_SA(0, 1), a2 + hstep, voffA);
            PG8_WAIT_V(8); PG8_WAIT_L(0); PG8_BAR; PG8_MMA(0, 0, At, B0); PG8_MMA(0, 1, At, B1); PG8_BAR; PG8_SCHED;
            PG8_LDA(At, 1, 1); PG8_STAGE(PG8_SB(1, 0), b3, voffB); PG8_STAGE(PG8_SB(1, 1), b3 + hstep, voffB); PG8_STAGE(PG8_SA(1, 0), a3, voffA);
            PG8_WAIT_V(8); PG8_WAIT_L(0); PG8_BAR; PG8_MMA(1, 0, At, B0); PG8_MMA(1, 1, At, B1); PG8_BAR; PG8_SCHED;
            } else {
            PG8_LDB(B0, 0, 0); PG8_SCHED; PG8_LDA(At, 0, 0); PG8_STAGE(PG8_SA(1, 1), a1 + hstep, voffA);
            PG8_WAIT_L(8); PG8_BAR; PG8_WAIT_L(0); PG8_MMA(0, 0, At, B0); PG8_BAR; PG8_SCHED;
            PG8_LDB(B1, 0, 1); PG8_STAGE(PG8_SB(0, 0), b2, voffB);
            PG8_BAR; PG8_WAIT_L(0); PG8_MMA(0, 1, At, B1); PG8_BAR;
            PG8_LDA(At, 0, 1); PG8_STAGE(PG8_SA(0, 0), a2, voffA);
            PG8_BAR; PG8_WAIT_L(0); PG8_MMA(1, 0, At, B0); PG8_BAR; PG8_SCHED;
            PG8_STAGE(PG8_SB(0, 1), b2 + hstep, voffB);
            PG8_WAIT_V(6); PG8_BAR; PG8_MMA(1, 1, At, B1); PG8_BAR;
            PG8_LDB(B0, 1, 0); PG8_SCHED; PG8_LDA(At, 1, 0); PG8_STAGE(PG8_SA(0, 1), a2 + hstep, voffA);
            PG8_WAIT_L(8); PG8_BAR; PG8_WAIT_L(0); PG8_MMA(0, 0, At, B0); PG8_BAR; PG8_SCHED;
            PG8_LDB(B1, 1, 1); PG8_STAGE(PG8_SB(1, 0), b3, voffB);
            PG8_BAR; PG8_WAIT_L(0); PG8_MMA(0, 1, At, B1); PG8_BAR;
            PG8_LDA(At, 1, 1); PG8_STAGE(PG8_SA(1, 0), a3, voffA);
            PG8_BAR; PG8_WAIT_L(0); PG8_MMA(1, 0, At, B0); PG8_BAR; PG8_SCHED;
            PG8_STAGE(PG8_SB(1, 1), b3 + hstep, voffB);
            PG8_WAIT_V(6); PG8_BAR; PG8_MMA(1, 1, At, B1); PG8_BAR;
            }
        }
        if constexpr (ALIGN_EPI) { if (wr == 0) PG8_BAR; }
        if constexpr (!Epi::AFTER_DRAIN) { E(acc, cur, wr, wc, fr, fq); S.done(cur); }
        if (!has_next) break;
#pragma unroll
        for (int a = 0; a < 2; ++a)
#pragma unroll
            for (int b = 0; b < 2; ++b)
#pragma unroll
                for (int m = 0; m < 4; ++m)
#pragma unroll
                    for (int n = 0; n < 2; ++n) acc[a][b][m][n] = (f32x4){0.f, 0.f, 0.f, 0.f};
        cur = nxt; cA = nA; cB = nB; ++ui;
        if constexpr (ALIGN_EPI) { if (wr == 1) PG8_BAR; }
    }
    PG8_WAIT_V(0);
    if constexpr (!ALIGN_EPI) { if (wr == 0) PG8_BAR; }
    PG8_BAR;
    if constexpr (Epi::AFTER_DRAIN) { E.fused(acc, cur, wr, wc, fr, fq, lds, wid, lane); S.done(cur); }
#undef PG8_SA
#undef PG8_SB
#undef PG8_STAGE
#undef PG8_LDA
#undef PG8_LDB
#undef PG8_MMA
#undef PG8_WAIT_V
#undef PG8_WAIT_L
#undef PG8_BAR
#undef PG8_SCHED
}
}

namespace cg = cooperative_groups;
#ifndef MK_MODE
#define MK_MODE 2
#endif
constexpr int NWAVES = 8;

constexpr int NB = 8, SEQ = 4096, DM = 1024, NL = 2;
constexpr int M = NB * SEQ;
constexpr int PIN = 2688, PINP = 2816;
constexpr int DFF = 2816, DUP = 2 * DFF;
constexpr int DA = 256, DB = 384, DC = 384;
constexpr int NMOD = 6 * DM;
constexpr int PC_OFF = 1280;
constexpr int NPHASE = 22;

constexpr size_t MiB = 1u << 20;
constexpr size_t WS_CTL = 0, CTL_ZERO_BYTES = 64 * 1024;
constexpr size_t WS_SMALL = 1 * MiB;
constexpr size_t SM_SGUW = 0, SM_LRUWA = 256 * 1024, SM_LRUWX = 352 * 1024, SM_RW2 = 448 * 1024, SM_RA2 = 544 * 1024, SM_RG2 = 640 * 1024;
constexpr size_t WS_MOD = 2 * MiB;
constexpr size_t WS_LRUS = 3 * MiB;
constexpr size_t WS_WIN = 4 * MiB, WS_WOUT = 15 * MiB, WS_WUP = 19 * MiB, WS_WDN = 41 * MiB;
constexpr size_t WS_SS = 57 * MiB, WS_SW1 = 60 * MiB, WS_SW2 = 61 * MiB;
constexpr size_t WS_HY = 64 * MiB;
constexpr size_t WS_P = 128 * MiB;
constexpr size_t WS_UV = 304 * MiB;
constexpr size_t WS_R = 304 * MiB, WS_K = 328 * MiB, WS_V = 352 * MiB, WS_KK = 376 * MiB, WS_BV = 400 * MiB;
constexpr size_t WS_LD = 424 * MiB;
constexpr size_t WS_O = 448 * MiB;
constexpr size_t WS_Q2 = 472 * MiB;
constexpr size_t WS_TG = 496 * MiB, WS_HG = 500 * MiB, WS_HV = 504 * MiB;
constexpr size_t WS_END = 512 * MiB;
static_assert(WS_Q2 + (size_t)M * 384 * 2 <= WS_END && WS_UV + (size_t)M * DFF * 2 <= WS_END && WS_P + (size_t)M * PINP * 2 <= WS_UV, "d_ws map");
static_assert(WS_WDN + (size_t)NL * DM * DFF * 2 <= WS_HY && WS_WIN + (size_t)NL * PINP * DM * 2 <= WS_WOUT && WS_WUP + (size_t)NL * DUP * DM * 2 <= WS_WDN, "weights map");
constexpr int CW_BAR = 1024;

constexpr int RING_BYTES = 131072;
constexpr int LDSCTL_OFF = RING_BYTES, MISC_OFF = LDSCTL_OFF + 320;
constexpr int TAIL_OFF = 132096;
constexpr int LDS_BYTES = 147456;

#define GAS __attribute__((address_space(1)))
#define LAS __attribute__((address_space(3)))
typedef unsigned short bf16;
typedef float f32x4 __attribute__((ext_vector_type(4)));
typedef float f32x2 __attribute__((ext_vector_type(2)));
typedef float f32x16 __attribute__((ext_vector_type(16)));
typedef short bf16x8 __attribute__((ext_vector_type(8)));
typedef unsigned u32x2 __attribute__((ext_vector_type(2)));
typedef unsigned u32x4 __attribute__((ext_vector_type(4)));
typedef GAS unsigned gu32;
#define RLX_AGENT __ATOMIC_RELAXED, __HIP_MEMORY_SCOPE_AGENT

__device__ __forceinline__ float bflo(unsigned w) { return __builtin_bit_cast(float, w << 16); }
__device__ __forceinline__ float bfhi(unsigned w) { return __builtin_bit_cast(float, w & 0xffff0000u); }
__device__ __forceinline__ float bf1(bf16 u) { return __builtin_bit_cast(float, (unsigned)u << 16); }
__device__ __forceinline__ unsigned pk2(float lo, float hi) { return pg8::cvt_pk_bf16(lo, hi); }
__device__ __forceinline__ bf16 f2bf(float f) { return (bf16)(pg8::cvt_pk_bf16(f, f) & 0xffffu); }
__device__ __forceinline__ f32x4 unpack4(u32x2 w) { return (f32x4){bflo(w.x), bfhi(w.x), bflo(w.y), bfhi(w.y)}; }
__device__ __forceinline__ u32x2 pack4(f32x4 v) { u32x2 w; w.x = pk2(v[0], v[1]); w.y = pk2(v[2], v[3]); return w; }

__device__ __forceinline__ float fexp(float x) { return __builtin_amdgcn_exp2f(x * 1.4426950408889634f); }
__device__ __forceinline__ float flog(float x) { return __builtin_amdgcn_logf(x) * 0.6931471805599453f; }
__device__ __forceinline__ float fsigmoid(float x) { return __builtin_amdgcn_rcpf(1.f + fexp(-x)); }
__device__ __forceinline__ float fgelu(float x) { const float y = 1.5957691216f * x * (1.f + 0.044715f * x * x); return x * fsigmoid(y); }
__device__ __forceinline__ float fsilu(float x) { return x * fsigmoid(x); }
__device__ __forceinline__ float fsoftplus(float x) { return fmaxf(x, 0.f) + flog(1.f + fexp(-fabsf(x))); }
__device__ __forceinline__ float fsoftplus_acc(float x) { return fmaxf(x, 0.f) + log1pf(expf(-fabsf(x))); }
__device__ __forceinline__ float ftanh(float x) { return 1.f - 2.f * __builtin_amdgcn_rcpf(1.f + fexp(2.f * x)); }
__device__ __forceinline__ float fnegexpm1(float x) {
    const float ser = -x * (1.f + x * (0.5f + x * (0.16666667f + x * (0.041666668f + x * (0.008333334f + x * 0.0013888889f)))));
    return x > -0.25f ? ser : 1.f - fexp(x);
}
__device__ __forceinline__ int opaque_tid() { int t = threadIdx.x; asm volatile("" : "+v"(t)); return t; }
template <int CTRL> __device__ __forceinline__ float dppf(float x) { return __builtin_bit_cast(float, __builtin_amdgcn_mov_dpp(__builtin_bit_cast(int, x), CTRL, 0xf, 0xf, true)); }
__device__ __forceinline__ float red16(float p) { p += dppf<0xB1>(p); p += dppf<0x4E>(p); p += dppf<0x141>(p); p += dppf<0x128>(p); return p; }
__device__ __forceinline__ float wave_sum(float v) { return pg8::xrow16_sum(red16(v)); }
#define XB_TMO      128
#define XB_XCNT(j)  (256  + 64 * (j))
#define XB_XSUB(j)  (1280 + 64 * (j))
#define XB_XGEN(j)  (2304 + 64 * (j))
#define XB_TOP      3328
#define XB_TOPGEN   3392
#define XCD_BAR_WORDS 3456
#define XB_SPIN_CAP (1u << 18)

__device__ __forceinline__ unsigned xb_ld(unsigned* p)              { return __hip_atomic_load(p, __ATOMIC_RELAXED, __HIP_MEMORY_SCOPE_AGENT); }
__device__ __forceinline__ unsigned xb_add(unsigned* p, unsigned v) { return __hip_atomic_fetch_add(p, v, __ATOMIC_RELAXED, __HIP_MEMORY_SCOPE_AGENT); }
__device__ __forceinline__ unsigned xb_xcc_id() { return (unsigned)__builtin_amdgcn_s_getreg((3 << 11) | 20) & 0xFu; }
#define XB_SPIN(cond, bar) do { unsigned _sp = 0; while (cond) { __builtin_amdgcn_s_sleep(1); \
    if ((++_sp & 255u) == 0u) { if (xb_ld(&(bar)[XB_TMO])) break; if (_sp > XB_SPIN_CAP) { atomicAdd(&(bar)[XB_TMO], 1u); break; } } } } while (0)

struct XcdBarrier {
    unsigned* bar; unsigned x;
    volatile LAS unsigned* st;
};

__device__ __forceinline__ XcdBarrier xcd_barrier_post(unsigned* bar, volatile LAS unsigned* st) {
    XcdBarrier b; b.bar = bar; b.x = xb_xcc_id(); b.st = st;
    if (threadIdx.x == 0) (void)xb_add(&bar[XB_XCNT(b.x)], 1u);
    return b;
}
__device__ __forceinline__ void xcd_barrier_complete(unsigned* bar, unsigned x, unsigned& nloc, unsigned& nx) {
    const unsigned G = gridDim.x * gridDim.y * gridDim.z;
    unsigned sum, cnt, mine, sp = 0u;
    for (;;) {
        sum = 0u; cnt = 0u; mine = 0u;
#pragma unroll
        for (unsigned j = 0; j < 16; ++j) { const unsigned c = xb_ld(&bar[XB_XCNT(j)]); sum += c; cnt += (c > 0u) ? 1u : 0u; mine = (j == x) ? c : mine; }
        if (sum == G) break;
        __builtin_amdgcn_s_sleep(1);
        if ((++sp & 255u) == 0u) { if (xb_ld(&bar[XB_TMO])) break; if (sp > XB_SPIN_CAP) { atomicAdd(&bar[XB_TMO], 1u); break; } }
    }
    nloc = mine > 0u ? mine : 1u; nx = cnt > 0u ? cnt : 1u;
}

__device__ __forceinline__ void xcd_barrier(const XcdBarrier& b) {
    asm volatile("s_waitcnt vmcnt(0)" ::: "memory");
    __syncthreads();
    if (threadIdx.x == 0) {
        unsigned* bar = b.bar;
        __builtin_amdgcn_s_waitcnt(0);
        unsigned nloc = b.st[0], nx = b.st[1];
        if (nloc == 0u) { xcd_barrier_complete(bar, b.x, nloc, nx); b.st[0] = nloc; b.st[1] = nx; }
        const unsigned old = xb_add(&bar[XB_XSUB(b.x)], 1u);
        const unsigned gen = old / nloc;
        if (old + 1u == (gen + 1u) * nloc) {
            __builtin_amdgcn_fence(__ATOMIC_RELEASE, "agent");
            asm volatile("s_waitcnt vmcnt(0)" ::: "memory");
            const unsigned og = xb_add(&bar[XB_TOP], 1u);
            const unsigned tg = og / nx;
            if (og + 1u == (tg + 1u) * nx) xb_add(&bar[XB_TOPGEN], 1u);
            else XB_SPIN(xb_ld(&bar[XB_TOPGEN]) == tg, bar);
            __builtin_amdgcn_fence(__ATOMIC_ACQUIRE, "agent");
            xb_add(&bar[XB_XGEN(b.x)], 1u);
            asm volatile("s_waitcnt vmcnt(0)" ::: "memory");
        } else {
            XB_SPIN(xb_ld(&bar[XB_XGEN(b.x)]) == gen, bar);
            __builtin_amdgcn_fence(__ATOMIC_ACQUIRE, "agent");
            asm volatile("s_waitcnt vmcnt(0)" ::: "memory");
        }
    }
    __syncthreads();
}

struct Frame {
    LAS unsigned char* lds;
    volatile LAS unsigned* MISC;
    gu32* ctl;
    int wave, vcu, G;
    const float *x, *c, *w_mod, *b_mod, *norm_mix, *w_in, *w_out, *sgu_ln_g, *sgu_ln_b, *sgu_w, *sgu_b, *lru_conv_w, *lru_conv_b, *lru_w_a, *lru_b_a, *lru_w_x, *lru_b_x, *lru_lambda,
        *rwkv_mu, *rwkv_w0, *rwkv_w2, *rwkv_a0, *rwkv_a2, *rwkv_g2, *rwkv_k_k, *rwkv_k_a, *rwkv_r_k, *rwkv_ln_w, *rwkv_ln_b, *norm_ffn, *ffn_w_up, *ffn_conv_w, *ffn_conv_b, *ffn_w_down, *norm_final;
    float* out;
    bf16 *SGUW, *LRUWA, *LRUWX, *RW2, *RA2, *RG2;
    float *MOD, *LRUSA, *LRUSH;
    bf16 *WIN, *WOUT, *WUP, *WDN;
    bf16 *HY, *P, *UG, *UV, *R, *K, *V, *KK, *BV, *Q2, *O, *LD;
    float *TG, *HG, *HV;
    float *SS, *SW1, *SW2;
};

__device__ __forceinline__ void p0_transpose_item(const float* W, int K, int N, bf16* WT, int k0, int n0, int drow0, LAS float* scr, int lane) {
#pragma unroll 8
    for (int i = 0; i < 32; ++i) { const int kk = 2 * i + (lane >> 5); scr[kk * 33 + (lane & 31)] = W[(size_t)(k0 + kk) * N + n0 + (lane & 31)]; }
    asm volatile("s_waitcnt lgkmcnt(0)" ::: "memory");
    const int c = lane & 7;
#pragma unroll
    for (int j = 0; j < 4; ++j) { const int n = (lane >> 3) + 8 * j; const LAS float* s = scr + (8 * c) * 33 + n;
        u32x4 o; o.x = pk2(s[0 * 33], s[1 * 33]); o.y = pk2(s[2 * 33], s[3 * 33]); o.z = pk2(s[4 * 33], s[5 * 33]); o.w = pk2(s[6 * 33], s[7 * 33]);
        *(u32x4*)(WT + (size_t)(drow0 + n) * K + k0 + 8 * c) = o; }
    asm volatile("s_waitcnt lgkmcnt(0)" ::: "memory");
}
__device__ __forceinline__ void p0_prologue(Frame& F) {
    const int tid = opaque_tid(), lane = tid & 63, wave = F.wave;
    const int gw = F.vcu * NWAVES + wave, NGW = F.G * NWAVES;
    const int gt = F.vcu * (NWAVES * 64) + tid, NGT = F.G * NWAVES * 64;
    if (F.vcu < 192) {
        LAS float* cact = (LAS float*)(F.lds + 73728);
        LAS float* red = (LAS float*)(F.lds + 106496);
        for (int i = tid; i < NB * DM; i += NWAVES * 64) { const float cv = F.c[i]; cact[i] = cv * fsigmoid(cv); }
        __syncthreads();
        const int l = F.vcu / 96, n0 = (F.vcu % 96) * 64;
        const float* wm = F.w_mod + ((size_t)l * DM + 128 * wave) * NMOD + n0 + lane;
        float acc[NB];
#pragma unroll
        for (int b = 0; b < NB; ++b) acc[b] = 0.f;
        for (int k4 = 0; k4 < 128; k4 += 4) {
            const float w0 = wm[(size_t)(k4 + 0) * NMOD], w1 = wm[(size_t)(k4 + 1) * NMOD], w2 = wm[(size_t)(k4 + 2) * NMOD], w3 = wm[(size_t)(k4 + 3) * NMOD];
#pragma unroll
            for (int b = 0; b < NB; ++b) { const f32x4 cv = *(const LAS f32x4*)(cact + b * DM + 128 * wave + k4); acc[b] += cv[0] * w0 + cv[1] * w1 + cv[2] * w2 + cv[3] * w3; }
        }
#pragma unroll
        for (int b = 0; b < NB; ++b) red[(wave * NB + b) * 64 + lane] = acc[b];
        __syncthreads();
        { const int b = tid >> 6, col = tid & 63; float s = F.b_mod[l * NMOD + n0 + col];
#pragma unroll
          for (int w = 0; w < NWAVES; ++w) s += red[(w * NB + b) * 64 + col];
          F.MOD[(size_t)(l * NB + b) * NMOD + n0 + col] = s; }
        __syncthreads();
    }
    {
        LAS float* scr = (LAS float*)(F.lds + wave * 9216);
        constexpr int I_IN = (DM / 64) * (PIN / 32), I_OUT = (DM / 64) * (DM / 32), I_UP = (DM / 64) * (DUP / 32), I_DN = (DFF / 64) * (DM / 32);
        constexpr int PER_L = I_IN + I_OUT + I_UP + I_DN;
        for (int it = gw; it < NL * PER_L; it += NGW) {
            const int l = it / PER_L; int r = it % PER_L;
            if (r < I_IN) { const int nblk = PIN / 32, kb = r / nblk, nb = r % nblk; p0_transpose_item(F.w_in + (size_t)l * DM * PIN, DM, PIN, F.WIN + (size_t)l * PINP * DM, 64 * kb, 32 * nb, 32 * nb, scr, lane); continue; } r -= I_IN;
            if (r < I_OUT) { const int nblk = DM / 32, kb = r / nblk, nb = r % nblk; p0_transpose_item(F.w_out + (size_t)l * DM * DM, DM, DM, F.WOUT + (size_t)l * DM * DM, 64 * kb, 32 * nb, 32 * nb, scr, lane); continue; } r -= I_OUT;
            if (r < I_UP) { const int nblk = DUP / 32, kb = r / nblk, nb = r % nblk; const int n0 = 32 * nb, isv = n0 >= DFF ? 1 : 0, j = n0 - isv * DFF, drow = (j / 128) * 256 + isv * 128 + (j % 128);
                p0_transpose_item(F.ffn_w_up + (size_t)l * DM * DUP, DM, DUP, F.WUP + (size_t)l * DUP * DM, 64 * kb, n0, drow, scr, lane); continue; } r -= I_UP;
            { const int nblk = DM / 32, kb = r / nblk, nb = r % nblk; p0_transpose_item(F.ffn_w_down + (size_t)l * DFF * DM, DFF, DM, F.WDN + (size_t)l * DM * DFF, 64 * kb, 32 * nb, 32 * nb, scr, lane); }
        }
        for (int i = gt; i < NL * (PINP - PIN) * DM / 8; i += NGT) { const int l = i / ((PINP - PIN) * DM / 8), o = i % ((PINP - PIN) * DM / 8);
            *(u32x4*)(F.WIN + (size_t)l * PINP * DM + (size_t)PIN * DM + (size_t)o * 8) = (u32x4){0u, 0u, 0u, 0u}; }
    }
    for (int i = gt; i < NL * 4 * 128 * 128; i += NGT) { const int s = i & 127, t = (i >> 7) & 127; F.SGUW[i] = s <= t ? f2bf(F.sgu_w[i]) : (bf16)0; }
    for (int i = gt; i < NL * 6 * 64 * 64; i += NGT) { const int ii = i & 63, j = (i >> 6) & 63, lh = i >> 12;
        F.LRUWA[i] = f2bf(F.lru_w_a[(size_t)lh * 4096 + ii * 64 + j]); F.LRUWX[i] = f2bf(F.lru_w_x[(size_t)lh * 4096 + ii * 64 + j]); }
    for (int i = gt; i < NL * 384 * 64; i += NGT) { const int k = i & 63, n = (i >> 6) % 384, l = i / (384 * 64);
        F.RW2[i] = f2bf(F.rwkv_w2[(size_t)l * 64 * 384 + k * 384 + n]); F.RA2[i] = f2bf(F.rwkv_a2[(size_t)l * 64 * 384 + k * 384 + n]); }
    for (int i = gt; i < NL * 384 * 128; i += NGT) { const int k = i & 127, n = (i >> 7) % 384, l = i / (384 * 128);
        F.RG2[i] = f2bf(F.rwkv_g2[(size_t)l * 128 * 384 + k * 384 + n]); }
}

__device__ __forceinline__ void norm_mod_phase(Frame& F, const float* X, const float* gamma, const float* mod_l, int sh_idx, int sc_idx, bf16* H) {
    const int gw = F.vcu * NWAVES + F.wave, NGW = F.G * NWAVES, lane = opaque_tid() & 63;
    f32x4 g[4], nx[4];
#pragma unroll
    for (int j = 0; j < 4; ++j) g[j] = *(const f32x4*)(gamma + 4 * (lane + 64 * j));
    if (gw < M) {
#pragma unroll
        for (int j = 0; j < 4; ++j) nx[j] = ((const f32x4*)(X + (size_t)gw * DM) + lane)[64 * j];
    }
    for (int m = gw; m < M; m += NGW) {
        f32x4 v[4]; float s = 0.f;
#pragma unroll
        for (int j = 0; j < 4; ++j) { v[j] = nx[j]; s += (v[j][0] * v[j][0] + v[j][1] * v[j][1]) + (v[j][2] * v[j][2] + v[j][3] * v[j][3]); }
        if (m + NGW < M) {
#pragma unroll
            for (int j = 0; j < 4; ++j) nx[j] = ((const f32x4*)(X + (size_t)(m + NGW) * DM) + lane)[64 * j];
        }
        const float* mb = mod_l + (size_t)(m >> 12) * NMOD;
        f32x4 sc[4], sh[4];
#pragma unroll
        for (int j = 0; j < 4; ++j) { const int c = 4 * (lane + 64 * j); sc[j] = *(const f32x4*)(mb + sc_idx * DM + c); sh[j] = *(const f32x4*)(mb + sh_idx * DM + c); }
        const float rstd = __builtin_amdgcn_rsqf(wave_sum(s) * (1.f / DM) + 1e-6f);
        u32x2* o8 = (u32x2*)(H + (size_t)m * DM) + lane;
#pragma unroll
        for (int j = 0; j < 4; ++j) { const f32x4 y = (v[j] * rstd) * g[j] * (sc[j] + 1.f) + sh[j]; o8[64 * j] = pack4(y); }
    }
}
__device__ __forceinline__ void final_norm_phase(Frame& F, float* X, const float* gamma) {
    const int gw = F.vcu * NWAVES + F.wave, NGW = F.G * NWAVES, lane = opaque_tid() & 63;
    f32x4 g[4], nx[4];
#pragma unroll
    for (int j = 0; j < 4; ++j) g[j] = *(const f32x4*)(gamma + 4 * (lane + 64 * j));
    if (gw < M) {
#pragma unroll
        for (int j = 0; j < 4; ++j) nx[j] = ((const f32x4*)(X + (size_t)gw * DM) + lane)[64 * j];
    }
    for (int m = gw; m < M; m += NGW) {
        f32x4 v[4]; float s = 0.f;
#pragma unroll
        for (int j = 0; j < 4; ++j) { v[j] = nx[j]; s += (v[j][0] * v[j][0] + v[j][1] * v[j][1]) + (v[j][2] * v[j][2] + v[j][3] * v[j][3]); }
        if (m + NGW < M) {
#pragma unroll
            for (int j = 0; j < 4; ++j) nx[j] = ((const f32x4*)(X + (size_t)(m + NGW) * DM) + lane)[64 * j];
        }
        const float rstd = __builtin_amdgcn_rsqf(wave_sum(s) * (1.f / DM) + 1e-6f);
        f32x4* xr = (f32x4*)(X + (size_t)m * DM) + lane;
#pragma unroll
        for (int j = 0; j < 4; ++j) xr[64 * j] = (v[j] * rstd) * g[j];
    }
}

__device__ __forceinline__ void norm0_phase(Frame& F, const float* X, const float* gamma, const float* mod_l, int sc_idx, bf16* XS) {
    const int gw = F.vcu * NWAVES + F.wave, NGW = F.G * NWAVES, lane = opaque_tid() & 63;
    f32x4 g[4], nx[4];
#pragma unroll
    for (int j = 0; j < 4; ++j) g[j] = *(const f32x4*)(gamma + 4 * (lane + 64 * j));
    if (gw < M) {
#pragma unroll
        for (int j = 0; j < 4; ++j) nx[j] = ((const f32x4*)(X + (size_t)gw * DM) + lane)[64 * j];
    }
    for (int m = gw; m < M; m += NGW) {
        f32x4 v[4]; float s = 0.f;
#pragma unroll
        for (int j = 0; j < 4; ++j) { v[j] = nx[j]; s += (v[j][0] * v[j][0] + v[j][1] * v[j][1]) + (v[j][2] * v[j][2] + v[j][3] * v[j][3]); }
        if (m + NGW < M) {
#pragma unroll
            for (int j = 0; j < 4; ++j) nx[j] = ((const f32x4*)(X + (size_t)(m + NGW) * DM) + lane)[64 * j];
        }
        const float* mb = mod_l + (size_t)(m >> 12) * NMOD + sc_idx * DM;
        f32x4 sc[4];
#pragma unroll
        for (int j = 0; j < 4; ++j) sc[j] = *(const f32x4*)(mb + 4 * (lane + 64 * j));
        const float tot = wave_sum(s);
        u32x2* o8 = (u32x2*)(XS + (size_t)m * DM) + lane;
#pragma unroll
        for (int j = 0; j < 4; ++j) o8[64 * j] = pack4(v[j] * g[j] * (sc[j] + 1.f));
        if (lane < 4) *(f32x4*)(F.SS + (size_t)m * 16 + 4 * lane) = (f32x4){lane == 0 ? tot : 0.f, 0.f, 0.f, 0.f};
    }
}
__device__ __forceinline__ void sw_phase(Frame& F) {
    const int tid = opaque_tid(), lane = tid & 63;
    const int gw = F.vcu * NWAVES + F.wave, NGW = F.G * NWAVES;
    LAS float* shl = (LAS float*)F.lds;
    for (int i = tid; i < NL * 2 * NB * DM / 4; i += NWAVES * 64) { const int e = 4 * i, k = e & 1023, b = (e >> 10) & 7, wh = (e >> 13) & 1, l = e >> 14;
        *(LAS f32x4*)(shl + e) = *(const f32x4*)(F.MOD + (size_t)(l * NB + b) * NMOD + (wh ? 3 : 0) * DM + k); }
    __syncthreads();
    constexpr int NT = NL * (PINP + DUP);
    for (int t = gw; t < NT; t += NGW) {
        const int l = t / (PINP + DUP), r = t - l * (PINP + DUP), wh = r >= PINP ? 1 : 0, n = r - wh * PINP;
        const bf16* wrow = (wh ? F.WUP + ((size_t)l * DUP + n) * DM : F.WIN + ((size_t)l * PINP + n) * DM) + 16 * lane;
        const u32x4 wa = *(const u32x4*)(wrow), wb = *(const u32x4*)(wrow + 8);
        float w[16] = {bflo(wa.x), bfhi(wa.x), bflo(wa.y), bfhi(wa.y), bflo(wa.z), bfhi(wa.z), bflo(wa.w), bfhi(wa.w), bflo(wb.x), bfhi(wb.x), bflo(wb.y), bfhi(wb.y), bflo(wb.z), bfhi(wb.z), bflo(wb.w), bfhi(wb.w)};
        float res = 0.f;
#pragma unroll
        for (int b = 0; b < NB; ++b) { const LAS float* sp = shl + ((l * 2 + wh) * NB + b) * DM + 16 * lane; float a = 0.f;
#pragma unroll
            for (int j = 0; j < 4; ++j) { const f32x4 sv = *(const LAS f32x4*)(sp + 4 * j); a += (sv[0] * w[4 * j] + sv[1] * w[4 * j + 1]) + (sv[2] * w[4 * j + 2] + sv[3] * w[4 * j + 3]); }
            a = wave_sum(a); if (lane == b) res = a; }
        if (lane < NB) { float* dst = wh ? F.SW2 + ((size_t)(l * NB + lane)) * DUP + n : F.SW1 + ((size_t)(l * NB + lane)) * PINP + n; *dst = res; }
    }
    __syncthreads();
}

__device__ __forceinline__ void final_scale_phase(Frame& F, const bf16* XS, float* out) {
    const int gw = F.vcu * NWAVES + F.wave, NGW = F.G * NWAVES, lane = opaque_tid() & 63;
    u32x2 nx[4]; float nss = 0.f;
#define FS_LOAD(m_) do { _Pragma("unroll") for (int j = 0; j < 4; ++j) nx[j] = ((const u32x2*)(XS + (size_t)(m_) * DM) + lane)[64 * j]; nss = F.SS[(size_t)(m_) * 16 + (lane & 15)]; } while (0)
    if (gw < M) FS_LOAD(gw);
    for (int m = gw; m < M; m += NGW) {
        u32x2 v[4];
#pragma unroll
        for (int j = 0; j < 4; ++j) v[j] = nx[j];
        const float ss = nss;
        if (m + NGW < M) FS_LOAD(m + NGW);
        const float rstd = __builtin_amdgcn_rsqf(red16(ss) * (1.f / DM) + 1e-6f);
        f32x4* o = (f32x4*)(out + (size_t)m * DM) + lane;
#pragma unroll
        for (int j = 0; j < 4; ++j) o[64 * j] = unpack4(v[j]) * rstd;
    }
#undef FS_LOAD
}

#define LDS_BAR() do { asm volatile("s_waitcnt lgkmcnt(0)" ::: "memory"); __builtin_amdgcn_s_barrier(); asm volatile("" ::: "memory"); } while (0)
template <int PARTS  >
__device__ __forceinline__ void mix_chunk(Frame& F, const int l, const int ch) {
    const int wave = F.wave;
    const int n = ch & 31; const size_t r0 = (size_t)ch * 128;
    const bf16* P = F.P; bf16* Y = F.HY;
    LAS unsigned char* lds = F.lds;
#ifndef MK_MIXDUP
#define MK_MIXDUP 0
#endif
    if (PARTS & 1) for (int mrep = 0; mrep <= ((MK_MIXDUP) & 1); ++mrep) {
        if (mrep) LDS_BAR();
        const int tid = opaque_tid(), lane = tid & 63, r = lane & 31, hh = lane >> 5;
        LAS bf16* VT = (LAS bf16*)lds;
        LAS f32x2* ST = (LAS f32x2*)(lds + 69632);
        const int t = tid & 127, q = __builtin_amdgcn_readfirstlane(tid >> 7);
        const bf16* src = P + (r0 + t) * PINP + 256 + 64 * q;
        float v[64]; float s = 0.f, ss = 0.f;
#pragma unroll
        for (int i = 0; i < 8; ++i) { const u32x4 w = *(const u32x4*)(src + 8 * i);
            const float e0 = fgelu(bflo(w.x)), e1 = fgelu(bfhi(w.x)), e2 = fgelu(bflo(w.y)), e3 = fgelu(bfhi(w.y)), e4 = fgelu(bflo(w.z)), e5 = fgelu(bfhi(w.z)), e6 = fgelu(bflo(w.w)), e7 = fgelu(bfhi(w.w));
            v[8 * i + 0] = e0; v[8 * i + 1] = e1; v[8 * i + 2] = e2; v[8 * i + 3] = e3; v[8 * i + 4] = e4; v[8 * i + 5] = e5; v[8 * i + 6] = e6; v[8 * i + 7] = e7;
            s += ((e0 + e1) + (e2 + e3)) + ((e4 + e5) + (e6 + e7)); ss += ((e0 * e0 + e1 * e1) + (e2 * e2 + e3 * e3)) + ((e4 * e4 + e5 * e5) + (e6 * e6 + e7 * e7)); }
        ST[q * 128 + t] = (f32x2){s, ss};
        LDS_BAR();
        const f32x2 a0 = ST[t], a1 = ST[128 + t], a2 = ST[256 + t], a3 = ST[384 + t];
        const float mean = ((a0.x + a1.x) + (a2.x + a3.x)) * (1.f / 256.f), ex2 = ((a0.y + a1.y) + (a2.y + a3.y)) * (1.f / 256.f);
        const float rstd = __builtin_amdgcn_rsqf(fmaxf(ex2 - mean * mean, 0.f) + 1e-5f);
        const float* lg = F.sgu_ln_g + l * DA + 64 * q; const float* lb = F.sgu_ln_b + l * DA + 64 * q;
#pragma unroll
        for (int i = 0; i < 64; ++i) VT[(64 * q + i) * 136 + t] = f2bf((v[i] - mean) * rstd * lg[i] + lb[i]);
        LDS_BAR();
        const int h = wave >> 1, dh = wave & 1;
        const bf16* Wg = F.SGUW + (size_t)(l * 4 + h) * 128 * 128;
        const LAS bf16* vrow = VT + (64 * h + 32 * dh + r) * 136 + 8 * hh;
#pragma unroll 1
        for (int tb = 0; tb < 4; ++tb) {
            f32x16 acc;
#pragma unroll
            for (int i = 0; i < 16; ++i) acc[i] = 0.f;
            const bf16* wrow = Wg + (size_t)(32 * tb + r) * 128 + 8 * hh;
#pragma unroll 2
            for (int ks = 0; ks < 2 * (tb + 1); ++ks) {
                const bf16x8 a = *(const LAS bf16x8*)(vrow + 16 * ks);
                const bf16x8 b = *(const bf16x8*)(wrow + 16 * ks);
                acc = __builtin_amdgcn_mfma_f32_32x32x16_bf16(a, b, acc, 0, 0, 0);
            }
            const int tt = 32 * tb + r; const size_t row = r0 + tt;
            const float bias = F.sgu_b[(l * 4 + h) * 128 + tt];
            u32x2 uq[4];
#pragma unroll
            for (int g = 0; g < 4; ++g) uq[g] = *(const u32x2*)(P + row * PINP + 64 * h + 32 * dh + 8 * g + 4 * hh);
#pragma unroll
            for (int g = 0; g < 4; ++g) { const int c4 = 64 * h + 32 * dh + 8 * g + 4 * hh;
                const f32x4 u = unpack4(uq[g]);
                f32x4 y; y[0] = fgelu(u[0]) * (acc[4 * g + 0] + bias); y[1] = fgelu(u[1]) * (acc[4 * g + 1] + bias); y[2] = fgelu(u[2]) * (acc[4 * g + 2] + bias); y[3] = fgelu(u[3]) * (acc[4 * g + 3] + bias);
                *(u32x2*)(Y + row * DM + c4) = pack4(y); }
        }
    }
    LDS_BAR();
    if (PARTS & 2) for (int mrep = 0; mrep <= (((MK_MIXDUP) >> 1) & 1); ++mrep) {
        if (mrep) LDS_BAR();
        const int tid = opaque_tid(), lane = tid & 63, r = lane & 31, hh = lane >> 5;
        LAS bf16* XC = (LAS bf16*)lds;
        LAS float* LA = (LAS float*)(lds + 25088);
        LAS float* BT = (LAS float*)(lds + 25088 + 49152);
        const int q = tid % 96, rs = tid / 96, c4 = 4 * q; const bool act = tid < DB;
        f32x4 cw0, cw1, cw2, cw3, cb, bra, bix, sp8;
        { cw0 = *(const f32x4*)(F.lru_conv_w + (l * 4 + 0) * DB + c4); cw1 = *(const f32x4*)(F.lru_conv_w + (l * 4 + 1) * DB + c4); cw2 = *(const f32x4*)(F.lru_conv_w + (l * 4 + 2) * DB + c4); cw3 = *(const f32x4*)(F.lru_conv_w + (l * 4 + 3) * DB + c4);
          cb = *(const f32x4*)(F.lru_conv_b + l * DB + c4); bra = *(const f32x4*)(F.lru_b_a + l * DB + c4); bix = *(const f32x4*)(F.lru_b_x + l * DB + c4);
          const f32x4 lam = *(const f32x4*)(F.lru_lambda + l * DB + c4);
#pragma unroll
          for (int e = 0; e < 4; ++e) sp8[e] = -8.f * fsoftplus_acc(-lam[e]); }
        float hst = 0.f, ca = 1.f;
        for (int tq = 0; tq < 4; ++tq) {
            if (act) {
                const bf16* src = P + (r0 + 32 * tq + 8 * rs) * PINP + 512 + c4;
                u32x2 raw[11];
                const bool hashalo = (n > 0) || (tq > 0) || (rs > 0);
#pragma unroll
                for (int i = 0; i < 11; ++i) raw[i] = (i >= 3 || hashalo) ? *(const u32x2*)(src + (ptrdiff_t)(i - 3) * PINP) : (u32x2){0u, 0u};
                f32x4 x3 = unpack4(raw[0]), x2 = unpack4(raw[1]), x1 = unpack4(raw[2]);
#pragma unroll
                for (int i = 0; i < 8; ++i) { const f32x4 x0 = unpack4(raw[3 + i]);
                    const f32x4 xc = cb + cw0 * x3 + cw1 * x2 + cw2 * x1 + cw3 * x0; x3 = x2; x2 = x1; x1 = x0;
                    *(LAS u32x2*)(XC + (8 * rs + i) * 392 + c4) = pack4(xc); }
            }
            LDS_BAR();
            for (int k = 0; k < 3; ++k) {
                const int id = wave + 8 * k, mat = id / 12, hb = (id % 12) >> 1, jt = id & 1;
                const bf16* Wt = (mat ? F.LRUWX : F.LRUWA) + (size_t)((l * 6 + hb) * 64 + 32 * jt + r) * 64 + 8 * hh;
                const LAS bf16* xrow = XC + r * 392 + 64 * hb + 8 * hh;
                f32x16 acc;
#pragma unroll
                for (int i = 0; i < 16; ++i) acc[i] = 0.f;
#pragma unroll
                for (int ks = 0; ks < 4; ++ks) { const bf16x8 a = *(const LAS bf16x8*)(xrow + 16 * ks); const bf16x8 b = *(const bf16x8*)(Wt + 16 * ks);
                    acc = __builtin_amdgcn_mfma_f32_32x32x16_bf16(a, b, acc, 0, 0, 0); }
                LAS float* dst = (mat ? BT : LA) + 64 * hb + 32 * jt + r;
#pragma unroll
                for (int rg = 0; rg < 16; ++rg) dst[((rg & 3) + 8 * (rg >> 2) + 4 * hh) * DB] = acc[rg];
            }
            LDS_BAR();
            if (act) {
#pragma unroll 2
                for (int i = 0; i < 8; ++i) { const int tl = rs + 4 * i;
                    const f32x4 rp = *(const LAS f32x4*)(LA + tl * DB + c4) + bra, ip = *(const LAS f32x4*)(BT + tl * DB + c4) + bix;
                    const f32x4 xc = unpack4(*(const LAS u32x2*)(XC + tl * 392 + c4));
                    f32x4 av, bv;
#pragma unroll
                    for (int e = 0; e < 4; ++e) { const float la = sp8[e] * fsigmoid(rp[e]); av[e] = fexp(la);
                        bv[e] = __builtin_amdgcn_sqrtf(fmaxf(fnegexpm1(2.f * la), 0.f)) * (fsigmoid(ip[e]) * xc[e]); }
                    *(LAS f32x4*)(LA + tl * DB + c4) = av; *(LAS f32x4*)(BT + tl * DB + c4) = bv; }
            }
            LDS_BAR();
            if (act) {
#pragma unroll 8
                for (int i = 0; i < 32; ++i) { const float a = LA[i * DB + tid], bt = BT[i * DB + tid]; hst = a * hst + bt; ca *= a; LA[i * DB + tid] = hst; BT[i * DB + tid] = ca; }
            }
            LDS_BAR();
            if (act) {
                u32x2 yg[8];
#pragma unroll
                for (int i = 0; i < 8; ++i) yg[i] = *(const u32x2*)(P + (r0 + 32 * tq + rs + 4 * i) * PINP + 896 + c4);
#pragma unroll
                for (int i = 0; i < 8; ++i) { const int tl = rs + 4 * i; const size_t row = r0 + 32 * tq + tl;
                    const f32x4 h4 = *(const LAS f32x4*)(LA + tl * DB + c4), ca4 = *(const LAS f32x4*)(BT + tl * DB + c4), y4 = unpack4(yg[i]);
                    f32x4 gl; gl[0] = fgelu(y4[0]); gl[1] = fgelu(y4[1]); gl[2] = fgelu(y4[2]); gl[3] = fgelu(y4[3]);
                    *(u32x2*)(Y + row * DM + 256 + c4) = pack4(gl * h4); *(u32x2*)(F.Q2 + row * DB + c4) = pack4(gl * ca4); }
            }
        }
        if (act) { F.LRUSA[(size_t)ch * DB + tid] = ca; F.LRUSH[(size_t)ch * DB + tid] = hst; }
    }
    LDS_BAR();
    if (PARTS & 4) for (int mrep = 0; mrep <= (((MK_MIXDUP) >> 2) & 1); ++mrep) {
        if (mrep) LDS_BAR();
        const int tid = opaque_tid(), lane = tid & 63, r = lane & 31, hh = lane >> 5;
        LAS bf16* TW = (LAS bf16*)lds;
        LAS bf16* XA = TW + 32 * 72;
        LAS bf16* SG = XA + 32 * 72;
        LAS float* LW = (LAS float*)(lds + 17920);
        LAS bf16* LAa = (LAS bf16*)(lds + 67072);
        LAS bf16* LG = (LAS bf16*)(lds + 91648);
        const float* mu = F.rwkv_mu + l * 1408;
        const int q = tid % 96, rs = tid / 96, n4 = 4 * q; const bool act3 = tid < 384;
        f32x4 p_mr, p_mk, p_mv, p_w0, p_a0, p_kk, p_ka;
        { p_mr = *(const f32x4*)(mu + n4); p_mk = *(const f32x4*)(mu + 384 + n4); p_mv = *(const f32x4*)(mu + 768 + n4);
          p_w0 = *(const f32x4*)(F.rwkv_w0 + l * DC + n4); p_a0 = *(const f32x4*)(F.rwkv_a0 + l * DC + n4); p_kk = *(const f32x4*)(F.rwkv_k_k + l * DC + n4); p_ka = *(const f32x4*)(F.rwkv_k_a + l * DC + n4); }
        const bf16* pc = P + PC_OFF + 1152 + 4 * lane; const f32x4 mu4 = *(const f32x4*)(mu + 1152 + 4 * lane);
        LAS bf16* c1dst = lane < 16 ? TW + 4 * lane : (lane < 32 ? XA + 4 * (lane - 16) : SG + 4 * (lane - 32));
        const int c1stride = lane < 32 ? 72 : 136;
#ifndef MK_CDUP
#define MK_CDUP 0
#endif
        for (int tb = 0; tb < 4; ++tb) {
            for (int c12 = 0; c12 <= ((MK_CDUP) & 1); ++c12) {
            if (c12) LDS_BAR();
            {
                const int t0 = 32 * tb + 4 * wave;
                f32x4 prev = (f32x4){0.f, 0.f, 0.f, 0.f};
                if (t0 > 0 || n > 0) prev = unpack4(*(const u32x2*)(pc + (r0 + t0 - 1) * PINP));
#pragma unroll
                for (int i = 0; i < 4; ++i) {
                    const f32x4 cur = unpack4(*(const u32x2*)(pc + (r0 + t0 + i) * PINP));
                    const f32x4 xs = cur + (prev - cur) * mu4; prev = cur;
                    f32x4 y;
#pragma unroll
                    for (int e = 0; e < 4; ++e) y[e] = lane < 16 ? ftanh(xs[e]) : (lane < 32 ? xs[e] : fsigmoid(xs[e]));
                    *(LAS u32x2*)(c1dst + (4 * wave + i) * c1stride) = pack4(y); }
            }
            LDS_BAR();
            for (int u = wave; u < 36; u += 8) {
                const int lora = u < 12 ? 0 : (u < 24 ? 1 : 2), nt = u - 12 * lora;
                f32x16 acc;
#pragma unroll
                for (int i = 0; i < 16; ++i) acc[i] = 0.f;
                const int nrow = 32 * nt + r;
                if (lora == 0) { const bf16* wr = F.RG2 + ((size_t)l * 384 + nrow) * 128 + 8 * hh; const LAS bf16* xr = SG + r * 136 + 8 * hh;
#pragma unroll
                    for (int ks = 0; ks < 8; ++ks) acc = __builtin_amdgcn_mfma_f32_32x32x16_bf16(*(const LAS bf16x8*)(xr + 16 * ks), *(const bf16x8*)(wr + 16 * ks), acc, 0, 0, 0);
                } else { const bf16* wr = (lora == 1 ? F.RW2 : F.RA2) + ((size_t)l * 384 + nrow) * 64 + 8 * hh; const LAS bf16* xr = (lora == 1 ? TW : XA) + r * 72 + 8 * hh;
#pragma unroll
                    for (int ks = 0; ks < 4; ++ks) acc = __builtin_amdgcn_mfma_f32_32x32x16_bf16(*(const LAS bf16x8*)(xr + 16 * ks), *(const bf16x8*)(wr + 16 * ks), acc, 0, 0, 0);
                }
                if (lora == 1) { LAS float* d = LW + 32 * nt + r;
#pragma unroll
                    for (int rg = 0; rg < 16; ++rg) d[((rg & 3) + 8 * (rg >> 2) + 4 * hh) * 384] = acc[rg];
                } else { LAS bf16* d = (lora == 0 ? LG : LAa) + 32 * nt + r;
#pragma unroll
                    for (int rg = 0; rg < 16; ++rg) d[((rg & 3) + 8 * (rg >> 2) + 4 * hh) * 384] = f2bf(acc[rg]); }
            }
            LDS_BAR();
            }
            for (int c3r = 0; c3r <= (((MK_CDUP) >> 1) & 1); ++c3r)
            if (act3) {
                struct RowIn { u32x2 rc, kc, vc, rp, kp, vp; };
#define C3_LOAD(T, i) do { const int t_ = 32 * tb + rs + 4 * (i); const bf16* prow_ = P + (r0 + t_) * PINP + PC_OFF + n4; T.rc = *(const u32x2*)(prow_); T.kc = *(const u32x2*)(prow_ + 384); T.vc = *(const u32x2*)(prow_ + 768); \
        if (t_ > 0 || n > 0) { T.rp = *(const u32x2*)(prow_ - PINP); T.kp = *(const u32x2*)(prow_ - PINP + 384); T.vp = *(const u32x2*)(prow_ - PINP + 768); } else { T.rp = (u32x2){0u, 0u}; T.kp = T.rp; T.vp = T.rp; } } while (0)
                RowIn rin[2];
                C3_LOAD(rin[0], 0);
#pragma unroll
                for (int i = 0; i < 8; ++i) {
                    if (i + 1 < 8) C3_LOAD(rin[(i + 1) & 1], i + 1);
                    const RowIn& T = rin[i & 1];
                    const int tl = rs + 4 * i; const size_t row = r0 + 32 * tb + tl;
                    f32x4 rc = unpack4(T.rc), kc = unpack4(T.kc), vc = unpack4(T.vc);
                    const f32x4 rp = unpack4(T.rp), kp = unpack4(T.kp), vp = unpack4(T.vp);
                    rc = rc + (rp - rc) * p_mr; kc = kc + (kp - kc) * p_mk; vc = vc + (vp - vc) * p_mv;
                    const f32x4 lw = *(const LAS f32x4*)(LW + tl * 384 + n4), la = unpack4(*(const LAS u32x2*)(LAa + tl * 384 + n4));
                    const u32x2 lg = *(const LAS u32x2*)(LG + tl * 384 + n4);
                    const f32x4 kr = kc * p_kk;
                    const float ss = red16((kr[0] * kr[0] + kr[1] * kr[1]) + (kr[2] * kr[2] + kr[3] * kr[3]));
                    const float rn = __builtin_amdgcn_rsqf(fmaxf(ss, 1e-24f));
                    f32x4 dec, km, kk4, bv4;
#pragma unroll
                    for (int e = 0; e < 4; ++e) {
                        const float wv = -fsoftplus(-(p_w0[e] + lw[e])) - 0.5f; dec[e] = -fexp(wv);
                        const float a = fsigmoid(p_a0[e] + la[e]);
                        kk4[e] = kr[e] * rn; bv4[e] = kk4[e] * a;
                        km[e] = kc[e] * (1.f + (a - 1.f) * p_ka[e]); }
                    *(u32x2*)(F.R + row * DC + n4) = pack4(rc); *(u32x2*)(F.K + row * DC + n4) = pack4(km); *(u32x2*)(F.V + row * DC + n4) = pack4(vc);
                    *(u32x2*)(F.LD + row * DC + n4) = pack4(dec); *(u32x2*)(F.KK + row * DC + n4) = pack4(kk4); *(u32x2*)(F.BV + row * DC + n4) = pack4(bv4);
                    *(u32x2*)(Y + row * DM + 640 + n4) = lg;
                }
#undef C3_LOAD
            }
        }
    }
    LDS_BAR();
}

__device__ __forceinline__ void rwkv_scan_item(Frame& F, const int it) {
#define SC_BAR() do { asm volatile("s_waitcnt lgkmcnt(0)" ::: "memory"); __builtin_amdgcn_s_barrier(); asm volatile("" ::: "memory"); } while (0)
    const int tid = opaque_tid();
    const int b = it / 24, h = (it % 24) >> 2, qt = it & 3;
    constexpr int CS = 16;
    constexpr int BUFF = 5 * CS * 64 + CS * 16;
    constexpr int OPF = CS * 16 * 16;
    constexpr int NCK = SEQ / CS;
    LAS float* buf = (LAS float*)F.lds;
    LAS float* opart = buf + 2 * BUFF;
    const size_t base = (size_t)b * SEQ * DC + 64 * h;
    if (tid >= 256) {
        const int lt = tid - 256, st = lt >> 4, q = lt & 15, vst = lt >> 2, vq = lt & 3;
        const size_t go = base + (size_t)st * DC + 4 * q;
        const bf16* gKK = F.KK + go; const bf16* gBV = F.BV + go; const bf16* gK = F.K + go; const bf16* gR = F.R + go; const bf16* gW = F.LD + go;
        const bf16* gV = F.V + base + (size_t)vst * DC + 16 * qt + 4 * vq;
        const int fg = lt >> 6, frow = (lt >> 2) & 15, fqd = lt & 3;
        bf16* gO = F.O + base + 16 * qt + (size_t)(4 * fg + fqd) * DC + frow;
        const bool ldv = lt < CS * 4;
        u32x2 kk0, bv0, k0, r0, v0 = (u32x2){0u, 0u}, kk1, bv1, k1, r1, v1 = (u32x2){0u, 0u}, kk2, bv2, k2, r2, v2 = (u32x2){0u, 0u}, w0, w1, w2;
#define SC_LOAD(S, ck) do { const size_t _o = (size_t)(ck) * CS * DC; kk##S = *(const u32x2*)(gKK + _o); bv##S = *(const u32x2*)(gBV + _o); k##S = *(const u32x2*)(gK + _o); r##S = *(const u32x2*)(gR + _o); \
        w##S = *(const u32x2*)(gW + _o); if (ldv) v##S = *(const u32x2*)(gV + _o); } while (0)
#define SC_STORE(S, bb) do { LAS float* _b = (bb) + st * 64 + 4 * q; *(LAS f32x4*)(_b) = unpack4(kk##S); { const f32x4 ld_ = unpack4(w##S); *(LAS f32x4*)(_b + CS * 64) = (f32x4){fexp(ld_[0]), fexp(ld_[1]), fexp(ld_[2]), fexp(ld_[3])}; } *(LAS f32x4*)(_b + 2 * CS * 64) = unpack4(bv##S); \
        *(LAS f32x4*)(_b + 3 * CS * 64) = unpack4(k##S); *(LAS f32x4*)(_b + 4 * CS * 64) = unpack4(r##S); if (ldv) { const f32x4 vv_ = unpack4(v##S); LAS float* _v = (bb) + 5 * CS * 64 + (4 * vq) * CS + vst; _v[0] = vv_[0]; _v[CS] = vv_[1]; _v[2 * CS] = vv_[2]; _v[3 * CS] = vv_[3]; } } while (0)
#define SC_FLUSH(ckf) do { const LAS f32x4* pp = (const LAS f32x4*)(opart + ((ckf) & 1) * OPF + fg * 1024 + 64 * frow + 16 * fqd); \
        f32x4 sm = (pp[0] + pp[1]) + (pp[2] + pp[3]); \
        _Pragma("unroll") for (int e_ = 0; e_ < 4; ++e_) { float x_ = sm[e_]; x_ += dppf<0xB1>(x_); x_ += dppf<0x4E>(x_); sm[e_] = x_; } \
        gO[(size_t)(ckf) * CS * DC] = f2bf(fqd == 0 ? sm[0] : (fqd == 1 ? sm[1] : (fqd == 2 ? sm[2] : sm[3]))); } while (0)
#define SC_ITER(S, c) do { if ((c) > 0) SC_FLUSH((c) - 1); if ((c) + 1 < NCK) SC_STORE(S, buf + (((c) + 1) & 1) * BUFF); if ((c) + 4 < NCK) SC_LOAD(S, (c) + 4); SC_BAR(); } while (0)
        SC_LOAD(0, 0); SC_LOAD(1, 1); SC_LOAD(2, 2); SC_STORE(0, buf); SC_LOAD(0, 3);
        SC_BAR();
        for (int ck = 0; ck < NCK; ck += 3) {
            SC_ITER(1, ck);
            if (ck + 1 < NCK) SC_ITER(2, ck + 1);
            if (ck + 2 < NCK) SC_ITER(0, ck + 2);
        }
        SC_FLUSH(NCK - 1);
#undef SC_ITER
#undef SC_LOAD
#undef SC_STORE
#undef SC_FLUSH
    } else {
        const int gl = tid & 15, row = tid >> 4;
#define SC_READ(T, cbp, tt) do { T.kk = *(const LAS f32x4*)((cbp) + (tt) * 64 + 4 * gl); T.w = *(const LAS f32x4*)((cbp) + CS * 64 + (tt) * 64 + 4 * gl); T.bb = *(const LAS f32x4*)((cbp) + 2 * CS * 64 + (tt) * 64 + 4 * gl); \
        T.k = *(const LAS f32x4*)((cbp) + 3 * CS * 64 + (tt) * 64 + 4 * gl); T.r = *(const LAS f32x4*)((cbp) + 4 * CS * 64 + (tt) * 64 + 4 * gl); } while (0)
        struct StepIn { f32x4 kk, w, bb, k, r; };
        SC_BAR();
        f32x2 sA = (f32x2){0.f, 0.f}, sB = (f32x2){0.f, 0.f};
        for (int ck = 0; ck < NCK; ++ck) {
            const LAS float* cb = buf + (ck & 1) * BUFF; LAS float* op = opart + (ck & 1) * OPF;
            StepIn sin[3];
            f32x4 vr[4], oq;
#pragma unroll
            for (int j = 0; j < 4; ++j) vr[j] = *(const LAS f32x4*)(cb + 5 * CS * 64 + row * CS + 4 * j);
            SC_READ(sin[0], cb, 0); SC_READ(sin[1], cb, 1);
#pragma unroll
            for (int tt = 0; tt < CS; ++tt) {
                if (tt + 2 < CS) SC_READ(sin[(tt + 2) % 3], cb, tt + 2);
                const StepIn& cur = sin[tt % 3];
                const f32x2 kkA = (f32x2){cur.kk[0], cur.kk[1]}, kkB = (f32x2){cur.kk[2], cur.kk[3]};
                f32x2 d2 = sA * kkA; d2 = sB * kkB + d2;
                const float p = red16(d2[0] + d2[1]);
                const float vv = vr[tt >> 2][tt & 3];
                const f32x2 uA = (f32x2){cur.k[0], cur.k[1]} * vv, uB = (f32x2){cur.k[2], cur.k[3]} * vv;
                sA = sA * (f32x2){cur.w[0], cur.w[1]} + uA; sB = sB * (f32x2){cur.w[2], cur.w[3]} + uB;
                sA = sA - (f32x2){cur.bb[0], cur.bb[1]} * p; sB = sB - (f32x2){cur.bb[2], cur.bb[3]} * p;
                f32x2 o2 = sA * (f32x2){cur.r[0], cur.r[1]}; o2 = sB * (f32x2){cur.r[2], cur.r[3]} + o2;
                oq[tt & 3] = o2[0] + o2[1];
                if ((tt & 3) == 3) *(LAS f32x4*)(op + (tt >> 2) * 1024 + 4 * tid) = oq;
            }
            SC_BAR();
        }
#undef SC_READ
    }
#undef SC_BAR
}
__device__ __forceinline__ void lru_fin_chunk(Frame& F, const int ch) {
    const int tid = opaque_tid(); if (tid >= 384) return;
    const int q = tid % 96, rs = tid / 96, b = ch >> 5, n = ch & 31;
    f32x4 hin = (f32x4){0.f, 0.f, 0.f, 0.f};
    for (int j = 0; j < n; ++j) { const f32x4 a = *(const f32x4*)(F.LRUSA + (size_t)(b * 32 + j) * DB + 4 * q), hh = *(const f32x4*)(F.LRUSH + (size_t)(b * 32 + j) * DB + 4 * q); hin = a * hin + hh; }
    bf16* Y = F.HY;
    for (int t0 = rs; t0 < 128; t0 += 32) {
        u32x2 a1[8], a2[8];
#pragma unroll
        for (int i = 0; i < 8; ++i) { const size_t row = (size_t)ch * 128 + t0 + 4 * i; a1[i] = *(const u32x2*)(Y + row * DM + 256 + 4 * q); a2[i] = *(const u32x2*)(F.Q2 + row * DB + 4 * q); }
#pragma unroll
        for (int i = 0; i < 8; ++i) { const size_t row = (size_t)ch * 128 + t0 + 4 * i; *(u32x2*)(Y + row * DM + 256 + 4 * q) = pack4(unpack4(a1[i]) + unpack4(a2[i]) * hin); }
    }
}
__device__ __forceinline__ void rwkv_fin_phase(Frame& F, const int l) {
    const int gw = F.vcu * NWAVES + F.wave, NGW = F.G * NWAVES, lane = opaque_tid() & 63, sub = lane >> 4, q = lane & 15;
    bf16* Y = F.HY;
    struct FinIn { u32x2 ov, r, k, v, g; };
#define FIN_LOAD(T, idx_) do { const int m_ = (idx_) / 6, h_ = (idx_) - 6 * m_; const size_t o_ = (size_t)m_ * DC + 64 * h_ + 4 * q; T.ov = *(const u32x2*)(F.O + o_); T.r = *(const u32x2*)(F.R + o_); T.k = *(const u32x2*)(F.K + o_); \
        T.v = *(const u32x2*)(F.V + o_); T.g = *(const u32x2*)(Y + (size_t)m_ * DM + 640 + 64 * h_ + 4 * q); } while (0)
    FinIn fin[2];
    constexpr int NIT = (M * 6) / (256 * NWAVES * 4);
    const int idx0 = gw * 4 + sub, stride = NGW * 4;
    if (NGW * 4 * NIT != M * 6) return;
    FIN_LOAD(fin[0], idx0);
#pragma unroll 2
    for (int it = 0; it < NIT; ++it) {
        const int idx = idx0 + it * stride;
        if (it + 1 < NIT) { if (it & 1) FIN_LOAD(fin[0], idx + stride); else FIN_LOAD(fin[1], idx + stride); }
        const FinIn& T = (it & 1) ? fin[1] : fin[0];
        const int m = idx / 6, h = idx - 6 * m; const int n4 = 64 * h + 4 * q;
        const f32x4 ov = unpack4(T.ov);
        const float mean = red16((ov[0] + ov[1]) + (ov[2] + ov[3])) * (1.f / 64.f);
        const f32x4 d = ov - mean;
        const float var = red16((d[0] * d[0] + d[1] * d[1]) + (d[2] * d[2] + d[3] * d[3])) * (1.f / 64.f);
        const float rstd = __builtin_amdgcn_rsqf(var + 64e-5f);
        const f32x4 lw = *(const f32x4*)(F.rwkv_ln_w + l * DC + n4), lb = *(const f32x4*)(F.rwkv_ln_b + l * DC + n4), rk = *(const f32x4*)(F.rwkv_r_k + l * DC + n4);
        const f32x4 r4 = unpack4(T.r), k4 = unpack4(T.k), v4 = unpack4(T.v);
        const f32x4 t4 = r4 * k4 * rk;
        const float bs = red16((t4[0] + t4[1]) + (t4[2] + t4[3]));
        const f32x4 g4 = unpack4(T.g);
        const f32x4 y = ((d * rstd) * lw + lb + v4 * bs) * g4;
        *(u32x2*)(Y + (size_t)m * DM + 640 + n4) = pack4(y);
    }
#undef FIN_LOAD
}
__device__ __forceinline__ void ffn_glu_phase(Frame& F, const int l) {
    constexpr int CG = DFF / 8, SEG = 32, NSEG = M / SEG;
    const int gt = F.vcu * (NWAVES * 64) + opaque_tid(), NGT = F.G * NWAVES * 64;
    for (int id = gt; id < NSEG * CG; id += NGT) {
        const int rsg = id / CG, cg8 = id - rsg * CG; const int col = 8 * cg8; const size_t row0 = (size_t)rsg * SEG;
        float w0[8], w1[8], w2[8], cb[8], x1[8], x2[8];
        { const float* cw = F.ffn_conv_w + (size_t)l * 3 * DFF + col; const float* cbp = F.ffn_conv_b + (size_t)l * DFF + col;
#pragma unroll
          for (int e = 0; e < 8; ++e) { w0[e] = cw[e]; w1[e] = cw[DFF + e]; w2[e] = cw[2 * DFF + e]; cb[e] = cbp[e]; x1[e] = 0.f; x2[e] = 0.f; } }
        if ((row0 & (SEQ - 1)) != 0) {
            const u32x4 a = *(const u32x4*)(F.UG + (row0 - 2) * DFF + col), bq = *(const u32x4*)(F.UG + (row0 - 1) * DFF + col);
            x2[0] = bflo(a.x); x2[1] = bfhi(a.x); x2[2] = bflo(a.y); x2[3] = bfhi(a.y); x2[4] = bflo(a.z); x2[5] = bfhi(a.z); x2[6] = bflo(a.w); x2[7] = bfhi(a.w);
            x1[0] = bflo(bq.x); x1[1] = bfhi(bq.x); x1[2] = bflo(bq.y); x1[3] = bfhi(bq.y); x1[4] = bflo(bq.z); x1[5] = bfhi(bq.z); x1[6] = bflo(bq.w); x1[7] = bfhi(bq.w);
        }
        u32x4 ga[4], va[4], gb[4], vb[4];
#define FF_LOAD(G_, V_, grp) do { _Pragma("unroll") for (int i_ = 0; i_ < 4; ++i_) { G_[i_] = *(const u32x4*)(F.UG + (row0 + 4 * (grp) + i_) * DFF + col); V_[i_] = *(const u32x4*)(F.UV + (row0 + 4 * (grp) + i_) * DFF + col); } } while (0)
#define FF_DO(G_, V_, grp) do { _Pragma("unroll") for (int i_ = 0; i_ < 4; ++i_) { const u32x4 gq = G_[i_], vq = V_[i_]; float x0[8], vv[8], y[8]; \
            x0[0] = bflo(gq.x); x0[1] = bfhi(gq.x); x0[2] = bflo(gq.y); x0[3] = bfhi(gq.y); x0[4] = bflo(gq.z); x0[5] = bfhi(gq.z); x0[6] = bflo(gq.w); x0[7] = bfhi(gq.w); \
            vv[0] = bflo(vq.x); vv[1] = bfhi(vq.x); vv[2] = bflo(vq.y); vv[3] = bfhi(vq.y); vv[4] = bflo(vq.z); vv[5] = bfhi(vq.z); vv[6] = bflo(vq.w); vv[7] = bfhi(vq.w); \
            _Pragma("unroll") for (int e = 0; e < 8; ++e) { const float gc = cb[e] + w0[e] * x2[e] + w1[e] * x1[e] + w2[e] * x0[e]; y[e] = fsilu(gc) * vv[e]; x2[e] = x1[e]; x1[e] = x0[e]; } \
            u32x4 o; o.x = pk2(y[0], y[1]); o.y = pk2(y[2], y[3]); o.z = pk2(y[4], y[5]); o.w = pk2(y[6], y[7]); \
            *(u32x4*)(F.UV + (row0 + 4 * (grp) + i_) * DFF + col) = o; } } while (0)
        FF_LOAD(ga, va, 0);
        for (int grp = 0; grp < SEG / 4; grp += 2) {
            FF_LOAD(gb, vb, grp + 1);
            FF_DO(ga, va, grp);
            if (grp + 2 < SEG / 4) FF_LOAD(ga, va, grp + 2);
            FF_DO(gb, vb, grp + 1);
        }
#undef FF_LOAD
#undef FF_DO
    }
}

__device__ __forceinline__ void ffn_fix_phase(Frame& F, const int l) {
    const int gt = F.vcu * (NWAVES * 64) + opaque_tid(), NGT = F.G * NWAVES * 64;
    constexpr int C4 = DFF / 4, NT = M / 256;
    const float* cw = F.ffn_conv_w + (size_t)l * 3 * DFF; const float* cbp = F.ffn_conv_b + (size_t)l * DFF;
    for (int id = gt; id < NT * C4; id += NGT) {
        const int pm = id / C4, c = 4 * (id - pm * C4);
        if ((pm & 15) == 0) continue;
        const f32x4 w0 = *(const f32x4*)(cw + c), w1 = *(const f32x4*)(cw + DFF + c), w2 = *(const f32x4*)(cw + 2 * DFF + c), cb = *(const f32x4*)(cbp + c);
        const f32x4 gm2 = *(const f32x4*)(F.TG + ((size_t)(pm - 1) * 2 + 0) * DFF + c), gm1 = *(const f32x4*)(F.TG + ((size_t)(pm - 1) * 2 + 1) * DFF + c);
        const f32x4 g0 = *(const f32x4*)(F.HG + ((size_t)pm * 2 + 0) * DFF + c), g1 = *(const f32x4*)(F.HG + ((size_t)pm * 2 + 1) * DFF + c);
        const f32x4 v0 = *(const f32x4*)(F.HV + ((size_t)pm * 2 + 0) * DFF + c), v1 = *(const f32x4*)(F.HV + ((size_t)pm * 2 + 1) * DFF + c);
        f32x4 h0, h1;
#pragma unroll
        for (int e = 0; e < 4; ++e) { const float a = cb[e] + w0[e] * gm2[e] + w1[e] * gm1[e] + w2[e] * g0[e], b = cb[e] + w0[e] * gm1[e] + w1[e] * g0[e] + w2[e] * g1[e];
            h0[e] = fsilu(a) * v0[e]; h1[e] = fsilu(b) * v1[e]; }
        *(u32x2*)(F.UV + ((size_t)pm * 256 + 0) * DFF + c) = pack4(h0); *(u32x2*)(F.UV + ((size_t)pm * 256 + 1) * DFF + c) = pack4(h1);
    }
}

struct Args { const float* in[35]; float* out; unsigned char* ws; int ph_lo, ph_hi; };
__device__ __forceinline__ void frame_init(Frame& F, LAS unsigned char* lds) {
    typedef const __attribute__((address_space(4))) Args* ArgP;
    ArgP ap = (ArgP)__builtin_amdgcn_kernarg_segment_ptr(); asm volatile("" : "+s"(ap));
    F.lds = lds; F.MISC = (volatile LAS unsigned*)(lds + MISC_OFF);
    F.wave = __builtin_amdgcn_readfirstlane(threadIdx.x >> 6);
    F.G = gridDim.x; { const int bx = blockIdx.x; F.vcu = (F.G % 8 == 0) ? (bx % 8) * (F.G / 8) + bx / 8 : bx; }
    unsigned char* ws = ap->ws;
    F.ctl = (gu32*)(ws + WS_CTL);
    F.x = ap->in[0]; F.c = ap->in[1]; F.w_mod = ap->in[2]; F.b_mod = ap->in[3]; F.norm_mix = ap->in[4]; F.w_in = ap->in[5]; F.w_out = ap->in[6];
    F.sgu_ln_g = ap->in[7]; F.sgu_ln_b = ap->in[8]; F.sgu_w = ap->in[9]; F.sgu_b = ap->in[10];
    F.lru_conv_w = ap->in[11]; F.lru_conv_b = ap->in[12]; F.lru_w_a = ap->in[13]; F.lru_b_a = ap->in[14]; F.lru_w_x = ap->in[15]; F.lru_b_x = ap->in[16]; F.lru_lambda = ap->in[17];
    F.rwkv_mu = ap->in[18]; F.rwkv_w0 = ap->in[19]; F.rwkv_w2 = ap->in[20]; F.rwkv_a0 = ap->in[21]; F.rwkv_a2 = ap->in[22]; F.rwkv_g2 = ap->in[23]; F.rwkv_k_k = ap->in[24]; F.rwkv_k_a = ap->in[25];
    F.rwkv_r_k = ap->in[26]; F.rwkv_ln_w = ap->in[27]; F.rwkv_ln_b = ap->in[28]; F.norm_ffn = ap->in[29]; F.ffn_w_up = ap->in[30]; F.ffn_conv_w = ap->in[31]; F.ffn_conv_b = ap->in[32];
    F.ffn_w_down = ap->in[33]; F.norm_final = ap->in[34]; F.out = ap->out;
    F.SGUW = (bf16*)(ws + WS_SMALL + SM_SGUW); F.LRUWA = (bf16*)(ws + WS_SMALL + SM_LRUWA); F.LRUWX = (bf16*)(ws + WS_SMALL + SM_LRUWX);
    F.RW2 = (bf16*)(ws + WS_SMALL + SM_RW2); F.RA2 = (bf16*)(ws + WS_SMALL + SM_RA2); F.RG2 = (bf16*)(ws + WS_SMALL + SM_RG2);
    F.MOD = (float*)(ws + WS_MOD); F.LRUSA = (float*)(ws + WS_LRUS); F.LRUSH = F.LRUSA + 256 * DB;
    F.WIN = (bf16*)(ws + WS_WIN); F.WOUT = (bf16*)(ws + WS_WOUT); F.WUP = (bf16*)(ws + WS_WUP); F.WDN = (bf16*)(ws + WS_WDN);
    F.HY = (bf16*)(ws + WS_HY); F.P = (bf16*)(ws + WS_P); F.UG = (bf16*)(ws + WS_P); F.UV = (bf16*)(ws + WS_UV); F.O = (bf16*)(ws + WS_O);
    F.R = (bf16*)(ws + WS_R); F.K = (bf16*)(ws + WS_K); F.V = (bf16*)(ws + WS_V); F.KK = (bf16*)(ws + WS_KK); F.BV = (bf16*)(ws + WS_BV); F.LD = (bf16*)(ws + WS_LD); F.Q2 = (bf16*)(ws + WS_Q2);
    F.SS = (float*)(ws + WS_SS); F.SW1 = (float*)(ws + WS_SW1); F.SW2 = (float*)(ws + WS_SW2);
    F.TG = (float*)(ws + WS_TG); F.HG = (float*)(ws + WS_HG); F.HV = (float*)(ws + WS_HV);
}
__global__ void __launch_bounds__(NWAVES * 64, 2) mk_fwd(Args args) {
    extern __shared__ __attribute__((aligned(16))) unsigned char lds_raw[];
    LAS unsigned char* const lds = (LAS unsigned char*)lds_raw;
    for (int u = threadIdx.x; u < (LDS_BYTES - LDSCTL_OFF) / 4; u += NWAVES * 64) ((LAS unsigned*)(lds + LDSCTL_OFF))[u] = 0u;
    __syncthreads();
#if MK_MODE == 2
    XcdBarrier bar = xcd_barrier_post((unsigned*)((gu32*)(args.ws + WS_CTL) + CW_BAR), (volatile LAS unsigned*)(lds + MISC_OFF) + 8);
#define GRID_BAR() xcd_barrier(bar)
#elif MK_MODE == 1
    cg::grid_group grid = cg::this_grid();
#define GRID_BAR() grid.sync()
#else
#define GRID_BAR() do { } while (0)
#endif
    const int lo = args.ph_lo, hi = args.ph_hi;
#define IN(k) (lo <= (k) && (k) < hi)
#ifndef MK_PHMASK
#define MK_PHMASK 0xFFF
#endif
#define EN(t) (((MK_PHMASK) >> (t)) & 1)
#ifndef MK_DUPMASK
#define MK_DUPMASK 0
#endif
#define REP2(t) (((MK_DUPMASK) >> (t)) & 1)
#define SEAM(k) do { if (IN(k) && IN((k) + 1)) GRID_BAR(); } while (0)
#define PH_BEGIN(t, k) if (EN(t) && IN(k)) { for (int rep = 0; rep <= REP2(t); ++rep) { if (rep) GRID_BAR(); Frame F; frame_init(F, lds); \
        const float* mod_l = F.MOD + (size_t)l * NB * NMOD; const float* Xin = (l == 0) ? F.x : F.out; (void)mod_l; (void)Xin;
#define PH_END(k) } } SEAM(k);

    { const int l = 0; PH_BEGIN(0, 0) p0_prologue(F); PH_END(0) }
    for (int l = 0; l < NL; ++l) {
        const int pb = 1 + 10 * l;
        if (l == 0) { PH_BEGIN(1, pb + 0) sw_phase(F); norm0_phase(F, F.x, F.norm_mix, mod_l, 1, F.HY); PH_END(pb + 0) }
        PH_BEGIN(2, pb + 1) pg8::Gemm g{F.HY, F.WIN + (size_t)l * PINP * DM, M, PINP, DM}; pg8::StaticOrder S; S.init(M, PINP, F.G, (int)blockIdx.x);
            pg8::EpiBf16N E{F.P, PINP, F.SS, F.SW1 + (size_t)l * NB * PINP, PINP, SEQ};
            pg8::gemm_phase<pg8::EpiBf16N, pg8::StaticOrder, true, true>(F.lds, g, S, E); PH_END(pb + 1)
        PH_BEGIN(3, pb + 2) for (int ch = F.vcu; ch < M / 128; ch += F.G) mix_chunk<4>(F, l, ch); PH_END(pb + 2)
        PH_BEGIN(4, pb + 3)
            if (F.G >= 256) { if (F.vcu < 192) rwkv_scan_item(F, F.vcu); else if (rep == 0) for (int ch = F.vcu - 192; ch < M / 128; ch += F.G - 192) mix_chunk<3>(F, l, ch); }
            else { for (int it = F.vcu; it < 192; it += F.G) { rwkv_scan_item(F, it); __syncthreads(); } if (rep == 0) for (int ch = F.vcu; ch < M / 128; ch += F.G) mix_chunk<3>(F, l, ch); }
        PH_END(pb + 3)
        PH_BEGIN(5, pb + 4) for (int ch = F.vcu; ch < M / 128; ch += F.G) lru_fin_chunk(F, ch); rwkv_fin_phase(F, l); PH_END(pb + 4)
        PH_BEGIN(6, pb + 5) pg8::Gemm g{F.HY, F.WOUT + (size_t)l * DM * DM, M, DM, DM}; pg8::StaticOrder S; S.init(M, DM, F.G, (int)blockIdx.x);
            pg8::EpiResNorm E{Xin, F.out, DM, mod_l + 2 * DM, NMOD, SEQ, F.P, F.norm_ffn + l * DM, mod_l + 4 * DM, F.SS};
            pg8::gemm_phase<pg8::EpiResNorm, pg8::StaticOrder, true, true>(F.lds, g, S, E); PH_END(pb + 5)
        PH_BEGIN(8, pb + 7) pg8::Gemm g{F.P, F.WUP + (size_t)l * DUP * DM, M, DUP, DM}; pg8::StaticOrder S; S.init(M, DUP, F.G, (int)blockIdx.x);
            pg8::EpiGLU E{F.UV, DFF, F.ffn_conv_w + (size_t)l * 3 * DFF, F.ffn_conv_b + (size_t)l * DFF, F.TG, F.HG, F.HV, (LAS float*)(F.lds + TAIL_OFF), F.SS, F.SW2 + (size_t)l * NB * DUP, DUP, SEQ};
            pg8::gemm_phase<pg8::EpiGLU, pg8::StaticOrder, true, true>(F.lds, g, S, E); PH_END(pb + 7)
        PH_BEGIN(9, pb + 8) ffn_fix_phase(F, l); PH_END(pb + 8)
        PH_BEGIN(10, pb + 9) pg8::Gemm g{F.UV, F.WDN + (size_t)l * DM * DFF, M, DM, DFF}; pg8::StaticOrder S; S.init(M, DM, F.G, (int)blockIdx.x);
            if (l + 1 < NL) { pg8::EpiResNorm E{F.out, F.out, DM, mod_l + 5 * DM, NMOD, SEQ, F.HY, F.norm_mix + (l + 1) * DM, mod_l + (size_t)NB * NMOD + 1 * DM, F.SS};
                pg8::gemm_phase<pg8::EpiResNorm, pg8::StaticOrder, true, true>(F.lds, g, S, E); }
            else { pg8::EpiResNorm E{F.out, nullptr, DM, mod_l + 5 * DM, NMOD, SEQ, F.HY, F.norm_final, nullptr, F.SS};
                pg8::gemm_phase<pg8::EpiResNorm, pg8::StaticOrder, true, true>(F.lds, g, S, E); } PH_END(pb + 9)
    }
    { const int l = 0; PH_BEGIN(11, NPHASE - 1) final_scale_phase(F, F.HY, F.out); PH_END(NPHASE - 1) }
#undef IN
#undef SEAM
}

extern "C" void kernel_launch(void* const* d_in, const int* in_sizes, int n_in, void* d_out, int out_size, void* d_ws, size_t ws_size, hipStream_t stream) {
    static int grid = 0;
    if (grid == 0) {
        if (n_in != 35 || in_sizes[0] != M * DM || out_size != M * DM || ws_size < WS_END) { fprintf(stderr, "kernel_launch: unexpected shapes (n_in %d, in0 %d, out %d, ws %zu); nothing launched\n", n_in, n_in > 0 ? in_sizes[0] : -1, out_size, ws_size); grid = -1; return; }
        int dev = 0, cus = 0, per_cu = 0;
        if (hipGetDevice(&dev) != hipSuccess || hipDeviceGetAttribute(&cus, hipDeviceAttributeMultiprocessorCount, dev) != hipSuccess) { grid = -1; return; }
        if (hipFuncSetAttribute((const void*)mk_fwd, hipFuncAttributeMaxDynamicSharedMemorySize, LDS_BYTES) != hipSuccess) { fprintf(stderr, "kernel_launch: hipFuncSetAttribute failed\n"); grid = -1; return; }
        if (hipOccupancyMaxActiveBlocksPerMultiprocessor(&per_cu, (const void*)mk_fwd, NWAVES * 64, LDS_BYTES) != hipSuccess || per_cu < 1) { fprintf(stderr, "kernel_launch: occupancy query says %d blocks per CU\n", per_cu); per_cu = 1; }
        (void)hipGetLastError();
        grid = cus;
    }
    if (grid < 0) return;
    Args a{};
    for (int i = 0; i < 35; ++i) a.in[i] = (const float*)d_in[i];
    a.out = (float*)d_out; a.ws = (unsigned char*)d_ws;
#if MK_MODE == 0
    for (int ph = 0; ph < NPHASE; ++ph) { a.ph_lo = ph; a.ph_hi = ph + 1; hipLaunchKernelGGL(mk_fwd, dim3(grid), dim3(NWAVES * 64), LDS_BYTES, stream, a); }
#else
    (void)hipMemsetAsync((char*)d_ws + WS_CTL, 0, CTL_ZERO_BYTES, stream);
    a.ph_lo = 0; a.ph_hi = NPHASE;
#if MK_MODE == 1
    void* kargs[] = {&a};
    hipError_t e = hipLaunchCooperativeKernel((const void*)mk_fwd, dim3(grid), dim3(NWAVES * 64), kargs, LDS_BYTES, stream);
    if (e != hipSuccess) fprintf(stderr, "kernel_launch: cooperative launch failed: %s (grid %d)\n", hipGetErrorString(e), grid);
#else
    hipLaunchKernelGGL(mk_fwd, dim3(grid), dim3(NWAVES * 64), LDS_BYTES, stream, a);
#endif
#endif
}
```

```cpp
#include <hip/hip_runtime.h>
#include <hip/hip_cooperative_groups.h>
#include <cstdio>
#include <cstdint>
namespace pg8 {
#define PG8_LAS __attribute__((address_space(3)))
typedef unsigned short bf16_t;
typedef short bf16x8 __attribute__((ext_vector_type(8)));
typedef float f32x4 __attribute__((ext_vector_type(4)));
typedef unsigned u32x4 __attribute__((ext_vector_type(4)));
constexpr int BM = 256, BK = 64, HALF = 128, HTB = HALF * BK * 2  , STAGE_BYTES = 8 * HTB, NXCD = 8, WGM = 8;

__host__ __device__ __forceinline__ int lds_byte(int r, int c) { const int st = (r >> 4) * 2 + (c >> 5), rr = r & 15, cc = c & 31, ob = rr * 64 + cc * 2; return st * 1024 + (ob ^ (((ob >> 9) & 1) << 5)); }
__host__ __device__ __forceinline__ void stage_rc(int b, int& R, int& C) { const int st = b / 1024, sb = b % 1024, swz = sb ^ (((sb >> 9) & 1) << 5); R = (st >> 1) * 16 + swz / 64; C = (st & 1) * 32 + (swz % 64) / 2; }
__host__ __device__ __forceinline__ int perm32(int rho) { const int n = rho >> 4, i = rho & 15; return 8 * (i >> 2) + 4 * n + (i & 3); }

struct Unit { int pm, pn; };
struct Gemm { const bf16_t* A; const bf16_t* Bt; int M, N, K; };

struct StaticOrder {
    int nM, nN, nwg, G, c;
    __host__ __device__ void init(int M, int N, int G_, int c_) { nM = M / BM; nN = N / BM; nwg = nM * nN; G = G_; c = c_; }
    __host__ __device__ __forceinline__ bool next(int i, Unit& u) const {
        const long L = (long)i * G + c; if (L >= nwg) return false;
        int wgid = (int)L; { const int q = nwg / NXCD, r = nwg % NXCD, xcd = wgid % NXCD, off = wgid / NXCD; wgid = (xcd < r ? xcd * (q + 1) : r * (q + 1) + (xcd - r) * q) + off; }
        const int nig = WGM * nN, gid = wgid / nig, fm = gid * WGM, gsz = (nM - fm) < WGM ? (nM - fm) : WGM;
        u.pm = fm + ((wgid % nig) % gsz); u.pn = (wgid % nig) / gsz; return true;
    }
    __device__ __forceinline__ void a_ready(const Unit&) const {}
    __device__ __forceinline__ void done(const Unit&) const {}
};

__device__ __forceinline__ unsigned cvt_pk_bf16(float lo, float hi) { unsigned r; asm volatile("v_cvt_pk_bf16_f32 %0, %1, %2" : "=v"(r) : "v"(lo), "v"(hi)); return r; }
typedef float f32x2 __attribute__((ext_vector_type(2)));
__device__ __forceinline__ f32x2 gelu_pk(f32x2 v) {
    const f32x2 av = __builtin_elementwise_abs(v), d = av * 0.2316418882f + 1.0f;
    f32x2 t; t.x = __builtin_amdgcn_rcpf(d.x); t.y = __builtin_amdgcn_rcpf(d.y);
    f32x2 q = t * 0.5307027145f + (-0.7265760135f); q = q * t + 0.7107068705f; q = q * t + (-0.142248368f); q = q * t + 0.127414796f; q = q * t;
    const f32x2 s = (v * v) * (-0.72134752044f);
    f32x2 e; e.x = __builtin_amdgcn_exp2f(s.x); e.y = __builtin_amdgcn_exp2f(s.y);
    const f32x2 m = v * (q * e), r = v - m;
    f32x2 o; o.x = v.x < 0.f ? m.x : r.x; o.y = v.y < 0.f ? m.y : r.y; return o;
}

template <int ACT  > struct EpiBf16 {
    static constexpr bool PERM = true, AFTER_DRAIN = false; static_assert(ACT == 0 || ACT == 1, "EpiBf16: ACT is 0 (none) or 1 (gelu_pk)");
    bf16_t* O; int ldc; const float* bias; int split_cols; size_t split_stride; float scale0;
    __device__ __forceinline__ void operator()(const f32x4 (&acc)[2][2][4][2], const Unit& u, int wr, int wc, int fr, int fq) const {
        const int row0 = u.pm * BM + wr * 64 + fr; int colt = u.pn * BM; bf16_t* base = O;
        float sc = 1.f; if (split_cols) { const int t = colt / split_cols; base += (size_t)t * split_stride; colt -= t * split_cols; if (t == 0) sc = scale0; }
        const int col0 = colt + wc * 32 + 8 * fq, bcol0 = u.pn * BM + wc * 32 + 8 * fq;
        f32x4 bv[2][2];
#pragma unroll
        for (int bj = 0; bj < 2; ++bj)
#pragma unroll
            for (int n = 0; n < 2; ++n) bv[bj][n] = bias ? *(const f32x4*)(bias + bcol0 + bj * HALF + 4 * n) : (f32x4){0.f, 0.f, 0.f, 0.f};
#pragma unroll
        for (int ai = 0; ai < 2; ++ai)
#pragma unroll
            for (int m = 0; m < 4; ++m) { bf16_t* rowp = base + (size_t)(row0 + ai * HALF + m * 16) * ldc + col0;
#pragma unroll
                for (int bj = 0; bj < 2; ++bj) { f32x4 v0 = acc[ai][bj][m][0] + bv[bj][0], v1 = acc[ai][bj][m][1] + bv[bj][1];
                    if (ACT == 1) { f32x2 a = gelu_pk((f32x2){v0[0], v0[1]}), b = gelu_pk((f32x2){v0[2], v0[3]}), c = gelu_pk((f32x2){v1[0], v1[1]}), d = gelu_pk((f32x2){v1[2], v1[3]});
                        v0 = (f32x4){a.x, a.y, b.x, b.y}; v1 = (f32x4){c.x, c.y, d.x, d.y}; }
                    v0 = v0 * sc; v1 = v1 * sc; u32x4 w; w.x = cvt_pk_bf16(v0[0], v0[1]); w.y = cvt_pk_bf16(v0[2], v0[3]); w.z = cvt_pk_bf16(v1[0], v1[1]); w.w = cvt_pk_bf16(v1[2], v1[3]);
                    *(u32x4*)(rowp + bj * HALF) = w; } }
    }
};

typedef unsigned u32x2v __attribute__((ext_vector_type(2)));

struct EpiRes {
    static constexpr bool PERM = false, AFTER_DRAIN = false;
    const float* base; float* out; int ldc; const float* gate; int gate_ld; int rows_per_batch;
    __device__ __forceinline__ void operator()(const f32x4 (&acc)[2][2][4][2], const Unit& u, int wr, int wc, int fr, int fq) const {
        asm volatile("" : "+v"(fr), "+v"(fq));
        const int row0 = u.pm * BM + wr * 64 + fr, col0 = u.pn * BM + wc * 32 + 4 * fq;
        const float* gp = gate + (size_t)((u.pm * BM) / rows_per_batch) * gate_ld + col0;
        f32x4 gv[2][2];
#pragma unroll
        for (int bj = 0; bj < 2; ++bj)
#pragma unroll
            for (int n = 0; n < 2; ++n) gv[bj][n] = *(const f32x4*)(gp + bj * HALF + n * 16);
        f32x4 pre[3][2][2];
#define ER_LOAD(slot, g_) do { const size_t off_ = (size_t)(row0 + ((g_) >> 2) * HALF + ((g_) & 3) * 16) * ldc + col0; _Pragma("unroll") for (int bj = 0; bj < 2; ++bj) _Pragma("unroll") for (int n = 0; n < 2; ++n) pre[slot][bj][n] = *(const f32x4*)(base + off_ + bj * HALF + n * 16); } while (0)
        ER_LOAD(0, 0); ER_LOAD(1, 1);
#pragma unroll
        for (int g = 0; g < 8; ++g) { const int ai = g >> 2, m = g & 3; const size_t off = (size_t)(row0 + ai * HALF + m * 16) * ldc + col0;
            if (g + 2 < 8) ER_LOAD((g + 2) % 3, g + 2);
#pragma unroll
            for (int bj = 0; bj < 2; ++bj)
#pragma unroll
                for (int n = 0; n < 2; ++n) *(f32x4*)(out + off + bj * HALF + n * 16) = pre[g % 3][bj][n] + gv[bj][n] * acc[ai][bj][m][n]; }
#undef ER_LOAD
    }
};
struct EpiGV {
    static constexpr bool PERM = true, AFTER_DRAIN = false;
    bf16_t* G; bf16_t* V; int ldc;
    __device__ __forceinline__ void operator()(const f32x4 (&acc)[2][2][4][2], const Unit& u, int wr, int wc, int fr, int fq) const {
        const int row0 = u.pm * BM + wr * 64 + fr, col0 = u.pn * HALF + wc * 32 + 8 * fq;
#pragma unroll
        for (int ai = 0; ai < 2; ++ai)
#pragma unroll
            for (int m = 0; m < 4; ++m) { const size_t off = (size_t)(row0 + ai * HALF + m * 16) * ldc + col0;
#pragma unroll
                for (int bj = 0; bj < 2; ++bj) { const f32x4 v0 = acc[ai][bj][m][0], v1 = acc[ai][bj][m][1];
                    u32x4 w; w.x = cvt_pk_bf16(v0[0], v0[1]); w.y = cvt_pk_bf16(v0[2], v0[3]); w.z = cvt_pk_bf16(v1[0], v1[1]); w.w = cvt_pk_bf16(v1[2], v1[3]);
                    *(u32x4*)((bj ? V : G) + off) = w; } }
    }
};

__device__ __forceinline__ float xrow16_sum(float x) {
    auto s = __builtin_amdgcn_permlane16_swap(__float_as_uint(x), __float_as_uint(x), false, false);
    x = __uint_as_float(s[0]) + __uint_as_float(s[1]);
    auto t = __builtin_amdgcn_permlane32_swap(__float_as_uint(x), __float_as_uint(x), false, false);
    return __uint_as_float(t[0]) + __uint_as_float(t[1]);
}
__device__ __forceinline__ void load_rstd8(const float* SS, int row0, int fq, float inv_n, float eps, float (&rstd)[8]) {
    f32x4 p[8];
#pragma unroll
    for (int g = 0; g < 8; ++g) p[g] = *(const f32x4*)(SS + (size_t)(row0 + (g >> 2) * HALF + (g & 3) * 16) * 16 + 4 * fq);
#pragma unroll
    for (int g = 0; g < 8; ++g) rstd[g] = __builtin_amdgcn_rsqf(xrow16_sum((p[g][0] + p[g][1]) + (p[g][2] + p[g][3])) * inv_n + eps);
}
template <bool BASEB>
struct EpiResNormT {
    static constexpr bool PERM = true, AFTER_DRAIN = false;
    const void* base; bf16_t* out; int ldc; const float* gate; int gate_ld; int rows_per_batch; bf16_t* XS; const float* gamma; const float* sc; float* SS;
    __device__ __forceinline__ void operator()(const f32x4 (&acc)[2][2][4][2], const Unit& u, int wr, int wc, int fr, int fq) const {
        asm volatile("" : "+v"(fr), "+v"(fq));
        const int row0 = u.pm * BM + wr * 64 + fr, col0 = u.pn * BM + wc * 32 + 8 * fq;
        const int b = (u.pm * BM) / rows_per_batch;
        const float* gp = gate + (size_t)b * gate_ld + col0; const float* sp = sc + (size_t)b * gate_ld + col0;
        f32x4 gv[2][2], gs[2][2];
#pragma unroll
        for (int bj = 0; bj < 2; ++bj)
#pragma unroll
            for (int n = 0; n < 2; ++n) { gv[bj][n] = *(const f32x4*)(gp + bj * HALF + n * 4); gs[bj][n] = *(const f32x4*)(gamma + col0 + bj * HALF + n * 4); if (sc) gs[bj][n] = gs[bj][n] * (*(const f32x4*)(sp + bj * HALF + n * 4) + 1.f); }
        f32x4 pre[2][2][2]; u32x4 preb[2][2];
#define ER_LOAD(slot, g_) do { const size_t off_ = (size_t)(row0 + ((g_) >> 2) * HALF + ((g_) & 3) * 16) * ldc + col0; _Pragma("unroll") for (int bj = 0; bj < 2; ++bj) { \
        if (BASEB) preb[slot][bj] = *(const u32x4*)((const bf16_t*)base + off_ + bj * HALF); else { _Pragma("unroll") for (int n = 0; n < 2; ++n) pre[slot][bj][n] = *(const f32x4*)((const float*)base + off_ + bj * HALF + n * 4); } } } while (0)
        ER_LOAD(0, 0);
#pragma unroll
        for (int g = 0; g < 8; ++g) { const int ai = g >> 2, m = g & 3; const size_t off = (size_t)(row0 + ai * HALF + m * 16) * ldc + col0;
            if (g + 1 < 8) ER_LOAD((g + 1) & 1, g + 1);
            float ssq = 0.f;
#pragma unroll
            for (int bj = 0; bj < 2; ++bj) { u32x4 w, wo;
#pragma unroll
                for (int n = 0; n < 2; ++n) {
                    f32x4 bs;
                    if (BASEB) { const unsigned w0 = n == 0 ? preb[g & 1][bj].x : preb[g & 1][bj].z, w1 = n == 0 ? preb[g & 1][bj].y : preb[g & 1][bj].w;
                        bs = (f32x4){__uint_as_float(w0 << 16), __uint_as_float(w0 & 0xffff0000u), __uint_as_float(w1 << 16), __uint_as_float(w1 & 0xffff0000u)}; }
                    else bs = pre[g & 1][bj][n];
                    const f32x4 o = bs + gv[bj][n] * acc[ai][bj][m][n];
                    if (n == 0) { wo.x = cvt_pk_bf16(o[0], o[1]); wo.y = cvt_pk_bf16(o[2], o[3]); } else { wo.z = cvt_pk_bf16(o[0], o[1]); wo.w = cvt_pk_bf16(o[2], o[3]); }
                    const f32x4 xs = o * gs[bj][n];
                    if (n == 0) { w.x = cvt_pk_bf16(xs[0], xs[1]); w.y = cvt_pk_bf16(xs[2], xs[3]); } else { w.z = cvt_pk_bf16(xs[0], xs[1]); w.w = cvt_pk_bf16(xs[2], xs[3]); }
                    ssq += (o[0] * o[0] + o[1] * o[1]) + (o[2] * o[2] + o[3] * o[3]); }
                if (out) *(u32x4*)(out + off + bj * HALF) = wo;
                *(u32x4*)(XS + off + bj * HALF) = w; }
            ssq = xrow16_sum(ssq);
            if (fq == 0) SS[(size_t)(row0 + ai * HALF + m * 16) * 16 + 4 * u.pn + wc] = ssq; }
#undef ER_LOAD
    }
};
struct EpiBf16N {
    static constexpr bool PERM = true, AFTER_DRAIN = false;
    bf16_t* O; int ldc; const float* SS; const float* SW; int sw_ld; int rows_per_batch;
    __device__ __forceinline__ void operator()(const f32x4 (&acc)[2][2][4][2], const Unit& u, int wr, int wc, int fr, int fq) const {
        asm volatile("" : "+v"(fr), "+v"(fq));
        const int row0 = u.pm * BM + wr * 64 + fr, col0 = u.pn * BM + wc * 32 + 8 * fq;
        float rstd[8]; load_rstd8(SS, row0, fq, 1.f / 1024.f, 1e-6f, rstd);
        const float* swp = SW + (size_t)((u.pm * BM) / rows_per_batch) * sw_ld + col0;
        f32x4 sw[2][2];
#pragma unroll
        for (int bj = 0; bj < 2; ++bj)
#pragma unroll
            for (int n = 0; n < 2; ++n) sw[bj][n] = *(const f32x4*)(swp + bj * HALF + 4 * n);
#pragma unroll
        for (int ai = 0; ai < 2; ++ai)
#pragma unroll
            for (int m = 0; m < 4; ++m) { bf16_t* rowp = O + (size_t)(row0 + ai * HALF + m * 16) * ldc + col0; const float rs = rstd[ai * 4 + m];
#pragma unroll
                for (int bj = 0; bj < 2; ++bj) { const f32x4 v0 = acc[ai][bj][m][0] * rs + sw[bj][0], v1 = acc[ai][bj][m][1] * rs + sw[bj][1];
                    u32x4 w; w.x = cvt_pk_bf16(v0[0], v0[1]); w.y = cvt_pk_bf16(v0[2], v0[3]); w.z = cvt_pk_bf16(v1[0], v1[1]); w.w = cvt_pk_bf16(v1[2], v1[3]);
                    *(u32x4*)(rowp + bj * HALF) = w; } }
    }
};

template <int CTRL> __device__ __forceinline__ float dpp_keep(float old, float src) {
    return __builtin_bit_cast(float, __builtin_amdgcn_update_dpp(__builtin_bit_cast(int, old), __builtin_bit_cast(int, src), CTRL, 0xf, 0xf, false)); }
template <int CTRL> __device__ __forceinline__ float dpp_mov(float src) { return __builtin_bit_cast(float, __builtin_amdgcn_mov_dpp(__builtin_bit_cast(int, src), CTRL, 0xf, 0xf, true)); }
struct EpiGLU {
    static constexpr bool PERM = true, AFTER_DRAIN = false;
    bf16_t* H; int ldc; const float* cw; const float* cb; float* TG; float* HG; float* HV; PG8_LAS float* tail;
    const float* SS; const float* SW; int sw_ld; int rows_per_batch;
    __device__ __forceinline__ void operator()(const f32x4 (&acc)[2][2][4][2], const Unit& u, int wr, int wc, int fr, int fq) const {
        asm volatile("" : "+v"(fr), "+v"(fq));
        const int row0 = u.pm * BM + wr * 64 + fr, cl = wc * 32 + 8 * fq, col0 = u.pn * HALF + cl;
        f32x4 (&ac)[2][2][4][2] = const_cast<f32x4 (&)[2][2][4][2]>(acc);
        { float rstd[8]; load_rstd8(SS, row0, fq, 1.f / 1024.f, 1e-6f, rstd);
          const float* swp = SW + (size_t)((u.pm * BM) / rows_per_batch) * sw_ld + u.pn * BM + cl;
#pragma unroll
          for (int bj = 0; bj < 2; ++bj)
#pragma unroll
              for (int n = 0; n < 2; ++n) { const f32x4 swv = *(const f32x4*)(swp + bj * HALF + 4 * n);
#pragma unroll
                  for (int ai = 0; ai < 2; ++ai)
#pragma unroll
                      for (int m = 0; m < 4; ++m) ac[ai][bj][m][n] = ac[ai][bj][m][n] * rstd[ai * 4 + m] + swv; } }
#define GN(ai_, m_, n_) (acc[ai_][0][m_][n_])
#define VN(ai_, m_, n_) (acc[ai_][1][m_][n_])
        if (fr >= 14) {
#pragma unroll
            for (int ai = 0; ai < 2; ++ai)
#pragma unroll
                for (int n = 0; n < 2; ++n) *(PG8_LAS f32x4*)(tail + ((ai * 2 + wr) * 2 + (fr - 14)) * 128 + cl + 4 * n) = GN(ai, 3, n);
            if (wr == 1) {
#pragma unroll
                for (int n = 0; n < 2; ++n) *(f32x4*)(TG + ((size_t)u.pm * 2 + (fr - 14)) * ldc + col0 + 4 * n) = GN(1, 3, n);
            }
        }
        if (wr == 0 && fr < 2) {
#pragma unroll
            for (int n = 0; n < 2; ++n) { *(f32x4*)(HG + ((size_t)u.pm * 2 + fr) * ldc + col0 + 4 * n) = GN(0, 0, n); *(f32x4*)(HV + ((size_t)u.pm * 2 + fr) * ldc + col0 + 4 * n) = VN(0, 0, n); }
        }
        f32x4 w0[2], w1[2], w2[2], b0[2];
#pragma unroll
        for (int n = 0; n < 2; ++n) { w0[n] = *(const f32x4*)(cw + col0 + 4 * n); w1[n] = *(const f32x4*)(cw + ldc + col0 + 4 * n); w2[n] = *(const f32x4*)(cw + 2 * ldc + col0 + 4 * n); b0[n] = *(const f32x4*)(cb + col0 + 4 * n); }
        asm volatile("s_waitcnt lgkmcnt(0)" ::: "memory"); __builtin_amdgcn_s_barrier(); asm volatile("" ::: "memory");
#pragma unroll
        for (int ai = 0; ai < 2; ++ai) {
            f32x4 t0[2], t1[2];
            const bool have = (wr == 1) || (ai == 1);
            const int sa = (wr == 1) ? ai : 0, sw = (wr == 1) ? 0 : 1;
#pragma unroll
            for (int n = 0; n < 2; ++n) {
                t0[n] = have ? *(const PG8_LAS f32x4*)(tail + ((sa * 2 + sw) * 2 + 0) * 128 + cl + 4 * n) : (f32x4){0.f, 0.f, 0.f, 0.f};
                t1[n] = have ? *(const PG8_LAS f32x4*)(tail + ((sa * 2 + sw) * 2 + 1) * 128 + cl + 4 * n) : (f32x4){0.f, 0.f, 0.f, 0.f}; }
#pragma unroll
            for (int m = 0; m < 4; ++m) {
                u32x4 wout;
#pragma unroll
                for (int n = 0; n < 2; ++n) {
                    f32x4 hv; const f32x4 gcur = GN(ai, m, n), vcur = VN(ai, m, n); const f32x4 gprev = m > 0 ? GN(ai, (m > 0 ? m - 1 : 0), n) : gcur;
#pragma unroll
                    for (int i = 0; i < 4; ++i) {
                        const float g0 = gcur[i];
                        float p1, p2;
                        if (m == 0) { p1 = t1[n][i]; p2 = (fr == 0) ? t0[n][i] : t1[n][i]; }
                        else { const float pv = gprev[i]; p1 = dpp_mov<0x121>(pv); p2 = dpp_mov<0x122>(pv); }
                        const float g1 = dpp_keep<0x111>(p1, g0), g2 = dpp_keep<0x112>(p2, g0);
                        const float gc = b0[n][i] + w0[n][i] * g2 + w1[n][i] * g1 + w2[n][i] * g0;
                        hv[i] = gc * __builtin_amdgcn_rcpf(1.f + __builtin_amdgcn_exp2f(-1.4426950408889634f * gc)) * vcur[i];
                    }
                    if (n == 0) { wout.x = cvt_pk_bf16(hv[0], hv[1]); wout.y = cvt_pk_bf16(hv[2], hv[3]); } else { wout.z = cvt_pk_bf16(hv[0], hv[1]); wout.w = cvt_pk_bf16(hv[2], hv[3]); }
                }
                *(u32x4*)(H + (size_t)(row0 + ai * HALF + m * 16) * ldc + col0) = wout;
            }
        }
#undef GN
#undef VN
    }
};
template <class Epi, class Sched, bool ALIGN_EPI = false, bool SP2 = false>
__device__ __forceinline__ void gemm_phase(PG8_LAS unsigned char* lds, const Gemm g, const Sched& S, const Epi& E) {
    int tid_ = threadIdx.x; asm volatile("" : "+v"(tid_));
    const int tid = tid_, wid = __builtin_amdgcn_readfirstlane(tid >> 6), lane = tid & 63, wr = wid >> 2, wc = wid & 3, fr = lane & 15, fq = lane >> 4;
    const int K = g.K, nt = K / BK;
    unsigned voffA[2], voffB[2];
#pragma unroll
    for (int i = 0; i < 2; ++i) { int R, C; stage_rc(tid * 16 + i * 8192, R, C); const int Rb = Epi::PERM ? ((R & ~31) + perm32(R & 31)) : R;
        voffA[i] = (unsigned)(R * K + C) * 2u; voffB[i] = (unsigned)(Rb * K + C) * 2u; }
    const size_t kstep = (size_t)(BK * 2);
    const size_t hstep = (size_t)HALF * K * 2;
    const size_t tstep = 2 * hstep;
    const unsigned ldsw = (unsigned)wid * 1024u;
    const int aoff = lds_byte(wr * 64 + fr, fq * 8), boff = lds_byte(wc * 32 + fr, fq * 8);
#define PG8_SA(b, h) (((b) * 2 + (h)) * HTB)
#define PG8_SB(b, h) ((4 + (b) * 2 + (h)) * HTB)
#define PG8_STAGE(bufoff, gbase, voff) do { _Pragma("unroll") for (int _i = 0; _i < 2; ++_i) \
        __builtin_amdgcn_global_load_lds((const unsigned*)((const char*)(gbase) + (voff)[_i]), (PG8_LAS unsigned*)(lds + (bufoff) + ldsw + _i * 8192), 16, 0, 0); } while (0)
#define PG8_LDA(dst, b, h) do { _Pragma("unroll") for (int m = 0; m < 4; ++m) _Pragma("unroll") for (int k = 0; k < 2; ++k) dst[m][k] = *(const PG8_LAS bf16x8*)(lds + PG8_SA(b, h) + aoff + m * 2048 + k * 1024); } while (0)
#define PG8_LDB(dst, b, h) do { _Pragma("unroll") for (int n = 0; n < 2; ++n) _Pragma("unroll") for (int k = 0; k < 2; ++k) dst[n][k] = *(const PG8_LAS bf16x8*)(lds + PG8_SB(b, h) + boff + n * 2048 + k * 1024); } while (0)
#define PG8_MMA(ai, bj, At, Bt) do { __builtin_amdgcn_s_setprio(1); _Pragma("unroll") for (int m = 0; m < 4; ++m) _Pragma("unroll") for (int n = 0; n < 2; ++n) _Pragma("unroll") for (int k = 0; k < 2; ++k) \
        acc[ai][bj][m][n] = __builtin_amdgcn_mfma_f32_16x16x32_bf16(Bt[n][k], At[m][k], acc[ai][bj][m][n], 0, 0, 0); __builtin_amdgcn_s_setprio(0); } while (0)
#define PG8_WAIT_V(n) asm volatile("s_waitcnt vmcnt(" #n ")" ::: "memory")
#define PG8_WAIT_L(n) asm volatile("s_waitcnt lgkmcnt(" #n ")" ::: "memory")
#define PG8_BAR __builtin_amdgcn_s_barrier()
#define PG8_SCHED __builtin_amdgcn_sched_barrier(0)
    Unit cur, nxt; int ui = 0;
    if (!S.next(0, cur)) return;
    f32x4 acc[2][2][4][2];
#pragma unroll
    for (int a = 0; a < 2; ++a)
#pragma unroll
        for (int b = 0; b < 2; ++b)
#pragma unroll
            for (int m = 0; m < 4; ++m)
#pragma unroll
                for (int n = 0; n < 2; ++n) acc[a][b][m][n] = (f32x4){0.f, 0.f, 0.f, 0.f};
    bf16x8 At[4][2], B0[2][2], B1[2][2];
    const char* cA = (const char*)g.A + (size_t)cur.pm * tstep; const char* cB = (const char*)g.Bt + (size_t)cur.pn * tstep;
    S.a_ready(cur);
    if constexpr (SP2) {
        PG8_STAGE(PG8_SB(0, 0), cB, voffB); PG8_STAGE(PG8_SB(0, 1), cB + hstep, voffB); PG8_STAGE(PG8_SA(0, 0), cA, voffA); PG8_STAGE(PG8_SA(0, 1), cA + hstep, voffA);
        if (wr == 1) PG8_BAR;
        PG8_WAIT_V(2); PG8_BAR;
        PG8_STAGE(PG8_SB(1, 0), cB + kstep, voffB); PG8_STAGE(PG8_SA(1, 0), cA + kstep, voffA); PG8_STAGE(PG8_SB(1, 1), cB + hstep + kstep, voffB);
        PG8_WAIT_V(6); PG8_BAR;
    } else {
        PG8_STAGE(PG8_SB(0, 0), cB, voffB); PG8_STAGE(PG8_SA(0, 0), cA, voffA); PG8_STAGE(PG8_SB(0, 1), cB + hstep, voffB); PG8_STAGE(PG8_SA(0, 1), cA + hstep, voffA);
        if (wr == 1) PG8_BAR;
        PG8_WAIT_V(4); PG8_BAR;
        PG8_STAGE(PG8_SB(1, 0), cB + kstep, voffB); PG8_STAGE(PG8_SA(1, 0), cA + kstep, voffA); PG8_STAGE(PG8_SB(1, 1), cB + hstep + kstep, voffB);
        PG8_WAIT_V(6); PG8_BAR;
    }
    for (;;) {
        const bool has_next = S.next(ui + 1, nxt);
        const char* nA = has_next ? (const char*)g.A + (size_t)nxt.pm * tstep : cA; const char* nB = has_next ? (const char*)g.Bt + (size_t)nxt.pn * tstep : cB;
        for (int t = 0; t < nt; t += 2) {
            const bool last = (t == nt - 2);
            const char* a1 = cA + (size_t)(t + 1) * kstep;
            const char* a2 = last ? nA : cA + (size_t)(t + 2) * kstep; const char* b2 = last ? nB : cB + (size_t)(t + 2) * kstep;
            const char* a3 = a2 + kstep; const char* b3 = b2 + kstep;
            if (last && has_next) S.a_ready(nxt);
            if constexpr (SP2) {
            PG8_LDB(B0, 0, 0); PG8_LDB(B1, 0, 1); PG8_SCHED; PG8_LDA(At, 0, 0); PG8_STAGE(PG8_SA(1, 1), a1 + hstep, voffA);
            PG8_WAIT_V(8); PG8_WAIT_L(0); PG8_BAR; PG8_MMA(0, 0, At, B0); PG8_MMA(0, 1, At, B1); PG8_BAR; PG8_SCHED;
            PG8_LDA(At, 0, 1); PG8_STAGE(PG8_SB(0, 0), b2, voffB); PG8_STAGE(PG8_SB(0, 1), b2 + hstep, voffB); PG8_STAGE(PG8_SA(0, 0), a2, voffA);
            PG8_WAIT_V(8); PG8_WAIT_L(0); PG8_BAR; PG8_MMA(1, 0, At, B0); PG8_MMA(1, 1, At, B1); PG8_BAR; PG8_SCHED;
            PG8_LDB(B0, 1, 0); PG8_LDB(B1, 1, 1); PG8_SCHED; PG8_LDA(At, 1, 0); PG8_STAGE(PG8_SA(0, 1), a2 + hstep, voffA);
            PG8_WAIT_V(8); PG8_WAIT_L(0); PG8_BAR; PG8_MMA(0, 0, At, B0); PG8_MMA(0, 1, At, B1); PG8_BAR; PG8_SCHED;
            PG8_LDA(At, 1, 1); PG8_STAGE(PG8_SB(1, 0), b3, voffB); PG8_STAGE(PG8_SB(1, 1), b3 + hstep, voffB); PG8_STAGE(PG8_SA(1, 0), a3, voffA);
            PG8_WAIT_V(8); PG8_WAIT_L(0); PG8_BAR; PG8_MMA(1, 0, At, B0); PG8_MMA(1, 1, At, B1); PG8_BAR; PG8_SCHED;
            } else {
            PG8_LDB(B0, 0, 0); PG8_SCHED; PG8_LDA(At, 0, 0); PG8_STAGE(PG8_SA(1, 1), a1 + hstep, voffA);
            PG8_WAIT_L(8); PG8_BAR; PG8_WAIT_L(0); PG8_MMA(0, 0, At, B0); PG8_BAR; PG8_SCHED;
            PG8_LDB(B1, 0, 1); PG8_STAGE(PG8_SB(0, 0), b2, voffB);
            PG8_BAR; PG8_WAIT_L(0); PG8_MMA(0, 1, At, B1); PG8_BAR;
            PG8_LDA(At, 0, 1); PG8_STAGE(PG8_SA(0, 0), a2, voffA);
            PG8_BAR; PG8_WAIT_L(0); PG8_MMA(1, 0, At, B0); PG8_BAR; PG8_SCHED;
            PG8_STAGE(PG8_SB(0, 1), b2 + hstep, voffB);
            PG8_WAIT_V(6); PG8_BAR; PG8_MMA(1, 1, At, B1); PG8_BAR;
            PG8_LDB(B0, 1, 0); PG8_SCHED; PG8_LDA(At, 1, 0); PG8_STAGE(PG8_SA(0, 1), a2 + hstep, voffA);
            PG8_WAIT_L(8); PG8_BAR; PG8_WAIT_L(0); PG8_MMA(0, 0, At, B0); PG8_BAR; PG8_SCHED;
            PG8_LDB(B1, 1, 1); PG8_STAGE(PG8_SB(1, 0), b3, voffB);
            PG8_BAR; PG8_WAIT_L(0); PG8_MMA(0, 1, At, B1); PG8_BAR;
            PG8_LDA(At, 1, 1); PG8_STAGE(PG8_SA(1, 0), a3, voffA);
            PG8_BAR; PG8_WAIT_L(0); PG8_MMA(1, 0, At, B0); PG8_BAR; PG8_SCHED;
            PG8_STAGE(PG8_SB(1, 1), b3 + hstep, voffB);
            PG8_WAIT_V(6); PG8_BAR; PG8_MMA(1, 1, At, B1); PG8_BAR;
            }
        }
        if constexpr (ALIGN_EPI) { if (wr == 0) PG8_BAR; }
        if constexpr (!Epi::AFTER_DRAIN) { E(acc, cur, wr, wc, fr, fq); S.done(cur); }
        if (!has_next) break;
#pragma unroll
        for (int a = 0; a < 2; ++a)
#pragma unroll
            for (int b = 0; b < 2; ++b)
#pragma unroll
                for (int m = 0; m < 4; ++m)
#pragma unroll
                    for (int n = 0; n < 2; ++n) acc[a][b][m][n] = (f32x4){0.f, 0.f, 0.f, 0.f};
        cur = nxt; cA = nA; cB = nB; ++ui;
        if constexpr (ALIGN_EPI) { if (wr == 1) PG8_BAR; }
    }
    PG8_WAIT_V(0);
    if constexpr (!ALIGN_EPI) { if (wr == 0) PG8_BAR; }
    PG8_BAR;
    if constexpr (Epi::AFTER_DRAIN) { E.fused(acc, cur, wr, wc, fr, fq, lds, wid, lane); S.done(cur); }
#undef PG8_SA
#undef PG8_SB
#undef PG8_STAGE
#undef PG8_LDA
#undef PG8_LDB
#undef PG8_MMA
#undef PG8_WAIT_V
#undef PG8_WAIT_L
#undef PG8_BAR
#undef PG8_SCHED
}
}

namespace cg = cooperative_groups;
#ifndef MK_MODE
#define MK_MODE 2
#endif
constexpr int NWAVES = 8;

constexpr int NB = 8, SEQ = 4096, DM = 1024, NL = 2;
constexpr int M = NB * SEQ;
constexpr int PIN = 2688, PINP = 2816;
constexpr int DFF = 2816, DUP = 2 * DFF;
constexpr int DA = 256, DB = 384, DC = 384;
constexpr int NMOD = 6 * DM;
constexpr int PC_OFF = 1280;
constexpr int NPHASE = 22;

constexpr size_t MiB = 1u << 20;
constexpr size_t WS_CTL = 0, CTL_ZERO_BYTES = 64 * 1024;
constexpr size_t WS_SMALL = 1 * MiB;
constexpr size_t SM_SGUW = 0, SM_LRUWA = 256 * 1024, SM_LRUWX = 352 * 1024, SM_RW2 = 448 * 1024, SM_RA2 = 544 * 1024, SM_RG2 = 640 * 1024;
constexpr size_t WS_MOD = 2 * MiB;
constexpr size_t WS_LRUS = 3 * MiB;
constexpr size_t WS_WIN = 4 * MiB, WS_WOUT = 15 * MiB, WS_WUP = 19 * MiB, WS_WDN = 41 * MiB;
constexpr size_t WS_SS = 57 * MiB, WS_SW1 = 60 * MiB, WS_SW2 = 61 * MiB;
constexpr size_t WS_BON = 62 * MiB;
constexpr size_t WS_HY = 64 * MiB;
constexpr size_t WS_P = 128 * MiB;
constexpr size_t WS_UV = 304 * MiB;
constexpr size_t WS_R = 304 * MiB, WS_K = 328 * MiB, WS_V = 352 * MiB, WS_KK = 376 * MiB, WS_BV = 400 * MiB;
constexpr size_t WS_LD = 424 * MiB;
constexpr size_t WS_O = 448 * MiB;
constexpr size_t WS_Q2 = 472 * MiB;
constexpr size_t WS_TG = 496 * MiB, WS_HG = 500 * MiB, WS_HV = 504 * MiB;
constexpr size_t WS_END = 512 * MiB;
static_assert(WS_Q2 + (size_t)M * 384 * 2 <= WS_END && WS_UV + (size_t)M * DFF * 2 <= WS_END && WS_P + (size_t)M * PINP * 2 <= WS_UV, "d_ws map");
static_assert(WS_WDN + (size_t)NL * DM * DFF * 2 <= WS_HY && WS_WIN + (size_t)NL * PINP * DM * 2 <= WS_WOUT && WS_WUP + (size_t)NL * DUP * DM * 2 <= WS_WDN, "weights map");
constexpr int CW_BAR = 1024;
constexpr int CW_SHAD = 6144;

constexpr int RING_BYTES = 131072;
constexpr int LDSCTL_OFF = RING_BYTES, MISC_OFF = LDSCTL_OFF + 320;
constexpr int TAIL_OFF = 132096;
constexpr int LDS_BYTES = 147456;

#define GAS __attribute__((address_space(1)))
#define LAS __attribute__((address_space(3)))
typedef unsigned short bf16;
typedef float f32x4 __attribute__((ext_vector_type(4)));
typedef float f32x2 __attribute__((ext_vector_type(2)));
typedef float f32x16 __attribute__((ext_vector_type(16)));
typedef short bf16x8 __attribute__((ext_vector_type(8)));
typedef unsigned u32x2 __attribute__((ext_vector_type(2)));
typedef unsigned u32x4 __attribute__((ext_vector_type(4)));
typedef GAS unsigned gu32;
#define RLX_AGENT __ATOMIC_RELAXED, __HIP_MEMORY_SCOPE_AGENT

__device__ __forceinline__ float bflo(unsigned w) { return __builtin_bit_cast(float, w << 16); }
__device__ __forceinline__ float bfhi(unsigned w) { return __builtin_bit_cast(float, w & 0xffff0000u); }
__device__ __forceinline__ float bf1(bf16 u) { return __builtin_bit_cast(float, (unsigned)u << 16); }
__device__ __forceinline__ unsigned pk2(float lo, float hi) { return pg8::cvt_pk_bf16(lo, hi); }
__device__ __forceinline__ bf16 f2bf(float f) { return (bf16)(pg8::cvt_pk_bf16(f, f) & 0xffffu); }
__device__ __forceinline__ bf16 f2bf_n(float f) { const __bf16 h = (__bf16)f; return __builtin_bit_cast(bf16, h); }
__device__ __forceinline__ f32x4 unpack4(u32x2 w) { return (f32x4){bflo(w.x), bfhi(w.x), bflo(w.y), bfhi(w.y)}; }
__device__ __forceinline__ u32x2 pack4(f32x4 v) { u32x2 w; w.x = pk2(v[0], v[1]); w.y = pk2(v[2], v[3]); return w; }

__device__ __forceinline__ float fexp(float x) { return __builtin_amdgcn_exp2f(x * 1.4426950408889634f); }
__device__ __forceinline__ float flog(float x) { return __builtin_amdgcn_logf(x) * 0.6931471805599453f; }
__device__ __forceinline__ float fsigmoid(float x) { return __builtin_amdgcn_rcpf(1.f + fexp(-x)); }
__device__ __forceinline__ float fgelu(float x) { const float y = 1.5957691216f * x * (1.f + 0.044715f * x * x); return x * fsigmoid(y); }
__device__ __forceinline__ float fsilu(float x) { return x * fsigmoid(x); }
__device__ __forceinline__ float fsoftplus(float x) { return fmaxf(x, 0.f) + flog(1.f + fexp(-fabsf(x))); }
__device__ __forceinline__ float fsoftplus_acc(float x) { return fmaxf(x, 0.f) + log1pf(expf(-fabsf(x))); }
__device__ __forceinline__ float ftanh(float x) { return 1.f - 2.f * __builtin_amdgcn_rcpf(1.f + fexp(2.f * x)); }
__device__ __forceinline__ float fnegexpm1(float x) {
    const float ser = -x * (1.f + x * (0.5f + x * (0.16666667f + x * (0.041666668f + x * (0.008333334f + x * 0.0013888889f)))));
    return x > -0.25f ? ser : 1.f - fexp(x);
}
__device__ __forceinline__ int opaque_tid() { int t = threadIdx.x; asm volatile("" : "+v"(t)); return t; }
template <int CTRL> __device__ __forceinline__ float dppf(float x) { return __builtin_bit_cast(float, __builtin_amdgcn_mov_dpp(__builtin_bit_cast(int, x), CTRL, 0xf, 0xf, true)); }
__device__ __forceinline__ float red16(float p) { p += dppf<0xB1>(p); p += dppf<0x4E>(p); p += dppf<0x141>(p); p += dppf<0x128>(p); return p; }
__device__ __forceinline__ float wave_sum(float v) { return pg8::xrow16_sum(red16(v)); }
#define XB_TMO      128
#define XB_XCNT(j)  (256  + 64 * (j))
#define XB_XSUB(j)  (1280 + 64 * (j))
#define XB_XGEN(j)  (2304 + 64 * (j))
#define XB_TOP      3328
#define XB_TOPGEN   3392
#define XCD_BAR_WORDS 3456
#define XB_SPIN_CAP (1u << 18)

__device__ __forceinline__ unsigned xb_ld(unsigned* p)              { return __hip_atomic_load(p, __ATOMIC_RELAXED, __HIP_MEMORY_SCOPE_AGENT); }
__device__ __forceinline__ unsigned xb_add(unsigned* p, unsigned v) { return __hip_atomic_fetch_add(p, v, __ATOMIC_RELAXED, __HIP_MEMORY_SCOPE_AGENT); }
__device__ __forceinline__ unsigned xb_xcc_id() { return (unsigned)__builtin_amdgcn_s_getreg((3 << 11) | 20) & 0xFu; }
#define XB_SPIN(cond, bar) do { unsigned _sp = 0; while (cond) { __builtin_amdgcn_s_sleep(1); \
    if ((++_sp & 255u) == 0u) { if (xb_ld(&(bar)[XB_TMO])) break; if (_sp > XB_SPIN_CAP) { atomicAdd(&(bar)[XB_TMO], 1u); break; } } } } while (0)

struct XcdBarrier {
    unsigned* bar; unsigned x;
    volatile LAS unsigned* st;
};

__device__ __forceinline__ XcdBarrier xcd_barrier_post(unsigned* bar, volatile LAS unsigned* st) {
    XcdBarrier b; b.bar = bar; b.x = xb_xcc_id(); b.st = st;
    if (threadIdx.x == 0) (void)xb_add(&bar[XB_XCNT(b.x)], 1u);
    return b;
}
__device__ __forceinline__ void xcd_barrier_complete(unsigned* bar, unsigned x, unsigned& nloc, unsigned& nx) {
    const unsigned G = gridDim.x * gridDim.y * gridDim.z;
    unsigned sum, cnt, mine, sp = 0u;
    for (;;) {
        sum = 0u; cnt = 0u; mine = 0u;
#pragma unroll
        for (unsigned j = 0; j < 16; ++j) { const unsigned c = xb_ld(&bar[XB_XCNT(j)]); sum += c; cnt += (c > 0u) ? 1u : 0u; mine = (j == x) ? c : mine; }
        if (sum == G) break;
        __builtin_amdgcn_s_sleep(1);
        if ((++sp & 255u) == 0u) { if (xb_ld(&bar[XB_TMO])) break; if (sp > XB_SPIN_CAP) { atomicAdd(&bar[XB_TMO], 1u); break; } }
    }
    nloc = mine > 0u ? mine : 1u; nx = cnt > 0u ? cnt : 1u;
}

__device__ __forceinline__ void xcd_barrier(const XcdBarrier& b) {
    asm volatile("s_waitcnt vmcnt(0)" ::: "memory");
    __syncthreads();
    if (threadIdx.x == 0) {
        unsigned* bar = b.bar;
        __builtin_amdgcn_s_waitcnt(0);
        unsigned nloc = b.st[0], nx = b.st[1];
        if (nloc == 0u) { xcd_barrier_complete(bar, b.x, nloc, nx); b.st[0] = nloc; b.st[1] = nx; }
        const unsigned old = xb_add(&bar[XB_XSUB(b.x)], 1u);
        const unsigned gen = old / nloc;
        if (old + 1u == (gen + 1u) * nloc) {
            __builtin_amdgcn_fence(__ATOMIC_RELEASE, "agent");
            asm volatile("s_waitcnt vmcnt(0)" ::: "memory");
            const unsigned og = xb_add(&bar[XB_TOP], 1u);
            const unsigned tg = og / nx;
            if (og + 1u == (tg + 1u) * nx) xb_add(&bar[XB_TOPGEN], 1u);
            else XB_SPIN(xb_ld(&bar[XB_TOPGEN]) == tg, bar);
            __builtin_amdgcn_fence(__ATOMIC_ACQUIRE, "agent");
            xb_add(&bar[XB_XGEN(b.x)], 1u);
            asm volatile("s_waitcnt vmcnt(0)" ::: "memory");
        } else {
            XB_SPIN(xb_ld(&bar[XB_XGEN(b.x)]) == gen, bar);
            __builtin_amdgcn_fence(__ATOMIC_ACQUIRE, "agent");
            asm volatile("s_waitcnt vmcnt(0)" ::: "memory");
        }
    }
    __syncthreads();
}

struct Frame {
    LAS unsigned char* lds;
    volatile LAS unsigned* MISC;
    gu32* ctl;
    int wave, vcu, G;
    const float *x, *c, *w_mod, *b_mod, *norm_mix, *w_in, *w_out, *sgu_ln_g, *sgu_ln_b, *sgu_w, *sgu_b, *lru_conv_w, *lru_conv_b, *lru_w_a, *lru_b_a, *lru_w_x, *lru_b_x, *lru_lambda,
        *rwkv_mu, *rwkv_w0, *rwkv_w2, *rwkv_a0, *rwkv_a2, *rwkv_g2, *rwkv_k_k, *rwkv_k_a, *rwkv_r_k, *rwkv_ln_w, *rwkv_ln_b, *norm_ffn, *ffn_w_up, *ffn_conv_w, *ffn_conv_b, *ffn_w_down, *norm_final;
    float* out;
    bf16 *SGUW, *LRUWA, *LRUWX, *RW2, *RA2, *RG2;
    float *MOD, *LRUSA, *LRUSH;
    bf16 *WIN, *WOUT, *WUP, *WDN;
    bf16 *HY, *P, *UG, *UV, *R, *K, *V, *KK, *BV, *Q2, *O, *LD;
    float *TG, *HG, *HV;
    float *SS, *SW1, *SW2, *BON;
};

__device__ __forceinline__ void p0_transpose_item(const float* W, int K, int N, bf16* WT, int k0, int n0, int drow0, LAS float* scr, int lane) {
#pragma unroll
    for (int i = 0; i < 32; ++i) { const int kk = 2 * i + (lane >> 5); scr[kk * 33 + (lane & 31)] = W[(size_t)(k0 + kk) * N + n0 + (lane & 31)]; }
    asm volatile("s_waitcnt lgkmcnt(0)" ::: "memory");
    const int c = lane & 7;
#pragma unroll
    for (int j = 0; j < 4; ++j) { const int n = (lane >> 3) + 8 * j; const LAS float* s = scr + (8 * c) * 33 + n;
        u32x4 o; o.x = pk2(s[0 * 33], s[1 * 33]); o.y = pk2(s[2 * 33], s[3 * 33]); o.z = pk2(s[4 * 33], s[5 * 33]); o.w = pk2(s[6 * 33], s[7 * 33]);
        *(u32x4*)(WT + (size_t)(drow0 + n) * K + k0 + 8 * c) = o; }
    asm volatile("s_waitcnt lgkmcnt(0)" ::: "memory");
}
constexpr int P0_I_IN = (DM / 64) * (PIN / 32), P0_I_OUT = (DM / 64) * (DM / 32), P0_I_UP = (DM / 64) * (DUP / 32), P0_I_DN = (DFF / 64) * (DM / 32);
constexpr int P0_PER_L = P0_I_IN + P0_I_OUT + P0_I_UP + P0_I_DN;
__device__ __forceinline__ void p0_convert_item(Frame& F, const int it, LAS float* scr, const int lane) {
    const int l = it / P0_PER_L; int r = it % P0_PER_L;
    if (r < P0_I_IN) { const int nblk = PIN / 32, kb = r / nblk, nb = r % nblk; p0_transpose_item(F.w_in + (size_t)l * DM * PIN, DM, PIN, F.WIN + (size_t)l * PINP * DM, 64 * kb, 32 * nb, 32 * nb, scr, lane); return; } r -= P0_I_IN;
    if (r < P0_I_OUT) { const int nblk = DM / 32, kb = r / nblk, nb = r % nblk; p0_transpose_item(F.w_out + (size_t)l * DM * DM, DM, DM, F.WOUT + (size_t)l * DM * DM, 64 * kb, 32 * nb, 32 * nb, scr, lane); return; } r -= P0_I_OUT;
    if (r < P0_I_UP) { const int nblk = DUP / 32, kb = r / nblk, nb = r % nblk; const int n0 = 32 * nb, isv = n0 >= DFF ? 1 : 0, j = n0 - isv * DFF, drow = (j / 128) * 256 + isv * 128 + (j % 128);
        p0_transpose_item(F.ffn_w_up + (size_t)l * DM * DUP, DM, DUP, F.WUP + (size_t)l * DUP * DM, 64 * kb, n0, drow, scr, lane); return; } r -= P0_I_UP;
    { const int nblk = DM / 32, kb = r / nblk, nb = r % nblk; p0_transpose_item(F.ffn_w_down + (size_t)l * DFF * DM, DFF, DM, F.WDN + (size_t)l * DM * DFF, 64 * kb, 32 * nb, 32 * nb, scr, lane); }
}
__device__ __forceinline__ bool p0_defer_layers(const Frame& F) { return false; }
__device__ __forceinline__ void p0_deferred_items(Frame& F, const int wv, const int nwv) {
    LAS float* scr = (LAS float*)(F.lds + F.wave * 9216); const int lane = opaque_tid() & 63;
    for (int it = P0_PER_L + wv; it < NL * P0_PER_L; it += nwv) p0_convert_item(F, it, scr, lane);
}
#ifndef MK_TSEC0
#define MK_TSEC0 -1
#endif
#define TSEC0_MARK(k_) do { if (MK_TSEC0 >= 0 && tid == 0) { asm volatile("s_waitcnt vmcnt(0) lgkmcnt(0)" ::: "memory"); volatile LAS unsigned long long* ts_ = (volatile LAS unsigned long long*)(F.lds + 140000); \
        const unsigned long long t_ = __builtin_amdgcn_s_memrealtime(); if ((k_) >= 0) ts_[(k_) < 0 ? 0 : (k_)] += t_ - ts_[3]; ts_[3] = t_; } } while (0)
__device__ __forceinline__ void p0_prologue(Frame& F) {
    const int tid = opaque_tid(), lane = tid & 63, wave = F.wave;
    TSEC0_MARK(-1);
    const int gw = F.vcu * NWAVES + wave, NGW = F.G * NWAVES;
    const int gt = F.vcu * (NWAVES * 64) + tid, NGT = F.G * NWAVES * 64;
    if (F.vcu < 192) {
        LAS float* cact = (LAS float*)(F.lds + 73728);
        LAS float* red = (LAS float*)(F.lds + 106496);
        for (int i = tid; i < NB * DM; i += NWAVES * 64) { const float cv = F.c[i]; cact[i] = cv * fsigmoid(cv); }
        __syncthreads();
        const int l = F.vcu / 96, n0 = (F.vcu % 96) * 64;
        const float* wm = F.w_mod + ((size_t)l * DM + 128 * wave) * NMOD + n0 + lane;
        float acc[NB];
#pragma unroll
        for (int b = 0; b < NB; ++b) acc[b] = 0.f;
#pragma unroll 1
        for (int k16 = 0; k16 < 128; k16 += 16) {
            float wv[16];
#pragma unroll
            for (int j = 0; j < 16; ++j) wv[j] = wm[(size_t)(k16 + j) * NMOD];
#pragma unroll
            for (int j4 = 0; j4 < 16; j4 += 4) {
#pragma unroll
                for (int b = 0; b < NB; ++b) { const f32x4 cv = *(const LAS f32x4*)(cact + b * DM + 128 * wave + k16 + j4); acc[b] += cv[0] * wv[j4] + cv[1] * wv[j4 + 1] + cv[2] * wv[j4 + 2] + cv[3] * wv[j4 + 3]; } }
        }
#pragma unroll
        for (int b = 0; b < NB; ++b) red[(wave * NB + b) * 64 + lane] = acc[b];
        __syncthreads();
        { const int b = tid >> 6, col = tid & 63; float s = F.b_mod[l * NMOD + n0 + col];
#pragma unroll
          for (int w = 0; w < NWAVES; ++w) s += red[(w * NB + b) * 64 + col];
          F.MOD[(size_t)(l * NB + b) * NMOD + n0 + col] = s; }
        __syncthreads();
    }
    TSEC0_MARK(0);
    {
        LAS float* scr = (LAS float*)(F.lds + wave * 9216);
        const int NITEM = p0_defer_layers(F) ? P0_PER_L : NL * P0_PER_L; constexpr int SHARE_A = 8 * 64 * NWAVES;
        const bool grid256 = F.G == 256;
        const int nA = grid256 ? (SHARE_A < NITEM ? SHARE_A : NITEM) : 0;
        for (int pass = 0; pass < 2; ++pass)
        for (int it = (pass == 0 ? (gw - 192 * NWAVES) : nA + gw); it < (pass == 0 ? nA : NITEM); it += (pass == 0 ? 64 * NWAVES : NGW)) {
            if (pass == 0 && F.vcu < 192) break;
            p0_convert_item(F, it, scr, lane);
        }
        for (int i = gt; i < NL * (PINP - PIN) * DM / 8; i += NGT) { const int l = i / ((PINP - PIN) * DM / 8), o = i % ((PINP - PIN) * DM / 8);
            *(u32x4*)(F.WIN + (size_t)l * PINP * DM + (size_t)PIN * DM + (size_t)o * 8) = (u32x4){0u, 0u, 0u, 0u}; }
    }
    TSEC0_MARK(1);
    for (int i = gt; i < NL * 4 * 128 * 128; i += NGT) { const int s = i & 127, t = (i >> 7) & 127; F.SGUW[i] = s <= t ? f2bf(F.sgu_w[i]) : (bf16)0; }
    for (int i = gt; i < NL * 6 * 64 * 64; i += NGT) { const int ii = i & 63, j = (i >> 6) & 63, lh = i >> 12;
        F.LRUWA[i] = f2bf(F.lru_w_a[(size_t)lh * 4096 + ii * 64 + j]); F.LRUWX[i] = f2bf(F.lru_w_x[(size_t)lh * 4096 + ii * 64 + j]); }
    for (int i = gt; i < NL * 12 * 4 * 512; i += NGT) { const int e = i & 7, ln_ = (i >> 3) & 63, ks = (i >> 9) & 3, nt = (i >> 11) % 12, l = i / (12 * 4 * 512);
        const int n = 32 * nt + (ln_ & 31), k = 16 * ks + 8 * (ln_ >> 5) + e;
        F.RW2[i] = f2bf(F.rwkv_w2[(size_t)l * 64 * 384 + k * 384 + n]); F.RA2[i] = f2bf(F.rwkv_a2[(size_t)l * 64 * 384 + k * 384 + n]); }
    for (int i = gt; i < NL * 12 * 8 * 512; i += NGT) { const int e = i & 7, ln_ = (i >> 3) & 63, ks = (i >> 9) & 7, nt = (i >> 12) % 12, l = i / (12 * 8 * 512);
        const int n = 32 * nt + (ln_ & 31), k = 16 * ks + 8 * (ln_ >> 5) + e;
        F.RG2[i] = f2bf(F.rwkv_g2[(size_t)l * 128 * 384 + k * 384 + n]); }
    TSEC0_MARK(2);
    if (MK_TSEC0 >= 0 && F.vcu == (MK_TSEC0 >= 4 ? 192 : 0) && tid == 0) { volatile LAS unsigned long long* ts_ = (volatile LAS unsigned long long*)(F.lds + 140000); unsigned long long* slot = (unsigned long long*)((unsigned char*)F.ctl + 49152); slot[0] = ts_[0]; slot[1] = ts_[1]; slot[2] = ts_[2]; }
}

__device__ __forceinline__ void norm_mod_phase(Frame& F, const float* X, const float* gamma, const float* mod_l, int sh_idx, int sc_idx, bf16* H) {
    const int gw = F.vcu * NWAVES + F.wave, NGW = F.G * NWAVES, lane = opaque_tid() & 63;
    f32x4 g[4], nx[4];
#pragma unroll
    for (int j = 0; j < 4; ++j) g[j] = *(const f32x4*)(gamma + 4 * (lane + 64 * j));
    if (gw < M) {
#pragma unroll
        for (int j = 0; j < 4; ++j) nx[j] = ((const f32x4*)(X + (size_t)gw * DM) + lane)[64 * j];
    }
    for (int m = gw; m < M; m += NGW) {
        f32x4 v[4]; float s = 0.f;
#pragma unroll
        for (int j = 0; j < 4; ++j) { v[j] = nx[j]; s += (v[j][0] * v[j][0] + v[j][1] * v[j][1]) + (v[j][2] * v[j][2] + v[j][3] * v[j][3]); }
        if (m + NGW < M) {
#pragma unroll
            for (int j = 0; j < 4; ++j) nx[j] = ((const f32x4*)(X + (size_t)(m + NGW) * DM) + lane)[64 * j];
        }
        const float* mb = mod_l + (size_t)(m >> 12) * NMOD;
        f32x4 sc[4], sh[4];
#pragma unroll
        for (int j = 0; j < 4; ++j) { const int c = 4 * (lane + 64 * j); sc[j] = *(const f32x4*)(mb + sc_idx * DM + c); sh[j] = *(const f32x4*)(mb + sh_idx * DM + c); }
        const float rstd = __builtin_amdgcn_rsqf(wave_sum(s) * (1.f / DM) + 1e-6f);
        u32x2* o8 = (u32x2*)(H + (size_t)m * DM) + lane;
#pragma unroll
        for (int j = 0; j < 4; ++j) { const f32x4 y = (v[j] * rstd) * g[j] * (sc[j] + 1.f) + sh[j]; o8[64 * j] = pack4(y); }
    }
}
__device__ __forceinline__ void final_norm_phase(Frame& F, float* X, const float* gamma) {
    const int gw = F.vcu * NWAVES + F.wave, NGW = F.G * NWAVES, lane = opaque_tid() & 63;
    f32x4 g[4], nx[4];
#pragma unroll
    for (int j = 0; j < 4; ++j) g[j] = *(const f32x4*)(gamma + 4 * (lane + 64 * j));
    if (gw < M) {
#pragma unroll
        for (int j = 0; j < 4; ++j) nx[j] = ((const f32x4*)(X + (size_t)gw * DM) + lane)[64 * j];
    }
    for (int m = gw; m < M; m += NGW) {
        f32x4 v[4]; float s = 0.f;
#pragma unroll
        for (int j = 0; j < 4; ++j) { v[j] = nx[j]; s += (v[j][0] * v[j][0] + v[j][1] * v[j][1]) + (v[j][2] * v[j][2] + v[j][3] * v[j][3]); }
        if (m + NGW < M) {
#pragma unroll
            for (int j = 0; j < 4; ++j) nx[j] = ((const f32x4*)(X + (size_t)(m + NGW) * DM) + lane)[64 * j];
        }
        const float rstd = __builtin_amdgcn_rsqf(wave_sum(s) * (1.f / DM) + 1e-6f);
        f32x4* xr = (f32x4*)(X + (size_t)m * DM) + lane;
#pragma unroll
        for (int j = 0; j < 4; ++j) xr[64 * j] = (v[j] * rstd) * g[j];
    }
}

__device__ __forceinline__ void norm0_phase(Frame& F, const float* X, const float* gamma, const float* mod_l, int sc_idx, bf16* XS) {
    const int gw = F.vcu * NWAVES + F.wave, NGW = F.G * NWAVES, lane = opaque_tid() & 63;
    f32x4 g[4], nx[4];
#pragma unroll
    for (int j = 0; j < 4; ++j) g[j] = *(const f32x4*)(gamma + 4 * (lane + 64 * j));
    if (gw < M) {
#pragma unroll
        for (int j = 0; j < 4; ++j) nx[j] = ((const f32x4*)(X + (size_t)gw * DM) + lane)[64 * j];
    }
    for (int m = gw; m < M; m += NGW) {
        f32x4 v[4]; float s = 0.f;
#pragma unroll
        for (int j = 0; j < 4; ++j) { v[j] = nx[j]; s += (v[j][0] * v[j][0] + v[j][1] * v[j][1]) + (v[j][2] * v[j][2] + v[j][3] * v[j][3]); }
        if (m + NGW < M) {
#pragma unroll
            for (int j = 0; j < 4; ++j) nx[j] = ((const f32x4*)(X + (size_t)(m + NGW) * DM) + lane)[64 * j];
        }
        const float* mb = mod_l + (size_t)(m >> 12) * NMOD + sc_idx * DM;
        f32x4 sc[4];
#pragma unroll
        for (int j = 0; j < 4; ++j) sc[j] = *(const f32x4*)(mb + 4 * (lane + 64 * j));
        const float tot = wave_sum(s);
        u32x2* o8 = (u32x2*)(XS + (size_t)m * DM) + lane;
#pragma unroll
        for (int j = 0; j < 4; ++j) o8[64 * j] = pack4(v[j] * g[j] * (sc[j] + 1.f));
        if (lane < 4) *(f32x4*)(F.SS + (size_t)m * 16 + 4 * lane) = (f32x4){lane == 0 ? tot : 0.f, 0.f, 0.f, 0.f};
    }
}
__device__ __forceinline__ void sw_phase(Frame& F, const int lsel, const int gw, const int NGW, const int t_lo = 0, const int t_hi = PINP + DUP) {
    const int tid = opaque_tid(), lane = tid & 63;
    LAS float* shl = (LAS float*)F.lds;
    for (int i = tid; i < 2 * NB * DM / 4; i += NWAVES * 64) { const int e = 4 * i, k = e & 1023, b = (e >> 10) & 7, wh = (e >> 13) & 1;
        *(LAS f32x4*)(shl + e) = *(const f32x4*)(F.MOD + (size_t)(lsel * NB + b) * NMOD + (wh ? 3 : 0) * DM + k); }
    __syncthreads();
    const int NT = t_hi;
#define SW_ROW(t_) ({ const int l_ = lsel, r_ = (t_), wh_ = r_ >= PINP ? 1 : 0, n_ = r_ - wh_ * PINP; (wh_ ? F.WUP + ((size_t)l_ * DUP + n_) * DM : F.WIN + ((size_t)l_ * PINP + n_) * DM) + 16 * lane; })
    u32x4 nwa = (u32x4){0u, 0u, 0u, 0u}, nwb = nwa;
    if (t_lo + gw < NT) { const bf16* w_ = SW_ROW(t_lo + gw); nwa = *(const u32x4*)(w_); nwb = *(const u32x4*)(w_ + 8); }
    for (int t = t_lo + gw; t < NT; t += NGW) {
        const int l = lsel, r = t, wh = r >= PINP ? 1 : 0, n = r - wh * PINP;
        const u32x4 wa = nwa, wb = nwb;
        if (t + NGW < NT) { const bf16* w_ = SW_ROW(t + NGW); nwa = *(const u32x4*)(w_); nwb = *(const u32x4*)(w_ + 8); }
        float w[16] = {bflo(wa.x), bfhi(wa.x), bflo(wa.y), bfhi(wa.y), bflo(wa.z), bfhi(wa.z), bflo(wa.w), bfhi(wa.w), bflo(wb.x), bfhi(wb.x), bflo(wb.y), bfhi(wb.y), bflo(wb.z), bfhi(wb.z), bflo(wb.w), bfhi(wb.w)};
        float res = 0.f;
#pragma unroll
        for (int b = 0; b < NB; ++b) { const LAS float* sp = shl + (wh * NB + b) * DM + 16 * lane; float a = 0.f;
#pragma unroll
            for (int j = 0; j < 4; ++j) { const f32x4 sv = *(const LAS f32x4*)(sp + 4 * j); a += (sv[0] * w[4 * j] + sv[1] * w[4 * j + 1]) + (sv[2] * w[4 * j + 2] + sv[3] * w[4 * j + 3]); }
            a = wave_sum(a); if (lane == b) res = a; }
        if (lane < NB) { float* dst = wh ? F.SW2 + ((size_t)(l * NB + lane)) * DUP + n : F.SW1 + ((size_t)(l * NB + lane)) * PINP + n; *dst = res; }
    }
#undef SW_ROW
    __syncthreads();
}

__device__ __forceinline__ void final_scale_phase(Frame& F, const bf16* XS, float* out) {
    const int gw = F.vcu * NWAVES + F.wave, NGW = F.G * NWAVES, lane = opaque_tid() & 63;
    u32x2 nx[4]; float nss = 0.f;
#define FS_LOAD(m_) do { _Pragma("unroll") for (int j = 0; j < 4; ++j) nx[j] = ((const u32x2*)(XS + (size_t)(m_) * DM) + lane)[64 * j]; nss = F.SS[(size_t)(m_) * 16 + (lane & 15)]; } while (0)
    if (gw < M) FS_LOAD(gw);
    for (int m = gw; m < M; m += NGW) {
        u32x2 v[4];
#pragma unroll
        for (int j = 0; j < 4; ++j) v[j] = nx[j];
        const float ss = nss;
        if (m + NGW < M) FS_LOAD(m + NGW);
        const float rstd = __builtin_amdgcn_rsqf(red16(ss) * (1.f / DM) + 1e-6f);
        f32x4* o = (f32x4*)(out + (size_t)m * DM) + lane;
#pragma unroll
        for (int j = 0; j < 4; ++j) o[64 * j] = unpack4(v[j]) * rstd;
    }
#undef FS_LOAD
}

#define LDS_BAR() do { asm volatile("s_waitcnt lgkmcnt(0)" ::: "memory"); __builtin_amdgcn_s_barrier(); asm volatile("" ::: "memory"); } while (0)
template <int PARTS  >
__device__ __forceinline__ void mix_chunk(Frame& F, const int l, const int ch) {
    const int wave = F.wave;
    const int n = ch & 31; const size_t r0 = (size_t)ch * 128;
    const bf16* P = F.P; bf16* Y = F.HY;
    LAS unsigned char* lds = F.lds;
#ifndef MK_MIXDUP
#define MK_MIXDUP 0
#endif
    if (PARTS & 1) for (int mrep = 0; mrep <= ((MK_MIXDUP) & 1); ++mrep) {
        if (mrep) LDS_BAR();
        const int tid = opaque_tid(), lane = tid & 63, r = lane & 31, hh = lane >> 5;
        LAS bf16* VT = (LAS bf16*)lds;
        LAS f32x2* ST = (LAS f32x2*)(lds + 69632);
        const int t = tid & 127, q = __builtin_amdgcn_readfirstlane(tid >> 7);
        const bf16* src = P + (r0 + t) * PINP + 256 + 64 * q;
        float v[64]; float s = 0.f, ss = 0.f;
#pragma unroll
        for (int i = 0; i < 8; ++i) { const u32x4 w = *(const u32x4*)(src + 8 * i);
            const float e0 = fgelu(bflo(w.x)), e1 = fgelu(bfhi(w.x)), e2 = fgelu(bflo(w.y)), e3 = fgelu(bfhi(w.y)), e4 = fgelu(bflo(w.z)), e5 = fgelu(bfhi(w.z)), e6 = fgelu(bflo(w.w)), e7 = fgelu(bfhi(w.w));
            v[8 * i + 0] = e0; v[8 * i + 1] = e1; v[8 * i + 2] = e2; v[8 * i + 3] = e3; v[8 * i + 4] = e4; v[8 * i + 5] = e5; v[8 * i + 6] = e6; v[8 * i + 7] = e7;
            s += ((e0 + e1) + (e2 + e3)) + ((e4 + e5) + (e6 + e7)); ss += ((e0 * e0 + e1 * e1) + (e2 * e2 + e3 * e3)) + ((e4 * e4 + e5 * e5) + (e6 * e6 + e7 * e7)); }
        const int h = wave >> 1, dh = wave & 1;
        const bf16* Wg = F.SGUW + (size_t)(l * 4 + h) * 128 * 128;
        bf16x8 wn[8]; u32x2 uqn[4]; float biasn;
#pragma unroll
        for (int ks = 0; ks < 8; ++ks) wn[ks] = (bf16x8){0, 0, 0, 0, 0, 0, 0, 0};
#define A_PREF(tb_) do { const bf16* wrow_ = Wg + (size_t)(32 * (tb_) + r) * 128 + 8 * hh; _Pragma("unroll") for (int ks = 0; ks < 8; ++ks) if (ks < 2 * ((tb_) + 1)) wn[ks] = *(const bf16x8*)(wrow_ + 16 * ks); \
        const size_t row_ = r0 + 32 * (tb_) + r; biasn = F.sgu_b[(l * 4 + h) * 128 + 32 * (tb_) + r]; _Pragma("unroll") for (int g = 0; g < 4; ++g) uqn[g] = *(const u32x2*)(P + row_ * PINP + 64 * h + 32 * dh + 8 * g + 4 * hh); } while (0)
        A_PREF(0);
        ST[q * 128 + t] = (f32x2){s, ss};
        LDS_BAR();
        const f32x2 a0 = ST[t], a1 = ST[128 + t], a2 = ST[256 + t], a3 = ST[384 + t];
        const float mean = ((a0.x + a1.x) + (a2.x + a3.x)) * (1.f / 256.f), ex2 = ((a0.y + a1.y) + (a2.y + a3.y)) * (1.f / 256.f);
        const float rstd = __builtin_amdgcn_rsqf(fmaxf(ex2 - mean * mean, 0.f) + 1e-5f);
        const float* lg = F.sgu_ln_g + l * DA + 64 * q; const float* lb = F.sgu_ln_b + l * DA + 64 * q;
        {
            f32x4 gn[4], bn[4];
#pragma unroll
            for (int j = 0; j < 4; ++j) { gn[j] = *(const f32x4*)(lg + 4 * j); bn[j] = *(const f32x4*)(lb + 4 * j); }
#pragma unroll
            for (int grp = 0; grp < 4; ++grp) {
                f32x4 gc[4], bc[4];
#pragma unroll
                for (int j = 0; j < 4; ++j) { gc[j] = gn[j]; bc[j] = bn[j]; }
                if (grp < 3) {
#pragma unroll
                    for (int j = 0; j < 4; ++j) { gn[j] = *(const f32x4*)(lg + 16 * (grp + 1) + 4 * j); bn[j] = *(const f32x4*)(lb + 16 * (grp + 1) + 4 * j); } }
#pragma unroll
                for (int i = 0; i < 16; ++i) VT[(64 * q + 16 * grp + i) * 136 + t] = f2bf((v[16 * grp + i] - mean) * rstd * gc[i >> 2][i & 3] + bc[i >> 2][i & 3]);
            }
        }
        LDS_BAR();
        const LAS bf16* vrow = VT + (64 * h + 32 * dh + r) * 136 + 8 * hh;
#pragma unroll 1
        for (int tb = 0; tb < 4; ++tb) {
            bf16x8 wf[8]; u32x2 uq[4];
#pragma unroll
            for (int ks = 0; ks < 8; ++ks) wf[ks] = wn[ks];
#pragma unroll
            for (int g = 0; g < 4; ++g) uq[g] = uqn[g];
            const float bias = biasn;
            if (tb < 3) A_PREF(tb + 1);
            f32x16 acc;
#pragma unroll
            for (int i = 0; i < 16; ++i) acc[i] = 0.f;
#pragma unroll
            for (int ks = 0; ks < 8; ++ks) if (ks < 2 * (tb + 1)) {
                const bf16x8 a = *(const LAS bf16x8*)(vrow + 16 * ks);
                acc = __builtin_amdgcn_mfma_f32_32x32x16_bf16(a, wf[ks], acc, 0, 0, 0);
            }
            const int tt = 32 * tb + r; const size_t row = r0 + tt;
#pragma unroll
            for (int g = 0; g < 4; ++g) { const int c4 = 64 * h + 32 * dh + 8 * g + 4 * hh;
                const f32x4 u = unpack4(uq[g]);
                f32x4 y; y[0] = fgelu(u[0]) * (acc[4 * g + 0] + bias); y[1] = fgelu(u[1]) * (acc[4 * g + 1] + bias); y[2] = fgelu(u[2]) * (acc[4 * g + 2] + bias); y[3] = fgelu(u[3]) * (acc[4 * g + 3] + bias);
                *(u32x2*)(Y + row * DM + c4) = pack4(y); }
        }
#undef A_PREF
    }
    LDS_BAR();
    if (PARTS & 2) for (int mrep = 0; mrep <= (((MK_MIXDUP) >> 1) & 1); ++mrep) {
        if (mrep) LDS_BAR();
        const int tid = opaque_tid(), lane = tid & 63, r = lane & 31, hh = lane >> 5;
        LAS bf16* XC = (LAS bf16*)lds;
        LAS float* LA = (LAS float*)(lds + 25088);
        LAS float* BT = (LAS float*)(lds + 25088 + 49152);
        const int q = tid % 96, rs = tid / 96, c4 = 4 * q; const bool act = tid < DB;
        f32x4 cw0, cw1, cw2, cw3, cb;
        { cw0 = *(const f32x4*)(F.lru_conv_w + (l * 4 + 0) * DB + c4); cw1 = *(const f32x4*)(F.lru_conv_w + (l * 4 + 1) * DB + c4); cw2 = *(const f32x4*)(F.lru_conv_w + (l * 4 + 2) * DB + c4); cw3 = *(const f32x4*)(F.lru_conv_w + (l * 4 + 3) * DB + c4);
          cb = *(const f32x4*)(F.lru_conv_b + l * DB + c4); }
        float hst = 0.f, ca = 1.f;
        const int ln = tid & 31, rs16 = tid >> 5;
        f32x4 bra3[3], bix3[3], sp83[3];
#pragma unroll
        for (int j = 0; j < 3; ++j) { const int cj = 4 * (ln + 32 * j);
            bra3[j] = *(const f32x4*)(F.lru_b_a + l * DB + cj); bix3[j] = *(const f32x4*)(F.lru_b_x + l * DB + cj);
            const f32x4 lam = *(const f32x4*)(F.lru_lambda + l * DB + cj);
#pragma unroll
            for (int e = 0; e < 4; ++e) sp83[j][e] = -8.f * fsoftplus_acc(-lam[e]); }
        bf16x8 wB[3][4];
#pragma unroll
        for (int k = 0; k < 3; ++k) { const int id = wave + 8 * k, mat = id / 12, hb = (id % 12) >> 1, jt = id & 1;
            const bf16* Wt = (mat ? F.LRUWX : F.LRUWA) + (size_t)((l * 6 + hb) * 64 + 32 * jt + r) * 64 + 8 * hh;
#pragma unroll
            for (int ks = 0; ks < 4; ++ks) wB[k][ks] = *(const bf16x8*)(Wt + 16 * ks); }
        u32x2 raw[11];
#define B1_LOAD(tq_) do { if (act) { const bf16* src_ = P + (r0 + 32 * (tq_) + 8 * rs) * PINP + 512 + c4; const bool halo_ = (n > 0) || ((tq_) > 0) || (rs > 0); \
        _Pragma("unroll") for (int i = 0; i < 11; ++i) raw[i] = (i >= 3 || halo_) ? *(const u32x2*)(src_ + (ptrdiff_t)(i - 3) * PINP) : (u32x2){0u, 0u}; } } while (0)
        B1_LOAD(0);
        for (int tq = 0; tq < 4; ++tq) {
            u32x2 yg[2][3];
#pragma unroll
            for (int i = 0; i < 2; ++i) {
#pragma unroll
                for (int j = 0; j < 3; ++j) yg[i][j] = *(const u32x2*)(P + (r0 + 32 * tq + rs16 + 16 * i) * PINP + 896 + 4 * (ln + 32 * j)); }
            if (act) {
                f32x4 x3 = unpack4(raw[0]), x2 = unpack4(raw[1]), x1 = unpack4(raw[2]);
#pragma unroll
                for (int i = 0; i < 8; ++i) { const f32x4 x0 = unpack4(raw[3 + i]);
                    const f32x4 xc = cb + cw0 * x3 + cw1 * x2 + cw2 * x1 + cw3 * x0; x3 = x2; x2 = x1; x1 = x0;
                    *(LAS u32x2*)(XC + (8 * rs + i) * 392 + c4) = pack4(xc); }
            }
            if (tq < 3) B1_LOAD(tq + 1);
            LDS_BAR();
#pragma unroll
            for (int k = 0; k < 3; ++k) {
                const int id = wave + 8 * k, mat = id / 12, hb = (id % 12) >> 1, jt = id & 1;
                const LAS bf16* xrow = XC + r * 392 + 64 * hb + 8 * hh;
                f32x16 acc;
#pragma unroll
                for (int i = 0; i < 16; ++i) acc[i] = 0.f;
#pragma unroll
                for (int ks = 0; ks < 4; ++ks) { const bf16x8 a = *(const LAS bf16x8*)(xrow + 16 * ks);
                    acc = __builtin_amdgcn_mfma_f32_32x32x16_bf16(a, wB[k][ks], acc, 0, 0, 0); }
                LAS float* dst = (mat ? BT : LA) + 64 * hb + 32 * jt + r;
#pragma unroll
                for (int rg = 0; rg < 16; ++rg) dst[((rg & 3) + 8 * (rg >> 2) + 4 * hh) * DB] = acc[rg];
            }
            LDS_BAR();
#pragma unroll
            for (int i = 0; i < 2; ++i) { const int tl = rs16 + 16 * i;
#pragma unroll
                for (int j = 0; j < 3; ++j) { const int cj = 4 * (ln + 32 * j);
                    const f32x4 rp = *(const LAS f32x4*)(LA + tl * DB + cj) + bra3[j], ip = *(const LAS f32x4*)(BT + tl * DB + cj) + bix3[j];
                    const f32x4 xc = unpack4(*(const LAS u32x2*)(XC + tl * 392 + cj));
                    f32x4 av, bv;
#pragma unroll
                    for (int e = 0; e < 4; ++e) { const float la = sp83[j][e] * fsigmoid(rp[e]); const float a = fexp(la); av[e] = a;
                        const float x2 = 2.f * la, ser = -x2 * (1.f + x2 * (0.5f + x2 * (0.16666667f + x2 * (0.041666668f + x2 * (0.008333334f + x2 * 0.0013888889f)))));
                        const float om = x2 > -0.25f ? ser : 1.f - a * a;
                        bv[e] = __builtin_amdgcn_sqrtf(fmaxf(om, 0.f)) * (fsigmoid(ip[e]) * xc[e]); }
                    *(LAS f32x4*)(LA + tl * DB + cj) = av; *(LAS f32x4*)(BT + tl * DB + cj) = bv; } }
            LDS_BAR();
            if (act) {
#pragma unroll 8
                for (int i = 0; i < 32; ++i) { const float a = LA[i * DB + tid], bt = BT[i * DB + tid]; hst = a * hst + bt; ca *= a; LA[i * DB + tid] = hst; BT[i * DB + tid] = ca; }
            }
            LDS_BAR();
#pragma unroll
            for (int i = 0; i < 2; ++i) { const int tl = rs16 + 16 * i; const size_t row = r0 + 32 * tq + tl;
#pragma unroll
                for (int j = 0; j < 3; ++j) { const int cj = 4 * (ln + 32 * j);
                    const f32x4 h4 = *(const LAS f32x4*)(LA + tl * DB + cj), ca4 = *(const LAS f32x4*)(BT + tl * DB + cj), y4 = unpack4(yg[i][j]);
                    f32x4 gl; gl[0] = fgelu(y4[0]); gl[1] = fgelu(y4[1]); gl[2] = fgelu(y4[2]); gl[3] = fgelu(y4[3]);
                    *(u32x2*)(Y + row * DM + 256 + cj) = pack4(gl * h4); *(u32x2*)(F.Q2 + row * DB + cj) = pack4(gl * ca4); } }
        }
#undef B1_LOAD
        if (act) { F.LRUSA[(size_t)ch * DB + tid] = ca; F.LRUSH[(size_t)ch * DB + tid] = hst; }
    }
    LDS_BAR();
    if (PARTS & 4) for (int mrep = 0; mrep <= (((MK_MIXDUP) >> 2) & 1); ++mrep) {
        if (mrep) LDS_BAR();
        const int tid = opaque_tid(), lane = tid & 63, r = lane & 31, hh = lane >> 5;
        LAS bf16* TW = (LAS bf16*)lds;
        LAS bf16* XA = TW + 32 * 72;
        LAS bf16* SG = XA + 32 * 72;
        LAS float* LW = (LAS float*)(lds + 17920);
        LAS bf16* LAa = (LAS bf16*)(lds + 67072);
        LAS bf16* LG = (LAS bf16*)(lds + 91648);
        LAS float* CT = (LAS float*)(lds + 116224);
        const float* mu = F.rwkv_mu + l * 1408;
        for (int idx = tid; idx < 8 * 96; idx += NWAVES * 64) { const int arr = idx / 96, qd = idx - 96 * arr;
            const float* srcp = arr < 3 ? mu + 384 * arr : (arr == 3 ? F.rwkv_w0 : (arr == 4 ? F.rwkv_a0 : (arr == 5 ? F.rwkv_k_k : (arr == 6 ? F.rwkv_k_a : F.rwkv_r_k)))) + l * DC;
            *(LAS f32x4*)(CT + 384 * arr + 4 * qd) = *(const f32x4*)(srcp + 4 * qd); }
        const int ln = tid & 31, rs16 = tid >> 5;
        const bf16* pc = P + PC_OFF + 1152 + 4 * lane; const f32x4 mu4 = *(const f32x4*)(mu + 1152 + 4 * lane);
        LAS bf16* c1dst = lane < 16 ? TW + 4 * lane : (lane < 32 ? XA + 4 * (lane - 16) : SG + 4 * (lane - 32));
        const int c1stride = lane < 32 ? 72 : 136;
        u32x2 c1r[5];
#define C1_LOAD(tb_) do { const int t0_ = 32 * (tb_) + 4 * wave; c1r[0] = (t0_ > 0 || n > 0) ? *(const u32x2*)(pc + (r0 + t0_ - 1) * PINP) : (u32x2){0u, 0u}; \
        _Pragma("unroll") for (int i = 0; i < 4; ++i) c1r[1 + i] = *(const u32x2*)(pc + (r0 + t0_ + i) * PINP); } while (0)
        C1_LOAD(0);
        const float c1m = lane < 16 ? 2.f : 1.f;
#ifndef MK_TSEC
#define MK_TSEC -1
#endif
#define TSEC_MARK(k_) do { if (MK_TSEC >= 0 && tid == 0) { asm volatile("s_waitcnt vmcnt(0) lgkmcnt(0)" ::: "memory"); volatile LAS unsigned long long* ts_ = (volatile LAS unsigned long long*)(lds + 140000); \
        const unsigned long long t_ = __builtin_amdgcn_s_memrealtime(); if ((k_) >= 0) ts_[(k_) < 0 ? 0 : (k_)] += t_ - ts_[3]; ts_[3] = t_; } } while (0)
        for (int tb = 0; tb < 4; ++tb) {
            if (MK_TSEC >= 0 && tb > 0) C1_LOAD(tb);
            TSEC_MARK(-1);
            int lnq = ln, rsq = rs16; asm volatile("" : "+v"(lnq), "+v"(rsq));
            {
                f32x4 prev = unpack4(c1r[0]);
#pragma unroll
                for (int i = 0; i < 4; ++i) {
                    const f32x4 cur = unpack4(c1r[1 + i]);
                    const f32x4 xs = cur + (prev - cur) * mu4; prev = cur;
                    f32x4 y;
#pragma unroll
                    for (int e = 0; e < 4; ++e) { const float sg = fsigmoid(c1m * xs[e]); y[e] = lane < 16 ? 2.f * sg - 1.f : (lane < 32 ? xs[e] : sg); }
                    *(LAS u32x2*)(c1dst + (4 * wave + i) * c1stride) = pack4(y); }
            }
            LDS_BAR();
            TSEC_MARK(0);
            struct RowIn { u32x2 rc, kc, vc, rp, kp, vp; };
#define C3_LOAD(T, it_) do { const int t_ = 32 * tb + rsq + 16 * ((it_) / 3); const bf16* prow_ = P + (r0 + t_) * PINP + PC_OFF + 4 * (lnq + 32 * ((it_) % 3)); T.rc = *(const u32x2*)(prow_); T.kc = *(const u32x2*)(prow_ + 384); T.vc = *(const u32x2*)(prow_ + 768); \
        if (t_ > 0 || n > 0) { T.rp = *(const u32x2*)(prow_ - PINP); T.kp = *(const u32x2*)(prow_ - PINP + 384); T.vp = *(const u32x2*)(prow_ - PINP + 768); } else { T.rp = (u32x2){0u, 0u}; T.kp = T.rp; T.vp = T.rp; } } while (0)
            RowIn rin[3];
            {
                int wr = r, whh = hh; asm volatile("" : "+v"(wr), "+v"(whh));
                const bool lowv = wave < 4;
#define C2_OUT32(ACC_, dst_) do { LAS float* d = (dst_); _Pragma("unroll") for (int rg = 0; rg < 16; ++rg) d[((rg & 3) + 8 * (rg >> 2) + 4 * hh) * 384] = ACC_[rg]; } while (0)
#define C2_OUT16(ACC_, dst_) do { LAS bf16* d = (dst_); _Pragma("unroll") for (int rg = 0; rg < 16; ++rg) d[((rg & 3) + 8 * (rg >> 2) + 4 * hh) * 384] = f2bf_n(ACC_[rg]); } while (0)
#define C2_ZERO(ACC_) do { _Pragma("unroll") for (int i = 0; i < 16; ++i) ACC_[i] = 0.f; } while (0)
                const int wl = 8 * (32 * whh + wr);
                const bf16* pg0 = F.RG2 + (size_t)((l * 12 + wave) * 8) * 512 + wl;
                const bf16* p1 = lowv ? F.RG2 + (size_t)((l * 12 + 8 + wave) * 8) * 512 + wl : F.RW2 + (size_t)((l * 12 + wave - 4) * 4) * 512 + wl;
                bf16x8 wa0[8], wa1[8];
#pragma unroll
                for (int ks = 0; ks < 8; ++ks) wa0[ks] = *(const bf16x8*)(pg0 + 512 * ks);
#pragma unroll
                for (int ks = 0; ks < 8; ++ks) wa1[ks] = *(const bf16x8*)(p1 + (lowv ? 512 * ks : 512 * (ks & 3)));
                f32x16 acc0, acc1;
                C2_ZERO(acc0); C2_ZERO(acc1);
                { const LAS bf16* xr = SG + r * 136 + 8 * hh;
#pragma unroll
                  for (int ks = 0; ks < 8; ++ks) acc0 = __builtin_amdgcn_mfma_f32_32x32x16_bf16(*(const LAS bf16x8*)(xr + 16 * ks), wa0[ks], acc0, 0, 0, 0); }
                { const LAS bf16* xr = lowv ? SG + r * 136 + 8 * hh : TW + r * 72 + 8 * hh;
#pragma unroll
                  for (int ks = 0; ks < 4; ++ks) acc1 = __builtin_amdgcn_mfma_f32_32x32x16_bf16(*(const LAS bf16x8*)(xr + 16 * ks), wa1[ks], acc1, 0, 0, 0);
                  if (lowv) {
#pragma unroll
                      for (int ks = 4; ks < 8; ++ks) acc1 = __builtin_amdgcn_mfma_f32_32x32x16_bf16(*(const LAS bf16x8*)(xr + 16 * ks), wa1[ks], acc1, 0, 0, 0); } }
                const bf16* p2 = F.RW2 + (size_t)((l * 12 + 4 + wave) * 4) * 512 + wl;
                const bf16* p3 = F.RA2 + (size_t)((l * 12 + wave) * 4) * 512 + wl;
                const bf16* p4 = F.RA2 + (size_t)((l * 12 + (lowv ? 8 + wave : wave)) * 4) * 512 + wl;
                bf16x8 wb2[4], wb3[4], wb4[4];
#pragma unroll
                for (int ks = 0; ks < 4; ++ks) { wb2[ks] = *(const bf16x8*)(p2 + 512 * ks); wb3[ks] = *(const bf16x8*)(p3 + 512 * ks); wb4[ks] = *(const bf16x8*)(p4 + 512 * ks); }
                C3_LOAD(rin[0], 0); C3_LOAD(rin[1], 1);
                C2_OUT16(acc0, LG + 32 * wave + r);
                if (lowv) C2_OUT16(acc1, LG + 32 * (8 + wave) + r); else C2_OUT32(acc1, LW + 32 * (wave - 4) + r);
                C2_ZERO(acc0); C2_ZERO(acc1);
                { const LAS bf16* xr = TW + r * 72 + 8 * hh;
#pragma unroll
                  for (int ks = 0; ks < 4; ++ks) acc0 = __builtin_amdgcn_mfma_f32_32x32x16_bf16(*(const LAS bf16x8*)(xr + 16 * ks), wb2[ks], acc0, 0, 0, 0); }
                { const LAS bf16* xr = XA + r * 72 + 8 * hh;
#pragma unroll
                  for (int ks = 0; ks < 4; ++ks) acc1 = __builtin_amdgcn_mfma_f32_32x32x16_bf16(*(const LAS bf16x8*)(xr + 16 * ks), wb3[ks], acc1, 0, 0, 0); }
                C2_OUT32(acc0, LW + 32 * (4 + wave) + r);
                C2_OUT16(acc1, LAa + 32 * wave + r);
                if (lowv) { C2_ZERO(acc0); const LAS bf16* xr = XA + r * 72 + 8 * hh;
#pragma unroll
                    for (int ks = 0; ks < 4; ++ks) acc0 = __builtin_amdgcn_mfma_f32_32x32x16_bf16(*(const LAS bf16x8*)(xr + 16 * ks), wb4[ks], acc0, 0, 0, 0);
                    C2_OUT16(acc0, LAa + 32 * (8 + wave) + r); }
#undef C2_OUT32
#undef C2_OUT16
#undef C2_ZERO
            }
            LDS_BAR();
            TSEC_MARK(1);
            if (MK_TSEC < 0 && tb < 3) C1_LOAD(tb + 1);
#pragma unroll
            for (int it = 0; it < 6; ++it) {
                if (it + 2 < 6) C3_LOAD(rin[(it + 2) % 3], it + 2);
                const RowIn& T = rin[it % 3];
                const int tl = rsq + 16 * (it / 3), n4 = 4 * (lnq + 32 * (it % 3)); const size_t row = r0 + 32 * tb + tl;
                const f32x4 p_mr = *(const LAS f32x4*)(CT + n4), p_mk = *(const LAS f32x4*)(CT + 384 + n4), p_mv = *(const LAS f32x4*)(CT + 768 + n4), p_w0 = *(const LAS f32x4*)(CT + 1152 + n4),
                            p_a0 = *(const LAS f32x4*)(CT + 1536 + n4), p_kk = *(const LAS f32x4*)(CT + 1920 + n4), p_ka = *(const LAS f32x4*)(CT + 2304 + n4), p_rk = *(const LAS f32x4*)(CT + 2688 + n4);
                f32x4 rc = unpack4(T.rc), kc = unpack4(T.kc), vc = unpack4(T.vc);
                const f32x4 rp = unpack4(T.rp), kp = unpack4(T.kp), vp = unpack4(T.vp);
                rc = rc + (rp - rc) * p_mr; kc = kc + (kp - kc) * p_mk; vc = vc + (vp - vc) * p_mv;
                const f32x4 lw = *(const LAS f32x4*)(LW + tl * 384 + n4), la = unpack4(*(const LAS u32x2*)(LAa + tl * 384 + n4));
                const u32x2 lg = *(const LAS u32x2*)(LG + tl * 384 + n4);
                const f32x4 kr = kc * p_kk;
                const float ss = red16((kr[0] * kr[0] + kr[1] * kr[1]) + (kr[2] * kr[2] + kr[3] * kr[3]));
                const float rn = __builtin_amdgcn_rsqf(fmaxf(ss, 1e-24f));
                f32x4 dec, km, kk4, bv4;
#pragma unroll
                for (int e = 0; e < 4; ++e) {
                    dec[e] = -0.6065306597f * fsigmoid(p_w0[e] + lw[e]);
                    const float a = fsigmoid(p_a0[e] + la[e]);
                    kk4[e] = kr[e] * rn; bv4[e] = kk4[e] * a;
                    km[e] = kc[e] * (1.f + (a - 1.f) * p_ka[e]); }
                { const f32x4 t4 = rc * km * p_rk; const float bon = red16((t4[0] + t4[1]) + (t4[2] + t4[3])); if ((lnq & 15) == 0) F.BON[row * 6 + (n4 >> 6)] = bon; }
                *(u32x2*)(F.R + row * DC + n4) = pack4(rc); *(u32x2*)(F.K + row * DC + n4) = pack4(km); *(u32x2*)(F.V + row * DC + n4) = pack4(vc);
                *(u32x2*)(F.LD + row * DC + n4) = pack4(dec); *(u32x2*)(F.KK + row * DC + n4) = pack4(kk4); *(u32x2*)(F.BV + row * DC + n4) = pack4(bv4);
                *(u32x2*)(Y + row * DM + 640 + n4) = lg;
            }
#undef C3_LOAD
            TSEC_MARK(2);
        }
        if (MK_TSEC >= 0 && l == 0 && F.vcu == 0 && tid == 0) { volatile LAS unsigned long long* ts_ = (volatile LAS unsigned long long*)(lds + 140000); unsigned long long* slot = (unsigned long long*)((unsigned char*)F.ctl + 49152); slot[0] = ts_[0]; slot[1] = ts_[1]; slot[2] = ts_[2]; }
#undef C1_LOAD
    }
    LDS_BAR();
}

__device__ __forceinline__ void rwkv_scan_item(Frame& F, const int it) {
#define SC_BAR() do { asm volatile("s_waitcnt lgkmcnt(0)" ::: "memory"); __builtin_amdgcn_s_barrier(); asm volatile("" ::: "memory"); } while (0)
    const int tid = opaque_tid();
    const int b = it / 24, h = (it % 24) >> 2, qt = it & 3;
    constexpr int CS = 16;
    constexpr int BUFF = 5 * CS * 64 + CS * 16;
    constexpr int OPF = CS * 16 * 16;
    constexpr int NCK = SEQ / CS;
    LAS float* buf = (LAS float*)F.lds;
    LAS float* opart = buf + 2 * BUFF;
    const size_t base = (size_t)b * SEQ * DC + 64 * h;
    if (tid >= 256) {
        const int lt = tid - 256, st = lt >> 4, q = lt & 15, vst = lt >> 2, vq = lt & 3;
        const size_t go = base + (size_t)st * DC + 4 * q;
        const bf16* gKK = F.KK + go; const bf16* gBV = F.BV + go; const bf16* gK = F.K + go; const bf16* gR = F.R + go; const bf16* gW = F.LD + go;
        const bf16* gV = F.V + base + (size_t)vst * DC + 16 * qt + 4 * vq;
        const int fg = lt >> 6, frow = (lt >> 2) & 15, fqd = lt & 3;
        bf16* gO = F.O + base + 16 * qt + (size_t)(4 * fg + fqd) * DC + frow;
        const bool ldv = lt < CS * 4;
        u32x2 kk0, bv0, k0, r0, v0 = (u32x2){0u, 0u}, kk1, bv1, k1, r1, v1 = (u32x2){0u, 0u}, kk2, bv2, k2, r2, v2 = (u32x2){0u, 0u}, w0, w1, w2;
#define SC_LOAD(S, ck) do { const size_t _o = (size_t)(ck) * CS * DC; kk##S = *(const u32x2*)(gKK + _o); bv##S = *(const u32x2*)(gBV + _o); k##S = *(const u32x2*)(gK + _o); r##S = *(const u32x2*)(gR + _o); \
        w##S = *(const u32x2*)(gW + _o); if (ldv) v##S = *(const u32x2*)(gV + _o); } while (0)
#define SC_STORE(S, bb) do { LAS float* _b = (bb) + st * 64 + 4 * q; *(LAS f32x4*)(_b) = unpack4(kk##S); { const f32x4 ld_ = unpack4(w##S); *(LAS f32x4*)(_b + CS * 64) = (f32x4){fexp(ld_[0]), fexp(ld_[1]), fexp(ld_[2]), fexp(ld_[3])}; } *(LAS f32x4*)(_b + 2 * CS * 64) = unpack4(bv##S); \
        *(LAS f32x4*)(_b + 3 * CS * 64) = unpack4(k##S); *(LAS f32x4*)(_b + 4 * CS * 64) = unpack4(r##S); if (ldv) { const f32x4 vv_ = unpack4(v##S); LAS float* _v = (bb) + 5 * CS * 64 + (4 * vq) * CS + vst; _v[0] = vv_[0]; _v[CS] = vv_[1]; _v[2 * CS] = vv_[2]; _v[3 * CS] = vv_[3]; } } while (0)
#define SC_FLUSH(ckf) do { const LAS f32x4* pp = (const LAS f32x4*)(opart + ((ckf) & 1) * OPF + fg * 1024 + 64 * frow + 16 * fqd); \
        f32x4 sm = (pp[0] + pp[1]) + (pp[2] + pp[3]); \
        _Pragma("unroll") for (int e_ = 0; e_ < 4; ++e_) { float x_ = sm[e_]; x_ += dppf<0xB1>(x_); x_ += dppf<0x4E>(x_); sm[e_] = x_; } \
        gO[(size_t)(ckf) * CS * DC] = f2bf(fqd == 0 ? sm[0] : (fqd == 1 ? sm[1] : (fqd == 2 ? sm[2] : sm[3]))); } while (0)
#define SC_ITER(S, c) do { if ((c) > 0) SC_FLUSH((c) - 1); if ((c) + 1 < NCK) SC_STORE(S, buf + (((c) + 1) & 1) * BUFF); if ((c) + 4 < NCK) SC_LOAD(S, (c) + 4); SC_BAR(); } while (0)
        SC_LOAD(0, 0); SC_LOAD(1, 1); SC_LOAD(2, 2); SC_STORE(0, buf); SC_LOAD(0, 3);
        SC_BAR();
        for (int ck = 0; ck < NCK; ck += 3) {
            SC_ITER(1, ck);
            if (ck + 1 < NCK) SC_ITER(2, ck + 1);
            if (ck + 2 < NCK) SC_ITER(0, ck + 2);
        }
        SC_FLUSH(NCK - 1);
#undef SC_ITER
#undef SC_LOAD
#undef SC_STORE
#undef SC_FLUSH
    } else {
        const int gl = tid & 15, row = tid >> 4;
#define SC_READ(T, cbp, tt) do { T.kk = *(const LAS f32x4*)((cbp) + (tt) * 64 + 4 * gl); T.w = *(const LAS f32x4*)((cbp) + CS * 64 + (tt) * 64 + 4 * gl); T.bb = *(const LAS f32x4*)((cbp) + 2 * CS * 64 + (tt) * 64 + 4 * gl); \
        T.k = *(const LAS f32x4*)((cbp) + 3 * CS * 64 + (tt) * 64 + 4 * gl); T.r = *(const LAS f32x4*)((cbp) + 4 * CS * 64 + (tt) * 64 + 4 * gl); } while (0)
        struct StepIn { f32x4 kk, w, bb, k, r; };
        SC_BAR();
        f32x2 sA = (f32x2){0.f, 0.f}, sB = (f32x2){0.f, 0.f};
        for (int ck = 0; ck < NCK; ++ck) {
            const LAS float* cb = buf + (ck & 1) * BUFF; LAS float* op = opart + (ck & 1) * OPF;
            StepIn sin[3];
            f32x4 vr[4], oq;
#pragma unroll
            for (int j = 0; j < 4; ++j) vr[j] = *(const LAS f32x4*)(cb + 5 * CS * 64 + row * CS + 4 * j);
            SC_READ(sin[0], cb, 0); SC_READ(sin[1], cb, 1);
#pragma unroll
            for (int tt = 0; tt < CS; ++tt) {
                if (tt + 2 < CS) SC_READ(sin[(tt + 2) % 3], cb, tt + 2);
                const StepIn& cur = sin[tt % 3];
                const f32x2 kkA = (f32x2){cur.kk[0], cur.kk[1]}, kkB = (f32x2){cur.kk[2], cur.kk[3]};
                f32x2 d2 = sA * kkA; d2 = sB * kkB + d2;
                const float p = red16(d2[0] + d2[1]);
                const float vv = vr[tt >> 2][tt & 3];
                const f32x2 uA = (f32x2){cur.k[0], cur.k[1]} * vv, uB = (f32x2){cur.k[2], cur.k[3]} * vv;
                sA = sA * (f32x2){cur.w[0], cur.w[1]} + uA; sB = sB * (f32x2){cur.w[2], cur.w[3]} + uB;
                sA = sA - (f32x2){cur.bb[0], cur.bb[1]} * p; sB = sB - (f32x2){cur.bb[2], cur.bb[3]} * p;
                f32x2 o2 = sA * (f32x2){cur.r[0], cur.r[1]}; o2 = sB * (f32x2){cur.r[2], cur.r[3]} + o2;
                oq[tt & 3] = o2[0] + o2[1];
                if ((tt & 3) == 3) *(LAS f32x4*)(op + (tt >> 2) * 1024 + 4 * tid) = oq;
            }
            SC_BAR();
        }
#undef SC_READ
    }
#undef SC_BAR
}
__device__ __forceinline__ void lru_fin_chunk(Frame& F, const int ch) {
    const int tid = opaque_tid(), b = ch >> 5, n = ch & 31;
    if (n == 0) return;
    LAS f32x4* SEG = (LAS f32x4*)F.lds;
    if (tid < 384) {
        const int q = tid % 96, sg = tid / 96;
        f32x4 av[8], hv[8];
#pragma unroll
        for (int u = 0; u < 8; ++u) { const int j = 8 * sg + u, jc = j < n ? j : 0; av[u] = *(const f32x4*)(F.LRUSA + (size_t)(b * 32 + jc) * DB + 4 * q); hv[u] = *(const f32x4*)(F.LRUSH + (size_t)(b * 32 + jc) * DB + 4 * q); }
        f32x4 A = (f32x4){1.f, 1.f, 1.f, 1.f}, H = (f32x4){0.f, 0.f, 0.f, 0.f};
#pragma unroll
        for (int u = 0; u < 8; ++u) if (8 * sg + u < n) { H = av[u] * H + hv[u]; A = A * av[u]; }
        SEG[(2 * sg + 0) * 96 + q] = A; SEG[(2 * sg + 1) * 96 + q] = H;
    }
    asm volatile("s_waitcnt lgkmcnt(0)" ::: "memory"); __builtin_amdgcn_s_barrier(); asm volatile("" ::: "memory");
    const int ln = tid & 31, rs16 = tid >> 5;
    f32x4 hin[3];
#pragma unroll
    for (int j = 0; j < 3; ++j) { const int qd = ln + 32 * j; f32x4 hcar = SEG[96 + qd];
#pragma unroll
        for (int sg = 1; sg < 4; ++sg) hcar = SEG[(2 * sg) * 96 + qd] * hcar + SEG[(2 * sg + 1) * 96 + qd];
        hin[j] = hcar; }
    bf16* Y = F.HY;
#pragma unroll 1
    for (int bt = 0; bt < 3; ++bt) {
        u32x2 a1[8], a2[8];
#pragma unroll
        for (int k = 0; k < 8; ++k) { const int it = 8 * bt + k, i = it / 3, j = it - 3 * i; const size_t row = (size_t)ch * 128 + rs16 + 16 * i; const int cj = 4 * (ln + 32 * j);
            a1[k] = *(const u32x2*)(Y + row * DM + 256 + cj); a2[k] = *(const u32x2*)(F.Q2 + row * DB + cj); }
#pragma unroll
        for (int k = 0; k < 8; ++k) { const int it = 8 * bt + k, i = it / 3, j = it - 3 * i; const size_t row = (size_t)ch * 128 + rs16 + 16 * i; const int cj = 4 * (ln + 32 * j);
            const f32x4 hj = j == 0 ? hin[0] : (j == 1 ? hin[1] : hin[2]);
            *(u32x2*)(Y + row * DM + 256 + cj) = pack4(unpack4(a1[k]) + unpack4(a2[k]) * hj); }
    }
    asm volatile("s_waitcnt lgkmcnt(0)" ::: "memory"); __builtin_amdgcn_s_barrier(); asm volatile("" ::: "memory");
}
__device__ __forceinline__ void rwkv_fin_phase(Frame& F, const int l) {
    const int gw = F.vcu * NWAVES + F.wave, NGW = F.G * NWAVES, lane = opaque_tid() & 63, sub = lane >> 4, q = lane & 15;
    bf16* Y = F.HY;
    struct FinIn { u32x2 ov, v, g; float bon; };
#define FIN_LOAD(T, idx_) do { const int m_ = (idx_) / 6, h_ = (idx_) - 6 * m_; const size_t o_ = (size_t)m_ * DC + 64 * h_ + 4 * q; T.ov = *(const u32x2*)(F.O + o_); T.bon = F.BON[(size_t)m_ * 6 + h_]; \
        T.v = *(const u32x2*)(F.V + o_); T.g = *(const u32x2*)(Y + (size_t)m_ * DM + 640 + 64 * h_ + 4 * q); } while (0)
    FinIn fin[2];
    constexpr int NIT = (M * 6) / (256 * NWAVES * 4);
    const int idx0 = gw * 4 + sub, stride = NGW * 4;
    if (NGW * 4 * NIT != M * 6) return;
    FIN_LOAD(fin[0], idx0);
#pragma unroll 2
    for (int it = 0; it < NIT; ++it) {
        const int idx = idx0 + it * stride;
        if (it + 1 < NIT) { if (it & 1) FIN_LOAD(fin[0], idx + stride); else FIN_LOAD(fin[1], idx + stride); }
        const FinIn& T = (it & 1) ? fin[1] : fin[0];
        const int m = idx / 6, h = idx - 6 * m; const int n4 = 64 * h + 4 * q;
        const f32x4 ov = unpack4(T.ov);
        const float mean = red16((ov[0] + ov[1]) + (ov[2] + ov[3])) * (1.f / 64.f);
        const f32x4 d = ov - mean;
        const float var = red16((d[0] * d[0] + d[1] * d[1]) + (d[2] * d[2] + d[3] * d[3])) * (1.f / 64.f);
        const float rstd = __builtin_amdgcn_rsqf(var + 64e-5f);
        const f32x4 lw = *(const f32x4*)(F.rwkv_ln_w + l * DC + n4), lb = *(const f32x4*)(F.rwkv_ln_b + l * DC + n4), rk = *(const f32x4*)(F.rwkv_r_k + l * DC + n4);
        const f32x4 v4 = unpack4(T.v);
        const float bs = T.bon; (void)rk;
        const f32x4 g4 = unpack4(T.g);
        const f32x4 y = ((d * rstd) * lw + lb + v4 * bs) * g4;
        *(u32x2*)(Y + (size_t)m * DM + 640 + n4) = pack4(y);
    }
#undef FIN_LOAD
}
__device__ __forceinline__ void ffn_glu_phase(Frame& F, const int l) {
    constexpr int CG = DFF / 8, SEG = 32, NSEG = M / SEG;
    const int gt = F.vcu * (NWAVES * 64) + opaque_tid(), NGT = F.G * NWAVES * 64;
    for (int id = gt; id < NSEG * CG; id += NGT) {
        const int rsg = id / CG, cg8 = id - rsg * CG; const int col = 8 * cg8; const size_t row0 = (size_t)rsg * SEG;
        float w0[8], w1[8], w2[8], cb[8], x1[8], x2[8];
        { const float* cw = F.ffn_conv_w + (size_t)l * 3 * DFF + col; const float* cbp = F.ffn_conv_b + (size_t)l * DFF + col;
#pragma unroll
          for (int e = 0; e < 8; ++e) { w0[e] = cw[e]; w1[e] = cw[DFF + e]; w2[e] = cw[2 * DFF + e]; cb[e] = cbp[e]; x1[e] = 0.f; x2[e] = 0.f; } }
        if ((row0 & (SEQ - 1)) != 0) {
            const u32x4 a = *(const u32x4*)(F.UG + (row0 - 2) * DFF + col), bq = *(const u32x4*)(F.UG + (row0 - 1) * DFF + col);
            x2[0] = bflo(a.x); x2[1] = bfhi(a.x); x2[2] = bflo(a.y); x2[3] = bfhi(a.y); x2[4] = bflo(a.z); x2[5] = bfhi(a.z); x2[6] = bflo(a.w); x2[7] = bfhi(a.w);
            x1[0] = bflo(bq.x); x1[1] = bfhi(bq.x); x1[2] = bflo(bq.y); x1[3] = bfhi(bq.y); x1[4] = bflo(bq.z); x1[5] = bfhi(bq.z); x1[6] = bflo(bq.w); x1[7] = bfhi(bq.w);
        }
        u32x4 ga[4], va[4], gb[4], vb[4];
#define FF_LOAD(G_, V_, grp) do { _Pragma("unroll") for (int i_ = 0; i_ < 4; ++i_) { G_[i_] = *(const u32x4*)(F.UG + (row0 + 4 * (grp) + i_) * DFF + col); V_[i_] = *(const u32x4*)(F.UV + (row0 + 4 * (grp) + i_) * DFF + col); } } while (0)
#define FF_DO(G_, V_, grp) do { _Pragma("unroll") for (int i_ = 0; i_ < 4; ++i_) { const u32x4 gq = G_[i_], vq = V_[i_]; float x0[8], vv[8], y[8]; \
            x0[0] = bflo(gq.x); x0[1] = bfhi(gq.x); x0[2] = bflo(gq.y); x0[3] = bfhi(gq.y); x0[4] = bflo(gq.z); x0[5] = bfhi(gq.z); x0[6] = bflo(gq.w); x0[7] = bfhi(gq.w); \
            vv[0] = bflo(vq.x); vv[1] = bfhi(vq.x); vv[2] = bflo(vq.y); vv[3] = bfhi(vq.y); vv[4] = bflo(vq.z); vv[5] = bfhi(vq.z); vv[6] = bflo(vq.w); vv[7] = bfhi(vq.w); \
            _Pragma("unroll") for (int e = 0; e < 8; ++e) { const float gc = cb[e] + w0[e] * x2[e] + w1[e] * x1[e] + w2[e] * x0[e]; y[e] = fsilu(gc) * vv[e]; x2[e] = x1[e]; x1[e] = x0[e]; } \
            u32x4 o; o.x = pk2(y[0], y[1]); o.y = pk2(y[2], y[3]); o.z = pk2(y[4], y[5]); o.w = pk2(y[6], y[7]); \
            *(u32x4*)(F.UV + (row0 + 4 * (grp) + i_) * DFF + col) = o; } } while (0)
        FF_LOAD(ga, va, 0);
        for (int grp = 0; grp < SEG / 4; grp += 2) {
            FF_LOAD(gb, vb, grp + 1);
            FF_DO(ga, va, grp);
            if (grp + 2 < SEG / 4) FF_LOAD(ga, va, grp + 2);
            FF_DO(gb, vb, grp + 1);
        }
#undef FF_LOAD
#undef FF_DO
    }
}

__device__ __forceinline__ void ffn_fix_tile(Frame& F, const int l, const int pm) {
    if ((pm & 15) == 0) return;
    constexpr int C4 = DFF / 4;
    const float* cw = F.ffn_conv_w + (size_t)l * 3 * DFF; const float* cbp = F.ffn_conv_b + (size_t)l * DFF;
    for (int id = opaque_tid(); id < C4; id += NWAVES * 64) {
        const int c = 4 * id;
        const f32x4 w0 = *(const f32x4*)(cw + c), w1 = *(const f32x4*)(cw + DFF + c), w2 = *(const f32x4*)(cw + 2 * DFF + c), cb = *(const f32x4*)(cbp + c);
        const f32x4 gm2 = *(const f32x4*)(F.TG + ((size_t)(pm - 1) * 2 + 0) * DFF + c), gm1 = *(const f32x4*)(F.TG + ((size_t)(pm - 1) * 2 + 1) * DFF + c);
        const f32x4 g0 = *(const f32x4*)(F.HG + ((size_t)pm * 2 + 0) * DFF + c), g1 = *(const f32x4*)(F.HG + ((size_t)pm * 2 + 1) * DFF + c);
        const f32x4 v0 = *(const f32x4*)(F.HV + ((size_t)pm * 2 + 0) * DFF + c), v1 = *(const f32x4*)(F.HV + ((size_t)pm * 2 + 1) * DFF + c);
        f32x4 h0, h1;
#pragma unroll
        for (int e = 0; e < 4; ++e) { const float a = cb[e] + w0[e] * gm2[e] + w1[e] * gm1[e] + w2[e] * g0[e], b = cb[e] + w0[e] * gm1[e] + w1[e] * g0[e] + w2[e] * g1[e];
            h0[e] = fsilu(a) * v0[e]; h1[e] = fsilu(b) * v1[e]; }
        *(u32x2*)(F.UV + ((size_t)pm * 256 + 0) * DFF + c) = pack4(h0); *(u32x2*)(F.UV + ((size_t)pm * 256 + 1) * DFF + c) = pack4(h1);
    }
}

struct Args { const float* in[35]; float* out; unsigned char* ws; int ph_lo, ph_hi; };
__device__ __forceinline__ void frame_init(Frame& F, LAS unsigned char* lds) {
    typedef const __attribute__((address_space(4))) Args* ArgP;
    ArgP ap = (ArgP)__builtin_amdgcn_kernarg_segment_ptr(); asm volatile("" : "+s"(ap));
    F.lds = lds; F.MISC = (volatile LAS unsigned*)(lds + MISC_OFF);
    F.wave = __builtin_amdgcn_readfirstlane(threadIdx.x >> 6);
    F.G = gridDim.x; { const int bx = blockIdx.x; F.vcu = (F.G % 8 == 0) ? (bx % 8) * (F.G / 8) + bx / 8 : bx; }
    unsigned char* ws = ap->ws;
    F.ctl = (gu32*)(ws + WS_CTL);
    F.x = ap->in[0]; F.c = ap->in[1]; F.w_mod = ap->in[2]; F.b_mod = ap->in[3]; F.norm_mix = ap->in[4]; F.w_in = ap->in[5]; F.w_out = ap->in[6];
    F.sgu_ln_g = ap->in[7]; F.sgu_ln_b = ap->in[8]; F.sgu_w = ap->in[9]; F.sgu_b = ap->in[10];
    F.lru_conv_w = ap->in[11]; F.lru_conv_b = ap->in[12]; F.lru_w_a = ap->in[13]; F.lru_b_a = ap->in[14]; F.lru_w_x = ap->in[15]; F.lru_b_x = ap->in[16]; F.lru_lambda = ap->in[17];
    F.rwkv_mu = ap->in[18]; F.rwkv_w0 = ap->in[19]; F.rwkv_w2 = ap->in[20]; F.rwkv_a0 = ap->in[21]; F.rwkv_a2 = ap->in[22]; F.rwkv_g2 = ap->in[23]; F.rwkv_k_k = ap->in[24]; F.rwkv_k_a = ap->in[25];
    F.rwkv_r_k = ap->in[26]; F.rwkv_ln_w = ap->in[27]; F.rwkv_ln_b = ap->in[28]; F.norm_ffn = ap->in[29]; F.ffn_w_up = ap->in[30]; F.ffn_conv_w = ap->in[31]; F.ffn_conv_b = ap->in[32];
    F.ffn_w_down = ap->in[33]; F.norm_final = ap->in[34]; F.out = ap->out;
    F.SGUW = (bf16*)(ws + WS_SMALL + SM_SGUW); F.LRUWA = (bf16*)(ws + WS_SMALL + SM_LRUWA); F.LRUWX = (bf16*)(ws + WS_SMALL + SM_LRUWX);
    F.RW2 = (bf16*)(ws + WS_SMALL + SM_RW2); F.RA2 = (bf16*)(ws + WS_SMALL + SM_RA2); F.RG2 = (bf16*)(ws + WS_SMALL + SM_RG2);
    F.MOD = (float*)(ws + WS_MOD); F.LRUSA = (float*)(ws + WS_LRUS); F.LRUSH = F.LRUSA + 256 * DB;
    F.WIN = (bf16*)(ws + WS_WIN); F.WOUT = (bf16*)(ws + WS_WOUT); F.WUP = (bf16*)(ws + WS_WUP); F.WDN = (bf16*)(ws + WS_WDN);
    F.HY = (bf16*)(ws + WS_HY); F.P = (bf16*)(ws + WS_P); F.UG = (bf16*)(ws + WS_P); F.UV = (bf16*)(ws + WS_UV); F.O = (bf16*)(ws + WS_O);
    F.R = (bf16*)(ws + WS_R); F.K = (bf16*)(ws + WS_K); F.V = (bf16*)(ws + WS_V); F.KK = (bf16*)(ws + WS_KK); F.BV = (bf16*)(ws + WS_BV); F.LD = (bf16*)(ws + WS_LD); F.Q2 = (bf16*)(ws + WS_Q2);
    F.BON = (float*)(ws + WS_BON); F.SS = (float*)(ws + WS_SS); F.SW1 = (float*)(ws + WS_SW1); F.SW2 = (float*)(ws + WS_SW2);
    F.TG = (float*)(ws + WS_TG); F.HG = (float*)(ws + WS_HG); F.HV = (float*)(ws + WS_HV);
}
__global__ void __launch_bounds__(NWAVES * 64, 2) mk_fwd(Args args) {
    extern __shared__ __attribute__((aligned(16))) unsigned char lds_raw[];
    LAS unsigned char* const lds = (LAS unsigned char*)lds_raw;
    for (int u = threadIdx.x; u < (LDS_BYTES - LDSCTL_OFF) / 4; u += NWAVES * 64) ((LAS unsigned*)(lds + LDSCTL_OFF))[u] = 0u;
    __syncthreads();
#if MK_MODE == 2
    XcdBarrier bar = xcd_barrier_post((unsigned*)((gu32*)(args.ws + WS_CTL) + CW_BAR), (volatile LAS unsigned*)(lds + MISC_OFF) + 8);
#define GRID_BAR() xcd_barrier(bar)
#elif MK_MODE == 1
    cg::grid_group grid = cg::this_grid();
#define GRID_BAR() grid.sync()
#else
#define GRID_BAR() do { } while (0)
#endif
    const int lo = args.ph_lo, hi = args.ph_hi;
#define IN(k) (lo <= (k) && (k) < hi)
#ifndef MK_PHMASK
#define MK_PHMASK 0xFFF
#endif
#define EN(t) (((MK_PHMASK) >> (t)) & 1)
#ifndef MK_DUPMASK
#define MK_DUPMASK 0
#endif
#define REP2(t) (((MK_DUPMASK) >> (t)) & 1)
#define SEAM(k) do { if (IN(k) && IN((k) + 1)) GRID_BAR(); } while (0)
#define PH_BEGIN(t, k) if (EN(t) && IN(k)) { for (int rep = 0; rep <= REP2(t); ++rep) { if (rep) GRID_BAR(); Frame F; frame_init(F, lds); \
        const float* mod_l = F.MOD + (size_t)l * NB * NMOD; const float* Xin = (l == 0) ? F.x : F.out; (void)mod_l; (void)Xin;
#ifndef MK_STAMP_PHASE
#define MK_STAMP_PHASE -1
#endif
#define STAMP(k) do { if (MK_STAMP_PHASE >= 0 && blockIdx.x == 0 && threadIdx.x == 0) { ((unsigned long long*)(args.ws + WS_CTL + 32768))[k] = __builtin_amdgcn_s_memrealtime(); } } while (0)
#define PH_END(k) } } SEAM(k); STAMP((k) + 1);

#ifndef MK_SHADOW_PROBE
#define MK_SHADOW_PROBE 0
#endif
#define SHSTAMP(k) do { if (MK_SHADOW_PROBE == 1 && l == 0 && F.vcu == 192 && threadIdx.x == 0) { asm volatile("s_waitcnt vmcnt(0) lgkmcnt(0)" ::: "memory"); ((unsigned long long*)(args.ws + WS_CTL + 40960))[k] = __builtin_amdgcn_s_memrealtime(); } } while (0)
#define SCSTAMP(k) do { if (MK_SHADOW_PROBE == 2 && l == 0 && F.vcu == 0 && threadIdx.x == 0) { asm volatile("s_waitcnt vmcnt(0) lgkmcnt(0)" ::: "memory"); ((unsigned long long*)(args.ws + WS_CTL + 40960))[k] = __builtin_amdgcn_s_memrealtime(); } } while (0)
    STAMP(0);
    { const int l = 0; PH_BEGIN(0, 0) p0_prologue(F); PH_END(0) }
    for (int l = 0; l < NL; ++l) {
        const int pb = 1 + 10 * l;
        if (l == 0) { PH_BEGIN(1, pb + 0) sw_phase(F, 0, F.vcu * NWAVES + F.wave, F.G * NWAVES); norm0_phase(F, F.x, F.norm_mix, mod_l, 1, F.HY); PH_END(pb + 0) } else STAMP(pb + 1);
        PH_BEGIN(2, pb + 1) pg8::Gemm g{F.HY, F.WIN + (size_t)l * PINP * DM, M, PINP, DM}; pg8::StaticOrder S; S.init(M, PINP, F.G, (int)blockIdx.x);
            pg8::EpiBf16N E{F.P, PINP, F.SS, F.SW1 + (size_t)l * NB * PINP, PINP, SEQ};
            pg8::gemm_phase<pg8::EpiBf16N, pg8::StaticOrder, true, true>(F.lds, g, S, E); PH_END(pb + 1)
        PH_BEGIN(3, pb + 2) for (int ch = F.vcu; ch < M / 128; ch += F.G) mix_chunk<4>(F, l, ch); PH_END(pb + 2)
        PH_BEGIN(4, pb + 3)
            if (F.G >= 256) { if (F.vcu < 192) { SCSTAMP(2); rwkv_scan_item(F, F.vcu); SCSTAMP(3); } else if (rep == 0) { SHSTAMP(0); for (int ch = F.vcu - 192; ch < M / 128; ch += F.G - 192) mix_chunk<3>(F, l, ch);
                asm volatile("s_waitcnt vmcnt(0)" ::: "memory"); __syncthreads();
                if (threadIdx.x == 0) { unsigned* cnt = (unsigned*)(F.ctl + CW_SHAD + 64 * l); unsigned* tmo = (unsigned*)(F.ctl + CW_BAR);
                    __builtin_amdgcn_fence(__ATOMIC_RELEASE, "agent"); asm volatile("s_waitcnt vmcnt(0)" ::: "memory");
                    (void)xb_add(cnt, 1u); XB_SPIN(xb_ld(cnt) < (unsigned)(F.G - 192), tmo);
                    __builtin_amdgcn_fence(__ATOMIC_ACQUIRE, "agent"); asm volatile("s_waitcnt vmcnt(0)" ::: "memory"); }
                __syncthreads();
                for (int ch = F.vcu - 192; ch < M / 128; ch += F.G - 192) lru_fin_chunk(F, ch);
                if (l + 1 < NL) { __syncthreads(); sw_phase(F, l + 1, (F.vcu - 192) * NWAVES + F.wave, (F.G - 192) * NWAVES); }
                SHSTAMP(1); } }
            else { for (int it = F.vcu; it < 192; it += F.G) { rwkv_scan_item(F, it); __syncthreads(); } if (rep == 0) { for (int ch = F.vcu; ch < M / 128; ch += F.G) mix_chunk<3>(F, l, ch); if (l + 1 < NL) { __syncthreads(); sw_phase(F, l + 1, F.vcu * NWAVES + F.wave, F.G * NWAVES); } } }
        PH_END(pb + 3)
        PH_BEGIN(5, pb + 4) if (F.G < 256) for (int ch = F.vcu; ch < M / 128; ch += F.G) lru_fin_chunk(F, ch); rwkv_fin_phase(F, l); PH_END(pb + 4)
        PH_BEGIN(6, pb + 5) pg8::Gemm g{F.HY, F.WOUT + (size_t)l * DM * DM, M, DM, DM}; pg8::StaticOrder S; S.init(M, DM, F.G, (int)blockIdx.x);
            if (l == 0) { pg8::EpiResNormT<false> E{F.x, (bf16*)F.out, DM, mod_l + 2 * DM, NMOD, SEQ, F.P, F.norm_ffn + l * DM, mod_l + 4 * DM, F.SS};
                pg8::gemm_phase<pg8::EpiResNormT<false>, pg8::StaticOrder, true, true>(F.lds, g, S, E); }
            else { pg8::EpiResNormT<true> E{F.out, (bf16*)F.out, DM, mod_l + 2 * DM, NMOD, SEQ, F.P, F.norm_ffn + l * DM, mod_l + 4 * DM, F.SS};
                pg8::gemm_phase<pg8::EpiResNormT<true>, pg8::StaticOrder, true, true>(F.lds, g, S, E); } PH_END(pb + 5)
        STAMP(pb + 7);
        PH_BEGIN(8, pb + 7) pg8::Gemm g{F.P, F.WUP + (size_t)l * DUP * DM, M, DUP, DM}; pg8::StaticOrder S; S.init(M, DUP, F.G, (int)blockIdx.x);
            pg8::EpiGLU E{F.UV, DFF, F.ffn_conv_w + (size_t)l * 3 * DFF, F.ffn_conv_b + (size_t)l * DFF, F.TG, F.HG, F.HV, (LAS float*)(F.lds + TAIL_OFF), F.SS, F.SW2 + (size_t)l * NB * DUP, DUP, SEQ};
            pg8::gemm_phase<pg8::EpiGLU, pg8::StaticOrder, true, true>(F.lds, g, S, E); PH_END(pb + 7)
        STAMP(pb + 9);
        if (EN(10) && IN(pb + 9)) { Frame F; frame_init(F, lds); pg8::StaticOrder S; S.init(M, DM, F.G, (int)blockIdx.x); pg8::Unit fu;
#pragma unroll 1
            for (int i = 0; S.next(i, fu); ++i) ffn_fix_tile(F, l, fu.pm);
            asm volatile("s_waitcnt vmcnt(0)" ::: "memory"); __syncthreads(); }
        PH_BEGIN(10, pb + 9) pg8::Gemm g{F.UV, F.WDN + (size_t)l * DM * DFF, M, DM, DFF}; pg8::StaticOrder S; S.init(M, DM, F.G, (int)blockIdx.x);
            if (l + 1 < NL) { pg8::EpiResNormT<true> E{F.out, (bf16*)F.out, DM, mod_l + 5 * DM, NMOD, SEQ, F.HY, F.norm_mix + (l + 1) * DM, mod_l + (size_t)NB * NMOD + 1 * DM, F.SS};
                pg8::gemm_phase<pg8::EpiResNormT<true>, pg8::StaticOrder, true, true>(F.lds, g, S, E); }
            else { pg8::EpiResNormT<true> E{F.out, nullptr, DM, mod_l + 5 * DM, NMOD, SEQ, F.HY, F.norm_final, nullptr, F.SS};
                pg8::gemm_phase<pg8::EpiResNormT<true>, pg8::StaticOrder, true, true>(F.lds, g, S, E); } PH_END(pb + 9)
    }
    { const int l = 0; PH_BEGIN(11, NPHASE - 1) final_scale_phase(F, F.HY, F.out); PH_END(NPHASE - 1) }
    if (MK_STAMP_PHASE >= 0 && blockIdx.x == 0 && threadIdx.x == 0) { asm volatile("s_waitcnt vmcnt(0) lgkmcnt(0)" ::: "memory");
        const volatile unsigned long long* st = (const volatile unsigned long long*)(args.ws + WS_CTL + 32768);
        const unsigned long long d = (st[MK_STAMP_PHASE + 1] - st[MK_STAMP_PHASE]) * 10ull, r0 = __builtin_amdgcn_s_memrealtime();
        while (__builtin_amdgcn_s_memrealtime() - r0 < d) __builtin_amdgcn_s_sleep(8); }
    if (MK_SHADOW_PROBE == 2 && blockIdx.x == 0 && threadIdx.x == 0) { asm volatile("s_waitcnt vmcnt(0) lgkmcnt(0)" ::: "memory");
        const volatile unsigned long long* st = (const volatile unsigned long long*)(args.ws + WS_CTL + 40960);
        const unsigned long long d = (st[3] - st[2]) * 10ull, r0 = __builtin_amdgcn_s_memrealtime();
        while (__builtin_amdgcn_s_memrealtime() - r0 < d) __builtin_amdgcn_s_sleep(8); }
    if (MK_SHADOW_PROBE == 1 && blockIdx.x == 6 && threadIdx.x == 0) { asm volatile("s_waitcnt vmcnt(0) lgkmcnt(0)" ::: "memory");
        const volatile unsigned long long* st = (const volatile unsigned long long*)(args.ws + WS_CTL + 40960);
        const unsigned long long d = (st[1] - st[0]) * 10ull, r0 = __builtin_amdgcn_s_memrealtime();
        while (__builtin_amdgcn_s_memrealtime() - r0 < d) __builtin_amdgcn_s_sleep(8); }
#if defined(MK_TSEC0)
    if (MK_TSEC0 >= 0 && blockIdx.x == 0 && opaque_tid() == 0) { asm volatile("s_waitcnt vmcnt(0) lgkmcnt(0)" ::: "memory");
        const volatile unsigned long long* st = (const volatile unsigned long long*)(args.ws + WS_CTL + 49152);
        const unsigned long long d = st[MK_TSEC0 & 3] * 10ull, r0 = __builtin_amdgcn_s_memrealtime();
        while (__builtin_amdgcn_s_memrealtime() - r0 < d) __builtin_amdgcn_s_sleep(8); }
#endif
#ifdef MK_TSEC
    if (MK_TSEC >= 0 && blockIdx.x == 0 && opaque_tid() == 0) { asm volatile("s_waitcnt vmcnt(0) lgkmcnt(0)" ::: "memory");
        const volatile unsigned long long* st = (const volatile unsigned long long*)(args.ws + WS_CTL + 49152);
        const unsigned long long d = st[MK_TSEC] * 10ull, r0 = __builtin_amdgcn_s_memrealtime();
        while (__builtin_amdgcn_s_memrealtime() - r0 < d) __builtin_amdgcn_s_sleep(8); }
#endif
#undef IN
#undef SEAM
}

extern "C" void kernel_launch(void* const* d_in, const int* in_sizes, int n_in, void* d_out, int out_size, void* d_ws, size_t ws_size, hipStream_t stream) {
    static int grid = 0;
    if (grid == 0) {
        if (n_in != 35 || in_sizes[0] != M * DM || out_size != M * DM || ws_size < WS_END) { fprintf(stderr, "kernel_launch: unexpected shapes (n_in %d, in0 %d, out %d, ws %zu); nothing launched\n", n_in, n_in > 0 ? in_sizes[0] : -1, out_size, ws_size); grid = -1; return; }
        int dev = 0, cus = 0, per_cu = 0;
        if (hipGetDevice(&dev) != hipSuccess || hipDeviceGetAttribute(&cus, hipDeviceAttributeMultiprocessorCount, dev) != hipSuccess) { grid = -1; return; }
        if (hipFuncSetAttribute((const void*)mk_fwd, hipFuncAttributeMaxDynamicSharedMemorySize, LDS_BYTES) != hipSuccess) { fprintf(stderr, "kernel_launch: hipFuncSetAttribute failed\n"); grid = -1; return; }
        if (hipOccupancyMaxActiveBlocksPerMultiprocessor(&per_cu, (const void*)mk_fwd, NWAVES * 64, LDS_BYTES) != hipSuccess || per_cu < 1) { fprintf(stderr, "kernel_launch: occupancy query says %d blocks per CU\n", per_cu); per_cu = 1; }
        (void)hipGetLastError();
        grid = cus;
    }
    if (grid < 0) return;
    Args a{};
    for (int i = 0; i < 35; ++i) a.in[i] = (const float*)d_in[i];
    a.out = (float*)d_out; a.ws = (unsigned char*)d_ws;
#if MK_MODE == 0
    for (int ph = 0; ph < NPHASE; ++ph) { a.ph_lo = ph; a.ph_hi = ph + 1; hipLaunchKernelGGL(mk_fwd, dim3(grid), dim3(NWAVES * 64), LDS_BYTES, stream, a); }
#else
    (void)hipMemsetAsync((char*)d_ws + WS_CTL, 0, CTL_ZERO_BYTES, stream);
    a.ph_lo = 0; a.ph_hi = NPHASE;
#if MK_MODE == 1
    void* kargs[] = {&a};
    hipError_t e = hipLaunchCooperativeKernel((const void*)mk_fwd, dim3(grid), dim3(NWAVES * 64), kargs, LDS_BYTES, stream);
    if (e != hipSuccess) fprintf(stderr, "kernel_launch: cooperative launch failed: %s (grid %d)\n", hipGetErrorString(e), grid);
#else
    hipLaunchKernelGGL(mk_fwd, dim3(grid), dim3(NWAVES * 64), LDS_BYTES, stream, a);
#endif
#endif
}
```

```cpp
#include <hip/hip_runtime.h>
#include <hip/hip_cooperative_groups.h>
#include <cstdio>
#include <cstdint>
namespace pg8 {
#define PG8_LAS __attribute__((address_space(3)))
typedef unsigned short bf16_t;
typedef short bf16x8 __attribute__((ext_vector_type(8)));
typedef float f32x4 __attribute__((ext_vector_type(4)));
typedef unsigned u32x4 __attribute__((ext_vector_type(4)));
constexpr int BM = 256, BK = 64, HALF = 128, HTB = HALF * BK * 2  , STAGE_BYTES = 8 * HTB, NXCD = 8, WGM = 8;

__host__ __device__ __forceinline__ int lds_byte(int r, int c) { const int st = (r >> 4) * 2 + (c >> 5), rr = r & 15, cc = c & 31, ob = rr * 64 + cc * 2; return st * 1024 + (ob ^ (((ob >> 9) & 1) << 5)); }
__host__ __device__ __forceinline__ void stage_rc(int b, int& R, int& C) { const int st = b / 1024, sb = b % 1024, swz = sb ^ (((sb >> 9) & 1) << 5); R = (st >> 1) * 16 + swz / 64; C = (st & 1) * 32 + (swz % 64) / 2; }
__host__ __device__ __forceinline__ int perm32(int rho) { const int n = rho >> 4, i = rho & 15; return 8 * (i >> 2) + 4 * n + (i & 3); }

struct Unit { int pm, pn; };
struct Gemm { const bf16_t* A; const bf16_t* Bt; int M, N, K; };

struct StaticOrder {
    int nM, nN, nwg, G, c;
    __host__ __device__ void init(int M, int N, int G_, int c_) { nM = M / BM; nN = N / BM; nwg = nM * nN; G = G_; c = c_; }
    __host__ __device__ __forceinline__ bool next(int i, Unit& u) const {
        const long L = (long)i * G + c; if (L >= nwg) return false;
        int wgid = (int)L; { const int q = nwg / NXCD, r = nwg % NXCD, xcd = wgid % NXCD, off = wgid / NXCD; wgid = (xcd < r ? xcd * (q + 1) : r * (q + 1) + (xcd - r) * q) + off; }
        const int nig = WGM * nN, gid = wgid / nig, fm = gid * WGM, gsz = (nM - fm) < WGM ? (nM - fm) : WGM;
        u.pm = fm + ((wgid % nig) % gsz); u.pn = (wgid % nig) / gsz; return true;
    }
    __device__ __forceinline__ void a_ready(const Unit&) const {}
    __device__ __forceinline__ void done(const Unit&) const {}
};

typedef __bf16 bf16x2_native __attribute__((ext_vector_type(2)));
__device__ __forceinline__ unsigned cvt_pk_bf16(float lo, float hi) { typedef float f32x2_ __attribute__((ext_vector_type(2))); const bf16x2_native h = __builtin_convertvector((f32x2_){lo, hi}, bf16x2_native); return __builtin_bit_cast(unsigned, h); }
typedef float f32x2 __attribute__((ext_vector_type(2)));
__device__ __forceinline__ f32x2 gelu_pk(f32x2 v) {
    const f32x2 av = __builtin_elementwise_abs(v), d = av * 0.2316418882f + 1.0f;
    f32x2 t; t.x = __builtin_amdgcn_rcpf(d.x); t.y = __builtin_amdgcn_rcpf(d.y);
    f32x2 q = t * 0.5307027145f + (-0.7265760135f); q = q * t + 0.7107068705f; q = q * t + (-0.142248368f); q = q * t + 0.127414796f; q = q * t;
    const f32x2 s = (v * v) * (-0.72134752044f);
    f32x2 e; e.x = __builtin_amdgcn_exp2f(s.x); e.y = __builtin_amdgcn_exp2f(s.y);
    const f32x2 m = v * (q * e), r = v - m;
    f32x2 o; o.x = v.x < 0.f ? m.x : r.x; o.y = v.y < 0.f ? m.y : r.y; return o;
}

template <int ACT  > struct EpiBf16 {
    static constexpr bool PERM = true, AFTER_DRAIN = false; static_assert(ACT == 0 || ACT == 1, "EpiBf16: ACT is 0 (none) or 1 (gelu_pk)");
    bf16_t* O; int ldc; const float* bias; int split_cols; size_t split_stride; float scale0;
    __device__ __forceinline__ void operator()(const f32x4 (&acc)[2][2][4][2], const Unit& u, int wr, int wc, int fr, int fq) const {
        const int row0 = u.pm * BM + wr * 64 + fr; int colt = u.pn * BM; bf16_t* base = O;
        float sc = 1.f; if (split_cols) { const int t = colt / split_cols; base += (size_t)t * split_stride; colt -= t * split_cols; if (t == 0) sc = scale0; }
        const int col0 = colt + wc * 32 + 8 * fq, bcol0 = u.pn * BM + wc * 32 + 8 * fq;
        f32x4 bv[2][2];
#pragma unroll
        for (int bj = 0; bj < 2; ++bj)
#pragma unroll
            for (int n = 0; n < 2; ++n) bv[bj][n] = bias ? *(const f32x4*)(bias + bcol0 + bj * HALF + 4 * n) : (f32x4){0.f, 0.f, 0.f, 0.f};
#pragma unroll
        for (int ai = 0; ai < 2; ++ai)
#pragma unroll
            for (int m = 0; m < 4; ++m) { bf16_t* rowp = base + (size_t)(row0 + ai * HALF + m * 16) * ldc + col0;
#pragma unroll
                for (int bj = 0; bj < 2; ++bj) { f32x4 v0 = acc[ai][bj][m][0] + bv[bj][0], v1 = acc[ai][bj][m][1] + bv[bj][1];
                    if (ACT == 1) { f32x2 a = gelu_pk((f32x2){v0[0], v0[1]}), b = gelu_pk((f32x2){v0[2], v0[3]}), c = gelu_pk((f32x2){v1[0], v1[1]}), d = gelu_pk((f32x2){v1[2], v1[3]});
                        v0 = (f32x4){a.x, a.y, b.x, b.y}; v1 = (f32x4){c.x, c.y, d.x, d.y}; }
                    v0 = v0 * sc; v1 = v1 * sc; u32x4 w; w.x = cvt_pk_bf16(v0[0], v0[1]); w.y = cvt_pk_bf16(v0[2], v0[3]); w.z = cvt_pk_bf16(v1[0], v1[1]); w.w = cvt_pk_bf16(v1[2], v1[3]);
                    *(u32x4*)(rowp + bj * HALF) = w; } }
    }
};

typedef unsigned u32x2v __attribute__((ext_vector_type(2)));

struct EpiRes {
    static constexpr bool PERM = false, AFTER_DRAIN = false;
    const float* base; float* out; int ldc; const float* gate; int gate_ld; int rows_per_batch;
    __device__ __forceinline__ void operator()(const f32x4 (&acc)[2][2][4][2], const Unit& u, int wr, int wc, int fr, int fq) const {
        asm volatile("" : "+v"(fr), "+v"(fq));
        const int row0 = u.pm * BM + wr * 64 + fr, col0 = u.pn * BM + wc * 32 + 4 * fq;
        const float* gp = gate + (size_t)((u.pm * BM) / rows_per_batch) * gate_ld + col0;
        f32x4 gv[2][2];
#pragma unroll
        for (int bj = 0; bj < 2; ++bj)
#pragma unroll
            for (int n = 0; n < 2; ++n) gv[bj][n] = *(const f32x4*)(gp + bj * HALF + n * 16);
        f32x4 pre[3][2][2];
#define ER_LOAD(slot, g_) do { const size_t off_ = (size_t)(row0 + ((g_) >> 2) * HALF + ((g_) & 3) * 16) * ldc + col0; _Pragma("unroll") for (int bj = 0; bj < 2; ++bj) _Pragma("unroll") for (int n = 0; n < 2; ++n) pre[slot][bj][n] = *(const f32x4*)(base + off_ + bj * HALF + n * 16); } while (0)
        ER_LOAD(0, 0); ER_LOAD(1, 1);
#pragma unroll
        for (int g = 0; g < 8; ++g) { const int ai = g >> 2, m = g & 3; const size_t off = (size_t)(row0 + ai * HALF + m * 16) * ldc + col0;
            if (g + 2 < 8) ER_LOAD((g + 2) % 3, g + 2);
#pragma unroll
            for (int bj = 0; bj < 2; ++bj)
#pragma unroll
                for (int n = 0; n < 2; ++n) *(f32x4*)(out + off + bj * HALF + n * 16) = pre[g % 3][bj][n] + gv[bj][n] * acc[ai][bj][m][n]; }
#undef ER_LOAD
    }
};
struct EpiGV {
    static constexpr bool PERM = true, AFTER_DRAIN = false;
    bf16_t* G; bf16_t* V; int ldc;
    __device__ __forceinline__ void operator()(const f32x4 (&acc)[2][2][4][2], const Unit& u, int wr, int wc, int fr, int fq) const {
        const int row0 = u.pm * BM + wr * 64 + fr, col0 = u.pn * HALF + wc * 32 + 8 * fq;
#pragma unroll
        for (int ai = 0; ai < 2; ++ai)
#pragma unroll
            for (int m = 0; m < 4; ++m) { const size_t off = (size_t)(row0 + ai * HALF + m * 16) * ldc + col0;
#pragma unroll
                for (int bj = 0; bj < 2; ++bj) { const f32x4 v0 = acc[ai][bj][m][0], v1 = acc[ai][bj][m][1];
                    u32x4 w; w.x = cvt_pk_bf16(v0[0], v0[1]); w.y = cvt_pk_bf16(v0[2], v0[3]); w.z = cvt_pk_bf16(v1[0], v1[1]); w.w = cvt_pk_bf16(v1[2], v1[3]);
                    *(u32x4*)((bj ? V : G) + off) = w; } }
    }
};

__device__ __forceinline__ float xrow16_sum(float x) {
    auto s = __builtin_amdgcn_permlane16_swap(__float_as_uint(x), __float_as_uint(x), false, false);
    x = __uint_as_float(s[0]) + __uint_as_float(s[1]);
    auto t = __builtin_amdgcn_permlane32_swap(__float_as_uint(x), __float_as_uint(x), false, false);
    return __uint_as_float(t[0]) + __uint_as_float(t[1]);
}
__device__ __forceinline__ void load_rstd8(const float* SS, int row0, int fq, float inv_n, float eps, float (&rstd)[8]) {
    f32x4 p[8];
#pragma unroll
    for (int g = 0; g < 8; ++g) p[g] = *(const f32x4*)(SS + (size_t)(row0 + (g >> 2) * HALF + (g & 3) * 16) * 16 + 4 * fq);
#pragma unroll
    for (int g = 0; g < 8; ++g) rstd[g] = __builtin_amdgcn_rsqf(xrow16_sum((p[g][0] + p[g][1]) + (p[g][2] + p[g][3])) * inv_n + eps);
}
template <bool BASEB>
struct EpiResNormT {
    static constexpr bool PERM = true, AFTER_DRAIN = false;
    const void* base; bf16_t* out; int ldc; const float* gate; int gate_ld; int rows_per_batch; bf16_t* XS; const float* gamma; const float* sc; float* SS;
    __device__ __forceinline__ void operator()(const f32x4 (&acc)[2][2][4][2], const Unit& u, int wr, int wc, int fr, int fq) const {
        asm volatile("" : "+v"(fr), "+v"(fq));
        const int row0 = u.pm * BM + wr * 64 + fr, col0 = u.pn * BM + wc * 32 + 8 * fq;
        const int b = (u.pm * BM) / rows_per_batch;
        const float* gp = gate + (size_t)b * gate_ld + col0; const float* sp = sc + (size_t)b * gate_ld + col0;
        f32x4 gv[2][2], gs[2][2];
#pragma unroll
        for (int bj = 0; bj < 2; ++bj)
#pragma unroll
            for (int n = 0; n < 2; ++n) { gv[bj][n] = *(const f32x4*)(gp + bj * HALF + n * 4); gs[bj][n] = *(const f32x4*)(gamma + col0 + bj * HALF + n * 4); if (sc) gs[bj][n] = gs[bj][n] * (*(const f32x4*)(sp + bj * HALF + n * 4) + 1.f); }
        f32x4 pre[2][2][2]; u32x4 preb[2][2];
#define ER_LOAD(slot, g_) do { const size_t off_ = (size_t)(row0 + ((g_) >> 2) * HALF + ((g_) & 3) * 16) * ldc + col0; _Pragma("unroll") for (int bj = 0; bj < 2; ++bj) { \
        if (BASEB) preb[slot][bj] = *(const u32x4*)((const bf16_t*)base + off_ + bj * HALF); else { _Pragma("unroll") for (int n = 0; n < 2; ++n) pre[slot][bj][n] = *(const f32x4*)((const float*)base + off_ + bj * HALF + n * 4); } } } while (0)
        ER_LOAD(0, 0);
#pragma unroll
        for (int g = 0; g < 8; ++g) { const int ai = g >> 2, m = g & 3; const size_t off = (size_t)(row0 + ai * HALF + m * 16) * ldc + col0;
            if (g + 1 < 8) ER_LOAD((g + 1) & 1, g + 1);
            float ssq = 0.f;
#pragma unroll
            for (int bj = 0; bj < 2; ++bj) { u32x4 w, wo;
#pragma unroll
                for (int n = 0; n < 2; ++n) {
                    f32x4 bs;
                    if (BASEB) { const unsigned w0 = n == 0 ? preb[g & 1][bj].x : preb[g & 1][bj].z, w1 = n == 0 ? preb[g & 1][bj].y : preb[g & 1][bj].w;
                        bs = (f32x4){__uint_as_float(w0 << 16), __uint_as_float(w0 & 0xffff0000u), __uint_as_float(w1 << 16), __uint_as_float(w1 & 0xffff0000u)}; }
                    else bs = pre[g & 1][bj][n];
                    const f32x4 o = bs + gv[bj][n] * acc[ai][bj][m][n];
                    if (n == 0) { wo.x = cvt_pk_bf16(o[0], o[1]); wo.y = cvt_pk_bf16(o[2], o[3]); } else { wo.z = cvt_pk_bf16(o[0], o[1]); wo.w = cvt_pk_bf16(o[2], o[3]); }
                    const f32x4 xs = o * gs[bj][n];
                    if (n == 0) { w.x = cvt_pk_bf16(xs[0], xs[1]); w.y = cvt_pk_bf16(xs[2], xs[3]); } else { w.z = cvt_pk_bf16(xs[0], xs[1]); w.w = cvt_pk_bf16(xs[2], xs[3]); }
                    ssq += (o[0] * o[0] + o[1] * o[1]) + (o[2] * o[2] + o[3] * o[3]); }
                if (out) *(u32x4*)(out + off + bj * HALF) = wo;
                *(u32x4*)(XS + off + bj * HALF) = w; }
            ssq = xrow16_sum(ssq);
            if (fq == 0) SS[(size_t)(row0 + ai * HALF + m * 16) * 16 + 4 * u.pn + wc] = ssq; }
#undef ER_LOAD
    }
};
struct EpiBf16N {
    static constexpr bool PERM = true, AFTER_DRAIN = false;
    bf16_t* O; int ldc; const float* SS; const float* SW; int sw_ld; int rows_per_batch;
    __device__ __forceinline__ void operator()(const f32x4 (&acc)[2][2][4][2], const Unit& u, int wr, int wc, int fr, int fq) const {
        asm volatile("" : "+v"(fr), "+v"(fq));
        const int row0 = u.pm * BM + wr * 64 + fr, col0 = u.pn * BM + wc * 32 + 8 * fq;
        float rstd[8]; load_rstd8(SS, row0, fq, 1.f / 1024.f, 1e-6f, rstd);
        const float* swp = SW + (size_t)((u.pm * BM) / rows_per_batch) * sw_ld + col0;
        f32x4 sw[2][2];
#pragma unroll
        for (int bj = 0; bj < 2; ++bj)
#pragma unroll
            for (int n = 0; n < 2; ++n) sw[bj][n] = *(const f32x4*)(swp + bj * HALF + 4 * n);
#pragma unroll
        for (int ai = 0; ai < 2; ++ai)
#pragma unroll
            for (int m = 0; m < 4; ++m) { bf16_t* rowp = O + (size_t)(row0 + ai * HALF + m * 16) * ldc + col0; const float rs = rstd[ai * 4 + m];
#pragma unroll
                for (int bj = 0; bj < 2; ++bj) { const f32x4 v0 = acc[ai][bj][m][0] * rs + sw[bj][0], v1 = acc[ai][bj][m][1] * rs + sw[bj][1];
                    u32x4 w; w.x = cvt_pk_bf16(v0[0], v0[1]); w.y = cvt_pk_bf16(v0[2], v0[3]); w.z = cvt_pk_bf16(v1[0], v1[1]); w.w = cvt_pk_bf16(v1[2], v1[3]);
                    __builtin_nontemporal_store(w, (u32x4*)(rowp + bj * HALF)); } }
    }
};

template <int CTRL> __device__ __forceinline__ float dpp_keep(float old, float src) {
    return __builtin_bit_cast(float, __builtin_amdgcn_update_dpp(__builtin_bit_cast(int, old), __builtin_bit_cast(int, src), CTRL, 0xf, 0xf, false)); }
template <int CTRL> __device__ __forceinline__ float dpp_mov(float src) { return __builtin_bit_cast(float, __builtin_amdgcn_mov_dpp(__builtin_bit_cast(int, src), CTRL, 0xf, 0xf, true)); }
struct EpiGLU {
    static constexpr bool PERM = true, AFTER_DRAIN = false;
    bf16_t* H; int ldc; const float* cw; const float* cb; float* TG; float* HG; float* HV; PG8_LAS float* tail;
    const float* SS; const float* SW; int sw_ld; int rows_per_batch;
    __device__ __forceinline__ void operator()(const f32x4 (&acc)[2][2][4][2], const Unit& u, int wr, int wc, int fr, int fq) const {
        asm volatile("" : "+v"(fr), "+v"(fq));
        const int row0 = u.pm * BM + wr * 64 + fr, cl = wc * 32 + 8 * fq, col0 = u.pn * HALF + cl;
        f32x4 (&ac)[2][2][4][2] = const_cast<f32x4 (&)[2][2][4][2]>(acc);
        { float rstd[8]; load_rstd8(SS, row0, fq, 1.f / 1024.f, 1e-6f, rstd);
          const float* swp = SW + (size_t)((u.pm * BM) / rows_per_batch) * sw_ld + u.pn * BM + cl;
#pragma unroll
          for (int bj = 0; bj < 2; ++bj)
#pragma unroll
              for (int n = 0; n < 2; ++n) { const f32x4 swv = *(const f32x4*)(swp + bj * HALF + 4 * n);
#pragma unroll
                  for (int ai = 0; ai < 2; ++ai)
#pragma unroll
                      for (int m = 0; m < 4; ++m) ac[ai][bj][m][n] = ac[ai][bj][m][n] * rstd[ai * 4 + m] + swv; } }
#define GN(ai_, m_, n_) (acc[ai_][0][m_][n_])
#define VN(ai_, m_, n_) (acc[ai_][1][m_][n_])
        if (fr >= 14) {
#pragma unroll
            for (int ai = 0; ai < 2; ++ai)
#pragma unroll
                for (int n = 0; n < 2; ++n) *(PG8_LAS f32x4*)(tail + ((ai * 2 + wr) * 2 + (fr - 14)) * 128 + cl + 4 * n) = GN(ai, 3, n);
            if (wr == 1) {
#pragma unroll
                for (int n = 0; n < 2; ++n) *(f32x4*)(TG + ((size_t)u.pm * 2 + (fr - 14)) * ldc + col0 + 4 * n) = GN(1, 3, n);
            }
        }
        if (wr == 0 && fr < 2) {
#pragma unroll
            for (int n = 0; n < 2; ++n) { *(f32x4*)(HG + ((size_t)u.pm * 2 + fr) * ldc + col0 + 4 * n) = GN(0, 0, n); *(f32x4*)(HV + ((size_t)u.pm * 2 + fr) * ldc + col0 + 4 * n) = VN(0, 0, n); }
        }
        f32x4 w0[2], w1[2], w2[2], b0[2];
#pragma unroll
        for (int n = 0; n < 2; ++n) { w0[n] = *(const f32x4*)(cw + col0 + 4 * n); w1[n] = *(const f32x4*)(cw + ldc + col0 + 4 * n); w2[n] = *(const f32x4*)(cw + 2 * ldc + col0 + 4 * n); b0[n] = *(const f32x4*)(cb + col0 + 4 * n); }
        asm volatile("s_waitcnt lgkmcnt(0)" ::: "memory"); __builtin_amdgcn_s_barrier(); asm volatile("" ::: "memory");
#pragma unroll
        for (int ai = 0; ai < 2; ++ai) {
            f32x4 t0[2], t1[2];
            const bool have = (wr == 1) || (ai == 1);
            const int sa = (wr == 1) ? ai : 0, sw = (wr == 1) ? 0 : 1;
#pragma unroll
            for (int n = 0; n < 2; ++n) {
                t0[n] = have ? *(const PG8_LAS f32x4*)(tail + ((sa * 2 + sw) * 2 + 0) * 128 + cl + 4 * n) : (f32x4){0.f, 0.f, 0.f, 0.f};
                t1[n] = have ? *(const PG8_LAS f32x4*)(tail + ((sa * 2 + sw) * 2 + 1) * 128 + cl + 4 * n) : (f32x4){0.f, 0.f, 0.f, 0.f}; }
#pragma unroll
            for (int m = 0; m < 4; ++m) {
                u32x4 wout;
#pragma unroll
                for (int n = 0; n < 2; ++n) {
                    f32x4 hv; const f32x4 gcur = GN(ai, m, n), vcur = VN(ai, m, n); const f32x4 gprev = m > 0 ? GN(ai, (m > 0 ? m - 1 : 0), n) : gcur;
#pragma unroll
                    for (int i = 0; i < 4; ++i) {
                        const float g0 = gcur[i];
                        const float pv = m == 0 ? (fr == 14 ? t0[n][i] : t1[n][i]) : gprev[i];
                        const float x1 = fr == 15 ? pv : g0, x2 = fr >= 14 ? pv : g0;
                        float gc = b0[n][i] + w2[n][i] * g0;
                        gc = __builtin_fmaf(dpp_mov<0x121>(x1), w1[n][i], gc);
                        gc = __builtin_fmaf(dpp_mov<0x122>(x2), w0[n][i], gc);
                        hv[i] = gc * __builtin_amdgcn_rcpf(1.f + __builtin_amdgcn_exp2f(-1.4426950408889634f * gc)) * vcur[i];
                    }
                    if (n == 0) { wout.x = cvt_pk_bf16(hv[0], hv[1]); wout.y = cvt_pk_bf16(hv[2], hv[3]); } else { wout.z = cvt_pk_bf16(hv[0], hv[1]); wout.w = cvt_pk_bf16(hv[2], hv[3]); }
                }
                __builtin_nontemporal_store(wout, (u32x4*)(H + (size_t)(row0 + ai * HALF + m * 16) * ldc + col0));
            }
        }
#undef GN
#undef VN
    }
};
template <class Epi, class Sched, bool ALIGN_EPI = false, bool SP2 = false>
__device__ __forceinline__ void gemm_phase(PG8_LAS unsigned char* lds, const Gemm g, const Sched& S, const Epi& E) {
    int tid_ = threadIdx.x; asm volatile("" : "+v"(tid_));
    const int tid = tid_, wid = __builtin_amdgcn_readfirstlane(tid >> 6), lane = tid & 63, wr = wid >> 2, wc = wid & 3, fr = lane & 15, fq = lane >> 4;
    const int K = g.K, nt = K / BK;
    unsigned voffA[2], voffB[2];
#pragma unroll
    for (int i = 0; i < 2; ++i) { int R, C; stage_rc(tid * 16 + i * 8192, R, C); const int Rb = Epi::PERM ? ((R & ~31) + perm32(R & 31)) : R;
        voffA[i] = (unsigned)(R * K + C) * 2u; voffB[i] = (unsigned)(Rb * K + C) * 2u; }
    const size_t kstep = (size_t)(BK * 2);
    const size_t hstep = (size_t)HALF * K * 2;
    const size_t tstep = 2 * hstep;
    const unsigned ldsw = (unsigned)wid * 1024u;
    const int aoff = lds_byte(wr * 64 + fr, fq * 8), boff = lds_byte(wc * 32 + fr, fq * 8);
#define PG8_SA(b, h) (((b) * 2 + (h)) * HTB)
#define PG8_SB(b, h) ((4 + (b) * 2 + (h)) * HTB)
#define PG8_STAGE(bufoff, gbase, voff) do { _Pragma("unroll") for (int _i = 0; _i < 2; ++_i) \
        __builtin_amdgcn_global_load_lds((const unsigned*)((const char*)(gbase) + (voff)[_i]), (PG8_LAS unsigned*)(lds + (bufoff) + ldsw + _i * 8192), 16, 0, 0); } while (0)
#define PG8_LDA(dst, b, h) do { _Pragma("unroll") for (int m = 0; m < 4; ++m) _Pragma("unroll") for (int k = 0; k < 2; ++k) dst[m][k] = *(const PG8_LAS bf16x8*)(lds + PG8_SA(b, h) + aoff + m * 2048 + k * 1024); } while (0)
#define PG8_LDB(dst, b, h) do { _Pragma("unroll") for (int n = 0; n < 2; ++n) _Pragma("unroll") for (int k = 0; k < 2; ++k) dst[n][k] = *(const PG8_LAS bf16x8*)(lds + PG8_SB(b, h) + boff + n * 2048 + k * 1024); } while (0)
#define PG8_MMA(ai, bj, At, Bt) do { __builtin_amdgcn_s_setprio(1); _Pragma("unroll") for (int m = 0; m < 4; ++m) _Pragma("unroll") for (int n = 0; n < 2; ++n) _Pragma("unroll") for (int k = 0; k < 2; ++k) \
        acc[ai][bj][m][n] = __builtin_amdgcn_mfma_f32_16x16x32_bf16(Bt[n][k], At[m][k], acc[ai][bj][m][n], 0, 0, 0); __builtin_amdgcn_s_setprio(0); } while (0)
#define PG8_WAIT_V(n) asm volatile("s_waitcnt vmcnt(" #n ")" ::: "memory")
#define PG8_WAIT_L(n) asm volatile("s_waitcnt lgkmcnt(" #n ")" ::: "memory")
#define PG8_BAR __builtin_amdgcn_s_barrier()
#define PG8_SCHED __builtin_amdgcn_sched_barrier(0)
    Unit cur, nxt; int ui = 0;
    if (!S.next(0, cur)) return;
    f32x4 acc[2][2][4][2];
#pragma unroll
    for (int a = 0; a < 2; ++a)
#pragma unroll
        for (int b = 0; b < 2; ++b)
#pragma unroll
            for (int m = 0; m < 4; ++m)
#pragma unroll
                for (int n = 0; n < 2; ++n) acc[a][b][m][n] = (f32x4){0.f, 0.f, 0.f, 0.f};
    bf16x8 At[4][2], B0[2][2], B1[2][2];
    const char* cA = (const char*)g.A + (size_t)cur.pm * tstep; const char* cB = (const char*)g.Bt + (size_t)cur.pn * tstep;
    S.a_ready(cur);
    if constexpr (SP2) {
        PG8_STAGE(PG8_SB(0, 0), cB, voffB); PG8_STAGE(PG8_SB(0, 1), cB + hstep, voffB); PG8_STAGE(PG8_SA(0, 0), cA, voffA); PG8_STAGE(PG8_SA(0, 1), cA + hstep, voffA);
        if (wr == 1) PG8_BAR;
        PG8_WAIT_V(2); PG8_BAR;
        PG8_STAGE(PG8_SB(1, 0), cB + kstep, voffB); PG8_STAGE(PG8_SA(1, 0), cA + kstep, voffA); PG8_STAGE(PG8_SB(1, 1), cB + hstep + kstep, voffB);
        PG8_WAIT_V(6); PG8_BAR;
    } else {
        PG8_STAGE(PG8_SB(0, 0), cB, voffB); PG8_STAGE(PG8_SA(0, 0), cA, voffA); PG8_STAGE(PG8_SB(0, 1), cB + hstep, voffB); PG8_STAGE(PG8_SA(0, 1), cA + hstep, voffA);
        if (wr == 1) PG8_BAR;
        PG8_WAIT_V(4); PG8_BAR;
        PG8_STAGE(PG8_SB(1, 0), cB + kstep, voffB); PG8_STAGE(PG8_SA(1, 0), cA + kstep, voffA); PG8_STAGE(PG8_SB(1, 1), cB + hstep + kstep, voffB);
        PG8_WAIT_V(6); PG8_BAR;
    }
    for (;;) {
        const bool has_next = S.next(ui + 1, nxt);
        const char* nA = has_next ? (const char*)g.A + (size_t)nxt.pm * tstep : cA; const char* nB = has_next ? (const char*)g.Bt + (size_t)nxt.pn * tstep : cB;
        for (int t = 0; t < nt; t += 2) {
            const bool last = (t == nt - 2);
            const char* a1 = cA + (size_t)(t + 1) * kstep;
            const char* a2 = last ? nA : cA + (size_t)(t + 2) * kstep; const char* b2 = last ? nB : cB + (size_t)(t + 2) * kstep;
            const char* a3 = a2 + kstep; const char* b3 = b2 + kstep;
            if (last && has_next) S.a_ready(nxt);
            if constexpr (SP2) {
            PG8_LDB(B0, 0, 0); PG8_LDB(B1, 0, 1); PG8_SCHED; PG8_LDA(At, 0, 0); PG8_STAGE(PG8_SA(1, 1), a1 + hstep, voffA);
            PG8_WAIT_V(8); PG8_WAIT_L(0); PG8_BAR; PG8_MMA(0, 0, At, B0); PG8_MMA(0, 1, At, B1); PG8_BAR; PG8_SCHED;
            PG8_LDA(At, 0, 1); PG8_STAGE(PG8_SB(0, 0), b2, voffB); PG8_STAGE(PG8_SB(0, 1), b2 + hstep, voffB); PG8_STAGE(PG8_SA(0, 0), a2, voffA);
            PG8_WAIT_V(8); PG8_WAIT_L(0); PG8_BAR; PG8_MMA(1, 0, At, B0); PG8_MMA(1, 1, At, B1); PG8_BAR; PG8_SCHED;
            PG8_LDB(B0, 1, 0); PG8_LDB(B1, 1, 1); PG8_SCHED; PG8_LDA(At, 1, 0); PG8_STAGE(PG8_SA(0, 1), a2 + hstep, voffA);
            PG8_WAIT_V(8); PG8_WAIT_L(0); PG8_BAR; PG8_MMA(0, 0, At, B0); PG8_MMA(0, 1, At, B1); PG8_BAR; PG8_SCHED;
            PG8_LDA(At, 1, 1); PG8_STAGE(PG8_SB(1, 0), b3, voffB); PG8_STAGE(PG8_SB(1, 1), b3 + hstep, voffB); PG8_STAGE(PG8_SA(1, 0), a3, voffA);
            PG8_WAIT_V(8); PG8_WAIT_L(0); PG8_BAR; PG8_MMA(1, 0, At, B0); PG8_MMA(1, 1, At, B1); PG8_BAR; PG8_SCHED;
            } else {
            PG8_LDB(B0, 0, 0); PG8_SCHED; PG8_LDA(At, 0, 0); PG8_STAGE(PG8_SA(1, 1), a1 + hstep, voffA);
            PG8_WAIT_L(8); PG8_BAR; PG8_WAIT_L(0); PG8_MMA(0, 0, At, B0); PG8_BAR; PG8_SCHED;
            PG8_LDB(B1, 0, 1); PG8_STAGE(PG8_SB(0, 0), b2, voffB);
            PG8_BAR; PG8_WAIT_L(0); PG8_MMA(0, 1, At, B1); PG8_BAR;
            PG8_LDA(At, 0, 1); PG8_STAGE(PG8_SA(0, 0), a2, voffA);
            PG8_BAR; PG8_WAIT_L(0); PG8_MMA(1, 0, At, B0); PG8_BAR; PG8_SCHED;
            PG8_STAGE(PG8_SB(0, 1), b2 + hstep, voffB);
            PG8_WAIT_V(6); PG8_BAR; PG8_MMA(1, 1, At, B1); PG8_BAR;
            PG8_LDB(B0, 1, 0); PG8_SCHED; PG8_LDA(At, 1, 0); PG8_STAGE(PG8_SA(0, 1), a2 + hstep, voffA);
            PG8_WAIT_L(8); PG8_BAR; PG8_WAIT_L(0); PG8_MMA(0, 0, At, B0); PG8_BAR; PG8_SCHED;
            PG8_LDB(B1, 1, 1); PG8_STAGE(PG8_SB(1, 0), b3, voffB);
            PG8_BAR; PG8_WAIT_L(0); PG8_MMA(0, 1, At, B1); PG8_BAR;
            PG8_LDA(At, 1, 1); PG8_STAGE(PG8_SA(1, 0), a3, voffA);
            PG8_BAR; PG8_WAIT_L(0); PG8_MMA(1, 0, At, B0); PG8_BAR; PG8_SCHED;
            PG8_STAGE(PG8_SB(1, 1), b3 + hstep, voffB);
            PG8_WAIT_V(6); PG8_BAR; PG8_MMA(1, 1, At, B1); PG8_BAR;
            }
        }
        if constexpr (ALIGN_EPI) { if (wr == 0) PG8_BAR; }
        if constexpr (!Epi::AFTER_DRAIN) { E(acc, cur, wr, wc, fr, fq); S.done(cur); }
        if (!has_next) break;
#pragma unroll
        for (int a = 0; a < 2; ++a)
#pragma unroll
            for (int b = 0; b < 2; ++b)
#pragma unroll
                for (int m = 0; m < 4; ++m)
#pragma unroll
                    for (int n = 0; n < 2; ++n) acc[a][b][m][n] = (f32x4){0.f, 0.f, 0.f, 0.f};
        cur = nxt; cA = nA; cB = nB; ++ui;
        if constexpr (ALIGN_EPI) { if (wr == 1) PG8_BAR; }
    }
    PG8_WAIT_V(0);
    if constexpr (!ALIGN_EPI) { if (wr == 0) PG8_BAR; }
    PG8_BAR;
    if constexpr (Epi::AFTER_DRAIN) { E.fused(acc, cur, wr, wc, fr, fq, lds, wid, lane); S.done(cur); }
#undef PG8_SA
#undef PG8_SB
#undef PG8_STAGE
#undef PG8_LDA
#undef PG8_LDB
#undef PG8_MMA
#undef PG8_WAIT_V
#undef PG8_WAIT_L
#undef PG8_BAR
#undef PG8_SCHED
}
}

namespace cg = cooperative_groups;
#ifndef MK_MODE
#define MK_MODE 2
#endif
constexpr int NWAVES = 8;

constexpr int NB = 8, SEQ = 4096, DM = 1024, NL = 2;
constexpr int M = NB * SEQ;
constexpr int PIN = 2688, PINP = 2816;
constexpr int DFF = 2816, DUP = 2 * DFF;
constexpr int DA = 256, DB = 384, DC = 384;
constexpr int NMOD = 6 * DM;
constexpr int PC_OFF = 1280;
constexpr int NPHASE = 22;

constexpr size_t MiB = 1u << 20;
constexpr size_t WS_CTL = 0, CTL_ZERO_BYTES = 64 * 1024;
constexpr size_t WS_SMALL = 1 * MiB;
constexpr size_t SM_SGUW = 0, SM_LRUWA = 256 * 1024, SM_LRUWX = 352 * 1024, SM_RW2 = 448 * 1024, SM_RA2 = 544 * 1024, SM_RG2 = 640 * 1024;
constexpr size_t WS_MOD = 2 * MiB;
constexpr size_t WS_LRUS = 3 * MiB;
constexpr size_t WS_WIN = 4 * MiB, WS_WOUT = 15 * MiB, WS_WUP = 19 * MiB, WS_WDN = 41 * MiB;
constexpr size_t WS_SS = 57 * MiB, WS_SW1 = 60 * MiB, WS_SW2 = 61 * MiB;
constexpr size_t WS_BON = 62 * MiB;
constexpr size_t WS_HY = 64 * MiB;
constexpr size_t WS_P = 128 * MiB;
constexpr size_t WS_UV = 304 * MiB;
constexpr size_t WS_R = 304 * MiB, WS_K = 328 * MiB, WS_V = 352 * MiB, WS_KK = 376 * MiB, WS_BV = 400 * MiB;
constexpr size_t WS_LD = 424 * MiB;
constexpr size_t WS_O = 448 * MiB;
constexpr size_t WS_Q2 = 472 * MiB;
constexpr size_t WS_TG = 496 * MiB, WS_HG = 500 * MiB, WS_HV = 504 * MiB;
constexpr size_t WS_END = 512 * MiB;
static_assert(WS_Q2 + (size_t)M * 384 * 2 <= WS_END && WS_UV + (size_t)M * DFF * 2 <= WS_END && WS_P + (size_t)M * PINP * 2 <= WS_UV, "d_ws map");
static_assert(WS_WDN + (size_t)NL * DM * DFF * 2 <= WS_HY && WS_WIN + (size_t)NL * PINP * DM * 2 <= WS_WOUT && WS_WUP + (size_t)NL * DUP * DM * 2 <= WS_WDN, "weights map");
constexpr int CW_BAR = 1024;
constexpr int CW_SHAD = 6144;

constexpr int RING_BYTES = 131072;
constexpr int LDSCTL_OFF = RING_BYTES, MISC_OFF = LDSCTL_OFF + 320;
constexpr int TAIL_OFF = 132096;
constexpr int LDS_BYTES = 147456;

#define GAS __attribute__((address_space(1)))
#define LAS __attribute__((address_space(3)))
typedef unsigned short bf16;
typedef float f32x4 __attribute__((ext_vector_type(4)));
typedef float f32x2 __attribute__((ext_vector_type(2)));
typedef float f32x16 __attribute__((ext_vector_type(16)));
typedef short bf16x8 __attribute__((ext_vector_type(8)));
typedef unsigned u32x2 __attribute__((ext_vector_type(2)));
typedef unsigned u32x4 __attribute__((ext_vector_type(4)));
typedef GAS unsigned gu32;
#define RLX_AGENT __ATOMIC_RELAXED, __HIP_MEMORY_SCOPE_AGENT

__device__ __forceinline__ float bflo(unsigned w) { return __builtin_bit_cast(float, w << 16); }
__device__ __forceinline__ float bfhi(unsigned w) { return __builtin_bit_cast(float, w & 0xffff0000u); }
__device__ __forceinline__ float bf1(bf16 u) { return __builtin_bit_cast(float, (unsigned)u << 16); }
__device__ __forceinline__ unsigned pk2(float lo, float hi) { return pg8::cvt_pk_bf16(lo, hi); }
__device__ __forceinline__ bf16 f2bf(float f) { return (bf16)(pg8::cvt_pk_bf16(f, f) & 0xffffu); }
__device__ __forceinline__ bf16 f2bf_n(float f) { const __bf16 h = (__bf16)f; return __builtin_bit_cast(bf16, h); }
__device__ __forceinline__ f32x4 unpack4(u32x2 w) { return (f32x4){bflo(w.x), bfhi(w.x), bflo(w.y), bfhi(w.y)}; }
__device__ __forceinline__ u32x2 pack4(f32x4 v) { u32x2 w; w.x = pk2(v[0], v[1]); w.y = pk2(v[2], v[3]); return w; }

__device__ __forceinline__ float fexp(float x) { return __builtin_amdgcn_exp2f(x * 1.4426950408889634f); }
__device__ __forceinline__ float flog(float x) { return __builtin_amdgcn_logf(x) * 0.6931471805599453f; }
__device__ __forceinline__ float fsigmoid(float x) { return __builtin_amdgcn_rcpf(1.f + fexp(-x)); }
__device__ __forceinline__ float fgelu(float x) { const float y = 1.5957691216f * x * (1.f + 0.044715f * x * x); return x * fsigmoid(y); }
__device__ __forceinline__ float fsilu(float x) { return x * fsigmoid(x); }
__device__ __forceinline__ float fsoftplus(float x) { return fmaxf(x, 0.f) + flog(1.f + fexp(-fabsf(x))); }
__device__ __forceinline__ float fsoftplus_acc(float x) { return fmaxf(x, 0.f) + log1pf(expf(-fabsf(x))); }
__device__ __forceinline__ float ftanh(float x) { return 1.f - 2.f * __builtin_amdgcn_rcpf(1.f + fexp(2.f * x)); }
__device__ __forceinline__ float fnegexpm1(float x) {
    const float ser = -x * (1.f + x * (0.5f + x * (0.16666667f + x * (0.041666668f + x * (0.008333334f + x * 0.0013888889f)))));
    return x > -0.25f ? ser : 1.f - fexp(x);
}
__device__ __forceinline__ int opaque_tid() { int t = threadIdx.x; asm volatile("" : "+v"(t)); return t; }
template <int CTRL> __device__ __forceinline__ float dppf(float x) { return __builtin_bit_cast(float, __builtin_amdgcn_mov_dpp(__builtin_bit_cast(int, x), CTRL, 0xf, 0xf, true)); }
__device__ __forceinline__ float red16(float p) { p += dppf<0xB1>(p); p += dppf<0x4E>(p); p += dppf<0x141>(p); p += dppf<0x128>(p); return p; }
__device__ __forceinline__ float wave_sum(float v) { return pg8::xrow16_sum(red16(v)); }
#define XB_TMO      128
#define XB_XCNT(j)  (256  + 64 * (j))
#define XB_XSUB(j)  (1280 + 64 * (j))
#define XB_XGEN(j)  (2304 + 64 * (j))
#define XB_TOP      3328
#define XB_TOPGEN   3392
#define XCD_BAR_WORDS 3456
#define XB_SPIN_CAP (1u << 18)

__device__ __forceinline__ unsigned xb_ld(unsigned* p)              { return __hip_atomic_load(p, __ATOMIC_RELAXED, __HIP_MEMORY_SCOPE_AGENT); }
__device__ __forceinline__ unsigned xb_add(unsigned* p, unsigned v) { return __hip_atomic_fetch_add(p, v, __ATOMIC_RELAXED, __HIP_MEMORY_SCOPE_AGENT); }
__device__ __forceinline__ unsigned xb_xcc_id() { return (unsigned)__builtin_amdgcn_s_getreg((3 << 11) | 20) & 0xFu; }
#define XB_SPIN(cond, bar) do { unsigned _sp = 0; while (cond) { __builtin_amdgcn_s_sleep(1); \
    if ((++_sp & 255u) == 0u) { if (xb_ld(&(bar)[XB_TMO])) break; if (_sp > XB_SPIN_CAP) { atomicAdd(&(bar)[XB_TMO], 1u); break; } } } } while (0)

struct XcdBarrier {
    unsigned* bar; unsigned x;
    volatile LAS unsigned* st;
};

__device__ __forceinline__ XcdBarrier xcd_barrier_post(unsigned* bar, volatile LAS unsigned* st) {
    XcdBarrier b; b.bar = bar; b.x = xb_xcc_id(); b.st = st;
    if (threadIdx.x == 0) (void)xb_add(&bar[XB_XCNT(b.x)], 1u);
    return b;
}
__device__ __forceinline__ void xcd_barrier_complete(unsigned* bar, unsigned x, unsigned& nloc, unsigned& nx) {
    const unsigned G = gridDim.x * gridDim.y * gridDim.z;
    unsigned sum, cnt, mine, sp = 0u;
    for (;;) {
        sum = 0u; cnt = 0u; mine = 0u;
#pragma unroll
        for (unsigned j = 0; j < 16; ++j) { const unsigned c = xb_ld(&bar[XB_XCNT(j)]); sum += c; cnt += (c > 0u) ? 1u : 0u; mine = (j == x) ? c : mine; }
        if (sum == G) break;
        __builtin_amdgcn_s_sleep(1);
        if ((++sp & 255u) == 0u) { if (xb_ld(&bar[XB_TMO])) break; if (sp > XB_SPIN_CAP) { atomicAdd(&bar[XB_TMO], 1u); break; } }
    }
    nloc = mine > 0u ? mine : 1u; nx = cnt > 0u ? cnt : 1u;
}

__device__ __forceinline__ void xcd_barrier(const XcdBarrier& b) {
    asm volatile("s_waitcnt vmcnt(0)" ::: "memory");
    __syncthreads();
    if (threadIdx.x == 0) {
        unsigned* bar = b.bar;
        __builtin_amdgcn_s_waitcnt(0);
        unsigned nloc = b.st[0], nx = b.st[1];
        if (nloc == 0u) { xcd_barrier_complete(bar, b.x, nloc, nx); b.st[0] = nloc; b.st[1] = nx; }
        const unsigned old = xb_add(&bar[XB_XSUB(b.x)], 1u);
        const unsigned gen = old / nloc;
        if (old + 1u == (gen + 1u) * nloc) {
            __builtin_amdgcn_fence(__ATOMIC_RELEASE, "agent");
            asm volatile("s_waitcnt vmcnt(0)" ::: "memory");
            const unsigned og = xb_add(&bar[XB_TOP], 1u);
            const unsigned tg = og / nx;
            if (og + 1u == (tg + 1u) * nx) xb_add(&bar[XB_TOPGEN], 1u);
            else XB_SPIN(xb_ld(&bar[XB_TOPGEN]) == tg, bar);
            __builtin_amdgcn_fence(__ATOMIC_ACQUIRE, "agent");
            xb_add(&bar[XB_XGEN(b.x)], 1u);
            asm volatile("s_waitcnt vmcnt(0)" ::: "memory");
        } else {
            XB_SPIN(xb_ld(&bar[XB_XGEN(b.x)]) == gen, bar);
            __builtin_amdgcn_fence(__ATOMIC_ACQUIRE, "agent");
            asm volatile("s_waitcnt vmcnt(0)" ::: "memory");
        }
    }
    __syncthreads();
}

struct Frame {
    LAS unsigned char* lds;
    volatile LAS unsigned* MISC;
    gu32* ctl;
    int wave, vcu, G;
    const float *x, *c, *w_mod, *b_mod, *norm_mix, *w_in, *w_out, *sgu_ln_g, *sgu_ln_b, *sgu_w, *sgu_b, *lru_conv_w, *lru_conv_b, *lru_w_a, *lru_b_a, *lru_w_x, *lru_b_x, *lru_lambda,
        *rwkv_mu, *rwkv_w0, *rwkv_w2, *rwkv_a0, *rwkv_a2, *rwkv_g2, *rwkv_k_k, *rwkv_k_a, *rwkv_r_k, *rwkv_ln_w, *rwkv_ln_b, *norm_ffn, *ffn_w_up, *ffn_conv_w, *ffn_conv_b, *ffn_w_down, *norm_final;
    float* out;
    bf16 *SGUW, *LRUWA, *LRUWX, *RW2, *RA2, *RG2;
    float *MOD, *LRUSA, *LRUSH;
    bf16 *WIN, *WOUT, *WUP, *WDN;
    bf16 *HY, *P, *UG, *UV, *R, *K, *V, *KK, *BV, *Q2, *O, *LD;
    float *TG, *HG, *HV;
    float *SS, *SW1, *SW2, *BON;
};

__device__ __forceinline__ void p0_transpose_item(const float* W, int K, int N, bf16* WT, int k0, int n0, int drow0, LAS float* scr, int lane) {
#pragma unroll
    for (int i = 0; i < 32; ++i) { const int kk = 2 * i + (lane >> 5); scr[kk * 33 + (lane & 31)] = W[(size_t)(k0 + kk) * N + n0 + (lane & 31)]; }
    asm volatile("s_waitcnt lgkmcnt(0)" ::: "memory");
    const int c = lane & 7;
#pragma unroll
    for (int j = 0; j < 4; ++j) { const int n = (lane >> 3) + 8 * j; const LAS float* s = scr + (8 * c) * 33 + n;
        u32x4 o; o.x = pk2(s[0 * 33], s[1 * 33]); o.y = pk2(s[2 * 33], s[3 * 33]); o.z = pk2(s[4 * 33], s[5 * 33]); o.w = pk2(s[6 * 33], s[7 * 33]);
        *(u32x4*)(WT + (size_t)(drow0 + n) * K + k0 + 8 * c) = o; }
    asm volatile("s_waitcnt lgkmcnt(0)" ::: "memory");
}
constexpr int P0_I_IN = (DM / 64) * (PIN / 32), P0_I_OUT = (DM / 64) * (DM / 32), P0_I_UP = (DM / 64) * (DUP / 32), P0_I_DN = (DFF / 64) * (DM / 32);
constexpr int P0_PER_L = P0_I_IN + P0_I_OUT + P0_I_UP + P0_I_DN;
__device__ __forceinline__ void p0_convert_item(Frame& F, const int it, LAS float* scr, const int lane) {
    const int l = it / P0_PER_L; int r = it % P0_PER_L;
    if (r < P0_I_IN) { const int nblk = PIN / 32, kb = r / nblk, nb = r % nblk; p0_transpose_item(F.w_in + (size_t)l * DM * PIN, DM, PIN, F.WIN + (size_t)l * PINP * DM, 64 * kb, 32 * nb, 32 * nb, scr, lane); return; } r -= P0_I_IN;
    if (r < P0_I_OUT) { const int nblk = DM / 32, kb = r / nblk, nb = r % nblk; p0_transpose_item(F.w_out + (size_t)l * DM * DM, DM, DM, F.WOUT + (size_t)l * DM * DM, 64 * kb, 32 * nb, 32 * nb, scr, lane); return; } r -= P0_I_OUT;
    if (r < P0_I_UP) { const int nblk = DUP / 32, kb = r / nblk, nb = r % nblk; const int n0 = 32 * nb, isv = n0 >= DFF ? 1 : 0, j = n0 - isv * DFF, drow = (j / 128) * 256 + isv * 128 + (j % 128);
        p0_transpose_item(F.ffn_w_up + (size_t)l * DM * DUP, DM, DUP, F.WUP + (size_t)l * DUP * DM, 64 * kb, n0, drow, scr, lane); return; } r -= P0_I_UP;
    { const int nblk = DM / 32, kb = r / nblk, nb = r % nblk; p0_transpose_item(F.ffn_w_down + (size_t)l * DFF * DM, DFF, DM, F.WDN + (size_t)l * DM * DFF, 64 * kb, 32 * nb, 32 * nb, scr, lane); }
}
__device__ __forceinline__ bool p0_defer_layers(const Frame& F) { return false; }
__device__ __forceinline__ void p0_deferred_items(Frame& F, const int wv, const int nwv) {
    LAS float* scr = (LAS float*)(F.lds + F.wave * 9216); const int lane = opaque_tid() & 63;
    for (int it = P0_PER_L + wv; it < NL * P0_PER_L; it += nwv) p0_convert_item(F, it, scr, lane);
}
#ifndef MK_TSEC0
#define MK_TSEC0 -1
#endif
#define TSEC0_MARK(k_) do { if (MK_TSEC0 >= 0 && tid == 0) { asm volatile("s_waitcnt vmcnt(0) lgkmcnt(0)" ::: "memory"); volatile LAS unsigned long long* ts_ = (volatile LAS unsigned long long*)(F.lds + 140000); \
        const unsigned long long t_ = __builtin_amdgcn_s_memrealtime(); if ((k_) >= 0) ts_[(k_) < 0 ? 0 : (k_)] += t_ - ts_[3]; ts_[3] = t_; } } while (0)
__device__ __forceinline__ void p0_prologue(Frame& F) {
    const int tid = opaque_tid(), lane = tid & 63, wave = F.wave;
    TSEC0_MARK(-1);
    const int gw = F.vcu * NWAVES + wave, NGW = F.G * NWAVES;
    const int gt = F.vcu * (NWAVES * 64) + tid, NGT = F.G * NWAVES * 64;
    const bool p0_swap = F.vcu < 192 && (F.vcu & 1);
    for (int p0_step = 0; p0_step < 2; ++p0_step) {
    if ((p0_step == 0) != p0_swap) {
    if (F.vcu < 192) {
        LAS float* cact = (LAS float*)(F.lds + 73728);
        LAS float* red = (LAS float*)(F.lds + 106496);
        for (int i = tid; i < NB * DM; i += NWAVES * 64) { const float cv = F.c[i]; cact[i] = cv * fsigmoid(cv); }
        __syncthreads();
        const int l = F.vcu / 96, n0 = (F.vcu % 96) * 64;
        const float* wm = F.w_mod + ((size_t)l * DM + 128 * wave) * NMOD + n0 + lane;
        float acc[NB];
#pragma unroll
        for (int b = 0; b < NB; ++b) acc[b] = 0.f;
#pragma unroll 1
        for (int k16 = 0; k16 < 128; k16 += 16) {
            float wv[16];
#pragma unroll
            for (int j = 0; j < 16; ++j) wv[j] = wm[(size_t)(k16 + j) * NMOD];
#pragma unroll
            for (int j4 = 0; j4 < 16; j4 += 4) {
#pragma unroll
                for (int b = 0; b < NB; ++b) { const f32x4 cv = *(const LAS f32x4*)(cact + b * DM + 128 * wave + k16 + j4); acc[b] += cv[0] * wv[j4] + cv[1] * wv[j4 + 1] + cv[2] * wv[j4 + 2] + cv[3] * wv[j4 + 3]; } }
        }
#pragma unroll
        for (int b = 0; b < NB; ++b) red[(wave * NB + b) * 64 + lane] = acc[b];
        __syncthreads();
        { const int b = tid >> 6, col = tid & 63; float s = F.b_mod[l * NMOD + n0 + col];
#pragma unroll
          for (int w = 0; w < NWAVES; ++w) s += red[(w * NB + b) * 64 + col];
          F.MOD[(size_t)(l * NB + b) * NMOD + n0 + col] = s; }
        __syncthreads();
    }
    TSEC0_MARK(0);
    } else {
    {
        LAS float* scr = (LAS float*)(F.lds + wave * 9216);
        const int NITEM = p0_defer_layers(F) ? P0_PER_L : NL * P0_PER_L; constexpr int SHARE_A = 8 * 64 * NWAVES;
        const bool grid256 = F.G == 256;
        const int nA = grid256 ? (SHARE_A < NITEM ? SHARE_A : NITEM) : 0;
        for (int pass = 0; pass < 2; ++pass)
        for (int it = (pass == 0 ? (gw - 192 * NWAVES) : nA + gw); it < (pass == 0 ? nA : NITEM); it += (pass == 0 ? 64 * NWAVES : NGW)) {
            if (pass == 0 && F.vcu < 192) break;
            p0_convert_item(F, it, scr, lane);
        }
    }
    __syncthreads();
    } }
    TSEC0_MARK(1);
    if (NGT >= NL * 4 * 128 * 128) {
        const int i = gt;
        const bool c1 = i < NL * 4 * 128 * 128, c2 = i < NL * 6 * 64 * 64, c3 = i < NL * 12 * 4 * 512, c4 = i < NL * 12 * 8 * 512;
        float a_sgu = 0.f, a_la = 0.f, a_lx = 0.f, a_w2 = 0.f, a_a2 = 0.f, a_g2 = 0.f;
        if (c1) a_sgu = F.sgu_w[i];
        if (c2) { const int ii = i & 63, j = (i >> 6) & 63, lh = i >> 12; a_la = F.lru_w_a[(size_t)lh * 4096 + ii * 64 + j]; a_lx = F.lru_w_x[(size_t)lh * 4096 + ii * 64 + j]; }
        if (c3) { const int e = i & 7, ln_ = (i >> 3) & 63, ks = (i >> 9) & 3, nt = (i >> 11) % 12, l = i / (12 * 4 * 512); const int n = 32 * nt + (ln_ & 31), k = 16 * ks + 8 * (ln_ >> 5) + e;
            a_w2 = F.rwkv_w2[(size_t)l * 64 * 384 + k * 384 + n]; a_a2 = F.rwkv_a2[(size_t)l * 64 * 384 + k * 384 + n]; }
        if (c4) { const int e = i & 7, ln_ = (i >> 3) & 63, ks = (i >> 9) & 7, nt = (i >> 12) % 12, l = i / (12 * 8 * 512); const int n = 32 * nt + (ln_ & 31), k = 16 * ks + 8 * (ln_ >> 5) + e;
            a_g2 = F.rwkv_g2[(size_t)l * 128 * 384 + k * 384 + n]; }
        if (c1) { const int s = i & 127, t = (i >> 7) & 127; F.SGUW[i] = s <= t ? f2bf(a_sgu) : (bf16)0; }
        if (c2) { F.LRUWA[i] = f2bf(a_la); F.LRUWX[i] = f2bf(a_lx); }
        if (c3) { F.RW2[i] = f2bf(a_w2); F.RA2[i] = f2bf(a_a2); }
        if (c4) F.RG2[i] = f2bf(a_g2);
    } else {
    for (int i = gt; i < NL * 4 * 128 * 128; i += NGT) { const int s = i & 127, t = (i >> 7) & 127; F.SGUW[i] = s <= t ? f2bf(F.sgu_w[i]) : (bf16)0; }
        for (int i = gt; i < NL * 6 * 64 * 64; i += NGT) { const int ii = i & 63, j = (i >> 6) & 63, lh = i >> 12;
            F.LRUWA[i] = f2bf(F.lru_w_a[(size_t)lh * 4096 + ii * 64 + j]); F.LRUWX[i] = f2bf(F.lru_w_x[(size_t)lh * 4096 + ii * 64 + j]); }
        for (int i = gt; i < NL * 12 * 4 * 512; i += NGT) { const int e = i & 7, ln_ = (i >> 3) & 63, ks = (i >> 9) & 3, nt = (i >> 11) % 12, l = i / (12 * 4 * 512);
            const int n = 32 * nt + (ln_ & 31), k = 16 * ks + 8 * (ln_ >> 5) + e;
            F.RW2[i] = f2bf(F.rwkv_w2[(size_t)l * 64 * 384 + k * 384 + n]); F.RA2[i] = f2bf(F.rwkv_a2[(size_t)l * 64 * 384 + k * 384 + n]); }
        for (int i = gt; i < NL * 12 * 8 * 512; i += NGT) { const int e = i & 7, ln_ = (i >> 3) & 63, ks = (i >> 9) & 7, nt = (i >> 12) % 12, l = i / (12 * 8 * 512);
            const int n = 32 * nt + (ln_ & 31), k = 16 * ks + 8 * (ln_ >> 5) + e;
            F.RG2[i] = f2bf(F.rwkv_g2[(size_t)l * 128 * 384 + k * 384 + n]); }
    }
    TSEC0_MARK(2);
    if (MK_TSEC0 >= 0 && F.vcu == (MK_TSEC0 >= 4 ? 192 : 0) && tid == 0) { volatile LAS unsigned long long* ts_ = (volatile LAS unsigned long long*)(F.lds + 140000); unsigned long long* slot = (unsigned long long*)((unsigned char*)F.ctl + 49152); slot[0] = ts_[0]; slot[1] = ts_[1]; slot[2] = ts_[2]; }
}

__device__ __forceinline__ void norm_mod_phase(Frame& F, const float* X, const float* gamma, const float* mod_l, int sh_idx, int sc_idx, bf16* H) {
    const int gw = F.vcu * NWAVES + F.wave, NGW = F.G * NWAVES, lane = opaque_tid() & 63;
    f32x4 g[4], nx[4];
#pragma unroll
    for (int j = 0; j < 4; ++j) g[j] = *(const f32x4*)(gamma + 4 * (lane + 64 * j));
    if (gw < M) {
#pragma unroll
        for (int j = 0; j < 4; ++j) nx[j] = ((const f32x4*)(X + (size_t)gw * DM) + lane)[64 * j];
    }
    for (int m = gw; m < M; m += NGW) {
        f32x4 v[4]; float s = 0.f;
#pragma unroll
        for (int j = 0; j < 4; ++j) { v[j] = nx[j]; s += (v[j][0] * v[j][0] + v[j][1] * v[j][1]) + (v[j][2] * v[j][2] + v[j][3] * v[j][3]); }
        if (m + NGW < M) {
#pragma unroll
            for (int j = 0; j < 4; ++j) nx[j] = ((const f32x4*)(X + (size_t)(m + NGW) * DM) + lane)[64 * j];
        }
        const float* mb = mod_l + (size_t)(m >> 12) * NMOD;
        f32x4 sc[4], sh[4];
#pragma unroll
        for (int j = 0; j < 4; ++j) { const int c = 4 * (lane + 64 * j); sc[j] = *(const f32x4*)(mb + sc_idx * DM + c); sh[j] = *(const f32x4*)(mb + sh_idx * DM + c); }
        const float rstd = __builtin_amdgcn_rsqf(wave_sum(s) * (1.f / DM) + 1e-6f);
        u32x2* o8 = (u32x2*)(H + (size_t)m * DM) + lane;
#pragma unroll
        for (int j = 0; j < 4; ++j) { const f32x4 y = (v[j] * rstd) * g[j] * (sc[j] + 1.f) + sh[j]; o8[64 * j] = pack4(y); }
    }
}
__device__ __forceinline__ void final_norm_phase(Frame& F, float* X, const float* gamma) {
    const int gw = F.vcu * NWAVES + F.wave, NGW = F.G * NWAVES, lane = opaque_tid() & 63;
    f32x4 g[4], nx[4];
#pragma unroll
    for (int j = 0; j < 4; ++j) g[j] = *(const f32x4*)(gamma + 4 * (lane + 64 * j));
    if (gw < M) {
#pragma unroll
        for (int j = 0; j < 4; ++j) nx[j] = ((const f32x4*)(X + (size_t)gw * DM) + lane)[64 * j];
    }
    for (int m = gw; m < M; m += NGW) {
        f32x4 v[4]; float s = 0.f;
#pragma unroll
        for (int j = 0; j < 4; ++j) { v[j] = nx[j]; s += (v[j][0] * v[j][0] + v[j][1] * v[j][1]) + (v[j][2] * v[j][2] + v[j][3] * v[j][3]); }
        if (m + NGW < M) {
#pragma unroll
            for (int j = 0; j < 4; ++j) nx[j] = ((const f32x4*)(X + (size_t)(m + NGW) * DM) + lane)[64 * j];
        }
        const float rstd = __builtin_amdgcn_rsqf(wave_sum(s) * (1.f / DM) + 1e-6f);
        f32x4* xr = (f32x4*)(X + (size_t)m * DM) + lane;
#pragma unroll
        for (int j = 0; j < 4; ++j) xr[64 * j] = (v[j] * rstd) * g[j];
    }
}

__device__ __forceinline__ void norm0_phase(Frame& F, const float* X, const float* gamma, const float* mod_l, int sc_idx, bf16* XS) {
    const int gw = F.vcu * NWAVES + F.wave, NGW = F.G * NWAVES, lane = opaque_tid() & 63;
    f32x4 g[4], nx[4];
#pragma unroll
    for (int j = 0; j < 4; ++j) g[j] = *(const f32x4*)(gamma + 4 * (lane + 64 * j));
    if (gw < M) {
#pragma unroll
        for (int j = 0; j < 4; ++j) nx[j] = ((const f32x4*)(X + (size_t)gw * DM) + lane)[64 * j];
    }
    for (int m = gw; m < M; m += NGW) {
        f32x4 v[4]; float s = 0.f;
#pragma unroll
        for (int j = 0; j < 4; ++j) { v[j] = nx[j]; s += (v[j][0] * v[j][0] + v[j][1] * v[j][1]) + (v[j][2] * v[j][2] + v[j][3] * v[j][3]); }
        if (m + NGW < M) {
#pragma unroll
            for (int j = 0; j < 4; ++j) nx[j] = ((const f32x4*)(X + (size_t)(m + NGW) * DM) + lane)[64 * j];
        }
        const float* mb = mod_l + (size_t)(m >> 12) * NMOD + sc_idx * DM;
        f32x4 sc[4];
#pragma unroll
        for (int j = 0; j < 4; ++j) sc[j] = *(const f32x4*)(mb + 4 * (lane + 64 * j));
        const float tot = wave_sum(s);
        u32x2* o8 = (u32x2*)(XS + (size_t)m * DM) + lane;
#pragma unroll
        for (int j = 0; j < 4; ++j) o8[64 * j] = pack4(v[j] * g[j] * (sc[j] + 1.f));
        if (lane < 4) *(f32x4*)(F.SS + (size_t)m * 16 + 4 * lane) = (f32x4){lane == 0 ? tot : 0.f, 0.f, 0.f, 0.f};
    }
}
__device__ __forceinline__ void sw_phase(Frame& F, const int lsel, const int gw, const int NGW, const int t_lo = 0, const int t_hi = PINP + DUP) {
    const int tid = opaque_tid(), lane = tid & 63;
    LAS float* shl = (LAS float*)F.lds;
    for (int i = tid; i < 2 * NB * DM / 4; i += NWAVES * 64) { const int e = 4 * i, k = e & 1023, b = (e >> 10) & 7, wh = (e >> 13) & 1;
        *(LAS f32x4*)(shl + e) = *(const f32x4*)(F.MOD + (size_t)(lsel * NB + b) * NMOD + (wh ? 3 : 0) * DM + k); }
    __syncthreads();
    const int NT = t_hi;
#define SW_ROW(t_) ({ const int l_ = lsel, r_ = (t_), wh_ = r_ >= PINP ? 1 : 0, n_ = r_ - wh_ * PINP; (wh_ ? F.WUP + ((size_t)l_ * DUP + n_) * DM : F.WIN + ((size_t)l_ * PINP + n_) * DM) + 16 * lane; })
    u32x4 nwa = (u32x4){0u, 0u, 0u, 0u}, nwb = nwa;
    if (t_lo + gw < NT) { const bf16* w_ = SW_ROW(t_lo + gw); nwa = *(const u32x4*)(w_); nwb = *(const u32x4*)(w_ + 8); }
    for (int t = t_lo + gw; t < NT; t += NGW) {
        const int l = lsel, r = t, wh = r >= PINP ? 1 : 0, n = r - wh * PINP;
        const u32x4 wa = nwa, wb = nwb;
        if (t + NGW < NT) { const bf16* w_ = SW_ROW(t + NGW); nwa = *(const u32x4*)(w_); nwb = *(const u32x4*)(w_ + 8); }
        float w[16] = {bflo(wa.x), bfhi(wa.x), bflo(wa.y), bfhi(wa.y), bflo(wa.z), bfhi(wa.z), bflo(wa.w), bfhi(wa.w), bflo(wb.x), bfhi(wb.x), bflo(wb.y), bfhi(wb.y), bflo(wb.z), bfhi(wb.z), bflo(wb.w), bfhi(wb.w)};
        float res = 0.f;
#pragma unroll
        for (int b = 0; b < NB; ++b) { const LAS float* sp = shl + (wh * NB + b) * DM + 16 * lane; float a = 0.f;
#pragma unroll
            for (int j = 0; j < 4; ++j) { const f32x4 sv = *(const LAS f32x4*)(sp + 4 * j); a += (sv[0] * w[4 * j] + sv[1] * w[4 * j + 1]) + (sv[2] * w[4 * j + 2] + sv[3] * w[4 * j + 3]); }
            a = wave_sum(a); if (lane == b) res = a; }
        if (lane < NB) { float* dst = wh ? F.SW2 + ((size_t)(l * NB + lane)) * DUP + n : F.SW1 + ((size_t)(l * NB + lane)) * PINP + n; *dst = res; }
    }
#undef SW_ROW
    __syncthreads();
}

constexpr int G1_NMAIN = 2560;
__device__ __forceinline__ void g1_tail_phase(Frame& F, const int l) {
    const int tid = opaque_tid(), lane = tid & 63, wave = F.wave, r = lane & 31, hh = lane >> 5, wr = wave >> 2, wc = wave & 3;
    const bf16* W = F.WIN + ((size_t)l * PINP + G1_NMAIN) * DM;
    LAS float* RST = (LAS float*)(F.lds + 73728);
#define GT_BAR() do { asm volatile("s_waitcnt lgkmcnt(0)" ::: "memory"); __builtin_amdgcn_s_barrier(); asm volatile("" ::: "memory"); } while (0)
    for (int t = F.vcu; t < M / 128; t += F.G) {
        const bf16* A = F.HY + (size_t)t * 128 * DM;
        const int pr0 = tid >> 3, pc8 = 8 * (tid & 7);
        u32x4 ra[3][2], rb[3][2];
#define GT_LOAD(s_, ks_) do { _Pragma("unroll") for (int j = 0; j < 2; ++j) { ra[s_][j] = *(const u32x4*)(A + (size_t)(pr0 + 64 * j) * DM + 64 * (ks_) + pc8); rb[s_][j] = *(const u32x4*)(W + (size_t)(pr0 + 64 * j) * DM + 64 * (ks_) + pc8); } } while (0)
#define GT_STORE(s_, st_) do { LAS bf16* as_ = (LAS bf16*)(F.lds + (st_) * 36864); LAS bf16* bs_ = as_ + 128 * 72; _Pragma("unroll") for (int j = 0; j < 2; ++j) { *(LAS u32x4*)(as_ + (pr0 + 64 * j) * 72 + pc8) = ra[s_][j]; *(LAS u32x4*)(bs_ + (pr0 + 64 * j) * 72 + pc8) = rb[s_][j]; } } while (0)
        GT_LOAD(0, 0); GT_LOAD(1, 1); GT_LOAD(2, 2);
        if (tid < 128) { const float* sp = F.SS + ((size_t)t * 128 + tid) * 16; const f32x4 a = *(const f32x4*)(sp), b = *(const f32x4*)(sp + 4), c = *(const f32x4*)(sp + 8), d = *(const f32x4*)(sp + 12);
            const f32x4 s4 = (a + b) + (c + d); RST[tid] = __builtin_amdgcn_rsqf(((s4[0] + s4[1]) + (s4[2] + s4[3])) * (1.f / 1024.f) + 1e-6f); }
        GT_STORE(0, 0);
        GT_BAR();
        f32x16 acc0, acc1;
#pragma unroll
        for (int i = 0; i < 16; ++i) { acc0[i] = 0.f; acc1[i] = 0.f; }
#pragma unroll
        for (int ks = 0; ks < DM / 64; ++ks) {
            const LAS bf16* as_ = (const LAS bf16*)(F.lds + (ks & 1) * 36864); const LAS bf16* bs_ = as_ + 128 * 72;
            const LAS bf16* a0p = as_ + (64 * wr + r) * 72 + 8 * hh; const LAS bf16* bp = bs_ + (32 * wc + r) * 72 + 8 * hh;
#pragma unroll
            for (int kk = 0; kk < 4; ++kk) { const bf16x8 bv = *(const LAS bf16x8*)(bp + 16 * kk);
                acc0 = __builtin_amdgcn_mfma_f32_32x32x16_bf16(*(const LAS bf16x8*)(a0p + 16 * kk), bv, acc0, 0, 0, 0);
                acc1 = __builtin_amdgcn_mfma_f32_32x32x16_bf16(*(const LAS bf16x8*)(a0p + 32 * 72 + 16 * kk), bv, acc1, 0, 0, 0); }
            if (ks + 1 < DM / 64) GT_STORE((ks + 1) % 3, (ks + 1) & 1);
            if (ks + 3 < DM / 64) GT_LOAD(ks % 3, ks + 3);
            GT_BAR();
        }
        { const float sw = F.SW1[((size_t)l * NB + (t * 128) / SEQ) * PINP + G1_NMAIN + 32 * wc + r];
          LAS bf16* OT = (LAS bf16*)F.lds;
#pragma unroll
          for (int rg = 0; rg < 16; ++rg) { const int rw = 64 * wr + (rg & 3) + 8 * (rg >> 2) + 4 * hh;
              OT[rw * 136 + 32 * wc + r] = f2bf_n(acc0[rg] * RST[rw] + sw); OT[(rw + 32) * 136 + 32 * wc + r] = f2bf_n(acc1[rg] * RST[rw + 32] + sw); }
          GT_BAR();
          bf16* Po = F.P + (size_t)t * 128 * PINP + G1_NMAIN;
#pragma unroll
          for (int j = 0; j < 4; ++j) { const int pp = tid + 512 * j, rw = pp >> 4, c8 = 8 * (pp & 15); *(u32x4*)(Po + (size_t)rw * PINP + c8) = *(const LAS u32x4*)(OT + rw * 136 + c8); }
        }
        GT_BAR();
#undef GT_LOAD
#undef GT_STORE
    }
#undef GT_BAR
}

__device__ __forceinline__ void final_scale_phase(Frame& F, const bf16* XS, float* out) {
    const int gw = F.vcu * NWAVES + F.wave, NGW = F.G * NWAVES, lane = opaque_tid() & 63;
    u32x2 nx[4]; float nss = 0.f;
#define FS_LOAD(m_) do { _Pragma("unroll") for (int j = 0; j < 4; ++j) nx[j] = ((const u32x2*)(XS + (size_t)(m_) * DM) + lane)[64 * j]; nss = F.SS[(size_t)(m_) * 16 + (lane & 15)]; } while (0)
    if (gw < M) FS_LOAD(gw);
    for (int m = gw; m < M; m += NGW) {
        u32x2 v[4];
#pragma unroll
        for (int j = 0; j < 4; ++j) v[j] = nx[j];
        const float ss = nss;
        if (m + NGW < M) FS_LOAD(m + NGW);
        const float rstd = __builtin_amdgcn_rsqf(red16(ss) * (1.f / DM) + 1e-6f);
        f32x4* o = (f32x4*)(out + (size_t)m * DM) + lane;
#pragma unroll
        for (int j = 0; j < 4; ++j) o[64 * j] = unpack4(v[j]) * rstd;
    }
#undef FS_LOAD
}

#define LDS_BAR() do { asm volatile("s_waitcnt lgkmcnt(0)" ::: "memory"); __builtin_amdgcn_s_barrier(); asm volatile("" ::: "memory"); } while (0)
template <int PARTS  >
__device__ __forceinline__ void mix_chunk(Frame& F, const int l, const int ch) {
    const int wave = F.wave;
    const int n = ch & 31; const size_t r0 = (size_t)ch * 128;
    const bf16* P = F.P; bf16* Y = F.HY;
    LAS unsigned char* lds = F.lds;
#ifndef MK_MIXDUP
#define MK_MIXDUP 0
#endif
    if (PARTS & 1) for (int mrep = 0; mrep <= ((MK_MIXDUP) & 1); ++mrep) {
        if (mrep) LDS_BAR();
        const int tid = opaque_tid(), lane = tid & 63, r = lane & 31, hh = lane >> 5;
        LAS bf16* VT = (LAS bf16*)lds;
        LAS f32x2* ST = (LAS f32x2*)(lds + 69632);
        const int t = tid & 127, q = __builtin_amdgcn_readfirstlane(tid >> 7);
        const bf16* src = P + (r0 + t) * PINP + 256 + 64 * q;
        float v[64]; float s = 0.f, ss = 0.f;
#pragma unroll
        for (int i = 0; i < 8; ++i) { const u32x4 w = *(const u32x4*)(src + 8 * i);
            const float e0 = fgelu(bflo(w.x)), e1 = fgelu(bfhi(w.x)), e2 = fgelu(bflo(w.y)), e3 = fgelu(bfhi(w.y)), e4 = fgelu(bflo(w.z)), e5 = fgelu(bfhi(w.z)), e6 = fgelu(bflo(w.w)), e7 = fgelu(bfhi(w.w));
            v[8 * i + 0] = e0; v[8 * i + 1] = e1; v[8 * i + 2] = e2; v[8 * i + 3] = e3; v[8 * i + 4] = e4; v[8 * i + 5] = e5; v[8 * i + 6] = e6; v[8 * i + 7] = e7;
            s += ((e0 + e1) + (e2 + e3)) + ((e4 + e5) + (e6 + e7)); ss += ((e0 * e0 + e1 * e1) + (e2 * e2 + e3 * e3)) + ((e4 * e4 + e5 * e5) + (e6 * e6 + e7 * e7)); }
        const int h = wave >> 1, dh = wave & 1;
        const bf16* Wg = F.SGUW + (size_t)(l * 4 + h) * 128 * 128;
        bf16x8 wn[8]; u32x2 uqn[4]; float biasn;
#pragma unroll
        for (int ks = 0; ks < 8; ++ks) wn[ks] = (bf16x8){0, 0, 0, 0, 0, 0, 0, 0};
#define A_PREF(tb_) do { const bf16* wrow_ = Wg + (size_t)(32 * (tb_) + r) * 128 + 8 * hh; _Pragma("unroll") for (int ks = 0; ks < 8; ++ks) if (ks < 2 * ((tb_) + 1)) wn[ks] = *(const bf16x8*)(wrow_ + 16 * ks); \
        const size_t row_ = r0 + 32 * (tb_) + r; biasn = F.sgu_b[(l * 4 + h) * 128 + 32 * (tb_) + r]; _Pragma("unroll") for (int g = 0; g < 4; ++g) uqn[g] = *(const u32x2*)(P + row_ * PINP + 64 * h + 32 * dh + 8 * g + 4 * hh); } while (0)
        A_PREF(0);
        ST[q * 128 + t] = (f32x2){s, ss};
        LDS_BAR();
        const f32x2 a0 = ST[t], a1 = ST[128 + t], a2 = ST[256 + t], a3 = ST[384 + t];
        const float mean = ((a0.x + a1.x) + (a2.x + a3.x)) * (1.f / 256.f), ex2 = ((a0.y + a1.y) + (a2.y + a3.y)) * (1.f / 256.f);
        const float rstd = __builtin_amdgcn_rsqf(fmaxf(ex2 - mean * mean, 0.f) + 1e-5f);
        const float* lg = F.sgu_ln_g + l * DA + 64 * q; const float* lb = F.sgu_ln_b + l * DA + 64 * q;
        {
            f32x4 gn[4], bn[4];
#pragma unroll
            for (int j = 0; j < 4; ++j) { gn[j] = *(const f32x4*)(lg + 4 * j); bn[j] = *(const f32x4*)(lb + 4 * j); }
#pragma unroll
            for (int grp = 0; grp < 4; ++grp) {
                f32x4 gc[4], bc[4];
#pragma unroll
                for (int j = 0; j < 4; ++j) { gc[j] = gn[j]; bc[j] = bn[j]; }
                if (grp < 3) {
#pragma unroll
                    for (int j = 0; j < 4; ++j) { gn[j] = *(const f32x4*)(lg + 16 * (grp + 1) + 4 * j); bn[j] = *(const f32x4*)(lb + 16 * (grp + 1) + 4 * j); } }
#pragma unroll
                for (int i = 0; i < 16; ++i) VT[(64 * q + 16 * grp + i) * 136 + t] = f2bf((v[16 * grp + i] - mean) * rstd * gc[i >> 2][i & 3] + bc[i >> 2][i & 3]);
            }
        }
        LDS_BAR();
        const LAS bf16* vrow = VT + (64 * h + 32 * dh + r) * 136 + 8 * hh;
#pragma unroll 1
        for (int tb = 0; tb < 4; ++tb) {
            bf16x8 wf[8]; u32x2 uq[4];
#pragma unroll
            for (int ks = 0; ks < 8; ++ks) wf[ks] = wn[ks];
#pragma unroll
            for (int g = 0; g < 4; ++g) uq[g] = uqn[g];
            const float bias = biasn;
            if (tb < 3) A_PREF(tb + 1);
            f32x16 acc;
#pragma unroll
            for (int i = 0; i < 16; ++i) acc[i] = 0.f;
#pragma unroll
            for (int ks = 0; ks < 8; ++ks) if (ks < 2 * (tb + 1)) {
                const bf16x8 a = *(const LAS bf16x8*)(vrow + 16 * ks);
                acc = __builtin_amdgcn_mfma_f32_32x32x16_bf16(a, wf[ks], acc, 0, 0, 0);
            }
            const int tt = 32 * tb + r; const size_t row = r0 + tt;
#pragma unroll
            for (int g = 0; g < 4; ++g) { const int c4 = 64 * h + 32 * dh + 8 * g + 4 * hh;
                const f32x4 u = unpack4(uq[g]);
                f32x4 y; y[0] = fgelu(u[0]) * (acc[4 * g + 0] + bias); y[1] = fgelu(u[1]) * (acc[4 * g + 1] + bias); y[2] = fgelu(u[2]) * (acc[4 * g + 2] + bias); y[3] = fgelu(u[3]) * (acc[4 * g + 3] + bias);
                *(u32x2*)(Y + row * DM + c4) = pack4(y); }
        }
#undef A_PREF
    }
    LDS_BAR();
    if (PARTS & 2) for (int mrep = 0; mrep <= (((MK_MIXDUP) >> 1) & 1); ++mrep) {
        if (mrep) LDS_BAR();
        const int tid = opaque_tid(), lane = tid & 63, r = lane & 31, hh = lane >> 5;
        LAS bf16* XC = (LAS bf16*)lds;
        LAS float* LA = (LAS float*)(lds + 25088);
        LAS float* BT = (LAS float*)(lds + 25088 + 49152);
        const int q = tid % 96, rs = tid / 96, c4 = 4 * q; const bool act = tid < DB;
        f32x4 cw0, cw1, cw2, cw3, cb;
        { cw0 = *(const f32x4*)(F.lru_conv_w + (l * 4 + 0) * DB + c4); cw1 = *(const f32x4*)(F.lru_conv_w + (l * 4 + 1) * DB + c4); cw2 = *(const f32x4*)(F.lru_conv_w + (l * 4 + 2) * DB + c4); cw3 = *(const f32x4*)(F.lru_conv_w + (l * 4 + 3) * DB + c4);
          cb = *(const f32x4*)(F.lru_conv_b + l * DB + c4); }
        float hst = 0.f, ca = 1.f;
        const int ln = tid & 31, rs16 = tid >> 5;
        f32x4 bra3[3], bix3[3], sp83[3];
#pragma unroll
        for (int j = 0; j < 3; ++j) { const int cj = 4 * (ln + 32 * j);
            bra3[j] = *(const f32x4*)(F.lru_b_a + l * DB + cj); bix3[j] = *(const f32x4*)(F.lru_b_x + l * DB + cj);
            const f32x4 lam = *(const f32x4*)(F.lru_lambda + l * DB + cj);
#pragma unroll
            for (int e = 0; e < 4; ++e) sp83[j][e] = -8.f * fsoftplus_acc(-lam[e]); }
        bf16x8 wB[3][4];
#pragma unroll
        for (int k = 0; k < 3; ++k) { const int id = wave + 8 * k, mat = id / 12, hb = (id % 12) >> 1, jt = id & 1;
            const bf16* Wt = (mat ? F.LRUWX : F.LRUWA) + (size_t)((l * 6 + hb) * 64 + 32 * jt + r) * 64 + 8 * hh;
#pragma unroll
            for (int ks = 0; ks < 4; ++ks) wB[k][ks] = *(const bf16x8*)(Wt + 16 * ks); }
        u32x2 raw[11];
#define B1_LOAD(tq_) do { if (act) { const bf16* src_ = P + (r0 + 32 * (tq_) + 8 * rs) * PINP + 512 + c4; const bool halo_ = (n > 0) || ((tq_) > 0) || (rs > 0); \
        _Pragma("unroll") for (int i = 0; i < 11; ++i) raw[i] = (i >= 3 || halo_) ? *(const u32x2*)(src_ + (ptrdiff_t)(i - 3) * PINP) : (u32x2){0u, 0u}; } } while (0)
        B1_LOAD(0);
        for (int tq = 0; tq < 4; ++tq) {
            u32x2 yg[2][3];
#pragma unroll
            for (int i = 0; i < 2; ++i) {
#pragma unroll
                for (int j = 0; j < 3; ++j) yg[i][j] = *(const u32x2*)(P + (r0 + 32 * tq + rs16 + 16 * i) * PINP + 896 + 4 * (ln + 32 * j)); }
            if (act) {
                f32x4 x3 = unpack4(raw[0]), x2 = unpack4(raw[1]), x1 = unpack4(raw[2]);
#pragma unroll
                for (int i = 0; i < 8; ++i) { const f32x4 x0 = unpack4(raw[3 + i]);
                    const f32x4 xc = cb + cw0 * x3 + cw1 * x2 + cw2 * x1 + cw3 * x0; x3 = x2; x2 = x1; x1 = x0;
                    *(LAS u32x2*)(XC + (8 * rs + i) * 392 + c4) = pack4(xc); }
            }
            if (tq < 3) B1_LOAD(tq + 1);
            LDS_BAR();
#pragma unroll
            for (int k = 0; k < 3; ++k) {
                const int id = wave + 8 * k, mat = id / 12, hb = (id % 12) >> 1, jt = id & 1;
                const LAS bf16* xrow = XC + r * 392 + 64 * hb + 8 * hh;
                f32x16 acc;
#pragma unroll
                for (int i = 0; i < 16; ++i) acc[i] = 0.f;
#pragma unroll
                for (int ks = 0; ks < 4; ++ks) { const bf16x8 a = *(const LAS bf16x8*)(xrow + 16 * ks);
                    acc = __builtin_amdgcn_mfma_f32_32x32x16_bf16(a, wB[k][ks], acc, 0, 0, 0); }
                LAS float* dst = (mat ? BT : LA) + 64 * hb + 32 * jt + r;
#pragma unroll
                for (int rg = 0; rg < 16; ++rg) dst[((rg & 3) + 8 * (rg >> 2) + 4 * hh) * DB] = acc[rg];
            }
            LDS_BAR();
#pragma unroll
            for (int i = 0; i < 2; ++i) { const int tl = rs16 + 16 * i;
#pragma unroll
                for (int j = 0; j < 3; ++j) { const int cj = 4 * (ln + 32 * j);
                    const f32x4 rp = *(const LAS f32x4*)(LA + tl * DB + cj) + bra3[j], ip = *(const LAS f32x4*)(BT + tl * DB + cj) + bix3[j];
                    const f32x4 xc = unpack4(*(const LAS u32x2*)(XC + tl * 392 + cj));
                    f32x4 av, bv;
#pragma unroll
                    for (int e = 0; e < 4; ++e) { const float la = sp83[j][e] * fsigmoid(rp[e]); const float a = fexp(la); av[e] = a;
                        const float x2 = 2.f * la, ser = -x2 * (1.f + x2 * (0.5f + x2 * (0.16666667f + x2 * (0.041666668f + x2 * (0.008333334f + x2 * 0.0013888889f)))));
                        const float om = x2 > -0.25f ? ser : 1.f - a * a;
                        bv[e] = __builtin_amdgcn_sqrtf(fmaxf(om, 0.f)) * (fsigmoid(ip[e]) * xc[e]); }
                    *(LAS f32x4*)(LA + tl * DB + cj) = av; *(LAS f32x4*)(BT + tl * DB + cj) = bv; } }
            LDS_BAR();
            if (act) {
#pragma unroll 8
                for (int i = 0; i < 32; ++i) { const float a = LA[i * DB + tid], bt = BT[i * DB + tid]; hst = a * hst + bt; ca *= a; LA[i * DB + tid] = hst; BT[i * DB + tid] = ca; }
            }
            LDS_BAR();
#pragma unroll
            for (int i = 0; i < 2; ++i) { const int tl = rs16 + 16 * i; const size_t row = r0 + 32 * tq + tl;
#pragma unroll
                for (int j = 0; j < 3; ++j) { const int cj = 4 * (ln + 32 * j);
                    const f32x4 h4 = *(const LAS f32x4*)(LA + tl * DB + cj), ca4 = *(const LAS f32x4*)(BT + tl * DB + cj), y4 = unpack4(yg[i][j]);
                    f32x4 gl; gl[0] = fgelu(y4[0]); gl[1] = fgelu(y4[1]); gl[2] = fgelu(y4[2]); gl[3] = fgelu(y4[3]);
                    *(u32x2*)(Y + row * DM + 256 + cj) = pack4(gl * h4); *(u32x2*)(F.Q2 + row * DB + cj) = pack4(gl * ca4); } }
        }
#undef B1_LOAD
        if (act) { F.LRUSA[(size_t)ch * DB + tid] = ca; F.LRUSH[(size_t)ch * DB + tid] = hst; }
    }
    LDS_BAR();
    if (PARTS & 4) for (int mrep = 0; mrep <= (((MK_MIXDUP) >> 2) & 1); ++mrep) {
        if (mrep) LDS_BAR();
        const int tid = opaque_tid(), lane = tid & 63, r = lane & 31, hh = lane >> 5;
        LAS bf16* TW = (LAS bf16*)lds;
        LAS bf16* XA = TW + 32 * 72;
        LAS float* LW = (LAS float*)(lds + 17920);
        LAS bf16* LAa = (LAS bf16*)(lds + 67072);
        LAS float* CT = (LAS float*)(lds + 116224);
        const float* mu = F.rwkv_mu + l * 1408;
        for (int idx = tid; idx < 8 * 96; idx += NWAVES * 64) { const int arr = idx / 96, qd = idx - 96 * arr;
            const float* srcp = arr < 3 ? mu + 384 * arr : (arr == 3 ? F.rwkv_w0 : (arr == 4 ? F.rwkv_a0 : (arr == 5 ? F.rwkv_k_k : (arr == 6 ? F.rwkv_k_a : F.rwkv_r_k)))) + l * DC;
            *(LAS f32x4*)(CT + 384 * arr + 4 * qd) = *(const f32x4*)(srcp + 4 * qd); }
        const int ln = tid & 31, rs16 = tid >> 5;
        const bf16* pc = P + PC_OFF + 1152 + 4 * lane; const f32x4 mu4 = *(const f32x4*)(mu + 1152 + 4 * lane);
        LAS bf16* c1dst = lane < 16 ? TW + 4 * lane : XA + 4 * ((lane & 31) - 16);
        const int c1stride = 72;
        u32x2 c1r[5] = {(u32x2){0u, 0u}, (u32x2){0u, 0u}, (u32x2){0u, 0u}, (u32x2){0u, 0u}, (u32x2){0u, 0u}};
#define C1_LOAD(tb_) do { if (lane < 32) { const int t0_ = 32 * (tb_) + 4 * wave; c1r[0] = (t0_ > 0 || n > 0) ? *(const u32x2*)(pc + (r0 + t0_ - 1) * PINP) : (u32x2){0u, 0u}; \
        _Pragma("unroll") for (int i = 0; i < 4; ++i) c1r[1 + i] = *(const u32x2*)(pc + (r0 + t0_ + i) * PINP); } } while (0)
        C1_LOAD(0);
        const float c1m = lane < 16 ? 2.f : 1.f;
#ifndef MK_TSEC
#define MK_TSEC -1
#endif
#define TSEC_MARK(k_) do { if (MK_TSEC >= 0 && tid == 0) { asm volatile("s_waitcnt vmcnt(0) lgkmcnt(0)" ::: "memory"); volatile LAS unsigned long long* ts_ = (volatile LAS unsigned long long*)(lds + 140000); \
        const unsigned long long t_ = __builtin_amdgcn_s_memrealtime(); if ((k_) >= 0) ts_[(k_) < 0 ? 0 : (k_)] += t_ - ts_[3]; ts_[3] = t_; } } while (0)
        for (int tb = 0; tb < 4; ++tb) {
            if (MK_TSEC >= 0 && tb > 0) C1_LOAD(tb);
            TSEC_MARK(-1);
            int lnq = ln, rsq = rs16; asm volatile("" : "+v"(lnq), "+v"(rsq));
            {
                f32x4 prev = unpack4(c1r[0]);
#pragma unroll
                for (int i = 0; i < 4; ++i) {
                    const f32x4 cur = unpack4(c1r[1 + i]);
                    const f32x4 xs = cur + (prev - cur) * mu4; prev = cur;
                    f32x4 y;
#pragma unroll
                    for (int e = 0; e < 4; ++e) { const float sg = fsigmoid(c1m * xs[e]); y[e] = lane < 16 ? 2.f * sg - 1.f : xs[e]; }
                    if (lane < 32) *(LAS u32x2*)(c1dst + (4 * wave + i) * c1stride) = pack4(y); }
            }
            LDS_BAR();
            TSEC_MARK(0);
            struct RowIn { u32x2 rc, kc, vc, rp, kp, vp; };
#define C3_LOAD(T, it_) do { const int t_ = 32 * tb + rsq + 16 * ((it_) / 3); const bf16* prow_ = P + (r0 + t_) * PINP + PC_OFF + 4 * (lnq + 32 * ((it_) % 3)); T.rc = *(const u32x2*)(prow_); T.kc = *(const u32x2*)(prow_ + 384); T.vc = *(const u32x2*)(prow_ + 768); \
        if (t_ > 0 || n > 0) { T.rp = *(const u32x2*)(prow_ - PINP); T.kp = *(const u32x2*)(prow_ - PINP + 384); T.vp = *(const u32x2*)(prow_ - PINP + 768); } else { T.rp = (u32x2){0u, 0u}; T.kp = T.rp; T.vp = T.rp; } } while (0)
            RowIn rin[3];
            {
                int wr = r, whh = hh; asm volatile("" : "+v"(wr), "+v"(whh));
                const bool lowv = wave < 4;
                const int wl = 8 * (32 * whh + wr);
                const bf16* p0 = F.RW2 + (size_t)((l * 12 + wave) * 4) * 512 + wl;
                const bf16* p1 = lowv ? F.RW2 + (size_t)((l * 12 + 8 + wave) * 4) * 512 + wl : F.RA2 + (size_t)((l * 12 + wave - 4) * 4) * 512 + wl;
                const bf16* p2 = F.RA2 + (size_t)((l * 12 + 4 + wave) * 4) * 512 + wl;
                bf16x8 w0[4], w1[4], w2[4];
#pragma unroll
                for (int ks = 0; ks < 4; ++ks) { w0[ks] = *(const bf16x8*)(p0 + 512 * ks); w1[ks] = *(const bf16x8*)(p1 + 512 * ks); w2[ks] = *(const bf16x8*)(p2 + 512 * ks); }
                C3_LOAD(rin[0], 0); C3_LOAD(rin[1], 1);
#define C2_OUT32(ACC_, dst_) do { LAS float* d = (dst_); _Pragma("unroll") for (int rg = 0; rg < 16; ++rg) d[((rg & 3) + 8 * (rg >> 2) + 4 * hh) * 384] = ACC_[rg]; } while (0)
#define C2_OUT16(ACC_, dst_) do { LAS bf16* d = (dst_); _Pragma("unroll") for (int rg = 0; rg < 16; ++rg) d[((rg & 3) + 8 * (rg >> 2) + 4 * hh) * 384] = f2bf_n(ACC_[rg]); } while (0)
#define C2_ZERO(ACC_) do { _Pragma("unroll") for (int i = 0; i < 16; ++i) ACC_[i] = 0.f; } while (0)
                f32x16 acc0, acc1, acc2;
                C2_ZERO(acc0); C2_ZERO(acc1); C2_ZERO(acc2);
                { const LAS bf16* xr = TW + r * 72 + 8 * hh;
#pragma unroll
                  for (int ks = 0; ks < 4; ++ks) acc0 = __builtin_amdgcn_mfma_f32_32x32x16_bf16(*(const LAS bf16x8*)(xr + 16 * ks), w0[ks], acc0, 0, 0, 0); }
                { const LAS bf16* xr = (lowv ? TW : XA) + r * 72 + 8 * hh;
#pragma unroll
                  for (int ks = 0; ks < 4; ++ks) acc1 = __builtin_amdgcn_mfma_f32_32x32x16_bf16(*(const LAS bf16x8*)(xr + 16 * ks), w1[ks], acc1, 0, 0, 0); }
                { const LAS bf16* xr = XA + r * 72 + 8 * hh;
#pragma unroll
                  for (int ks = 0; ks < 4; ++ks) acc2 = __builtin_amdgcn_mfma_f32_32x32x16_bf16(*(const LAS bf16x8*)(xr + 16 * ks), w2[ks], acc2, 0, 0, 0); }
                C2_OUT32(acc0, LW + 32 * wave + r);
                if (lowv) C2_OUT32(acc1, LW + 32 * (8 + wave) + r); else C2_OUT16(acc1, LAa + 32 * (wave - 4) + r);
                C2_OUT16(acc2, LAa + 32 * (4 + wave) + r);
#undef C2_OUT32
#undef C2_OUT16
#undef C2_ZERO
            }
            LDS_BAR();
            if (tid < DC) { const float w0c = F.rwkv_w0[l * DC + tid];
#pragma unroll
                for (int sg = 0; sg < 2; ++sg) { float cum = 0.f;
#pragma unroll 8
                    for (int j = 0; j < 16; ++j) { LAS float* lp = LW + (16 * sg + j) * 384 + tid; cum += -0.6065306597f * fsigmoid(w0c + *lp); *lp = cum; } } }
            LDS_BAR();
            TSEC_MARK(1);
            if (MK_TSEC < 0 && tb < 3) C1_LOAD(tb + 1);
#pragma unroll
            for (int it = 0; it < 6; ++it) {
                if (it + 2 < 6) C3_LOAD(rin[(it + 2) % 3], it + 2);
                const RowIn& T = rin[it % 3];
                const int tl = rsq + 16 * (it / 3), n4 = 4 * (lnq + 32 * (it % 3)); const size_t row = r0 + 32 * tb + tl;
                const f32x4 p_mr = *(const LAS f32x4*)(CT + n4), p_mk = *(const LAS f32x4*)(CT + 384 + n4), p_mv = *(const LAS f32x4*)(CT + 768 + n4), p_w0 = *(const LAS f32x4*)(CT + 1152 + n4),
                            p_a0 = *(const LAS f32x4*)(CT + 1536 + n4), p_kk = *(const LAS f32x4*)(CT + 1920 + n4), p_ka = *(const LAS f32x4*)(CT + 2304 + n4), p_rk = *(const LAS f32x4*)(CT + 2688 + n4);
                f32x4 rc = unpack4(T.rc), kc = unpack4(T.kc), vc = unpack4(T.vc);
                const f32x4 rp = unpack4(T.rp), kp = unpack4(T.kp), vp = unpack4(T.vp);
                rc = rc + (rp - rc) * p_mr; kc = kc + (kp - kc) * p_mk; vc = vc + (vp - vc) * p_mv;
                const f32x4 cum4 = *(const LAS f32x4*)(LW + tl * 384 + n4), la = unpack4(*(const LAS u32x2*)(LAa + tl * 384 + n4));
                f32x4 cpv = (f32x4){0.f, 0.f, 0.f, 0.f}; if (rsq > 0) cpv = *(const LAS f32x4*)(LW + (tl - 1) * 384 + n4);
                const f32x4 kr = kc * p_kk;
                const float ss = red16((kr[0] * kr[0] + kr[1] * kr[1]) + (kr[2] * kr[2] + kr[3] * kr[3]));
                const float rn = __builtin_amdgcn_rsqf(fmaxf(ss, 1e-24f));
                f32x4 km, kk4, bv4, wt4, wp4, iw4;
#pragma unroll
                for (int e = 0; e < 4; ++e) {
                    wt4[e] = fexp(cum4[e]); wp4[e] = fexp(cpv[e]); iw4[e] = __builtin_amdgcn_rcpf(wt4[e]);
                    const float a = fsigmoid(p_a0[e] + la[e]);
                    kk4[e] = kr[e] * rn; bv4[e] = kk4[e] * a;
                    km[e] = kc[e] * (1.f + (a - 1.f) * p_ka[e]); }
                { const f32x4 t4 = rc * km * p_rk; const float bon = red16((t4[0] + t4[1]) + (t4[2] + t4[3])); if ((lnq & 15) == 0) F.BON[row * 6 + (n4 >> 6)] = bon; }
                *(u32x2*)(F.R + row * DC + n4) = pack4(rc * wt4); *(u32x2*)(F.K + row * DC + n4) = pack4(km * iw4); *(u32x2*)(F.V + row * DC + n4) = pack4(vc);
                *(u32x2*)(F.KK + row * DC + n4) = pack4(kk4 * wp4); *(u32x2*)(F.BV + row * DC + n4) = pack4(bv4 * iw4);
                if (rsq == 15) *(f32x4*)((float*)F.LD + (row >> 4) * DC + n4) = wt4;
            }
#undef C3_LOAD
            TSEC_MARK(2);
        }
        if (MK_TSEC >= 0 && l == 0 && F.vcu == 0 && tid == 0) { volatile LAS unsigned long long* ts_ = (volatile LAS unsigned long long*)(lds + 140000); unsigned long long* slot = (unsigned long long*)((unsigned char*)F.ctl + 49152); slot[0] = ts_[0]; slot[1] = ts_[1]; slot[2] = ts_[2]; }
#undef C1_LOAD
    }
    LDS_BAR();
}

__device__ __forceinline__ void rwkv_scan_item(Frame& F, const int it) {
#define SC_BAR() do { asm volatile("s_waitcnt lgkmcnt(0)" ::: "memory"); __builtin_amdgcn_s_barrier(); asm volatile("" ::: "memory"); } while (0)
    const int tid = opaque_tid();
    const int b = it / 24, h = (it % 24) >> 2, qt = it & 3;
    constexpr int CS = 16;
    constexpr int RS = 68;
    constexpr int VOFF = 4 * CS * RS + RS;
    constexpr int BUFF = VOFF + CS * 16;
    constexpr int OPF = CS * 16 * 16;
    constexpr int NCK = SEQ / CS;
    LAS float* buf = (LAS float*)F.lds;
    LAS float* opart = buf + 2 * BUFF;
    const size_t base = (size_t)b * SEQ * DC + 64 * h;
    if (tid >= 256) {
        const int lt = tid - 256, st = lt >> 4, q = lt & 15, vst = lt >> 2, vq = lt & 3;
        const unsigned lo = (unsigned)(st * DC + 4 * q) * 2u, lov = (unsigned)(vst * DC + 16 * qt + 4 * vq) * 2u;
        const char* uKK = (const char*)(F.KK + base); const char* uBV = (const char*)(F.BV + base); const char* uK = (const char*)(F.K + base); const char* uR = (const char*)(F.R + base);
        const char* uW = (const char*)((const float*)F.LD + (size_t)b * (SEQ / CS) * DC + 64 * h); const char* uV = (const char*)(F.V + base);
        const int fg = lt >> 6, frow = (lt >> 2) & 15, fqd = lt & 3;
        char* uO = (char*)(F.O + base); const unsigned loo = (unsigned)(16 * qt + (4 * fg + fqd) * DC + frow) * 2u;
        const bool ldv = lt < CS * 4;
        u32x2 kk0, bv0, k0, r0, v0 = (u32x2){0u, 0u}, kk1, bv1, k1, r1, v1 = (u32x2){0u, 0u}, kk2, bv2, k2, r2, v2 = (u32x2){0u, 0u};
        f32x4 w0, w1, w2; const bool ldw = lt < 16;
#define SC_LOAD(S, ck) do { const unsigned _o = (unsigned)(ck) * (unsigned)(CS * DC * 2); unsigned _a = _o + lo; asm volatile("" : "+v"(_a));   kk##S = *(const u32x2*)(uKK + _a); bv##S = *(const u32x2*)(uBV + _a); k##S = *(const u32x2*)(uK + _a); r##S = *(const u32x2*)(uR + _a); \
        w##S = *(const f32x4*)(uW + ((unsigned)(ck) * (unsigned)(DC * 4) + 16u * (unsigned)q)); if (ldv) v##S = *(const u32x2*)(uV + (_o + lov)); } while (0)
#define SC_STORE(S, bb) do { LAS float* _b = (bb) + st * RS + 4 * q; \
        *(LAS f32x4*)(_b) = unpack4(kk##S); *(LAS f32x4*)(_b + CS * RS) = unpack4(bv##S); *(LAS f32x4*)(_b + 2 * CS * RS) = unpack4(k##S); *(LAS f32x4*)(_b + 3 * CS * RS) = unpack4(r##S); \
        if (ldw) *(LAS f32x4*)((bb) + 4 * CS * RS + 4 * lt) = w##S; \
        if (ldv) { const f32x4 vv_ = unpack4(v##S); LAS float* _v = (bb) + VOFF + (4 * vq) * CS + vst; _v[0] = vv_[0]; _v[CS] = vv_[1]; _v[2 * CS] = vv_[2]; _v[3 * CS] = vv_[3]; } } while (0)
#define SC_FLUSH(ckf) do { const LAS f32x4* pp = (const LAS f32x4*)(opart + ((ckf) & 1) * OPF + fg * 1024 + 64 * frow + 16 * fqd); \
        f32x4 sm = (pp[0] + pp[1]) + (pp[2] + pp[3]); \
        _Pragma("unroll") for (int e_ = 0; e_ < 4; ++e_) { float x_ = sm[e_]; x_ += dppf<0xB1>(x_); x_ += dppf<0x4E>(x_); sm[e_] = x_; } \
        *(bf16*)(uO + ((unsigned)(ckf) * (unsigned)(CS * DC * 2) + loo)) = f2bf(fqd == 0 ? sm[0] : (fqd == 1 ? sm[1] : (fqd == 2 ? sm[2] : sm[3]))); } while (0)
#define SC_ITER(S, c) do { if ((c) > 0) SC_FLUSH((c) - 1); if ((c) + 1 < NCK) SC_STORE(S, buf + (((c) + 1) & 1) * BUFF); if ((c) + 4 < NCK) SC_LOAD(S, (c) + 4); SC_BAR(); } while (0)
        SC_LOAD(0, 0); SC_LOAD(1, 1); SC_LOAD(2, 2); SC_STORE(0, buf); SC_LOAD(0, 3);
        SC_BAR();
        for (int ck = 0; ck < NCK; ck += 3) {
            SC_ITER(1, ck);
            if (ck + 1 < NCK) SC_ITER(2, ck + 1);
            if (ck + 2 < NCK) SC_ITER(0, ck + 2);
        }
        SC_FLUSH(NCK - 1);
#undef SC_ITER
#undef SC_LOAD
#undef SC_STORE
#undef SC_FLUSH
    } else {
        const int gl = tid & 15, row = tid >> 4;
        __builtin_amdgcn_s_setprio(3);
#define SC_READ(T, cbp, tt) do { T.kk = *(const LAS f32x4*)((cbp) + (tt) * RS + 4 * gl); T.bb = *(const LAS f32x4*)((cbp) + CS * RS + (tt) * RS + 4 * gl); \
        T.k = *(const LAS f32x4*)((cbp) + 2 * CS * RS + (tt) * RS + 4 * gl); T.r = *(const LAS f32x4*)((cbp) + 3 * CS * RS + (tt) * RS + 4 * gl); } while (0)
        struct StepIn { f32x4 kk, bb, k, r; };
        SC_BAR();
        f32x2 sA = (f32x2){0.f, 0.f}, sB = (f32x2){0.f, 0.f};
        for (int ck = 0; ck < NCK; ++ck) {
            const LAS float* cb = buf + (ck & 1) * BUFF; LAS float* op = opart + (ck & 1) * OPF;
            StepIn sin[3];
            f32x4 vr[4], oq;
#pragma unroll
            for (int j = 0; j < 4; ++j) vr[j] = *(const LAS f32x4*)(cb + VOFF + row * CS + 4 * j);
            const f32x4 w16 = *(const LAS f32x4*)(cb + 4 * CS * RS + 4 * gl);
            SC_READ(sin[0], cb, 0); SC_READ(sin[1], cb, 1);
#pragma unroll
            for (int tt = 0; tt < CS; ++tt) {
                if (tt + 2 < CS) SC_READ(sin[(tt + 2) % 3], cb, tt + 2);
                const StepIn& cur = sin[tt % 3];
                const f32x2 kkA = (f32x2){cur.kk[0], cur.kk[1]}, kkB = (f32x2){cur.kk[2], cur.kk[3]};
                f32x2 d2 = sA * kkA; d2 = sB * kkB + d2;
                const float p = red16(d2[0] + d2[1]);
                const float vv = vr[tt >> 2][tt & 3];
                sA = (f32x2){cur.k[0], cur.k[1]} * vv + sA; sB = (f32x2){cur.k[2], cur.k[3]} * vv + sB;
                sA = sA - (f32x2){cur.bb[0], cur.bb[1]} * p; sB = sB - (f32x2){cur.bb[2], cur.bb[3]} * p;
                f32x2 o2 = sA * (f32x2){cur.r[0], cur.r[1]}; o2 = sB * (f32x2){cur.r[2], cur.r[3]} + o2;
                oq[tt & 3] = o2[0] + o2[1];
                if ((tt & 3) == 3) *(LAS f32x4*)(op + (tt >> 2) * 1024 + 4 * tid) = oq;
            }
            sA = sA * (f32x2){w16[0], w16[1]}; sB = sB * (f32x2){w16[2], w16[3]};
            SC_BAR();
        }
#undef SC_READ
        __builtin_amdgcn_s_setprio(0);
    }
#undef SC_BAR
}
__device__ __forceinline__ void lru_fin_chunk(Frame& F, const int ch) {
    const int tid = opaque_tid(), b = ch >> 5, n = ch & 31;
    if (n == 0) return;
    LAS f32x4* SEG = (LAS f32x4*)F.lds;
    if (tid < 384) {
        const int q = tid % 96, sg = tid / 96;
        f32x4 av[8], hv[8];
#pragma unroll
        for (int u = 0; u < 8; ++u) { const int j = 8 * sg + u, jc = j < n ? j : 0; av[u] = *(const f32x4*)(F.LRUSA + (size_t)(b * 32 + jc) * DB + 4 * q); hv[u] = *(const f32x4*)(F.LRUSH + (size_t)(b * 32 + jc) * DB + 4 * q); }
        f32x4 A = (f32x4){1.f, 1.f, 1.f, 1.f}, H = (f32x4){0.f, 0.f, 0.f, 0.f};
#pragma unroll
        for (int u = 0; u < 8; ++u) if (8 * sg + u < n) { H = av[u] * H + hv[u]; A = A * av[u]; }
        SEG[(2 * sg + 0) * 96 + q] = A; SEG[(2 * sg + 1) * 96 + q] = H;
    }
    asm volatile("s_waitcnt lgkmcnt(0)" ::: "memory"); __builtin_amdgcn_s_barrier(); asm volatile("" ::: "memory");
    const int ln = tid & 31, rs16 = tid >> 5;
    f32x4 hin[3];
#pragma unroll
    for (int j = 0; j < 3; ++j) { const int qd = ln + 32 * j; f32x4 hcar = SEG[96 + qd];
#pragma unroll
        for (int sg = 1; sg < 4; ++sg) hcar = SEG[(2 * sg) * 96 + qd] * hcar + SEG[(2 * sg + 1) * 96 + qd];
        hin[j] = hcar; }
    bf16* Y = F.HY;
#pragma unroll 1
    for (int bt = 0; bt < 3; ++bt) {
        u32x2 a1[8], a2[8];
#pragma unroll
        for (int k = 0; k < 8; ++k) { const int it = 8 * bt + k, i = it / 3, j = it - 3 * i; const size_t row = (size_t)ch * 128 + rs16 + 16 * i; const int cj = 4 * (ln + 32 * j);
            a1[k] = *(const u32x2*)(Y + row * DM + 256 + cj); a2[k] = *(const u32x2*)(F.Q2 + row * DB + cj); }
#pragma unroll
        for (int k = 0; k < 8; ++k) { const int it = 8 * bt + k, i = it / 3, j = it - 3 * i; const size_t row = (size_t)ch * 128 + rs16 + 16 * i; const int cj = 4 * (ln + 32 * j);
            const f32x4 hj = j == 0 ? hin[0] : (j == 1 ? hin[1] : hin[2]);
            *(u32x2*)(Y + row * DM + 256 + cj) = pack4(unpack4(a1[k]) + unpack4(a2[k]) * hj); }
    }
    asm volatile("s_waitcnt lgkmcnt(0)" ::: "memory"); __builtin_amdgcn_s_barrier(); asm volatile("" ::: "memory");
}
__device__ __forceinline__ void rwkv_fin_chunk(Frame& F, const int l, const int ch) {
    const int tid = opaque_tid(), lane = tid & 63, wave = F.wave, r = lane & 31, hh = lane >> 5;
    const int n = ch & 31; const size_t r0 = (size_t)ch * 128;
    const bf16* P = F.P; bf16* Y = F.HY;
    LAS bf16* GO = (LAS bf16*)F.lds;
    LAS bf16* SGh = (LAS bf16*)(F.lds + 98304);
#define FIN_BAR() do { asm volatile("s_waitcnt lgkmcnt(0)" ::: "memory"); __builtin_amdgcn_s_barrier(); asm volatile("" ::: "memory"); } while (0)
    const int sub = lane >> 4, q = lane & 15;
    struct FinIn { u32x2 ov, v; float bon; };
#define FIN_LOAD(T, il_) do { const int ml_ = (il_) / 6, h_ = (il_) - 6 * ml_; const size_t o_ = (r0 + ml_) * DC + 64 * h_ + 4 * q; T.ov = *(const u32x2*)(F.O + o_); T.bon = F.BON[(r0 + ml_) * 6 + h_]; \
        T.v = *(const u32x2*)(F.V + o_); } while (0)
    FinIn fin[4];
    const int il0 = wave * 4 + sub;
    constexpr int NIT = (128 * 6) / (NWAVES * 4);
    const bool fin_split = !(F.vcu & 1);
    auto fin_iters = [&](const int it0, const int it1) __attribute__((always_inline)) {
#pragma unroll 4
        for (int it = it0; it < it1; ++it) {
            const int il = il0 + it * (NWAVES * 4);
            if (it + 3 < NIT) FIN_LOAD(fin[(it + 3) & 3], il + 3 * NWAVES * 4);
            const FinIn& T = fin[it & 3];
            const int ml = il / 6, h = il - 6 * ml; const int n4 = 64 * h + 4 * q; const size_t m = r0 + ml;
            const f32x4 ov = unpack4(T.ov);
            const float mean = red16((ov[0] + ov[1]) + (ov[2] + ov[3])) * (1.f / 64.f);
            const f32x4 d = ov - mean;
            const float var = red16((d[0] * d[0] + d[1] * d[1]) + (d[2] * d[2] + d[3] * d[3])) * (1.f / 64.f);
            const float rstd = __builtin_amdgcn_rsqf(var + 64e-5f);
            const f32x4 lw = *(const f32x4*)(F.rwkv_ln_w + l * DC + n4), lb = *(const f32x4*)(F.rwkv_ln_b + l * DC + n4);
            const f32x4 v4 = unpack4(T.v);
            const f32x4 g4 = unpack4(*(const LAS u32x2*)(GO + (size_t)ml * 384 + n4));
            const f32x4 y = ((d * rstd) * lw + lb + v4 * T.bon) * g4;
            __builtin_nontemporal_store(pack4(y), (u32x2*)(Y + m * DM + 640 + n4));
        }
    };
    {
        const int cq = tid & 31, rsl = tid >> 5;
        const bf16* pc = P + PC_OFF + 1152 + 128 + 4 * cq; const f32x4 mu4 = *(const f32x4*)(F.rwkv_mu + l * 1408 + 1152 + 128 + 4 * cq);
        const int wl = 8 * (32 * hh + r);
        u32x2 cur[2][4], prv[2][4];
#pragma unroll
        for (int half = 0; half < 2; ++half)
#pragma unroll
            for (int i = 0; i < 4; ++i) { const int t = 64 * half + rsl + 16 * i; cur[half][i] = *(const u32x2*)(pc + (r0 + t) * PINP); prv[half][i] = (t > 0 || n > 0) ? *(const u32x2*)(pc + (r0 + t - 1) * PINP) : (u32x2){0u, 0u}; }
        bf16x8 wf[3][8];
#pragma unroll
        for (int k = 0; k < 3; ++k) { const int u = wave + 8 * k, nt = u % 12; const bf16* wp = F.RG2 + (size_t)((l * 12 + nt) * 8) * 512 + wl;
#pragma unroll
            for (int ks = 0; ks < 8; ++ks) wf[k][ks] = *(const bf16x8*)(wp + 512 * ks); }
        FIN_LOAD(fin[0], il0); FIN_LOAD(fin[1], il0 + NWAVES * 4); FIN_LOAD(fin[2], il0 + 2 * NWAVES * 4);
#pragma unroll
        for (int half = 0; half < 2; ++half) {
#pragma unroll
            for (int i = 0; i < 4; ++i) { const f32x4 c4 = unpack4(cur[half][i]), p4 = unpack4(prv[half][i]); const f32x4 xs = c4 + (p4 - c4) * mu4;
                f32x4 y; y[0] = fsigmoid(xs[0]); y[1] = fsigmoid(xs[1]); y[2] = fsigmoid(xs[2]); y[3] = fsigmoid(xs[3]);
                *(LAS u32x2*)(SGh + (rsl + 16 * i) * 136 + 4 * cq) = pack4(y); }
            FIN_BAR();
#pragma unroll
            for (int k = 0; k < 3; ++k) { const int u = wave + 8 * k, rt = u / 12, nt = u % 12;
                f32x16 acc;
#pragma unroll
                for (int i = 0; i < 16; ++i) acc[i] = 0.f;
                const LAS bf16* xr = SGh + (32 * rt + r) * 136 + 8 * hh;
#pragma unroll
                for (int ks = 0; ks < 8; ++ks) acc = __builtin_amdgcn_mfma_f32_32x32x16_bf16(*(const LAS bf16x8*)(xr + 16 * ks), wf[k][ks], acc, 0, 0, 0);
                LAS bf16* d = GO + (size_t)(64 * half + 32 * rt) * 384 + 32 * nt + r;
#pragma unroll
                for (int rg = 0; rg < 16; ++rg) d[((rg & 3) + 8 * (rg >> 2) + 4 * hh) * 384] = f2bf_n(acc[rg]); }
            FIN_BAR();
            if (fin_split) fin_iters(12 * half, 12 * half + 12);
        }
    }
    if (!fin_split) fin_iters(0, 24);
#undef FIN_LOAD
    FIN_BAR();
#undef FIN_BAR
}
__device__ __forceinline__ void ffn_glu_phase(Frame& F, const int l) {
    constexpr int CG = DFF / 8, SEG = 32, NSEG = M / SEG;
    const int gt = F.vcu * (NWAVES * 64) + opaque_tid(), NGT = F.G * NWAVES * 64;
    for (int id = gt; id < NSEG * CG; id += NGT) {
        const int rsg = id / CG, cg8 = id - rsg * CG; const int col = 8 * cg8; const size_t row0 = (size_t)rsg * SEG;
        float w0[8], w1[8], w2[8], cb[8], x1[8], x2[8];
        { const float* cw = F.ffn_conv_w + (size_t)l * 3 * DFF + col; const float* cbp = F.ffn_conv_b + (size_t)l * DFF + col;
#pragma unroll
          for (int e = 0; e < 8; ++e) { w0[e] = cw[e]; w1[e] = cw[DFF + e]; w2[e] = cw[2 * DFF + e]; cb[e] = cbp[e]; x1[e] = 0.f; x2[e] = 0.f; } }
        if ((row0 & (SEQ - 1)) != 0) {
            const u32x4 a = *(const u32x4*)(F.UG + (row0 - 2) * DFF + col), bq = *(const u32x4*)(F.UG + (row0 - 1) * DFF + col);
            x2[0] = bflo(a.x); x2[1] = bfhi(a.x); x2[2] = bflo(a.y); x2[3] = bfhi(a.y); x2[4] = bflo(a.z); x2[5] = bfhi(a.z); x2[6] = bflo(a.w); x2[7] = bfhi(a.w);
            x1[0] = bflo(bq.x); x1[1] = bfhi(bq.x); x1[2] = bflo(bq.y); x1[3] = bfhi(bq.y); x1[4] = bflo(bq.z); x1[5] = bfhi(bq.z); x1[6] = bflo(bq.w); x1[7] = bfhi(bq.w);
        }
        u32x4 ga[4], va[4], gb[4], vb[4];
#define FF_LOAD(G_, V_, grp) do { _Pragma("unroll") for (int i_ = 0; i_ < 4; ++i_) { G_[i_] = *(const u32x4*)(F.UG + (row0 + 4 * (grp) + i_) * DFF + col); V_[i_] = *(const u32x4*)(F.UV + (row0 + 4 * (grp) + i_) * DFF + col); } } while (0)
#define FF_DO(G_, V_, grp) do { _Pragma("unroll") for (int i_ = 0; i_ < 4; ++i_) { const u32x4 gq = G_[i_], vq = V_[i_]; float x0[8], vv[8], y[8]; \
            x0[0] = bflo(gq.x); x0[1] = bfhi(gq.x); x0[2] = bflo(gq.y); x0[3] = bfhi(gq.y); x0[4] = bflo(gq.z); x0[5] = bfhi(gq.z); x0[6] = bflo(gq.w); x0[7] = bfhi(gq.w); \
            vv[0] = bflo(vq.x); vv[1] = bfhi(vq.x); vv[2] = bflo(vq.y); vv[3] = bfhi(vq.y); vv[4] = bflo(vq.z); vv[5] = bfhi(vq.z); vv[6] = bflo(vq.w); vv[7] = bfhi(vq.w); \
            _Pragma("unroll") for (int e = 0; e < 8; ++e) { const float gc = cb[e] + w0[e] * x2[e] + w1[e] * x1[e] + w2[e] * x0[e]; y[e] = fsilu(gc) * vv[e]; x2[e] = x1[e]; x1[e] = x0[e]; } \
            u32x4 o; o.x = pk2(y[0], y[1]); o.y = pk2(y[2], y[3]); o.z = pk2(y[4], y[5]); o.w = pk2(y[6], y[7]); \
            *(u32x4*)(F.UV + (row0 + 4 * (grp) + i_) * DFF + col) = o; } } while (0)
        FF_LOAD(ga, va, 0);
        for (int grp = 0; grp < SEG / 4; grp += 2) {
            FF_LOAD(gb, vb, grp + 1);
            FF_DO(ga, va, grp);
            if (grp + 2 < SEG / 4) FF_LOAD(ga, va, grp + 2);
            FF_DO(gb, vb, grp + 1);
        }
#undef FF_LOAD
#undef FF_DO
    }
}

__device__ __forceinline__ void ffn_fix_tile(Frame& F, const int l, const int pm) {
    if ((pm & 15) == 0) return;
    constexpr int C4 = DFF / 4;
    const float* cw = F.ffn_conv_w + (size_t)l * 3 * DFF; const float* cbp = F.ffn_conv_b + (size_t)l * DFF;
    for (int id = opaque_tid(); id < C4; id += NWAVES * 64) {
        const int c = 4 * id;
        const f32x4 w0 = *(const f32x4*)(cw + c), w1 = *(const f32x4*)(cw + DFF + c), w2 = *(const f32x4*)(cw + 2 * DFF + c), cb = *(const f32x4*)(cbp + c);
        const f32x4 gm2 = *(const f32x4*)(F.TG + ((size_t)(pm - 1) * 2 + 0) * DFF + c), gm1 = *(const f32x4*)(F.TG + ((size_t)(pm - 1) * 2 + 1) * DFF + c);
        const f32x4 g0 = *(const f32x4*)(F.HG + ((size_t)pm * 2 + 0) * DFF + c), g1 = *(const f32x4*)(F.HG + ((size_t)pm * 2 + 1) * DFF + c);
        const f32x4 v0 = *(const f32x4*)(F.HV + ((size_t)pm * 2 + 0) * DFF + c), v1 = *(const f32x4*)(F.HV + ((size_t)pm * 2 + 1) * DFF + c);
        f32x4 h0, h1;
#pragma unroll
        for (int e = 0; e < 4; ++e) { const float a = cb[e] + w0[e] * gm2[e] + w1[e] * gm1[e] + w2[e] * g0[e], b = cb[e] + w0[e] * gm1[e] + w1[e] * g0[e] + w2[e] * g1[e];
            h0[e] = fsilu(a) * v0[e]; h1[e] = fsilu(b) * v1[e]; }
        *(u32x2*)(F.UV + ((size_t)pm * 256 + 0) * DFF + c) = pack4(h0); *(u32x2*)(F.UV + ((size_t)pm * 256 + 1) * DFF + c) = pack4(h1);
    }
}

struct Args { const float* in[35]; float* out; unsigned char* ws; int ph_lo, ph_hi; };
__device__ __forceinline__ void frame_init(Frame& F, LAS unsigned char* lds) {
    typedef const __attribute__((address_space(4))) Args* ArgP;
    ArgP ap = (ArgP)__builtin_amdgcn_kernarg_segment_ptr(); asm volatile("" : "+s"(ap));
    F.lds = lds; F.MISC = (volatile LAS unsigned*)(lds + MISC_OFF);
    F.wave = __builtin_amdgcn_readfirstlane(threadIdx.x >> 6);
    F.G = gridDim.x; { const int bx = blockIdx.x; F.vcu = (F.G % 8 == 0) ? (bx % 8) * (F.G / 8) + bx / 8 : bx; }
    unsigned char* ws = ap->ws;
    F.ctl = (gu32*)(ws + WS_CTL);
    F.x = ap->in[0]; F.c = ap->in[1]; F.w_mod = ap->in[2]; F.b_mod = ap->in[3]; F.norm_mix = ap->in[4]; F.w_in = ap->in[5]; F.w_out = ap->in[6];
    F.sgu_ln_g = ap->in[7]; F.sgu_ln_b = ap->in[8]; F.sgu_w = ap->in[9]; F.sgu_b = ap->in[10];
    F.lru_conv_w = ap->in[11]; F.lru_conv_b = ap->in[12]; F.lru_w_a = ap->in[13]; F.lru_b_a = ap->in[14]; F.lru_w_x = ap->in[15]; F.lru_b_x = ap->in[16]; F.lru_lambda = ap->in[17];
    F.rwkv_mu = ap->in[18]; F.rwkv_w0 = ap->in[19]; F.rwkv_w2 = ap->in[20]; F.rwkv_a0 = ap->in[21]; F.rwkv_a2 = ap->in[22]; F.rwkv_g2 = ap->in[23]; F.rwkv_k_k = ap->in[24]; F.rwkv_k_a = ap->in[25];
    F.rwkv_r_k = ap->in[26]; F.rwkv_ln_w = ap->in[27]; F.rwkv_ln_b = ap->in[28]; F.norm_ffn = ap->in[29]; F.ffn_w_up = ap->in[30]; F.ffn_conv_w = ap->in[31]; F.ffn_conv_b = ap->in[32];
    F.ffn_w_down = ap->in[33]; F.norm_final = ap->in[34]; F.out = ap->out;
    F.SGUW = (bf16*)(ws + WS_SMALL + SM_SGUW); F.LRUWA = (bf16*)(ws + WS_SMALL + SM_LRUWA); F.LRUWX = (bf16*)(ws + WS_SMALL + SM_LRUWX);
    F.RW2 = (bf16*)(ws + WS_SMALL + SM_RW2); F.RA2 = (bf16*)(ws + WS_SMALL + SM_RA2); F.RG2 = (bf16*)(ws + WS_SMALL + SM_RG2);
    F.MOD = (float*)(ws + WS_MOD); F.LRUSA = (float*)(ws + WS_LRUS); F.LRUSH = F.LRUSA + 256 * DB;
    F.WIN = (bf16*)(ws + WS_WIN); F.WOUT = (bf16*)(ws + WS_WOUT); F.WUP = (bf16*)(ws + WS_WUP); F.WDN = (bf16*)(ws + WS_WDN);
    F.HY = (bf16*)(ws + WS_HY); F.P = (bf16*)(ws + WS_P); F.UG = (bf16*)(ws + WS_P); F.UV = (bf16*)(ws + WS_UV); F.O = (bf16*)(ws + WS_O);
    F.R = (bf16*)(ws + WS_R); F.K = (bf16*)(ws + WS_K); F.V = (bf16*)(ws + WS_V); F.KK = (bf16*)(ws + WS_KK); F.BV = (bf16*)(ws + WS_BV); F.LD = (bf16*)(ws + WS_LD); F.Q2 = (bf16*)(ws + WS_Q2);
    F.BON = (float*)(ws + WS_BON); F.SS = (float*)(ws + WS_SS); F.SW1 = (float*)(ws + WS_SW1); F.SW2 = (float*)(ws + WS_SW2);
    F.TG = (float*)(ws + WS_TG); F.HG = (float*)(ws + WS_HG); F.HV = (float*)(ws + WS_HV);
}
__global__ void __launch_bounds__(NWAVES * 64, 2) mk_fwd(Args args) {
    extern __shared__ __attribute__((aligned(16))) unsigned char lds_raw[];
    LAS unsigned char* const lds = (LAS unsigned char*)lds_raw;
    for (int u = threadIdx.x; u < (LDS_BYTES - LDSCTL_OFF) / 4; u += NWAVES * 64) ((LAS unsigned*)(lds + LDSCTL_OFF))[u] = 0u;
    __syncthreads();
#if MK_MODE == 2
    XcdBarrier bar = xcd_barrier_post((unsigned*)((gu32*)(args.ws + WS_CTL) + CW_BAR), (volatile LAS unsigned*)(lds + MISC_OFF) + 8);
#define GRID_BAR() xcd_barrier(bar)
#elif MK_MODE == 1
    cg::grid_group grid = cg::this_grid();
#define GRID_BAR() grid.sync()
#else
#define GRID_BAR() do { } while (0)
#endif
    const int lo = args.ph_lo, hi = args.ph_hi;
#define IN(k) (lo <= (k) && (k) < hi)
#ifndef MK_PHMASK
#define MK_PHMASK 0xFFF
#endif
#define EN(t) (((MK_PHMASK) >> (t)) & 1)
#ifndef MK_DUPMASK
#define MK_DUPMASK 0
#endif
#define REP2(t) (((MK_DUPMASK) >> (t)) & 1)
#define SEAM(k) do { if (IN(k) && IN((k) + 1)) GRID_BAR(); } while (0)
#define PH_BEGIN(t, k) if (EN(t) && IN(k)) { for (int rep = 0; rep <= REP2(t); ++rep) { if (rep) GRID_BAR(); Frame F; frame_init(F, lds); \
        const float* mod_l = F.MOD + (size_t)l * NB * NMOD; const float* Xin = (l == 0) ? F.x : F.out; (void)mod_l; (void)Xin;
#ifndef MK_STAMP_PHASE
#define MK_STAMP_PHASE -1
#endif
#define STAMP(k) do { if (MK_STAMP_PHASE >= 0 && blockIdx.x == 0 && threadIdx.x == 0) { ((unsigned long long*)(args.ws + WS_CTL + 32768))[k] = __builtin_amdgcn_s_memrealtime(); } } while (0)
#define PH_END(k) } } SEAM(k); STAMP((k) + 1);

#ifndef MK_SHADOW_PROBE
#define MK_SHADOW_PROBE 0
#endif
#ifndef MK_PROBE_LAYER
#define MK_PROBE_LAYER 0
#endif
#define SHSTAMP(k) do { if (MK_SHADOW_PROBE == 1 && l == MK_PROBE_LAYER && F.vcu == 192 && threadIdx.x == 0) { asm volatile("s_waitcnt vmcnt(0) lgkmcnt(0)" ::: "memory"); ((unsigned long long*)(args.ws + WS_CTL + 40960))[k] = __builtin_amdgcn_s_memrealtime(); } } while (0)
#define SCSTAMP(k) do { if (MK_SHADOW_PROBE == 2 && l == MK_PROBE_LAYER && F.vcu == 0 && threadIdx.x == 0) { asm volatile("s_waitcnt vmcnt(0) lgkmcnt(0)" ::: "memory"); ((unsigned long long*)(args.ws + WS_CTL + 40960))[k] = __builtin_amdgcn_s_memrealtime(); } } while (0)
    STAMP(0);
    { const int l = 0; PH_BEGIN(0, 0) p0_prologue(F); PH_END(0) }
    for (int l = 0; l < NL; ++l) {
        const int pb = 1 + 10 * l;
        if (l == 0) { PH_BEGIN(1, pb + 0)
            if (F.vcu & 1) { norm0_phase(F, F.x, F.norm_mix, mod_l, 1, F.HY); __syncthreads(); sw_phase(F, 0, F.vcu * NWAVES + F.wave, F.G * NWAVES); }
            else { sw_phase(F, 0, F.vcu * NWAVES + F.wave, F.G * NWAVES); norm0_phase(F, F.x, F.norm_mix, mod_l, 1, F.HY); } PH_END(pb + 0) } else STAMP(pb + 1);
        PH_BEGIN(2, pb + 1) pg8::Gemm g{F.HY, F.WIN + (size_t)l * PINP * DM, M, G1_NMAIN, DM}; pg8::StaticOrder S; S.init(M, G1_NMAIN, F.G, (int)blockIdx.x);
            pg8::EpiBf16N E{F.P, PINP, F.SS, F.SW1 + (size_t)l * NB * PINP, PINP, SEQ};
            if (F.vcu & 1) { g1_tail_phase(F, l); __syncthreads(); }
            pg8::gemm_phase<pg8::EpiBf16N, pg8::StaticOrder, true, true>(F.lds, g, S, E);
            if (!(F.vcu & 1)) { __syncthreads(); g1_tail_phase(F, l); }
            PH_END(pb + 1)
        PH_BEGIN(3, pb + 2) for (int ch = F.vcu; ch < M / 128; ch += F.G) mix_chunk<4>(F, l, ch); PH_END(pb + 2)
        PH_BEGIN(4, pb + 3)
            if (F.G >= 256) { if (F.vcu < 192) { SCSTAMP(2); rwkv_scan_item(F, F.vcu); SCSTAMP(3); } else if (rep == 0) { SHSTAMP(0); for (int ch = F.vcu - 192; ch < M / 128; ch += F.G - 192) mix_chunk<3>(F, l, ch);
                asm volatile("s_waitcnt vmcnt(0)" ::: "memory"); __syncthreads();
                if (threadIdx.x == 0) { unsigned* cnt = (unsigned*)(F.ctl + CW_SHAD + 64 * l); unsigned* tmo = (unsigned*)(F.ctl + CW_BAR);
                    __builtin_amdgcn_fence(__ATOMIC_RELEASE, "agent"); asm volatile("s_waitcnt vmcnt(0)" ::: "memory");
                    (void)xb_add(cnt, 1u); XB_SPIN(xb_ld(cnt) < (unsigned)(F.G - 192), tmo);
                    __builtin_amdgcn_fence(__ATOMIC_ACQUIRE, "agent"); asm volatile("s_waitcnt vmcnt(0)" ::: "memory"); }
                __syncthreads();
                for (int ch = F.vcu - 192; ch < M / 128; ch += F.G - 192) lru_fin_chunk(F, ch);
                if (l + 1 < NL) { __syncthreads(); sw_phase(F, l + 1, (F.vcu - 192) * NWAVES + F.wave, (F.G - 192) * NWAVES, 0, PINP); }
                if (l > 0) { __syncthreads(); sw_phase(F, l, (F.vcu - 192) * NWAVES + F.wave, (F.G - 192) * NWAVES, PINP, PINP + DUP); }
                SHSTAMP(1); } }
            else { for (int it = F.vcu; it < 192; it += F.G) { rwkv_scan_item(F, it); __syncthreads(); } if (rep == 0) { for (int ch = F.vcu; ch < M / 128; ch += F.G) mix_chunk<3>(F, l, ch); if (l + 1 < NL) { __syncthreads(); sw_phase(F, l + 1, F.vcu * NWAVES + F.wave, F.G * NWAVES); } } }
        PH_END(pb + 3)
        PH_BEGIN(5, pb + 4) if (F.G < 256) for (int ch = F.vcu; ch < M / 128; ch += F.G) lru_fin_chunk(F, ch); for (int ch = F.vcu; ch < M / 128; ch += F.G) rwkv_fin_chunk(F, l, ch); PH_END(pb + 4)
        PH_BEGIN(6, pb + 5) pg8::Gemm g{F.HY, F.WOUT + (size_t)l * DM * DM, M, DM, DM}; pg8::StaticOrder S; S.init(M, DM, F.G, (int)blockIdx.x);
            if (l == 0) { pg8::EpiResNormT<false> E{F.x, (bf16*)F.out, DM, mod_l + 2 * DM, NMOD, SEQ, F.P, F.norm_ffn + l * DM, mod_l + 4 * DM, F.SS};
                pg8::gemm_phase<pg8::EpiResNormT<false>, pg8::StaticOrder, true, true>(F.lds, g, S, E); }
            else { pg8::EpiResNormT<true> E{F.out, (bf16*)F.out, DM, mod_l + 2 * DM, NMOD, SEQ, F.P, F.norm_ffn + l * DM, mod_l + 4 * DM, F.SS};
                pg8::gemm_phase<pg8::EpiResNormT<true>, pg8::StaticOrder, true, true>(F.lds, g, S, E); } PH_END(pb + 5)
        STAMP(pb + 7);
        PH_BEGIN(8, pb + 7) pg8::Gemm g{F.P, F.WUP + (size_t)l * DUP * DM, M, DUP, DM}; pg8::StaticOrder S; S.init(M, DUP, F.G, (int)blockIdx.x);
            pg8::EpiGLU E{F.UV, DFF, F.ffn_conv_w + (size_t)l * 3 * DFF, F.ffn_conv_b + (size_t)l * DFF, F.TG, F.HG, F.HV, (LAS float*)(F.lds + TAIL_OFF), F.SS, F.SW2 + (size_t)l * NB * DUP, DUP, SEQ};
            pg8::gemm_phase<pg8::EpiGLU, pg8::StaticOrder, true, true>(F.lds, g, S, E); PH_END(pb + 7)
        STAMP(pb + 9);
        if (EN(10) && IN(pb + 9)) { Frame F; frame_init(F, lds); pg8::StaticOrder S; S.init(M, DM, F.G, (int)blockIdx.x); pg8::Unit fu;
#pragma unroll 1
            for (int i = 0; S.next(i, fu); ++i) ffn_fix_tile(F, l, fu.pm);
            asm volatile("s_waitcnt vmcnt(0)" ::: "memory"); __syncthreads(); }
        PH_BEGIN(10, pb + 9) pg8::Gemm g{F.UV, F.WDN + (size_t)l * DM * DFF, M, DM, DFF}; pg8::StaticOrder S; S.init(M, DM, F.G, (int)blockIdx.x);
            if (l + 1 < NL) { pg8::EpiResNormT<true> E{F.out, (bf16*)F.out, DM, mod_l + 5 * DM, NMOD, SEQ, F.HY, F.norm_mix + (l + 1) * DM, mod_l + (size_t)NB * NMOD + 1 * DM, F.SS};
                pg8::gemm_phase<pg8::EpiResNormT<true>, pg8::StaticOrder, true, true>(F.lds, g, S, E); }
            else { pg8::EpiResNormT<true> E{F.out, nullptr, DM, mod_l + 5 * DM, NMOD, SEQ, F.HY, F.norm_final, nullptr, F.SS};
                pg8::gemm_phase<pg8::EpiResNormT<true>, pg8::StaticOrder, true, true>(F.lds, g, S, E); } PH_END(pb + 9)
    }
    { const int l = 0; PH_BEGIN(11, NPHASE - 1) final_scale_phase(F, F.HY, F.out); PH_END(NPHASE - 1) }
    if (MK_STAMP_PHASE >= 0 && blockIdx.x == 0 && threadIdx.x == 0) { asm volatile("s_waitcnt vmcnt(0) lgkmcnt(0)" ::: "memory");
        const volatile unsigned long long* st = (const volatile unsigned long long*)(args.ws + WS_CTL + 32768);
        const unsigned long long d = (st[MK_STAMP_PHASE + 1] - st[MK_STAMP_PHASE]) * 10ull, r0 = __builtin_amdgcn_s_memrealtime();
        while (__builtin_amdgcn_s_memrealtime() - r0 < d) __builtin_amdgcn_s_sleep(8); }
    if (MK_SHADOW_PROBE == 2 && blockIdx.x == 0 && threadIdx.x == 0) { asm volatile("s_waitcnt vmcnt(0) lgkmcnt(0)" ::: "memory");
        const volatile unsigned long long* st = (const volatile unsigned long long*)(args.ws + WS_CTL + 40960);
        const unsigned long long d = (st[3] - st[2]) * 10ull, r0 = __builtin_amdgcn_s_memrealtime();
        while (__builtin_amdgcn_s_memrealtime() - r0 < d) __builtin_amdgcn_s_sleep(8); }
    if (MK_SHADOW_PROBE == 1 && blockIdx.x == 6 && threadIdx.x == 0) { asm volatile("s_waitcnt vmcnt(0) lgkmcnt(0)" ::: "memory");
        const volatile unsigned long long* st = (const volatile unsigned long long*)(args.ws + WS_CTL + 40960);
        const unsigned long long d = (st[1] - st[0]) * 10ull, r0 = __builtin_amdgcn_s_memrealtime();
        while (__builtin_amdgcn_s_memrealtime() - r0 < d) __builtin_amdgcn_s_sleep(8); }
#if defined(MK_TSEC0)
    if (MK_TSEC0 >= 0 && blockIdx.x == 0 && opaque_tid() == 0) { asm volatile("s_waitcnt vmcnt(0) lgkmcnt(0)" ::: "memory");
        const volatile unsigned long long* st = (const volatile unsigned long long*)(args.ws + WS_CTL + 49152);
        const unsigned long long d = st[MK_TSEC0 & 3] * 10ull, r0 = __builtin_amdgcn_s_memrealtime();
        while (__builtin_amdgcn_s_memrealtime() - r0 < d) __builtin_amdgcn_s_sleep(8); }
#endif
#ifdef MK_TSEC
    if (MK_TSEC >= 0 && blockIdx.x == 0 && opaque_tid() == 0) { asm volatile("s_waitcnt vmcnt(0) lgkmcnt(0)" ::: "memory");
        const volatile unsigned long long* st = (const volatile unsigned long long*)(args.ws + WS_CTL + 49152);
        const unsigned long long d = st[MK_TSEC] * 10ull, r0 = __builtin_amdgcn_s_memrealtime();
        while (__builtin_amdgcn_s_memrealtime() - r0 < d) __builtin_amdgcn_s_sleep(8); }
#endif
#undef IN
#undef SEAM
}

extern "C" void kernel_launch(void* const* d_in, const int* in_sizes, int n_in, void* d_out, int out_size, void* d_ws, size_t ws_size, hipStream_t stream) {
    static int grid = 0;
    if (grid == 0) {
        if (n_in != 35 || in_sizes[0] != M * DM || out_size != M * DM || ws_size < WS_END) { fprintf(stderr, "kernel_launch: unexpected shapes (n_in %d, in0 %d, out %d, ws %zu); nothing launched\n", n_in, n_in > 0 ? in_sizes[0] : -1, out_size, ws_size); grid = -1; return; }
        int dev = 0, cus = 0, per_cu = 0;
        if (hipGetDevice(&dev) != hipSuccess || hipDeviceGetAttribute(&cus, hipDeviceAttributeMultiprocessorCount, dev) != hipSuccess) { grid = -1; return; }
        if (hipFuncSetAttribute((const void*)mk_fwd, hipFuncAttributeMaxDynamicSharedMemorySize, LDS_BYTES) != hipSuccess) { fprintf(stderr, "kernel_launch: hipFuncSetAttribute failed\n"); grid = -1; return; }
        if (hipOccupancyMaxActiveBlocksPerMultiprocessor(&per_cu, (const void*)mk_fwd, NWAVES * 64, LDS_BYTES) != hipSuccess || per_cu < 1) { fprintf(stderr, "kernel_launch: occupancy query says %d blocks per CU\n", per_cu); per_cu = 1; }
        (void)hipGetLastError();
        grid = cus;
    }
    if (grid < 0) return;
    Args a{};
    for (int i = 0; i < 35; ++i) a.in[i] = (const float*)d_in[i];
    a.out = (float*)d_out; a.ws = (unsigned char*)d_ws;
#if MK_MODE == 0
    for (int ph = 0; ph < NPHASE; ++ph) { a.ph_lo = ph; a.ph_hi = ph + 1; hipLaunchKernelGGL(mk_fwd, dim3(grid), dim3(NWAVES * 64), LDS_BYTES, stream, a); }
#else
    (void)hipMemsetAsync((char*)d_ws + WS_CTL, 0, CTL_ZERO_BYTES, stream);
    a.ph_lo = 0; a.ph_hi = NPHASE;
#if MK_MODE == 1
    void* kargs[] = {&a};
    hipError_t e = hipLaunchCooperativeKernel((const void*)mk_fwd, dim3(grid), dim3(NWAVES * 64), kargs, LDS_BYTES, stream);
    if (e != hipSuccess) fprintf(stderr, "kernel_launch: cooperative launch failed: %s (grid %d)\n", hipGetErrorString(e), grid);
#else
    hipLaunchKernelGGL(mk_fwd, dim3(grid), dim3(NWAVES * 64), LDS_BYTES, stream, a);
#endif
#endif
}
```
